# Optimizing an MI355X kernel written in HIP

```python
import math
import jax, jax.numpy as jnp
from jax import lax
import numpy as np

D_MODEL = 1024
BATCH = 16
SEQ = 256
DEPTH = 2
DEC_BATCH = 4
DEC_SEQ = 1024
PAST_LEN = 512

GRID_W = 64
N_EVEN = (DEPTH + 1) // 2
N_ODD = DEPTH // 2
S5_WIDTH = D_MODEL // 2
S5_GROUP_CH = 16
S5_GROUPS = S5_WIDTH // S5_GROUP_CH
S5_STATE = 64
GLA_HEADS = 4
GLA_VW = D_MODEL // 2
GLA_DV = GLA_VW // GLA_HEADS
GLA_DK = GLA_DV // 2
GLA_QK = GLA_HEADS * GLA_DK
GLA_RANK = 16
GLA_TAU = 16.0
GLA_CHUNK = 64
IN_EVEN = S5_WIDTH + 2 * GLA_QK + 2 * GLA_VW + 2 * GLA_RANK
MIX_EVEN = S5_WIDTH + GLA_VW
HEAD_DIM = 128
N_HEADS = D_MODEL // HEAD_DIM
KV_HEADS = 2
QKV_W = (N_HEADS + 2 * KV_HEADS) * HEAD_DIM
Q_BLOCK = 128
AXIS_DIM = HEAD_DIM // 2
ROPE_THETA = 10000.0
D_FF = 4 * D_MODEL
EPS = 1e-6

kernel_name = "hybrid_s5_gla_gqa_context_prefix_step"


def rms_norm(x, g):
    xf = x.astype(jnp.float32)
    y = xf * lax.rsqrt(jnp.mean(xf * xf, axis=-1, keepdims=True) + EPS)
    return (y * g.astype(jnp.float32)).astype(x.dtype)


def ada_mod(cond, w, b):
    m = jax.nn.silu(cond) @ w + b
    return jnp.split(m[:, None, :], 6, axis=-1)


def modulate(h, shift, scale):
    return h * (1 + scale) + shift


def _lin_rec(e1, e2):
    a1, b1 = e1
    a2, b2 = e2
    return a1 * a2, a2 * b1 + b2


def s5_bidir(u, h0_re, h0_im, lam_re, lam_im, log_dt, b_re, b_im, c_re, c_im, d_skip, w_glu, b_glu):
    f32 = jnp.float32
    B, L, _ = u.shape
    uf = u.astype(f32).reshape(B, L, S5_GROUPS, S5_GROUP_CH)
    uc = uf.astype(jnp.complex64)
    Bm = lax.complex(b_re.astype(f32), b_im.astype(f32))
    Cm = lax.complex(c_re.astype(f32), c_im.astype(f32))
    y = uf * d_skip.astype(f32).reshape(S5_GROUPS, S5_GROUP_CH)
    fin_re, fin_im = [], []
    for d, rev in ((0, False), (1, True)):
        lam = lax.complex(lam_re[d].astype(f32), lam_im[d].astype(f32))
        dt = jnp.exp(log_dt[d].astype(f32))[:, None]
        lam_bar = jnp.exp(lam * dt)
        b_bar = ((lam_bar - 1.0) / lam)[..., None] * Bm
        bu = jnp.einsum('blgc,gpc->blgp', uc, b_bar)
        h0 = lax.complex(h0_re[:, d].astype(f32), h0_im[:, d].astype(f32))
        edge = L - 1 if rev else 0
        bu = bu.at[:, edge].add(lam_bar * h0)
        a = jnp.broadcast_to(lam_bar, bu.shape)
        _, hs = lax.associative_scan(_lin_rec, (a, bu), reverse=rev, axis=1)
        fin = hs[:, edge]
        fin_re.append(jnp.real(fin))
        fin_im.append(jnp.imag(fin))
        y = y + jnp.real(jnp.einsum('blgp,gcp->blgc', hs, Cm))
    g = jax.nn.gelu(y.reshape(B, L, S5_WIDTH))
    out = g * jax.nn.sigmoid(g @ w_glu.astype(f32) + b_glu.astype(f32))
    return out.astype(u.dtype), jnp.stack(fin_re, axis=1), jnp.stack(fin_im, axis=1)


def gla_chunked(q, k, v, g, s0):
    B, L, H, K = q.shape
    n = L // GLA_CHUNK

    def to_chunks(t):
        return jnp.moveaxis(t.reshape(B, n, GLA_CHUNK, H, t.shape[-1]), 1, 0)

    mask = jnp.tril(jnp.ones((GLA_CHUNK, GLA_CHUNK), dtype=bool))

    def step(S, inp):
        qc, kc, vc, gc = inp
        b = jnp.cumsum(gc, axis=1)
        b_last = b[:, -1]
        qd = qc * jnp.exp(b)
        kd = kc * jnp.exp(-b)
        att = jnp.where(mask, jnp.einsum('bthk,bshk->bhts', qd, kd), 0.0)
        o = jnp.einsum('bthk,bhkv->bthv', qd, S) + jnp.einsum('bhts,bshv->bthv', att, vc)
        S = S * jnp.exp(b_last)[..., None] + jnp.einsum('bshk,bshv->bhkv', kc * jnp.exp(b_last[:, None] - b), vc)
        return S, o

    S, o = lax.scan(step, s0, (to_chunks(q), to_chunks(k), to_chunks(v), to_chunks(g)))
    o = jnp.moveaxis(o, 0, 1).reshape(B, L, H, v.shape[-1])
    return o, S


def gla_bidir(q, k, v, r, glr, s0, w_gate2, b_gate, gla_norm):
    f32 = jnp.float32
    B, L, _ = q.shape
    qf = q.astype(f32).reshape(B, L, GLA_HEADS, GLA_DK) * (GLA_DK ** -0.5)
    kf = k.astype(f32).reshape(B, L, GLA_HEADS, GLA_DK)
    vf = v.astype(f32).reshape(B, L, GLA_HEADS, GLA_DV)
    glr = glr.astype(f32).reshape(B, L, 2, GLA_RANK)
    o_sum = jnp.zeros((B, L, GLA_HEADS, GLA_DV), f32)
    finals = []
    for d in (0, 1):
        gd = jax.nn.log_sigmoid(glr[:, :, d] @ w_gate2[d].astype(f32) + b_gate[d].astype(f32))
        gd = gd.reshape(B, L, GLA_HEADS, GLA_DK) / GLA_TAU
        if d == 0:
            od, sd = gla_chunked(qf, kf, vf, gd, s0[:, d].astype(f32))
        else:
            od, sd = gla_chunked(jnp.flip(qf, 1), jnp.flip(kf, 1), jnp.flip(vf, 1), jnp.flip(gd, 1), s0[:, d].astype(f32))
            od = jnp.flip(od, 1)
        o_sum = o_sum + od
        finals.append(sd)
    o = rms_norm(o_sum, gla_norm) * jax.nn.silu(r.astype(f32)).reshape(B, L, GLA_HEADS, GLA_DV)
    return o.reshape(B, L, GLA_VW).astype(q.dtype), jnp.stack(finals, axis=1)


def even_mixer(h, h0_re, h0_im, gla_s0, w_in, w_out, lam_re, lam_im, log_dt, b_re, b_im, c_re, c_im,
               d_skip, w_glu, b_glu, w_gate2, b_gate, gla_norm):
    z = h @ w_in
    cuts = np.cumsum([S5_WIDTH, GLA_QK, GLA_QK, GLA_VW, GLA_VW]).tolist()
    u, q, k, v, r, glr = jnp.split(z, cuts, axis=-1)
    s5_out, s5_re, s5_im = s5_bidir(u, h0_re, h0_im, lam_re, lam_im, log_dt, b_re, b_im, c_re, c_im,
                                    d_skip, w_glu, b_glu)
    gla_out, gla_fin = gla_bidir(q, k, v, r, glr, gla_s0, w_gate2, b_gate, gla_norm)
    out = jnp.concatenate([s5_out, gla_out.astype(s5_out.dtype)], axis=-1) @ w_out
    return out, s5_re, s5_im, gla_fin


def attn_project(h, w_qkv, q_norm, k_norm):
    B, L, _ = h.shape
    z = h @ w_qkv
    q, k, v = jnp.split(z, [N_HEADS * HEAD_DIM, (N_HEADS + KV_HEADS) * HEAD_DIM], axis=-1)
    q = rms_norm(q.reshape(B, L, N_HEADS, HEAD_DIM), q_norm)
    k = rms_norm(k.reshape(B, L, KV_HEADS, HEAD_DIM), k_norm)
    v = v.reshape(B, L, KV_HEADS, HEAD_DIM)
    return q, k, v


def grid_rope(L):
    rows = L // GRID_W
    row = jnp.repeat(jnp.arange(rows, dtype=jnp.float32), GRID_W)
    col = jnp.tile(jnp.arange(GRID_W, dtype=jnp.float32), rows)
    inv = ROPE_THETA ** (-jnp.arange(0, AXIS_DIM, 2, dtype=jnp.float32) / AXIS_DIM)
    ang = jnp.concatenate([row[:, None] * inv, col[:, None] * inv], axis=-1)
    return jnp.cos(ang), jnp.sin(ang)


def apply_rope(x, cos, sin):
    xf = x.astype(jnp.float32).reshape(*x.shape[:-1], HEAD_DIM // 2, 2)
    x1, x2 = xf[..., 0], xf[..., 1]
    c = cos[None, :, None, :]
    s = sin[None, :, None, :]
    out = jnp.stack([x1 * c - x2 * s, x1 * s + x2 * c], axis=-1)
    return out.reshape(x.shape).astype(x.dtype)


def attend(q, k, v):
    B, Lq, H, Dh = q.shape
    rep = H // KV_HEADS
    nb = Lq // Q_BLOCK
    qb = jnp.moveaxis(q.reshape(B, nb, Q_BLOCK, KV_HEADS, rep, Dh), 1, 0)
    scale = Dh ** -0.5

    def block(qc):
        s = jnp.einsum('bqgrd,bkgd->bgrqk', qc, k).astype(jnp.float32) * scale
        p = jax.nn.softmax(s, axis=-1).astype(v.dtype)
        return jnp.einsum('bgrqk,bkgd->bqgrd', p, v)

    o = lax.map(block, qb)
    return jnp.moveaxis(o, 0, 1).reshape(B, Lq, H * Dh)


def sq_relu_mlp(h, w1, w2):
    return jnp.square(jax.nn.relu(h @ w1)) @ w2


def setup_inputs(seed: int = 0) -> dict:
    key = jax.random.key(seed)
    ks = iter(jax.random.split(key, 48))
    f32 = jnp.float32

    def nrm(shape, scale=1.0):
        return jax.random.normal(next(ks), shape, f32) * scale

    lam_im_base = jnp.pi * jnp.arange(S5_STATE, dtype=f32)
    return {
        "x_prompt": nrm((BATCH, SEQ, D_MODEL)),
        "x_sample": nrm((DEC_BATCH, DEC_SEQ, D_MODEL)),
        "state_s5_re": nrm((DEC_BATCH, N_EVEN, 2, S5_GROUPS, S5_STATE), 0.1),
        "state_s5_im": nrm((DEC_BATCH, N_EVEN, 2, S5_GROUPS, S5_STATE), 0.1),
        "state_gla": nrm((DEC_BATCH, N_EVEN, 2, GLA_HEADS, GLA_DK, GLA_DV), 0.1),
        "cache_k": nrm((DEC_BATCH, N_ODD, PAST_LEN, KV_HEADS, HEAD_DIM)),
        "cache_v": nrm((DEC_BATCH, N_ODD, PAST_LEN, KV_HEADS, HEAD_DIM)),
        "c": nrm((DEC_BATCH, D_MODEL)),
        "c_ctx": nrm((D_MODEL,)),
        "norm_mix": 1.0 + nrm((DEPTH, D_MODEL), 0.01),
        "norm_mlp": 1.0 + nrm((DEPTH, D_MODEL), 0.01),
        "w_ada": nrm((DEPTH, D_MODEL, 6 * D_MODEL), 0.5 * D_MODEL ** -0.5),
        "b_ada": nrm((DEPTH, 6 * D_MODEL), 0.01),
        "w_mlp_in": nrm((DEPTH, D_MODEL, D_FF), D_MODEL ** -0.5),
        "w_mlp_out": nrm((DEPTH, D_FF, D_MODEL), D_FF ** -0.5),
        "w_in_e": nrm((N_EVEN, D_MODEL, IN_EVEN), D_MODEL ** -0.5),
        "w_out_e": nrm((N_EVEN, MIX_EVEN, D_MODEL), MIX_EVEN ** -0.5),
        "s5_lambda_re": -0.5 + nrm((N_EVEN, 2, S5_GROUPS, S5_STATE), 0.01),
        "s5_lambda_im": lam_im_base + nrm((N_EVEN, 2, S5_GROUPS, S5_STATE), 0.01),
        "s5_log_dt": jax.random.uniform(next(ks), (N_EVEN, 2, S5_GROUPS), f32,
                                        minval=math.log(1e-3), maxval=math.log(1e-1)),
        "s5_b_re": nrm((N_EVEN, S5_GROUPS, S5_STATE, S5_GROUP_CH), (2 * S5_GROUP_CH) ** -0.5),
        "s5_b_im": nrm((N_EVEN, S5_GROUPS, S5_STATE, S5_GROUP_CH), (2 * S5_GROUP_CH) ** -0.5),
        "s5_c_re": nrm((N_EVEN, S5_GROUPS, S5_GROUP_CH, S5_STATE), 0.5 ** 0.5),
        "s5_c_im": nrm((N_EVEN, S5_GROUPS, S5_GROUP_CH, S5_STATE), 0.5 ** 0.5),
        "s5_d": nrm((N_EVEN, S5_WIDTH)),
        "s5_w_glu": nrm((N_EVEN, S5_WIDTH, S5_WIDTH), S5_WIDTH ** -0.5),
        "s5_b_glu": nrm((N_EVEN, S5_WIDTH), 0.01),
        "gla_w_gate2": nrm((N_EVEN, 2, GLA_RANK, GLA_QK), GLA_RANK ** -0.5),
        "gla_b_gate": nrm((N_EVEN, 2, GLA_QK), 0.01),
        "gla_norm": 1.0 + nrm((N_EVEN, GLA_DV), 0.01),
        "w_qkv_o": nrm((N_ODD, D_MODEL, QKV_W), D_MODEL ** -0.5),
        "w_o_o": nrm((N_ODD, N_HEADS * HEAD_DIM, D_MODEL), (N_HEADS * HEAD_DIM) ** -0.5),
        "q_norm": 1.0 + nrm((N_ODD, HEAD_DIM), 0.01),
        "k_norm": 1.0 + nrm((N_ODD, HEAD_DIM), 0.01),
    }


def reference(x_prompt, x_sample, state_s5_re, state_s5_im, state_gla, cache_k, cache_v, c, c_ctx,
              norm_mix, norm_mlp, w_ada, b_ada, w_mlp_in, w_mlp_out, w_in_e, w_out_e,
              s5_lambda_re, s5_lambda_im, s5_log_dt, s5_b_re, s5_b_im, s5_c_re, s5_c_im, s5_d,
              s5_w_glu, s5_b_glu, gla_w_gate2, gla_b_gate, gla_norm, w_qkv_o, w_o_o, q_norm, k_norm):
    yp, ys = x_prompt, x_sample
    bp = x_prompt.shape[0]
    new_s5_re, new_s5_im, new_gla, new_k, new_v = [], [], [], [], []
    for i in range(DEPTH):
        j = i // 2
        sp1, cp1, gp1, sp2, cp2, gp2 = ada_mod(c_ctx[None, :], w_ada[i], b_ada[i])
        sl1, cl1, gl1, sl2, cl2, gl2 = ada_mod(c, w_ada[i], b_ada[i])
        hp = modulate(rms_norm(yp, norm_mix[i]), sp1, cp1)
        hs = modulate(rms_norm(ys, norm_mix[i]), sl1, cl1)
        if i % 2 == 0:
            ev = (w_in_e[j], w_out_e[j], s5_lambda_re[j], s5_lambda_im[j], s5_log_dt[j], s5_b_re[j],
                  s5_b_im[j], s5_c_re[j], s5_c_im[j], s5_d[j], s5_w_glu[j], s5_b_glu[j],
                  gla_w_gate2[j], gla_b_gate[j], gla_norm[j])
            z_s5 = jnp.zeros((bp, 2, S5_GROUPS, S5_STATE), jnp.float32)
            z_gla = jnp.zeros((bp, 2, GLA_HEADS, GLA_DK, GLA_DV), jnp.float32)
            mp, s5r, s5i, gfin = even_mixer(hp, z_s5, z_s5, z_gla, *ev)
            new_s5_re.append(s5r)
            new_s5_im.append(s5i)
            new_gla.append(gfin)
            ms, _, _, _ = even_mixer(hs, state_s5_re[:, j], state_s5_im[:, j], state_gla[:, j], *ev)
        else:
            qp, kp, vp = attn_project(hp, w_qkv_o[j], q_norm[j], k_norm[j])
            mp = attend(qp, kp, vp) @ w_o_o[j]
            new_k.append(kp)
            new_v.append(vp)
            qs, ks_, vs = attn_project(hs, w_qkv_o[j], q_norm[j], k_norm[j])
            cos, sin = grid_rope(hs.shape[1])
            qs = apply_rope(qs, cos, sin)
            ks_ = apply_rope(ks_, cos, sin)
            k_all = jnp.concatenate([ks_, cache_k[:, j].astype(ks_.dtype)], axis=1)
            v_all = jnp.concatenate([vs, cache_v[:, j].astype(vs.dtype)], axis=1)
            ms = attend(qs, k_all, v_all) @ w_o_o[j]
        yp = yp + gp1 * mp
        ys = ys + gl1 * ms
        hp = modulate(rms_norm(yp, norm_mlp[i]), sp2, cp2)
        hs = modulate(rms_norm(ys, norm_mlp[i]), sl2, cl2)
        yp = yp + gp2 * sq_relu_mlp(hp, w_mlp_in[i], w_mlp_out[i])
        ys = ys + gl2 * sq_relu_mlp(hs, w_mlp_in[i], w_mlp_out[i])
    s5_re_out = jnp.stack(new_s5_re, axis=1)
    s5_im_out = jnp.stack(new_s5_im, axis=1)
    gla_out = jnp.stack(new_gla, axis=1)
    k_out = jnp.stack(new_k, axis=1)
    v_out = jnp.stack(new_v, axis=1)
    return (yp, ys, s5_re_out, s5_im_out, gla_out, k_out, v_out)
```

```cpp
#include <hip/hip_runtime.h>
#include <hip/hip_bf16.h>
#include <cstdio>
#include <cstdint>
#include <cmath>
namespace pg8 {
#define PG8_LAS __attribute__((address_space(3)))
typedef unsigned short bf16_t;
typedef short bf16x8 __attribute__((ext_vector_type(8)));
typedef float f32x4 __attribute__((ext_vector_type(4)));
typedef unsigned u32x4 __attribute__((ext_vector_type(4)));
constexpr int BM = 256, BK = 64, HALF = 128, HTB = HALF * BK * 2  , STAGE_BYTES = 8 * HTB, NXCD = 8, WGM = 8;

__host__ __device__ __forceinline__ int lds_byte(int r, int c) { const int st = (r >> 4) * 2 + (c >> 5), rr = r & 15, cc = c & 31, ob = rr * 64 + cc * 2; return st * 1024 + (ob ^ (((ob >> 9) & 1) << 5)); }
__host__ __device__ __forceinline__ void stage_rc(int b, int& R, int& C) { const int st = b / 1024, sb = b % 1024, swz = sb ^ (((sb >> 9) & 1) << 5); R = (st >> 1) * 16 + swz / 64; C = (st & 1) * 32 + (swz % 64) / 2; }
__host__ __device__ __forceinline__ int perm32(int rho) { const int n = rho >> 4, i = rho & 15; return 8 * (i >> 2) + 4 * n + (i & 3); }

struct Unit { int pm, pn; };
struct Gemm { const bf16_t* A; const bf16_t* Bt; int M, N, K; };

struct StaticOrder {
    int nM, nN, nwg, G, c;
    __host__ __device__ void init(int M, int N, int G_, int c_) { nM = M / BM; nN = N / BM; nwg = nM * nN; G = G_; c = c_; }
    __host__ __device__ bool next(int i, Unit& u) const {
        const long L = (long)i * G + c; if (L >= nwg) return false;
        int wgid = (int)L; { const int q = nwg / NXCD, r = nwg % NXCD, xcd = wgid % NXCD, off = wgid / NXCD; wgid = (xcd < r ? xcd * (q + 1) : r * (q + 1) + (xcd - r) * q) + off; }
        const int nig = WGM * nN, gid = wgid / nig, fm = gid * WGM, gsz = (nM - fm) < WGM ? (nM - fm) : WGM;
        u.pm = fm + ((wgid % nig) % gsz); u.pn = (wgid % nig) / gsz; return true;
    }
    __device__ __forceinline__ void a_ready(const Unit&) const {}
    __device__ __forceinline__ void done(const Unit&) const {}
};

__device__ __forceinline__ unsigned cvt_pk_bf16(float lo, float hi) { unsigned r; asm volatile("v_cvt_pk_bf16_f32 %0, %1, %2" : "=v"(r) : "v"(lo), "v"(hi)); return r; }
typedef float f32x2 __attribute__((ext_vector_type(2)));
template <int ACT  > struct EpiBf16 {
    static constexpr bool PERM = true, AFTER_DRAIN = false;
    bf16_t* O; int ldc;
    __device__ __forceinline__ void operator()(const f32x4 (&acc)[2][2][4][2], const Unit& u, int wr, int wc, int fr, int fq) const {
        const int row0 = u.pm * BM + wr * 64 + fr; const int col0 = u.pn * BM + wc * 32 + 8 * fq;
#pragma unroll
        for (int ai = 0; ai < 2; ++ai)
#pragma unroll
            for (int m = 0; m < 4; ++m) { bf16_t* rowp = O + (size_t)(row0 + ai * HALF + m * 16) * ldc + col0;
#pragma unroll
                for (int bj = 0; bj < 2; ++bj) { f32x4 v0 = acc[ai][bj][m][0], v1 = acc[ai][bj][m][1];
                    if (ACT == 2) {
#pragma unroll
                        for (int e = 0; e < 4; ++e) { float a = v0[e] > 0.f ? v0[e] : 0.f; v0[e] = a * a; float b = v1[e] > 0.f ? v1[e] : 0.f; v1[e] = b * b; } }
                    u32x4 w; w.x = cvt_pk_bf16(v0[0], v0[1]); w.y = cvt_pk_bf16(v0[2], v0[3]); w.z = cvt_pk_bf16(v1[0], v1[1]); w.w = cvt_pk_bf16(v1[2], v1[3]);
                    *(u32x4*)(rowp + bj * HALF) = w; } }
    }
};
struct EpiResid {
    static constexpr bool PERM = false, AFTER_DRAIN = false;
    const float* base_p; const float* base_s; float* out; const float* gate;
    __device__ __forceinline__ void operator()(const f32x4 (&acc)[2][2][4][2], const Unit& u, int wr, int wc, int fr, int fq) const {
        const int row0 = u.pm * BM + wr * 64 + fr; const int col0 = u.pn * BM + wc * 32 + 4 * fq;
        const int cond = u.pm < 16 ? 0 : 1 + ((u.pm - 16) >> 2);
        const float* gp = gate + cond * 6144; const float* bp = u.pm < 16 ? base_p : base_s;
        f32x4 gv[2][2];
#pragma unroll
        for (int bj = 0; bj < 2; ++bj)
#pragma unroll
            for (int n = 0; n < 2; ++n) gv[bj][n] = *(const f32x4*)(gp + col0 + bj * HALF + n * 16);
#pragma unroll
        for (int ai = 0; ai < 2; ++ai)
#pragma unroll
            for (int m = 0; m < 4; ++m) { const size_t off = (size_t)(row0 + ai * HALF + m * 16) * 1024 + col0;
#pragma unroll
                for (int bj = 0; bj < 2; ++bj)
#pragma unroll
                    for (int n = 0; n < 2; ++n) { const f32x4 b = *(const f32x4*)(bp + off + bj * HALF + n * 16);
                        *(f32x4*)(out + off + bj * HALF + n * 16) = b + gv[bj][n] * acc[ai][bj][m][n]; } }
    }
};
struct EpiGlu {
    static constexpr bool PERM = true, AFTER_DRAIN = false;
    const bf16_t* G; bf16_t* O; const float* bias;
    __device__ __forceinline__ void operator()(const f32x4 (&acc)[2][2][4][2], const Unit& u, int wr, int wc, int fr, int fq) const {
        const int row0 = u.pm * BM + wr * 64 + fr; const int col0 = u.pn * BM + wc * 32 + 8 * fq;
        f32x4 bv[2][2];
#pragma unroll
        for (int bj = 0; bj < 2; ++bj)
#pragma unroll
            for (int n = 0; n < 2; ++n) bv[bj][n] = *(const f32x4*)(bias + col0 + bj * HALF + 4 * n);
#pragma unroll
        for (int ai = 0; ai < 2; ++ai)
#pragma unroll
            for (int m = 0; m < 4; ++m) { const size_t row = (size_t)(row0 + ai * HALF + m * 16);
#pragma unroll
                for (int bj = 0; bj < 2; ++bj) { f32x4 v0 = acc[ai][bj][m][0] + bv[bj][0], v1 = acc[ai][bj][m][1] + bv[bj][1];
                    const u32x4 gw = *(const u32x4*)(G + row * 512 + col0 + bj * HALF);
                    float gf[8];
#pragma unroll
                    for (int e = 0; e < 4; ++e) { gf[2 * e] = __uint_as_float(gw[e] << 16); gf[2 * e + 1] = __uint_as_float(gw[e] & 0xffff0000u); }
                    float o[8];
#pragma unroll
                    for (int e = 0; e < 4; ++e) { o[e] = gf[e] / (1.f + __expf(-v0[e])); o[4 + e] = gf[4 + e] / (1.f + __expf(-v1[e])); }
                    u32x4 w; w.x = cvt_pk_bf16(o[0], o[1]); w.y = cvt_pk_bf16(o[2], o[3]); w.z = cvt_pk_bf16(o[4], o[5]); w.w = cvt_pk_bf16(o[6], o[7]);
                    *(u32x4*)(O + row * 1024 + col0 + bj * HALF) = w; } }
    }
};

template <class Epi, class Sched, bool ALIGN_EPI = false, bool SP2 = false>
__device__ __forceinline__ void gemm_phase(PG8_LAS unsigned char* lds, const Gemm g, const Sched& S, const Epi& E) {
    const int tid = threadIdx.x, wid = __builtin_amdgcn_readfirstlane(tid >> 6), lane = tid & 63, wr = wid >> 2, wc = wid & 3, fr = lane & 15, fq = lane >> 4;
    const int K = g.K, nt = K / BK;
    unsigned voffA[2], voffB[2];
#pragma unroll
    for (int i = 0; i < 2; ++i) { int R, C; stage_rc(tid * 16 + i * 8192, R, C); const int Rb = Epi::PERM ? ((R & ~31) + perm32(R & 31)) : R;
        voffA[i] = (unsigned)(R * K + C) * 2u; voffB[i] = (unsigned)(Rb * K + C) * 2u; }
    const size_t kstep = (size_t)(BK * 2);
    const size_t hstep = (size_t)HALF * K * 2;
    const size_t tstep = 2 * hstep;
    const unsigned ldsw = (unsigned)wid * 1024u;
    const int aoff = lds_byte(wr * 64 + fr, fq * 8), boff = lds_byte(wc * 32 + fr, fq * 8);
#define PG8_SA(b, h) (((b) * 2 + (h)) * HTB)
#define PG8_SB(b, h) ((4 + (b) * 2 + (h)) * HTB)
#define PG8_STAGE(bufoff, gbase, voff) do { _Pragma("unroll") for (int _i = 0; _i < 2; ++_i) \
        __builtin_amdgcn_global_load_lds((const unsigned*)((const char*)(gbase) + (voff)[_i]), (PG8_LAS unsigned*)(lds + (bufoff) + ldsw + _i * 8192), 16, 0, 0); } while (0)
#define PG8_LDA(dst, b, h) do { _Pragma("unroll") for (int m = 0; m < 4; ++m) _Pragma("unroll") for (int k = 0; k < 2; ++k) dst[m][k] = *(const PG8_LAS bf16x8*)(lds + PG8_SA(b, h) + aoff + m * 2048 + k * 1024); } while (0)
#define PG8_LDB(dst, b, h) do { _Pragma("unroll") for (int n = 0; n < 2; ++n) _Pragma("unroll") for (int k = 0; k < 2; ++k) dst[n][k] = *(const PG8_LAS bf16x8*)(lds + PG8_SB(b, h) + boff + n * 2048 + k * 1024); } while (0)
#define PG8_MMA(ai, bj, At, Bt) do { __builtin_amdgcn_s_setprio(1); _Pragma("unroll") for (int m = 0; m < 4; ++m) _Pragma("unroll") for (int n = 0; n < 2; ++n) _Pragma("unroll") for (int k = 0; k < 2; ++k) \
        acc[ai][bj][m][n] = __builtin_amdgcn_mfma_f32_16x16x32_bf16(Bt[n][k], At[m][k], acc[ai][bj][m][n], 0, 0, 0); __builtin_amdgcn_s_setprio(0); } while (0)
#define PG8_WAIT_V(n) asm volatile("s_waitcnt vmcnt(" #n ")" ::: "memory")
#define PG8_WAIT_L(n) asm volatile("s_waitcnt lgkmcnt(" #n ")" ::: "memory")
#define PG8_BAR __builtin_amdgcn_s_barrier()
#define PG8_SCHED __builtin_amdgcn_sched_barrier(0)
    Unit cur, nxt; int ui = 0;
    if (!S.next(0, cur)) return;
    f32x4 acc[2][2][4][2];
#pragma unroll
    for (int a = 0; a < 2; ++a)
#pragma unroll
        for (int b = 0; b < 2; ++b)
#pragma unroll
            for (int m = 0; m < 4; ++m)
#pragma unroll
                for (int n = 0; n < 2; ++n) acc[a][b][m][n] = (f32x4){0.f, 0.f, 0.f, 0.f};
    bf16x8 At[4][2], B0[2][2], B1[2][2];
    const char* cA = (const char*)g.A + (size_t)cur.pm * tstep; const char* cB = (const char*)g.Bt + (size_t)cur.pn * tstep;
    S.a_ready(cur);
    if constexpr (SP2) {
        PG8_STAGE(PG8_SB(0, 0), cB, voffB); PG8_STAGE(PG8_SB(0, 1), cB + hstep, voffB); PG8_STAGE(PG8_SA(0, 0), cA, voffA); PG8_STAGE(PG8_SA(0, 1), cA + hstep, voffA);
        if (wr == 1) PG8_BAR;
        PG8_WAIT_V(2); PG8_BAR;
        PG8_STAGE(PG8_SB(1, 0), cB + kstep, voffB); PG8_STAGE(PG8_SA(1, 0), cA + kstep, voffA); PG8_STAGE(PG8_SB(1, 1), cB + hstep + kstep, voffB);
        PG8_WAIT_V(6); PG8_BAR;
    } else {
        PG8_STAGE(PG8_SB(0, 0), cB, voffB); PG8_STAGE(PG8_SA(0, 0), cA, voffA); PG8_STAGE(PG8_SB(0, 1), cB + hstep, voffB); PG8_STAGE(PG8_SA(0, 1), cA + hstep, voffA);
        if (wr == 1) PG8_BAR;
        PG8_WAIT_V(4); PG8_BAR;
        PG8_STAGE(PG8_SB(1, 0), cB + kstep, voffB); PG8_STAGE(PG8_SA(1, 0), cA + kstep, voffA); PG8_STAGE(PG8_SB(1, 1), cB + hstep + kstep, voffB);
        PG8_WAIT_V(6); PG8_BAR;
    }
    for (;;) {
        const bool has_next = S.next(ui + 1, nxt);
        const char* nA = has_next ? (const char*)g.A + (size_t)nxt.pm * tstep : cA; const char* nB = has_next ? (const char*)g.Bt + (size_t)nxt.pn * tstep : cB;
        for (int t = 0; t < nt; t += 2) {
            const bool last = (t == nt - 2);
            const char* a1 = cA + (size_t)(t + 1) * kstep;
            const char* a2 = last ? nA : cA + (size_t)(t + 2) * kstep; const char* b2 = last ? nB : cB + (size_t)(t + 2) * kstep;
            const char* a3 = a2 + kstep; const char* b3 = b2 + kstep;
            if (last && has_next) S.a_ready(nxt);
            if constexpr (SP2) {
            PG8_LDB(B0, 0, 0); PG8_LDB(B1, 0, 1); PG8_SCHED; PG8_LDA(At, 0, 0); PG8_STAGE(PG8_SA(1, 1), a1 + hstep, voffA);
            PG8_WAIT_V(8); PG8_WAIT_L(0); PG8_BAR; PG8_MMA(0, 0, At, B0); PG8_MMA(0, 1, At, B1); PG8_BAR; PG8_SCHED;
            PG8_LDA(At, 0, 1); PG8_STAGE(PG8_SB(0, 0), b2, voffB); PG8_STAGE(PG8_SB(0, 1), b2 + hstep, voffB); PG8_STAGE(PG8_SA(0, 0), a2, voffA);
            PG8_WAIT_V(8); PG8_WAIT_L(0); PG8_BAR; PG8_MMA(1, 0, At, B0); PG8_MMA(1, 1, At, B1); PG8_BAR; PG8_SCHED;
            PG8_LDB(B0, 1, 0); PG8_LDB(B1, 1, 1); PG8_SCHED; PG8_LDA(At, 1, 0); PG8_STAGE(PG8_SA(0, 1), a2 + hstep, voffA);
            PG8_WAIT_V(8); PG8_WAIT_L(0); PG8_BAR; PG8_MMA(0, 0, At, B0); PG8_MMA(0, 1, At, B1); PG8_BAR; PG8_SCHED;
            PG8_LDA(At, 1, 1); PG8_STAGE(PG8_SB(1, 0), b3, voffB); PG8_STAGE(PG8_SB(1, 1), b3 + hstep, voffB); PG8_STAGE(PG8_SA(1, 0), a3, voffA);
            PG8_WAIT_V(8); PG8_WAIT_L(0); PG8_BAR; PG8_MMA(1, 0, At, B0); PG8_MMA(1, 1, At, B1); PG8_BAR; PG8_SCHED;
            } else {
            PG8_LDB(B0, 0, 0); PG8_SCHED; PG8_LDA(At, 0, 0); PG8_STAGE(PG8_SA(1, 1), a1 + hstep, voffA);
            PG8_WAIT_L(8); PG8_BAR; PG8_WAIT_L(0); PG8_MMA(0, 0, At, B0); PG8_BAR; PG8_SCHED;
            PG8_LDB(B1, 0, 1); PG8_STAGE(PG8_SB(0, 0), b2, voffB);
            PG8_BAR; PG8_WAIT_L(0); PG8_MMA(0, 1, At, B1); PG8_BAR;
            PG8_LDA(At, 0, 1); PG8_STAGE(PG8_SA(0, 0), a2, voffA);
            PG8_BAR; PG8_WAIT_L(0); PG8_MMA(1, 0, At, B0); PG8_BAR; PG8_SCHED;
            PG8_STAGE(PG8_SB(0, 1), b2 + hstep, voffB);
            PG8_WAIT_V(6); PG8_BAR; PG8_MMA(1, 1, At, B1); PG8_BAR;
            PG8_LDB(B0, 1, 0); PG8_SCHED; PG8_LDA(At, 1, 0); PG8_STAGE(PG8_SA(0, 1), a2 + hstep, voffA);
            PG8_WAIT_L(8); PG8_BAR; PG8_WAIT_L(0); PG8_MMA(0, 0, At, B0); PG8_BAR; PG8_SCHED;
            PG8_LDB(B1, 1, 1); PG8_STAGE(PG8_SB(1, 0), b3, voffB);
            PG8_BAR; PG8_WAIT_L(0); PG8_MMA(0, 1, At, B1); PG8_BAR;
            PG8_LDA(At, 1, 1); PG8_STAGE(PG8_SA(1, 0), a3, voffA);
            PG8_BAR; PG8_WAIT_L(0); PG8_MMA(1, 0, At, B0); PG8_BAR; PG8_SCHED;
            PG8_STAGE(PG8_SB(1, 1), b3 + hstep, voffB);
            PG8_WAIT_V(6); PG8_BAR; PG8_MMA(1, 1, At, B1); PG8_BAR;
            }
        }
        if constexpr (ALIGN_EPI) { if (wr == 0) PG8_BAR; }
        if constexpr (!Epi::AFTER_DRAIN) { E(acc, cur, wr, wc, fr, fq); S.done(cur); }
        if (!has_next) break;
#pragma unroll
        for (int a = 0; a < 2; ++a)
#pragma unroll
            for (int b = 0; b < 2; ++b)
#pragma unroll
                for (int m = 0; m < 4; ++m)
#pragma unroll
                    for (int n = 0; n < 2; ++n) acc[a][b][m][n] = (f32x4){0.f, 0.f, 0.f, 0.f};
        cur = nxt; cA = nA; cB = nB; ++ui;
        if constexpr (ALIGN_EPI) { if (wr == 1) PG8_BAR; }
    }
    PG8_WAIT_V(0);
    if constexpr (!ALIGN_EPI) { if (wr == 0) PG8_BAR; }
    PG8_BAR;
    if constexpr (Epi::AFTER_DRAIN) { E.fused(acc, cur, wr, wc, fr, fq, lds, wid, lane); S.done(cur); }
#undef PG8_SA
#undef PG8_SB
#undef PG8_STAGE
#undef PG8_LDA
#undef PG8_LDB
#undef PG8_MMA
#undef PG8_WAIT_V
#undef PG8_WAIT_L
#undef PG8_BAR
#undef PG8_SCHED
}
}

namespace att {
using bf16 = __hip_bfloat16;
constexpr int D = 128, NW = 8, QBLK = 32, KVBLK = 64; constexpr float SCALE = 0.088388347648318440f; constexpr float THR = 8.f; constexpr int SDEPTH = 2;
constexpr int LDQ = 1024, LDK = 256, LDO = 1024;
constexpr size_t SHM_V = KVBLK * D * 2, SHM_K = KVBLK * D * 2, SHM_ATTN = 2 * SHM_V + 2 * SHM_K + NW * 64 * 4;
using bf16x8 = __attribute__((ext_vector_type(8))) short;
using s16x4  = __attribute__((ext_vector_type(4))) short;
using f32x16 = __attribute__((ext_vector_type(16))) float;
using f32x8  = __attribute__((ext_vector_type(8))) float;
using u32x4  = __attribute__((ext_vector_type(4))) unsigned;
#define KSWZ(row, colB) ((row) * 256 + ((colB) ^ (((row) & 7) << 4)))
#define SBAR() __builtin_amdgcn_sched_barrier(0)
__device__ __forceinline__ int crow(int r, int hi) { return (r & 3) + 8 * (r >> 2) + 4 * hi; }
__device__ __forceinline__ unsigned cvtpk(float lo, float hi) {
  unsigned r; asm volatile("v_cvt_pk_bf16_f32 %0, %1, %2" : "=v"(r) : "v"(lo), "v"(hi)); return r;
}
template <typename TIn> struct Stage;
template <> struct Stage<bf16>  { using T = bf16x8;
  __device__ static __forceinline__ T ld8(const bf16* p) { return *reinterpret_cast<const bf16x8*>(p); }
  __device__ static __forceinline__ bf16x8 tobf(T x) { return x; } };
template <> struct Stage<float> { using T = f32x8;
  __device__ static __forceinline__ T ld8(const float* p) { return *reinterpret_cast<const f32x8*>(p); }
  __device__ static __forceinline__ bf16x8 tobf(T x) {
    u32x4 w = {cvtpk(x[0], x[1]), cvtpk(x[2], x[3]), cvtpk(x[4], x[5]), cvtpk(x[6], x[7])}; return *reinterpret_cast<bf16x8*>(&w); } };

__device__ __forceinline__ void partialSM(f32x16& p0, f32x16& p1, float& m_reg, float& mn, float& alpha) {
  constexpr float C = SCALE * 1.4426950408889634f;
  float pmax = p0[0]; for (int r = 1; r < 16; ++r) pmax = fmaxf(pmax, p0[r]); for (int r = 0; r < 16; ++r) pmax = fmaxf(pmax, p1[r]);
  { auto rr = __builtin_amdgcn_permlane32_swap(__float_as_uint(pmax), __float_as_uint(pmax), false, false);
    pmax = fmaxf(__uint_as_float(rr[0]), __uint_as_float(rr[1])); }
  if (__builtin_expect(__all(pmax - m_reg <= THR / SCALE), 1)) { mn = m_reg; alpha = 1.f; }
  else { mn = fmaxf(m_reg, pmax); alpha = __builtin_amdgcn_exp2f((m_reg - mn) * C); m_reg = mn; }
  float mnC = -mn * C;
  for (int r = 0; r < 16; ++r) p0[r] = fmaf(p0[r], C, mnC); for (int r = 0; r < 16; ++r) p1[r] = fmaf(p1[r], C, mnC);
  for (int r = 0; r < 16; ++r) p0[r] = __builtin_amdgcn_exp2f(p0[r]);
}
__device__ __forceinline__ void finishSM(f32x16& p0, f32x16& p1, float alpha, float& l_reg, bf16x8& pa0, bf16x8& pa1, bf16x8& pa2, bf16x8& pa3) {
  for (int r = 0; r < 16; ++r) p1[r] = __builtin_amdgcn_exp2f(p1[r]);
  float ps = 0; for (int r = 0; r < 16; ++r) ps += p0[r]; for (int r = 0; r < 16; ++r) ps += p1[r];
  { auto rr = __builtin_amdgcn_permlane32_swap(__float_as_uint(ps), __float_as_uint(ps), false, false);
    ps = __uint_as_float(rr[0]) + __uint_as_float(rr[1]); }
  l_reg = l_reg * alpha + ps;
#define PK4(P, BASE, OUT) do { unsigned a0 = cvtpk(P[BASE + 0], P[BASE + 1]), a1 = cvtpk(P[BASE + 2], P[BASE + 3]);   \
    unsigned b0 = cvtpk(P[BASE + 4], P[BASE + 5]), b1 = cvtpk(P[BASE + 6], P[BASE + 7]);                              \
    auto r0 = __builtin_amdgcn_permlane32_swap(a0, b0, false, false); auto r1 = __builtin_amdgcn_permlane32_swap(a1, b1, false, false); \
    u32x4 w = {r0[0], r1[0], r0[1], r1[1]}; OUT = *reinterpret_cast<bf16x8*>(&w); } while (0)
  PK4(p0, 0, pa0); PK4(p0, 8, pa1); PK4(p1, 0, pa2); PK4(p1, 8, pa3);
#undef PK4
}
__device__ __forceinline__ void qkt(f32x16& p0, f32x16& p1, const bf16* Ks, const bf16x8* qr, int r32, int hi) {
  p0 = f32x16{}; p1 = f32x16{};
  for (int d0 = 0; d0 < 8; ++d0) { int cb = (d0 * 16 + hi * 8) * 2;
    bf16x8 b0 = *reinterpret_cast<const bf16x8*>((const char*)Ks + KSWZ(r32, cb));
    bf16x8 b1 = *reinterpret_cast<const bf16x8*>((const char*)Ks + KSWZ(32 + r32, cb));
    p0 = __builtin_amdgcn_mfma_f32_32x32x16_bf16(b0, qr[d0], p0, 0, 0, 0);
    p1 = __builtin_amdgcn_mfma_f32_32x32x16_bf16(b1, qr[d0], p1, 0, 0, 0); }
}
__device__ __forceinline__ int v_st(int k, int c) { const int kk = (k & ~0xC) | ((k & 4) << 1) | ((k & 8) >> 1); return ((kk >> 3) * 4 + (c >> 5)) * 512 + ((kk & 7) * 32 + (c & 31)) * 2; }
__device__ __forceinline__ int v_rd_base(int lane) { return ((lane & 3) << 3) | (((lane >> 2) & 3) << 6) | (((lane >> 4) & 1) << 5) | (((lane >> 5) & 1) << 8); }
constexpr int v_rd_off(int d0, int ks, int half) { return d0 * 512 + ks * 4096 + half * 2048; }
template <int OFF> __device__ __forceinline__ s16x4 tr_read(int vb) {
  s16x4 r; asm volatile("ds_read_b64_tr_b16 %0, %1 offset:%2" : "=&v"(r) : "v"(vb), "i"(OFF) : "memory"); return r;
}
template <int D0> __device__ __forceinline__ void pv_one(f32x16& od, int vb, bf16x8 pa0, bf16x8 pa1, bf16x8 pa2, bf16x8 pa3) {
  const s16x4 l0 = tr_read<v_rd_off(D0, 0, 0)>(vb), h0 = tr_read<v_rd_off(D0, 0, 1)>(vb), l1 = tr_read<v_rd_off(D0, 1, 0)>(vb), h1 = tr_read<v_rd_off(D0, 1, 1)>(vb);
  const s16x4 l2 = tr_read<v_rd_off(D0, 2, 0)>(vb), h2 = tr_read<v_rd_off(D0, 2, 1)>(vb), l3 = tr_read<v_rd_off(D0, 3, 0)>(vb), h3 = tr_read<v_rd_off(D0, 3, 1)>(vb);
  asm volatile("s_waitcnt lgkmcnt(0)" ::: "memory"); SBAR();
#define PK(L, H) (bf16x8){L[0], L[1], L[2], L[3], H[0], H[1], H[2], H[3]}
  od = __builtin_amdgcn_mfma_f32_32x32x16_bf16(pa0, PK(l0, h0), od, 0, 0, 0);
  od = __builtin_amdgcn_mfma_f32_32x32x16_bf16(pa1, PK(l1, h1), od, 0, 0, 0);
  od = __builtin_amdgcn_mfma_f32_32x32x16_bf16(pa2, PK(l2, h2), od, 0, 0, 0);
  od = __builtin_amdgcn_mfma_f32_32x32x16_bf16(pa3, PK(l3, h3), od, 0, 0, 0);
#undef PK
}
__device__ __forceinline__ void pv_d0(f32x16* o, int vb, bf16x8 pa0, bf16x8 pa1, bf16x8 pa2, bf16x8 pa3) {
  pv_one<0>(o[0], vb, pa0, pa1, pa2, pa3); pv_one<1>(o[1], vb, pa0, pa1, pa2, pa3); pv_one<2>(o[2], vb, pa0, pa1, pa2, pa3); pv_one<3>(o[3], vb, pa0, pa1, pa2, pa3);
}

template <typename TQ>
__device__ __forceinline__ void attn_dense_body(const TQ* __restrict__ Qb, const bf16* __restrict__ Kh, const bf16* __restrict__ Vh,
                                                bf16* __restrict__ Ob, int seq, char* lds) {
  using St = Stage<bf16>; using SQ = Stage<TQ>;
  const int tid = threadIdx.x, wid = tid >> 6, lane = tid & 63, r32 = lane & 31, hi = lane >> 5;
  bf16* V_lds = (bf16*)lds; bf16* K_lds = (bf16*)(lds + 2 * SHM_V);
  float* ws = (float*)(lds + 2 * SHM_V + 2 * SHM_K) + wid * 64; float* li_l = ws; float* al_l = ws + 32;
  float m_reg = -1e30f, l_reg = 0; f32x16 o[4] = {}; bf16x8 qr[8];
  const TQ* Qw = Qb + (long)(wid * QBLK + r32) * LDQ + hi * 8;
#pragma unroll
  for (int d0 = 0; d0 < 8; ++d0) qr[d0] = SQ::tobf(SQ::ld8(Qw + d0 * 16));
  const int sr = tid >> 4, sc = (tid & 15) * 8, vst0 = v_st(sr, sc), vst1 = v_st(32 + sr, sc);
  const int vb0 = (int)(uintptr_t)V_lds + v_rd_base(lane);
  struct { typename St::T vs0, vs1, ks0, ks1; } sr_[SDEPTH];
#define SLOAD(i, k0) do { sr_[i].vs0 = St::ld8(&Vh[(long)((k0) + sr) * LDK + sc]); sr_[i].vs1 = St::ld8(&Vh[(long)((k0) + 32 + sr) * LDK + sc]); \
    sr_[i].ks0 = St::ld8(&Kh[(long)((k0) + sr) * LDK + sc]); sr_[i].ks1 = St::ld8(&Kh[(long)((k0) + 32 + sr) * LDK + sc]); } while (0)
#define SWRITE(b, i) do { *(bf16x8*)((char*)V_lds + (b) * SHM_V + vst0) = St::tobf(sr_[i].vs0);          \
    *(bf16x8*)((char*)V_lds + (b) * SHM_V + vst1) = St::tobf(sr_[i].vs1); int kc = sc * 2;               \
    *(bf16x8*)((char*)K_lds + (b) * SHM_K + KSWZ(sr, kc)) = St::tobf(sr_[i].ks0);                       \
    *(bf16x8*)((char*)K_lds + (b) * SHM_K + KSWZ(32 + sr, kc)) = St::tobf(sr_[i].ks1); } while (0)
#define SWAIT() do { if constexpr (SDEPTH == 2) asm volatile("s_waitcnt vmcnt(4)" ::: "memory"); else asm volatile("s_waitcnt vmcnt(0)" ::: "memory"); } while (0)
#define RESC(a) do { if (__any((a) < 1.f)) { if (hi == 0) al_l[r32] = (a); asm volatile("s_waitcnt lgkmcnt(0)" ::: "memory"); \
    for (int d = 0; d < 4; ++d) for (int r = 0; r < 16; ++r) o[d][r] *= al_l[crow(r, hi)]; } } while (0)
  f32x16 pA0, pA1, pB0, pB1; float mnA, mnB, alA, alB; bf16x8 pa0, pa1, pa2, pa3; const int NT = seq / KVBLK;
  constexpr int SE = 0, SO = SDEPTH - 1;
  SLOAD(SE, 0); asm volatile("s_waitcnt vmcnt(0)" ::: "memory"); SWRITE(0, SE); __syncthreads();
  qkt(pA0, pA1, K_lds, qr, r32, hi); partialSM(pA0, pA1, m_reg, mnA, alA);
  SLOAD(SO, KVBLK); if constexpr (SDEPTH == 2) { if (2 < NT) SLOAD(SE, 2 * KVBLK); }
  SWAIT(); SWRITE(1, SO); __syncthreads();
  for (int j = 1; j + 1 < NT; j += 2) {
    SBAR(); qkt(pB0, pB1, (bf16*)((char*)K_lds + SHM_K), qr, r32, hi);
    finishSM(pA0, pA1, alA, l_reg, pa0, pa1, pa2, pa3); SBAR();
    SLOAD(SO, (j + SDEPTH) * KVBLK); SBAR();
    pv_d0(o, vb0, pa0, pa1, pa2, pa3); partialSM(pB0, pB1, m_reg, mnB, alB);
    __syncthreads(); SWAIT(); SWRITE(0, SE);
    RESC(alB); __syncthreads();
    SBAR(); qkt(pA0, pA1, K_lds, qr, r32, hi);
    finishSM(pB0, pB1, alB, l_reg, pa0, pa1, pa2, pa3); SBAR();
    if (SDEPTH == 1 || j + 3 < NT) SLOAD(SE, (j + 1 + SDEPTH) * KVBLK); SBAR();
    pv_d0(o, vb0 + (int)SHM_V, pa0, pa1, pa2, pa3); partialSM(pA0, pA1, m_reg, mnA, alA);
    __syncthreads(); SWAIT(); SWRITE(1, SO);
    RESC(alA); __syncthreads();
  }
  SBAR(); qkt(pB0, pB1, (bf16*)((char*)K_lds + SHM_K), qr, r32, hi);
  finishSM(pA0, pA1, alA, l_reg, pa0, pa1, pa2, pa3); SBAR();
  pv_d0(o, vb0, pa0, pa1, pa2, pa3); partialSM(pB0, pB1, m_reg, mnB, alB);
  __syncthreads(); RESC(alB);
  finishSM(pB0, pB1, alB, l_reg, pa0, pa1, pa2, pa3); SBAR();
  pv_d0(o, vb0 + (int)SHM_V, pa0, pa1, pa2, pa3);
  if (hi == 0) li_l[r32] = l_reg; asm volatile("s_waitcnt lgkmcnt(0)" ::: "memory");
  float rli[16];
#pragma unroll
  for (int r = 0; r < 16; ++r) rli[r] = __builtin_amdgcn_rcpf(li_l[crow(r, hi)]);
  bf16* Ow = Ob + (long)(wid * QBLK) * LDO;
#pragma unroll
  for (int r = 0; r < 16; ++r) { int orow = crow(r, hi);
    for (int d0 = 0; d0 < 4; ++d0) Ow[(long)orow * LDO + d0 * 32 + r32] = __float2bfloat16(o[d0][r] * rli[r]); }
#undef SLOAD
#undef SWRITE
#undef SWAIT
#undef RESC
}
}

constexpr int NWAVES = 8;
constexpr int DM = 1024, NTOK = 8192, NPR = 4096, FF = 4096, INW = 2048, INE = 2080, QKVW = 1536;
constexpr float EPS = 1e-6f;
constexpr size_t OUT_Y = 0, OUT_S5RE = 8388608, OUT_S5IM = OUT_S5RE + 65536, OUT_GLA = OUT_S5IM + 65536, OUT_NK = OUT_GLA + 1048576, OUT_NV = OUT_NK + 1048576, OUT_END = OUT_NV + 1048576;
constexpr size_t MiB = 1u << 20;
constexpr size_t WS_CTL = 0, CTL_ZERO_BYTES = 64 * 1024;
constexpr size_t WS_ADA = 1 * MiB;
constexpr size_t WS_WIN = 2 * MiB, WS_WGLR = 6 * MiB, WS_WGLU = 6 * MiB + 512 * 1024, WS_WOUT = 7 * MiB, WS_W1 = 9 * MiB, WS_W2 = 25 * MiB, WS_WQKV = 41 * MiB, WS_WO = 44 * MiB;
constexpr size_t WS_H = 46 * MiB, WS_Y = 62 * MiB, WS_SCR = 94 * MiB;
constexpr size_t WS_Z = WS_SCR, WS_GLR = WS_SCR + 32 * MiB, WS_G = WS_SCR + 33 * MiB, WS_YF = WS_SCR + 41 * MiB, WS_SLOC = WS_SCR + 57 * MiB, WS_SIN = WS_SCR + 89 * MiB, WS_DEC = WS_SCR + 105 * MiB, WS_MIX = WS_SCR + 106 * MiB;
constexpr size_t WS_ACT = WS_SCR;
constexpr size_t WS_QKV = WS_SCR, WS_QN = WS_SCR + 24 * MiB, WS_KP = WS_SCR + 40 * MiB, WS_KS = WS_SCR + 42 * MiB, WS_VP = WS_SCR + 45 * MiB, WS_VS = WS_SCR + 47 * MiB, WS_OB = WS_SCR + 50 * MiB;
constexpr size_t WS_END = WS_SCR + 122 * MiB;
static_assert(WS_END <= 256 * MiB, "d_ws map");
constexpr int CW_BAR = 1024;
constexpr int RING_BYTES = 131072, LDSCTL_OFF = RING_BYTES, MISC_OFF = LDSCTL_OFF + 320, LDS_BYTES = 147456;

#define GAS __attribute__((address_space(1)))
#define LAS __attribute__((address_space(3)))
typedef unsigned short bf16;
typedef unsigned v4u __attribute__((ext_vector_type(4)));
typedef unsigned v2u __attribute__((ext_vector_type(2)));
typedef float f32x4 __attribute__((ext_vector_type(4)));
typedef float f32x16 __attribute__((ext_vector_type(16)));
typedef short bf16x8 __attribute__((ext_vector_type(8)));
typedef short s16x4 __attribute__((ext_vector_type(4)));
typedef GAS unsigned gu32;
#define RLX_AGENT __ATOMIC_RELAXED, __HIP_MEMORY_SCOPE_AGENT
#define LDS_WAIT() asm volatile("s_waitcnt lgkmcnt(0)" ::: "memory")
#define VM_WAIT() asm volatile("s_waitcnt vmcnt(0)" ::: "memory")
__device__ __forceinline__ unsigned f2bf(float f) { unsigned u = __builtin_bit_cast(unsigned, f); return (u + 0x7fffu + ((u >> 16) & 1u)) >> 16; }
__device__ __forceinline__ unsigned pk2(float lo, float hi) { return f2bf(lo) | (f2bf(hi) << 16); }
__device__ __forceinline__ float bf2f(unsigned short b) { return __uint_as_float(((unsigned)b) << 16); }
__device__ __forceinline__ float bflo(unsigned w) { return __uint_as_float(w << 16); }
__device__ __forceinline__ float bfhi(unsigned w) { return __uint_as_float(w & 0xffff0000u); }
__device__ __forceinline__ float wave_sum(float v) {
#pragma unroll
    for (int o = 1; o < 64; o <<= 1) v += __shfl_xor(v, o);
    return v;
}
__device__ __forceinline__ int crow(int r, int hi) { return (r & 3) + 8 * (r >> 2) + 4 * hi; }
__device__ __forceinline__ s16x4 tr_read4(unsigned addr) { s16x4 r; asm volatile("ds_read_b64_tr_b16 %0, %1" : "=&v"(r) : "v"(addr) : "memory"); return r; }

#define XB_TMO      128
#define XB_XCNT(j)  (256  + 64 * (j))
#define XB_XSUB(j)  (1280 + 64 * (j))
#define XB_XGEN(j)  (2304 + 64 * (j))
#define XB_TOP      3328
#define XB_TOPGEN   3392
#define XCD_BAR_WORDS 3456
#define XB_SPIN_CAP (1u << 18)

__device__ __forceinline__ unsigned xb_ld(unsigned* p)              { return __hip_atomic_load(p, __ATOMIC_RELAXED, __HIP_MEMORY_SCOPE_AGENT); }
__device__ __forceinline__ unsigned xb_add(unsigned* p, unsigned v) { return __hip_atomic_fetch_add(p, v, __ATOMIC_RELAXED, __HIP_MEMORY_SCOPE_AGENT); }
__device__ __forceinline__ unsigned xb_xcc_id() { return (unsigned)__builtin_amdgcn_s_getreg((3 << 11) | 20) & 0xFu; }
#define XB_SPIN(cond, bar) do { unsigned _sp = 0; while (cond) { __builtin_amdgcn_s_sleep(1); \
    if ((++_sp & 255u) == 0u) { if (xb_ld(&(bar)[XB_TMO])) break; if (_sp > XB_SPIN_CAP) { atomicAdd(&(bar)[XB_TMO], 1u); break; } } } } while (0)

struct XcdBarrier {
    unsigned* bar; unsigned x;
    volatile LAS unsigned* st;
};

__device__ __forceinline__ XcdBarrier xcd_barrier_post(unsigned* bar, volatile LAS unsigned* st) {
    XcdBarrier b; b.bar = bar; b.x = xb_xcc_id(); b.st = st;
    if (threadIdx.x == 0) (void)xb_add(&bar[XB_XCNT(b.x)], 1u);
    return b;
}
__device__ __forceinline__ void xcd_barrier_complete(unsigned* bar, unsigned x, unsigned& nloc, unsigned& nx) {
    const unsigned G = gridDim.x * gridDim.y * gridDim.z;
    unsigned sum, cnt, mine, sp = 0u;
    for (;;) {
        sum = 0u; cnt = 0u; mine = 0u;
#pragma unroll
        for (unsigned j = 0; j < 16; ++j) { const unsigned c = xb_ld(&bar[XB_XCNT(j)]); sum += c; cnt += (c > 0u) ? 1u : 0u; mine = (j == x) ? c : mine; }
        if (sum == G) break;
        __builtin_amdgcn_s_sleep(1);
        if ((++sp & 255u) == 0u) { if (xb_ld(&bar[XB_TMO])) break; if (sp > XB_SPIN_CAP) { atomicAdd(&bar[XB_TMO], 1u); break; } }
    }
    nloc = mine > 0u ? mine : 1u; nx = cnt > 0u ? cnt : 1u;
}

__device__ __forceinline__ void xcd_barrier(const XcdBarrier& b) {
    asm volatile("s_waitcnt vmcnt(0)" ::: "memory");
    __syncthreads();
    if (threadIdx.x == 0) {
        unsigned* bar = b.bar;
        __builtin_amdgcn_s_waitcnt(0);
        unsigned nloc = b.st[0], nx = b.st[1];
        if (nloc == 0u) { xcd_barrier_complete(bar, b.x, nloc, nx); b.st[0] = nloc; b.st[1] = nx; }
        const unsigned old = xb_add(&bar[XB_XSUB(b.x)], 1u);
        const unsigned gen = old / nloc;
        if (old + 1u == (gen + 1u) * nloc) {
            __builtin_amdgcn_fence(__ATOMIC_RELEASE, "agent");
            asm volatile("s_waitcnt vmcnt(0)" ::: "memory");
            const unsigned og = xb_add(&bar[XB_TOP], 1u);
            const unsigned tg = og / nx;
            if (og + 1u == (tg + 1u) * nx) xb_add(&bar[XB_TOPGEN], 1u);
            else XB_SPIN(xb_ld(&bar[XB_TOPGEN]) == tg, bar);
            __builtin_amdgcn_fence(__ATOMIC_ACQUIRE, "agent");
            xb_add(&bar[XB_XGEN(b.x)], 1u);
            asm volatile("s_waitcnt vmcnt(0)" ::: "memory");
        } else {
            XB_SPIN(xb_ld(&bar[XB_XGEN(b.x)]) == gen, bar);
            __builtin_amdgcn_fence(__ATOMIC_ACQUIRE, "agent");
            asm volatile("s_waitcnt vmcnt(0)" ::: "memory");
        }
    }
    __syncthreads();
}


struct Args { const float* in[34]; float* out; unsigned char* ws; int ph_lo, ph_hi; };

__device__ __forceinline__ void p0_transpose_item(const float* W, int ld, int K, bf16* WT, int nblk, LAS float* scr, int item, int lane) {
    const int kb = item / nblk, nb = item % nblk, k0 = 64 * kb, n0 = 32 * nb;
#pragma unroll 8
    for (int i = 0; i < 32; ++i) { const int kk = 2 * i + (lane >> 5); scr[kk * 33 + (lane & 31)] = W[(size_t)(k0 + kk) * ld + n0 + (lane & 31)]; }
    LDS_WAIT(); asm volatile("" ::: "memory");
    const int c = lane & 7;
#pragma unroll
    for (int j = 0; j < 4; ++j) { const int n = (lane >> 3) + 8 * j; const LAS float* s = scr + (8 * c) * 33 + n;
        v4u o; o.x = pk2(s[0 * 33], s[1 * 33]); o.y = pk2(s[2 * 33], s[3 * 33]); o.z = pk2(s[4 * 33], s[5 * 33]); o.w = pk2(s[6 * 33], s[7 * 33]);
        *(GAS v4u*)(WT + (size_t)(n0 + n) * K + k0 + 8 * c) = o; }
    LDS_WAIT(); asm volatile("" ::: "memory");
}
__device__ __forceinline__ void p0_prologue(const Args& A, LAS unsigned char* lds, int tid, int lane, int wave) {
    unsigned char* ws = A.ws;
    {
        LAS float* sc = (LAS float*)(lds);
        LAS float* red = (LAS float*)(lds + 20480);
        for (int i = tid; i < 5 * 1024; i += 512) { const int c = i >> 10, k = i & 1023; const float x = c == 0 ? A.in[8][k] : A.in[7][(c - 1) * 1024 + k]; sc[i] = x / (1.f + __expf(-x)); }
        __syncthreads();
        for (int ab = blockIdx.x; ab < 256; ab += gridDim.x) {
        const int layer = ab >> 7, n0 = (ab & 127) * 48;
        const float* W = A.in[11] + (size_t)layer * 1024 * 6144 + n0;
        const int kq = lane / 12, nq = lane % 12;
        f32x4 acc[5];
#pragma unroll
        for (int c = 0; c < 5; ++c) acc[c] = (f32x4){0.f, 0.f, 0.f, 0.f};
        if (kq < 4) {
#pragma unroll 4
            for (int i = 0; i < 32; ++i) { const int k = 128 * wave + 4 * i + kq; const f32x4 w = *(const f32x4*)(W + (size_t)k * 6144 + 4 * nq);
#pragma unroll
                for (int c = 0; c < 5; ++c) acc[c] += w * sc[c * 1024 + k]; }
#pragma unroll
            for (int c = 0; c < 5; ++c) *(LAS f32x4*)(red + ((wave * 4 + kq) * 5 + c) * 48 + 4 * nq) = acc[c];
        }
        __syncthreads();
        if (tid < 240) { const int c = tid / 48, n = tid % 48; float s = 0.f;
#pragma unroll 8
            for (int p = 0; p < 32; ++p) s += red[(p * 5 + c) * 48 + n];
            ((float*)(ws + WS_ADA))[(size_t)(layer * 5 + c) * 6144 + n0 + n] = s + A.in[12][layer * 6144 + n0 + n]; }
        __syncthreads();
        }
    }
    LAS float* scr = (LAS float*)(lds + wave * 16384);
    const int gw = blockIdx.x * NWAVES + wave, NGW = gridDim.x * NWAVES;
    constexpr int I_IN = 16 * 65, I_OUT = 16 * 32, I_GLU = 8 * 16, I_M1 = 16 * 128, I_M2 = 64 * 32, I_QKV = 16 * 48, I_WO = 16 * 32;
    constexpr int NITEMS = I_IN + I_OUT + I_GLU + 2 * I_M1 + 2 * I_M2 + I_QKV + I_WO;
    for (int it = gw; it < NITEMS; it += NGW) {
        int r = it;
        if (r < I_IN) { const int kb = r / 65, nb = r % 65;
            if (nb < 64) p0_transpose_item(A.in[15], INE, 1024, (bf16*)(ws + WS_WIN), 64, scr, kb * 64 + nb, lane);
            else p0_transpose_item(A.in[15] + 2048, INE, 1024, (bf16*)(ws + WS_WGLR), 1, scr, kb, lane);
            continue; } r -= I_IN;
        if (r < I_OUT) { p0_transpose_item(A.in[16], 1024, 1024, (bf16*)(ws + WS_WOUT), 32, scr, r, lane); continue; } r -= I_OUT;
        if (r < I_GLU) { p0_transpose_item(A.in[25], 512, 512, (bf16*)(ws + WS_WGLU), 16, scr, r, lane); continue; } r -= I_GLU;
        if (r < 2 * I_M1) { const int l = r / I_M1; p0_transpose_item(A.in[13] + (size_t)l * 1024 * 4096, 4096, 1024, (bf16*)(ws + WS_W1) + (size_t)l * 4096 * 1024, 128, scr, r % I_M1, lane); continue; } r -= 2 * I_M1;
        if (r < 2 * I_M2) { const int l = r / I_M2; p0_transpose_item(A.in[14] + (size_t)l * 4096 * 1024, 1024, 4096, (bf16*)(ws + WS_W2) + (size_t)l * 1024 * 4096, 32, scr, r % I_M2, lane); continue; } r -= 2 * I_M2;
        if (r < I_QKV) { p0_transpose_item(A.in[30], 1536, 1024, (bf16*)(ws + WS_WQKV), 48, scr, r, lane); continue; } r -= I_QKV;
        p0_transpose_item(A.in[31], 1024, 1024, (bf16*)(ws + WS_WO), 32, scr, r, lane);
    }
}

template <bool GLR>
__device__ __forceinline__ void norm_phase(const Args& A, LAS unsigned char* lds, const float* src_p, const float* src_s, const float* g, const float* ada, int ch_shift, int ch_scale,
                                           int tid, int lane, int wave) {
    unsigned char* ws = A.ws;
    bf16* H = (bf16*)(ws + WS_H);
    for (int blk = blockIdx.x; blk < NTOK / 32; blk += gridDim.x) {
        const int r0 = blk * 32; const int cond = r0 < NPR ? 0 : 1 + ((r0 - NPR) >> 10);
        const float* src = r0 < NPR ? src_p : src_s;
        const float* adc = ada + cond * 6144;
        f32x4 ga[4], gb[4];
#pragma unroll
        for (int j = 0; j < 4; ++j) { const int col = 4 * lane + 256 * j; const f32x4 gg = *(const f32x4*)(g + col), s1 = *(const f32x4*)(adc + ch_scale * 1024 + col); ga[j] = gg * (s1 + 1.0f); gb[j] = *(const f32x4*)(adc + ch_shift * 1024 + col); }
#pragma unroll
        for (int i = 0; i < 4; ++i) { const int row = r0 + wave * 4 + i;
            const GAS f32x4* xr = (const GAS f32x4*)(src + (size_t)row * 1024) + lane;
            f32x4 v[4]; float s = 0.f;
#pragma unroll
            for (int j = 0; j < 4; ++j) { v[j] = xr[64 * j]; s += (v[j].x * v[j].x + v[j].y * v[j].y) + (v[j].z * v[j].z + v[j].w * v[j].w); }
            const float rstd = 1.f / sqrtf(wave_sum(s) * (1.f / 1024.f) + EPS);
            GAS v2u* o8 = (GAS v2u*)(H + (size_t)row * 1024) + lane;
#pragma unroll
            for (int j = 0; j < 4; ++j) { const f32x4 h = v[j] * rstd * ga[j] + gb[j]; v2u w; w.x = pk2(h.x, h.y); w.y = pk2(h.z, h.w); o8[64 * j] = w;
                if (GLR) *(LAS v2u*)(lds + (wave * 4 + i) * 2064 + (4 * lane + 256 * j) * 2) = w; }
        }
        if (GLR) {
            __syncthreads();
            const bf16* WG = (const bf16*)(ws + WS_WGLR);
            const int r32 = lane & 31, hi = lane >> 5;
            f32x16 acc = {};
#pragma unroll
            for (int ks = 0; ks < 8; ++ks) { const int k = wave * 128 + ks * 16 + hi * 8;
                const bf16x8 a = *(const LAS bf16x8*)(lds + r32 * 2064 + k * 2);
                const bf16x8 b = *(const bf16x8*)(WG + (size_t)r32 * 1024 + k);
                acc = __builtin_amdgcn_mfma_f32_32x32x16_bf16(a, b, acc, 0, 0, 0); }
            LAS float* red = (LAS float*)(lds + 69632);
#pragma unroll
            for (int r = 0; r < 16; ++r) red[(wave * 32 + crow(r, hi)) * 32 + r32] = acc[r];
            __syncthreads();
            float* GLRo = (float*)(ws + WS_GLR);
#pragma unroll
            for (int e = 0; e < 2; ++e) { const int idx = tid + 512 * e; float s = 0.f;
#pragma unroll
                for (int w = 0; w < 8; ++w) s += red[w * 1024 + idx];
                GLRo[(size_t)(r0 + (idx >> 5)) * 32 + (idx & 31)] = s; }
            __syncthreads();
        }
    }
}

__device__ __forceinline__ float gelu_tanh(float y) { const float z = 0.7978845608028654f * (y + 0.044715f * y * y * y); const float e = __expf(2.f * z); const float t = 1.f - 2.f / (e + 1.f); return 0.5f * y * (1.f + t); }
__device__ __forceinline__ void s5_wave(const Args& A, LAS unsigned char* wl, LAS float* xch, bool sample, int b, int g, int ck, int pair, int lane) {
    unsigned char* ws = A.ws;
    const bf16* Z = (const bf16*)(ws + WS_Z); float* YF = (float*)(ws + WS_YF); bf16* G = (bf16*)(ws + WS_G);
    const int row0 = sample ? NPR + b * 1024 + ck * 256 : b * 256;
    LAS float* BU = (LAS float*)wl;
    LAS unsigned short* HL = (LAS unsigned short*)(wl + 8448);
    const int fr = lane & 15, fq = lane >> 4;
    bf16x8 cc[4];
#pragma unroll
    for (int ks = 0; ks < 4; ++ks) { const int k = 32 * ks + 8 * fq; const bool im = k >= 64; const float* src = (im ? A.in[23] : A.in[22]) + (size_t)(g * 16 + fr) * 64 + (k & 63);
        const f32x4 a = *(const f32x4*)src, bq = *(const f32x4*)(src + 4); const float sg = im ? -1.f : 1.f;
        v4u w; w.x = pk2(sg * a.x, sg * a.y); w.y = pk2(sg * a.z, sg * a.w); w.z = pk2(sg * bq.x, sg * bq.y); w.w = pk2(sg * bq.z, sg * bq.w); cc[ks] = __builtin_bit_cast(bf16x8, w); }
    const f32x4 dsk = *(const f32x4*)(A.in[24] + g * 16 + 4 * fq);
    float hin_re0 = 0.f, hin_re1 = 0.f, hin_im0 = 0.f, hin_im1 = 0.f;
    for (int pass = sample ? 0 : 1; pass < 2; ++pass) {
        for (int d = 0; d < 2; ++d) {
            const float lre = A.in[17][(d * 32 + g) * 64 + lane], lim = A.in[18][(d * 32 + g) * 64 + lane];
            const float dt = expf(A.in[19][d * 32 + g]);
            const float a_ = lre * dt, th = lim * dt;
            float sn, cs; sincosf(th, &sn, &cs);
            const float ea = expf(a_);
            const float lb_re = ea * cs, lb_im = ea * sn;
            const float sh = sinf(0.5f * th);
            const float nr = expm1f(a_) * cs - 2.f * sh * sh, ni = ea * sn;
            const float den = 1.f / (lre * lre + lim * lim);
            const float cf_re = (nr * lre + ni * lim) * den, cf_im = (ni * lre - nr * lim) * den;
            bf16x8 bb[8];
#pragma unroll
            for (int T = 0; T < 8; ++T) { const int p = 16 * (T & 3) + fr; const float cre = __shfl(cf_re, p), cim = __shfl(cf_im, p);
                v4u w = {0u, 0u, 0u, 0u};
                if (fq < 2) { const float* pr = A.in[20] + (size_t)(g * 64 + p) * 16 + 8 * fq; const float* pi = A.in[21] + (size_t)(g * 64 + p) * 16 + 8 * fq;
                    const f32x4 r0 = *(const f32x4*)pr, r1 = *(const f32x4*)(pr + 4), i0 = *(const f32x4*)pi, i1 = *(const f32x4*)(pi + 4);
                    f32x4 o0, o1;
                    if (T < 4) { o0 = r0 * cre - i0 * cim; o1 = r1 * cre - i1 * cim; } else { o0 = i0 * cre + r0 * cim; o1 = i1 * cre + r1 * cim; }
                    w.x = pk2(o0.x, o0.y); w.y = pk2(o0.z, o0.w); w.z = pk2(o1.x, o1.y); w.w = pk2(o1.z, o1.w); }
                bb[T] = __builtin_bit_cast(bf16x8, w); }
            float h_re, h_im;
            if (pass == 0) { h_re = 0.f; h_im = 0.f; }
            else { h_re = d == 0 ? hin_re0 : hin_re1; h_im = d == 0 ? hin_im0 : hin_im1; }
            for (int sci = 0; sci < 16; ++sci) {
                const int sc = d == 0 ? sci : 15 - sci; const int t0 = row0 + 16 * sc;
                v4u uw = {0u, 0u, 0u, 0u};
                if (fq < 2) uw = *(const v4u*)(Z + (size_t)(t0 + fr) * 2048 + g * 16 + 8 * fq);
                const bf16x8 uf = __builtin_bit_cast(bf16x8, uw);
#pragma unroll
                for (int T = 0; T < 8; ++T) { f32x4 acc = {0.f, 0.f, 0.f, 0.f}; acc = __builtin_amdgcn_mfma_f32_16x16x32_bf16(bb[T], uf, acc, 0, 0, 0);
                    *(LAS f32x4*)(BU + fr * 132 + 16 * T + 4 * fq) = acc; }
                LDS_WAIT();
#pragma unroll
                for (int ii = 0; ii < 16; ++ii) { const int i = d == 0 ? ii : 15 - ii;
                    const float br = BU[i * 132 + lane], bi = BU[i * 132 + 64 + lane];
                    const float nre = fmaf(lb_re, h_re, fmaf(-lb_im, h_im, br)), nim = fmaf(lb_re, h_im, fmaf(lb_im, h_re, bi));
                    h_re = nre; h_im = nim;
                    if (pass == 1) { HL[i * 136 + lane] = (unsigned short)f2bf(h_re); HL[i * 136 + 64 + lane] = (unsigned short)f2bf(h_im);
                        if (!sample && sci == 0 && ii == 0) { A.out[OUT_S5RE + (size_t)((b * 2 + d) * 32 + g) * 64 + lane] = h_re; A.out[OUT_S5IM + (size_t)((b * 2 + d) * 32 + g) * 64 + lane] = h_im; } }
                }
                if (pass == 1) {
                    LDS_WAIT();
                    f32x4 y = {0.f, 0.f, 0.f, 0.f};
#pragma unroll
                    for (int ks = 0; ks < 4; ++ks) { const bf16x8 hf = *(const LAS bf16x8*)((LAS unsigned char*)HL + fr * 272 + (32 * ks + 8 * fq) * 2);
                        y = __builtin_amdgcn_mfma_f32_16x16x32_bf16(cc[ks], hf, y, 0, 0, 0); }
                    float* yfp = YF + (size_t)(t0 + fr) * 512 + g * 16 + 4 * fq;
                    if (d == 0) *(f32x4*)yfp = y;
                    else { const f32x4 yf = *(const f32x4*)yfp; const v2u uu = *(const v2u*)(Z + (size_t)(t0 + fr) * 2048 + g * 16 + 4 * fq);
                        f32x4 u4; u4.x = bflo(uu.x); u4.y = bfhi(uu.x); u4.z = bflo(uu.y); u4.w = bfhi(uu.y);
                        const f32x4 yy = y + yf + dsk * u4;
                        v2u o; o.x = pk2(gelu_tanh(yy.x), gelu_tanh(yy.y)); o.y = pk2(gelu_tanh(yy.z), gelu_tanh(yy.w));
                        *(v2u*)(G + (size_t)(t0 + fr) * 512 + g * 16 + 4 * fq) = o; }
                    LDS_WAIT();
                }
            }
            if (pass == 0) {
                xch[(((pair * 4 + ck) * 2 + d) * 2 + 0) * 64 + lane] = h_re; xch[(((pair * 4 + ck) * 2 + d) * 2 + 1) * 64 + lane] = h_im;
            }
        }
        if (pass == 0) {
            __syncthreads();
            for (int d = 0; d < 2; ++d) {
                const float lre = A.in[17][(d * 32 + g) * 64 + lane], lim = A.in[18][(d * 32 + g) * 64 + lane];
                const float dt = expf(A.in[19][d * 32 + g]);
                float sn, cs; sincosf(lim * dt, &sn, &cs); const float ea = expf(lre * dt);
                float pr = ea * cs, pi = ea * sn;
#pragma unroll
                for (int s = 0; s < 8; ++s) { const float nr = pr * pr - pi * pi, ni = 2.f * pr * pi; pr = nr; pi = ni; }
                float hr = A.in[2][(size_t)((b * 2 + d) * 32 + g) * 64 + lane], hi_ = A.in[3][(size_t)((b * 2 + d) * 32 + g) * 64 + lane];
                if (d == 0) { for (int j = 0; j < ck; ++j) { const float er = xch[(((pair * 4 + j) * 2 + 0) * 2 + 0) * 64 + lane], ei = xch[(((pair * 4 + j) * 2 + 0) * 2 + 1) * 64 + lane];
                        const float nr = pr * hr - pi * hi_ + er, ni = pr * hi_ + pi * hr + ei; hr = nr; hi_ = ni; } }
                else { for (int j = 3; j > ck; --j) { const float er = xch[(((pair * 4 + j) * 2 + 1) * 2 + 0) * 64 + lane], ei = xch[(((pair * 4 + j) * 2 + 1) * 2 + 1) * 64 + lane];
                        const float nr = pr * hr - pi * hi_ + er, ni = pr * hi_ + pi * hr + ei; hr = nr; hi_ = ni; } }
                if (d == 0) { hin_re0 = hr; hin_im0 = hi_; } else { hin_re1 = hr; hin_im1 = hi_; }
            }
        }
    }
}

__device__ __forceinline__ int gla_slot(int bb, int h, int d, int j) { return bb < 16 ? ((bb * 4 + h) * 2 + d) * 4 + j : 512 + (((bb - 16) * 4 + h) * 2 + d) * 16 + j; }
constexpr int GL_V = 0, GL_VROW = 320;
constexpr int GL_KT = 20480, GL_KTROW = 144;
constexpr int GL_TOT = GL_KT + 4 * 9216;
constexpr int GL_PART = GL_TOT + 2048;
constexpr int GL_BYTES = GL_PART + 1024;
template <int MODE>
__device__ __forceinline__ void gla_prep(const Args& A, LAS unsigned char* lds, int bb, int h, int j, int row0, int tid, int lane, int wave) {
    unsigned char* ws = A.ws;
    const bf16* Z = (const bf16*)(ws + WS_Z); const float* GLRi = (const float*)(ws + WS_GLR);
    const int d = wave >> 2, wg = wave & 3;
#pragma unroll
    for (int i = 0; i < 2; ++i) { const int r = (tid >> 4) + 32 * i, c = tid & 15;
        const v4u v = *(const v4u*)(Z + (size_t)(row0 + r) * 2048 + 1024 + h * 128 + 8 * c);
        *(LAS v4u*)(lds + GL_V + r * GL_VROW + c * 16) = v; }
    float wg2[16];
#pragma unroll
    for (int r = 0; r < 16; ++r) wg2[r] = A.in[27][(size_t)(d * 16 + r) * 256 + h * 64 + lane];
    const float bg = A.in[28][d * 256 + h * 64 + lane];
    float gd[16]; float tot = 0.f;
#pragma unroll
    for (int i = 0; i < 16; ++i) { const float* gp = GLRi + (size_t)(row0 + 16 * wg + i) * 32 + 16 * d;
        float x = bg;
#pragma unroll
        for (int r = 0; r < 16; ++r) x = fmaf(gp[r], wg2[r], x);
        const float ls = fminf(x, 0.f) - log1pf(__expf(-fabsf(x)));
        gd[i] = ls * (1.f / 16.f); tot += gd[i]; }
    LAS float* TOT = (LAS float*)(lds + GL_TOT);
    TOT[(d * 4 + wg) * 64 + lane] = tot;
    __syncthreads();
    float off = 0.f, total = 0.f;
#pragma unroll
    for (int w = 0; w < 4; ++w) { const float tw = TOT[(d * 4 + w) * 64 + lane]; total += tw; if (d == 0 ? (w < wg) : (w > wg)) off += tw; }
    float bcum[16];
    if (d == 0) { float s = off;
#pragma unroll
        for (int i = 0; i < 16; ++i) { s += gd[i]; bcum[i] = s; } }
    else { float s = off;
#pragma unroll
        for (int i = 15; i >= 0; --i) { s += gd[i]; bcum[i] = s; } }
    LAS unsigned char* img = lds + GL_KT + d * 2 * 9216;
    if (MODE == 0) {
        unsigned pkk[8];
#pragma unroll
        for (int i = 0; i < 16; i += 2) { const float k0 = bf2f(Z[(size_t)(row0 + 16 * wg + i) * 2048 + 768 + h * 64 + lane]), k1 = bf2f(Z[(size_t)(row0 + 16 * wg + i + 1) * 2048 + 768 + h * 64 + lane]);
            pkk[i >> 1] = pk2(k0 * __expf(total - bcum[i]), k1 * __expf(total - bcum[i + 1])); }
        *(LAS v4u*)(img + lane * GL_KTROW + 32 * wg) = (v4u){pkk[0], pkk[1], pkk[2], pkk[3]};
        *(LAS v4u*)(img + lane * GL_KTROW + 32 * wg + 16) = (v4u){pkk[4], pkk[5], pkk[6], pkk[7]};
        if (wg == 0) ((float*)(ws + WS_DEC))[(size_t)gla_slot(bb, h, d, j) * 64 + lane] = __expf(total);
    } else {
#pragma unroll
        for (int i = 0; i < 16; ++i) { const size_t zr = (size_t)(row0 + 16 * wg + i) * 2048 + h * 64 + lane;
            const float q = bf2f(Z[zr + 512]) * 0.125f, k = bf2f(Z[zr + 768]);
            *(LAS unsigned short*)(img + (16 * wg + i) * GL_KTROW + lane * 2) = (unsigned short)f2bf(q * __expf(bcum[i]));
            *(LAS unsigned short*)(img + 9216 + (16 * wg + i) * GL_KTROW + lane * 2) = (unsigned short)f2bf(k * __expf(-bcum[i])); }
    }
    __syncthreads();
}
__device__ __forceinline__ void gla_task_rows(int task, int& bb, int& h, int& j, int& row0) {
    if (task < 256) { bb = task >> 4; h = (task >> 2) & 3; j = task & 3; row0 = bb * 256 + 64 * j; }
    else { const int t = task - 256; bb = 16 + (t >> 6); h = (t >> 4) & 3; j = t & 15; row0 = NPR + (bb - 16) * 1024 + 64 * j; }
}
__device__ __forceinline__ void gla_a_task(const Args& A, LAS unsigned char* lds, int task, int tid, int lane, int wave) {
    int bb, h, j, row0; gla_task_rows(task, bb, h, j, row0);
    gla_prep<0>(A, lds, bb, h, j, row0, tid, lane, wave);
    const int d = wave >> 2, wg = wave & 3, r32 = lane & 31, hi = lane >> 5;
    const unsigned lbase = (unsigned)(uintptr_t)(lds);
    const unsigned vaddr = lbase + GL_V + (8 * hi + ((lane & 15) >> 2)) * GL_VROW + (32 * wg + 16 * ((lane >> 4) & 1) + 4 * (lane & 3)) * 2;
    LAS unsigned char* img = lds + GL_KT + d * 2 * 9216;
    f32x16 acc0 = {}, acc1 = {};
#pragma unroll
    for (int ks = 0; ks < 4; ++ks) {
        const s16x4 lo = tr_read4(vaddr + (16 * ks) * GL_VROW), hi4 = tr_read4(vaddr + (16 * ks + 4) * GL_VROW);
        const bf16x8 b0 = *(const LAS bf16x8*)(img + r32 * GL_KTROW + (16 * ks + 8 * hi) * 2);
        const bf16x8 b1 = *(const LAS bf16x8*)(img + (32 + r32) * GL_KTROW + (16 * ks + 8 * hi) * 2);
        asm volatile("s_waitcnt lgkmcnt(0)" ::: "memory"); __builtin_amdgcn_sched_barrier(0);
        const bf16x8 a = (bf16x8){lo[0], lo[1], lo[2], lo[3], hi4[0], hi4[1], hi4[2], hi4[3]};
        acc0 = __builtin_amdgcn_mfma_f32_32x32x16_bf16(a, b0, acc0, 0, 0, 0);
        acc1 = __builtin_amdgcn_mfma_f32_32x32x16_bf16(a, b1, acc1, 0, 0, 0);
    }
    float* SL = (float*)(A.ws + WS_SLOC) + (size_t)gla_slot(bb, h, d, j) * 8192;
#pragma unroll
    for (int r = 0; r < 16; ++r) { const int v = 32 * wg + crow(r, hi); SL[v * 64 + r32] = acc0[r]; SL[v * 64 + 32 + r32] = acc1[r]; }
    __syncthreads();
}
__device__ __forceinline__ void gla_b_phase(const Args& A, int gtid, int nthreads) {
    unsigned char* ws = A.ws;
    const float* SL = (const float*)(ws + WS_SLOC); const float* DEC = (const float*)(ws + WS_DEC); bf16* SIN = (bf16*)(ws + WS_SIN);
    for (int it = gtid; it < 160 * 2048; it += nthreads) {
        const int s = it >> 11, e = it & 2047;
        const int grp = s / 5, m = s % 5; const int chain = m == 4 ? 128 + grp : grp * 4 + m;
        const bool samp = chain >= 128; const int ci = samp ? chain - 128 : chain;
        const int bb = (samp ? 16 : 0) + (ci >> 3), h = (ci >> 1) & 3, d = ci & 1, n = samp ? 16 : 4;
        const int v = e >> 4, kk = (e & 15) * 4;
        f32x4 S = {0.f, 0.f, 0.f, 0.f};
        if (samp) { const float* s0 = A.in[4] + (size_t)(((bb - 16) * 2 + d) * 4 + h) * 8192;
#pragma unroll
            for (int q = 0; q < 4; ++q) S[q] = s0[(kk + q) * 128 + v]; }
        for (int i = 0; i < n; ++i) { const int j = d == 0 ? i : n - 1 - i; const size_t slot = (size_t)gla_slot(bb, h, d, j);
            v2u w; w.x = pk2(S.x, S.y); w.y = pk2(S.z, S.w); *(v2u*)(SIN + slot * 8192 + v * 64 + kk) = w;
            const f32x4 dc = *(const f32x4*)(DEC + slot * 64 + kk), sl = *(const f32x4*)(SL + slot * 8192 + v * 64 + kk);
            S = S * dc + sl; }
        if (!samp) { float* o = A.out + OUT_GLA + (size_t)((bb * 2 + d) * 4 + h) * 8192;
#pragma unroll
            for (int q = 0; q < 4; ++q) o[(kk + q) * 128 + v] = S[q]; }
    }
}
__device__ __forceinline__ void gla_c_task(const Args& A, LAS unsigned char* lds, int task, int tid, int lane, int wave) {
    int bb, h, j, row0; gla_task_rows(task, bb, h, j, row0);
    gla_prep<1>(A, lds, bb, h, j, row0, tid, lane, wave);
    unsigned char* ws = A.ws;
    const bf16* Z = (const bf16*)(ws + WS_Z); const bf16* SIN = (const bf16*)(ws + WS_SIN); bf16* MIX = (bf16*)(ws + WS_MIX);
    const int ti = wave >> 2, vi = wave & 3, r32 = lane & 31, hi = lane >> 5;
    const unsigned lbase = (unsigned)(uintptr_t)(lds);
    const unsigned vaddr = lbase + GL_V + (4 * hi + ((lane & 15) >> 2)) * GL_VROW + (32 * vi + 16 * ((lane >> 4) & 1) + 4 * (lane & 3)) * 2;
    f32x16 o = {};
    const int t = 32 * ti + r32;
#pragma unroll
    for (int d = 0; d < 2; ++d) {
        LAS unsigned char* qimg = lds + GL_KT + d * 2 * 9216; LAS unsigned char* kimg = qimg + 9216;
        bf16x8 qf[4];
#pragma unroll
        for (int ks = 0; ks < 4; ++ks) qf[ks] = *(const LAS bf16x8*)(qimg + t * GL_KTROW + (16 * ks + 8 * hi) * 2);
        const bf16* SI = SIN + (size_t)gla_slot(bb, h, d, j) * 8192 + (size_t)(32 * vi + r32) * 64 + 8 * hi;
#pragma unroll
        for (int ks = 0; ks < 4; ++ks) { const bf16x8 sa = *(const bf16x8*)(SI + 16 * ks); o = __builtin_amdgcn_mfma_f32_32x32x16_bf16(sa, qf[ks], o, 0, 0, 0); }
#pragma unroll
        for (int si = 0; si < 2; ++si) {
            f32x16 x = {};
#pragma unroll
            for (int ks = 0; ks < 4; ++ks) { const bf16x8 ka = *(const LAS bf16x8*)(kimg + (32 * si + r32) * GL_KTROW + (16 * ks + 8 * hi) * 2); x = __builtin_amdgcn_mfma_f32_32x32x16_bf16(ka, qf[ks], x, 0, 0, 0); }
            unsigned pw[8];
#pragma unroll
            for (int r = 0; r < 16; r += 2) { const int s0 = 32 * si + crow(r, hi), s1 = s0 + 1;
                const float x0 = (d == 0 ? (s0 <= t) : (s0 >= t)) ? x[r] : 0.f, x1 = (d == 0 ? (s1 <= t) : (s1 >= t)) ? x[r + 1] : 0.f;
                pw[r >> 1] = pk2(x0, x1); }
#pragma unroll
            for (int sp = 0; sp < 2; ++sp) {
                const s16x4 lo = tr_read4(vaddr + (32 * si + 16 * sp) * GL_VROW), hi4 = tr_read4(vaddr + (32 * si + 16 * sp + 8) * GL_VROW);
                asm volatile("s_waitcnt lgkmcnt(0)" ::: "memory"); __builtin_amdgcn_sched_barrier(0);
                const bf16x8 va = (bf16x8){lo[0], lo[1], lo[2], lo[3], hi4[0], hi4[1], hi4[2], hi4[3]};
                const v4u pq = {pw[4 * sp], pw[4 * sp + 1], pw[4 * sp + 2], pw[4 * sp + 3]};
                o = __builtin_amdgcn_mfma_f32_32x32x16_bf16(va, __builtin_bit_cast(bf16x8, pq), o, 0, 0, 0);
            }
        }
    }
    float ss = 0.f;
#pragma unroll
    for (int r = 0; r < 16; ++r) ss += o[r] * o[r];
    ss += __shfl_xor(ss, 32);
    LAS float* PART = (LAS float*)(lds + GL_PART);
    if (hi == 0) PART[(ti * 4 + vi) * 32 + r32] = ss;
    __syncthreads();
    const float tot = PART[(ti * 4 + 0) * 32 + r32] + PART[(ti * 4 + 1) * 32 + r32] + PART[(ti * 4 + 2) * 32 + r32] + PART[(ti * 4 + 3) * 32 + r32];
    const float rstd = 1.f / sqrtf(tot * (1.f / 128.f) + EPS);
    const size_t row = (size_t)(row0 + t);
#pragma unroll
    for (int rq = 0; rq < 4; ++rq) { const int v = 32 * vi + 8 * rq + 4 * hi;
        const v2u rr = *(const v2u*)(Z + row * 2048 + 1536 + h * 128 + v);
        const f32x4 gn = *(const f32x4*)(A.in[29] + v);
        float rv[4] = {bflo(rr.x), bfhi(rr.x), bflo(rr.y), bfhi(rr.y)}; float ov[4];
#pragma unroll
        for (int e = 0; e < 4; ++e) { const float sl = rv[e] / (1.f + __expf(-rv[e])); ov[e] = o[4 * rq + e] * rstd * gn[e] * sl; }
        v2u w; w.x = pk2(ov[0], ov[1]); w.y = pk2(ov[2], ov[3]);
        *(v2u*)(MIX + row * 1024 + 512 + h * 128 + v) = w; }
    __syncthreads();
}

__device__ __forceinline__ void qk_phase(const Args& A, int lane, int gw, int ngw) {
    unsigned char* ws = A.ws;
    const bf16* QKV = (const bf16*)(ws + WS_QKV); bf16* QN = (bf16*)(ws + WS_QN);
    const float qw0 = A.in[32][2 * lane], qw1 = A.in[32][2 * lane + 1], kw0 = A.in[33][2 * lane], kw1 = A.in[33][2 * lane + 1];
    const float inv = __powf(10000.f, -(float)(2 * (lane & 31)) / 64.f);
    for (int row = gw; row < NTOK + 2048; row += ngw) {
        if (row >= NTOK) {
            const int cr = row - NTOK, b = cr >> 9, pl = cr & 511;
            const f32x4 kx = *(const f32x4*)(A.in[5] + (size_t)(b * 512 + pl) * 256 + 4 * lane), vx = *(const f32x4*)(A.in[6] + (size_t)(b * 512 + pl) * 256 + 4 * lane);
            v2u kwd, vwd; kwd.x = pk2(kx.x, kx.y); kwd.y = pk2(kx.z, kx.w); vwd.x = pk2(vx.x, vx.y); vwd.y = pk2(vx.z, vx.w);
            *(v2u*)((bf16*)(ws + WS_KS) + (size_t)(b * 1536 + 1024 + pl) * 256 + 4 * lane) = kwd;
            *(v2u*)((bf16*)(ws + WS_VS) + (size_t)(b * 1536 + 1024 + pl) * 256 + 4 * lane) = vwd;
            continue;
        }
        const bool samp = row >= NPR; const int b = samp ? (row - NPR) >> 10 : row >> 8, t = samp ? (row - NPR) & 1023 : row & 255;
        float cs = 1.f, sn = 0.f;
        if (samp) { const float pos = (float)(lane < 32 ? (t >> 6) : (t & 63)); sincosf(pos * inv, &sn, &cs); }
        const unsigned* src = (const unsigned*)(QKV + (size_t)row * QKVW);
        bf16* kdst = samp ? (bf16*)(ws + WS_KS) + (size_t)(b * 1536 + t) * 256 : (bf16*)(ws + WS_KP) + (size_t)row * 256;
        bf16* vdst = samp ? (bf16*)(ws + WS_VS) + (size_t)(b * 1536 + t) * 256 : (bf16*)(ws + WS_VP) + (size_t)row * 256;
#pragma unroll
        for (int hd = 0; hd < 10; ++hd) {
            const unsigned w = src[hd * 64 + lane]; float x0 = bflo(w), x1 = bfhi(w);
            const float rstd = 1.f / sqrtf(wave_sum(x0 * x0 + x1 * x1) * (1.f / 128.f) + EPS);
            x0 *= rstd * (hd < 8 ? qw0 : kw0); x1 *= rstd * (hd < 8 ? qw1 : kw1);
            if (hd >= 8 && !samp) { float* nk = A.out + OUT_NK + ((size_t)row * 2 + (hd - 8)) * 128 + 2 * lane; nk[0] = x0; nk[1] = x1; }
            const float y0 = x0 * cs - x1 * sn, y1 = x0 * sn + x1 * cs;
            const unsigned ow = pk2(y0, y1);
            if (hd < 8) ((unsigned*)(QN + (size_t)row * 1024))[hd * 64 + lane] = ow;
            else ((unsigned*)kdst)[(hd - 8) * 64 + lane] = ow;
        }
#pragma unroll
        for (int hv = 0; hv < 2; ++hv) { const unsigned w = src[(10 + hv) * 64 + lane]; ((unsigned*)vdst)[hv * 64 + lane] = w;
            if (!samp) { float* nv = A.out + OUT_NV + ((size_t)row * 2 + hv) * 128 + 2 * lane; nv[0] = bflo(w); nv[1] = bfhi(w); } }
    }
}

__global__ void __launch_bounds__(NWAVES * 64, 2) fwd_kernel(Args args) {
    extern __shared__ __attribute__((aligned(16))) unsigned char lds_raw[];
    LAS unsigned char* lds = (LAS unsigned char*)lds_raw;
    volatile LAS unsigned* MISC = (volatile LAS unsigned*)(lds + MISC_OFF);
    const int tid = threadIdx.x, lane = tid & 63, wave = __builtin_amdgcn_readfirstlane(tid >> 6);
    const int G = gridDim.x;
    unsigned char* ws = args.ws;
    gu32* ctl = (gu32*)(ws + WS_CTL);
    for (int u = tid; u < (LDS_BYTES - LDSCTL_OFF) / 4; u += NWAVES * 64) ((LAS unsigned*)(lds + LDSCTL_OFF))[u] = 0u;
    __syncthreads();
    const int lo = args.ph_lo, hi = args.ph_hi;
    const bool use_bar = (hi - lo) > 1;
    XcdBarrier bar; bar.bar = (unsigned*)(ctl + CW_BAR); bar.x = 0; bar.st = nullptr;
    if (use_bar) bar = xcd_barrier_post((unsigned*)(ctl + CW_BAR), MISC + 8);
#define IN(k) (lo <= (k) && (k) < hi)
#define SEAM(k) do { if ((k) + 1 < hi) xcd_barrier(bar); } while (0)
    const float* ADA = (const float*)(ws + WS_ADA);
    bf16* H = (bf16*)(ws + WS_H); float* Y = (float*)(ws + WS_Y);
    const float* xs_off = args.in[1] - (size_t)NPR * 1024;

    if (IN(0)) { p0_prologue(args, lds, tid, lane, wave); SEAM(0); }
    if (IN(1)) { norm_phase<true>(args, lds, args.in[0], xs_off, args.in[9], ADA, 0, 1, tid, lane, wave); SEAM(1); }
    if (IN(2)) { pg8::Gemm g{H, (const bf16*)(ws + WS_WIN), NTOK, INW, 1024}; pg8::StaticOrder S; S.init(NTOK, INW, G, (int)blockIdx.x);
        pg8::EpiBf16<0> E{(bf16*)(ws + WS_Z), INW};
        pg8::gemm_phase<pg8::EpiBf16<0>, pg8::StaticOrder, true, true>(lds, g, S, E); SEAM(2); }
    if (IN(3)) {
        for (int vb = blockIdx.x; vb < 256; vb += G) {
            if (vb < 64) { const int pg = vb * 2 + (wave >> 2); s5_wave(args, lds + wave * 12800, (LAS float*)(lds + 8 * 12800), true, pg >> 5, pg & 31, wave & 3, wave >> 2, lane); __syncthreads(); }
            else if (vb < 128) { const int idx = (vb - 64) * 8 + wave; s5_wave(args, lds + wave * 12800, (LAS float*)(lds + 8 * 12800), false, idx >> 5, idx & 31, 0, 0, lane); __syncthreads(); }
            else { for (int q = 0; q < 4; ++q) gla_a_task(args, lds, (vb - 128) * 4 + q, tid, lane, wave); }
        }
        SEAM(3); }
    if (IN(4)) {
        const int ngemm = G >= 128 ? 64 : G;
        if ((int)blockIdx.x < ngemm) { pg8::Gemm g{(const bf16*)(ws + WS_G), (const bf16*)(ws + WS_WGLU), NTOK, 512, 512}; pg8::StaticOrder S; S.init(NTOK, 512, ngemm, (int)blockIdx.x);
            pg8::EpiGlu E{(const bf16*)(ws + WS_G), (bf16*)(ws + WS_MIX), args.in[26]};
            pg8::gemm_phase<pg8::EpiGlu, pg8::StaticOrder, true, true>(lds, g, S, E); }
        if (G < 128 || (int)blockIdx.x >= ngemm) { const int nb = G < 128 ? G : G - ngemm, bi = G < 128 ? (int)blockIdx.x : (int)blockIdx.x - ngemm; gla_b_phase(args, bi * 512 + tid, nb * 512); }
        SEAM(4); }
    if (IN(5)) { for (int task = blockIdx.x; task < 512; task += G) gla_c_task(args, lds, task, tid, lane, wave); SEAM(5); }
    if (IN(6)) { pg8::Gemm g{(const bf16*)(ws + WS_MIX), (const bf16*)(ws + WS_WOUT), NTOK, 1024, 1024}; pg8::StaticOrder S; S.init(NTOK, 1024, G, (int)blockIdx.x);
        pg8::EpiResid E{args.in[0], xs_off, Y, ADA + 2 * 1024};
        pg8::gemm_phase<pg8::EpiResid, pg8::StaticOrder, true, true>(lds, g, S, E); SEAM(6); }
    if (IN(7)) { norm_phase<false>(args, lds, Y, Y, args.in[10], ADA, 3, 4, tid, lane, wave); SEAM(7); }
    if (IN(8)) { pg8::Gemm g{H, (const bf16*)(ws + WS_W1), NTOK, FF, 1024}; pg8::StaticOrder S; S.init(NTOK, FF, G, (int)blockIdx.x);
        pg8::EpiBf16<2> E{(bf16*)(ws + WS_ACT), FF};
        pg8::gemm_phase<pg8::EpiBf16<2>, pg8::StaticOrder, true, true>(lds, g, S, E); SEAM(8); }
    if (IN(9)) { pg8::Gemm g{(const bf16*)(ws + WS_ACT), (const bf16*)(ws + WS_W2), NTOK, 1024, FF}; pg8::StaticOrder S; S.init(NTOK, 1024, G, (int)blockIdx.x);
        pg8::EpiResid E{Y, Y, Y, ADA + 5 * 1024};
        pg8::gemm_phase<pg8::EpiResid, pg8::StaticOrder, true, true>(lds, g, S, E); SEAM(9); }
    const float* ADA1 = ADA + 5 * 6144;
    if (IN(10)) { norm_phase<false>(args, lds, Y, Y, args.in[9] + 1024, ADA1, 0, 1, tid, lane, wave); SEAM(10); }
    if (IN(11)) { pg8::Gemm g{H, (const bf16*)(ws + WS_WQKV), NTOK, QKVW, 1024}; pg8::StaticOrder S; S.init(NTOK, QKVW, G, (int)blockIdx.x);
        pg8::EpiBf16<0> E{(bf16*)(ws + WS_QKV), QKVW};
        pg8::gemm_phase<pg8::EpiBf16<0>, pg8::StaticOrder, true, true>(lds, g, S, E); SEAM(11); }
    if (IN(12)) { qk_phase(args, lane, blockIdx.x * NWAVES + wave, G * NWAVES); SEAM(12); }
    if (IN(13)) {
        const att::bf16* QN = (const att::bf16*)(ws + WS_QN); att::bf16* OB = (att::bf16*)(ws + WS_OB);
        for (int u = blockIdx.x; u < 256; u += G) {
            if (u < 128) { const int b = u >> 5, hq = (u >> 2) & 7, qb = u & 3; const size_t qrow = (size_t)NPR + b * 1024 + qb * 256;
                att::attn_dense_body<att::bf16>(QN + qrow * 1024 + hq * 128, (const att::bf16*)(ws + WS_KS) + (size_t)b * 1536 * 256 + (hq >> 2) * 128, (const att::bf16*)(ws + WS_VS) + (size_t)b * 1536 * 256 + (hq >> 2) * 128,
                                                OB + qrow * 1024 + hq * 128, 1536, (char*)lds_raw); }
            else { const int v = u - 128, b = v >> 3, hq = v & 7; const size_t qrow = (size_t)b * 256;
                att::attn_dense_body<att::bf16>(QN + qrow * 1024 + hq * 128, (const att::bf16*)(ws + WS_KP) + qrow * 256 + (hq >> 2) * 128, (const att::bf16*)(ws + WS_VP) + qrow * 256 + (hq >> 2) * 128,
                                                OB + qrow * 1024 + hq * 128, 256, (char*)lds_raw); }
            __syncthreads();
        }
        SEAM(13); }
    if (IN(14)) { pg8::Gemm g{(const bf16*)(ws + WS_OB), (const bf16*)(ws + WS_WO), NTOK, 1024, 1024}; pg8::StaticOrder S; S.init(NTOK, 1024, G, (int)blockIdx.x);
        pg8::EpiResid E{Y, Y, Y, ADA1 + 2 * 1024};
        pg8::gemm_phase<pg8::EpiResid, pg8::StaticOrder, true, true>(lds, g, S, E); SEAM(14); }
    if (IN(15)) { norm_phase<false>(args, lds, Y, Y, args.in[10] + 1024, ADA1, 3, 4, tid, lane, wave); SEAM(15); }
    if (IN(16)) { pg8::Gemm g{H, (const bf16*)(ws + WS_W1) + (size_t)4096 * 1024, NTOK, FF, 1024}; pg8::StaticOrder S; S.init(NTOK, FF, G, (int)blockIdx.x);
        pg8::EpiBf16<2> E{(bf16*)(ws + WS_ACT), FF};
        pg8::gemm_phase<pg8::EpiBf16<2>, pg8::StaticOrder, true, true>(lds, g, S, E); SEAM(16); }
    if (IN(17)) { pg8::Gemm g{(const bf16*)(ws + WS_ACT), (const bf16*)(ws + WS_W2) + (size_t)1024 * 4096, NTOK, 1024, FF}; pg8::StaticOrder S; S.init(NTOK, 1024, G, (int)blockIdx.x);
        pg8::EpiResid E{Y, Y, args.out + OUT_Y, ADA1 + 5 * 1024};
        pg8::gemm_phase<pg8::EpiResid, pg8::StaticOrder, true, true>(lds, g, S, E); }
#undef IN
#undef SEAM
}
constexpr int N_PHASES = 18;

#ifndef MK_ONE_LAUNCH
#define MK_ONE_LAUNCH 1
#endif
extern "C" void kernel_launch(void* const* d_in, const int* in_sizes, int n_in, void* d_out, int out_size, void* d_ws, size_t ws_size, hipStream_t stream) {
    static int grid = 0;
    if (grid == 0) {
        if (n_in != 34 || out_size != (int)OUT_END || ws_size < WS_END) { fprintf(stderr, "kernel_launch: unexpected shapes: n_in %d out %d ws %zu\n", n_in, out_size, ws_size); grid = -1; return; }
        int dev = 0, cus = 0, per_cu = 0;
        if (hipGetDevice(&dev) != hipSuccess || hipDeviceGetAttribute(&cus, hipDeviceAttributeMultiprocessorCount, dev) != hipSuccess) { grid = -1; return; }
        if (hipFuncSetAttribute((const void*)fwd_kernel, hipFuncAttributeMaxDynamicSharedMemorySize, LDS_BYTES) != hipSuccess) { fprintf(stderr, "kernel_launch: hipFuncSetAttribute failed\n"); grid = -1; return; }
        if (hipOccupancyMaxActiveBlocksPerMultiprocessor(&per_cu, (const void*)fwd_kernel, NWAVES * 64, LDS_BYTES) != hipSuccess || per_cu < 1) { fprintf(stderr, "kernel_launch: occupancy query says %d blocks per CU\n", per_cu); }
        (void)hipGetLastError();
        grid = cus < 256 ? cus : 256;
    }
    if (grid < 0) return;
    (void)hipMemsetAsync((char*)d_ws + WS_CTL, 0, CTL_ZERO_BYTES, stream);
    Args a{};
    for (int i = 0; i < 34; ++i) a.in[i] = (const float*)d_in[i];
    a.out = (float*)d_out; a.ws = (unsigned char*)d_ws;
#if MK_ONE_LAUNCH
    a.ph_lo = 0; a.ph_hi = N_PHASES;
    hipLaunchKernelGGL(fwd_kernel, dim3(grid), dim3(NWAVES * 64), LDS_BYTES, stream, a);
#else
    for (int p = 0; p < N_PHASES; ++p) { a.ph_lo = p; a.ph_hi = p + 1; hipLaunchKernelGGL(fwd_kernel, dim3(grid), dim3(NWAVES * 64), LDS_BYTES, stream, a); }
#endif
    const hipError_t le = hipPeekAtLastError();
    if (le != hipSuccess) fprintf(stderr, "kernel_launch: launch failed: %s\n", hipGetErrorName(le));
}
```

```cpp
#include <hip/hip_runtime.h>
#include <hip/hip_bf16.h>
#include <cstdio>
#include <cstdint>
#include <cmath>
namespace pg8 {
#define PG8_LAS __attribute__((address_space(3)))
typedef unsigned short bf16_t;
typedef short bf16x8 __attribute__((ext_vector_type(8)));
typedef float f32x4 __attribute__((ext_vector_type(4)));
typedef unsigned u32x4 __attribute__((ext_vector_type(4)));
constexpr int BM = 256, BK = 64, HALF = 128, HTB = HALF * BK * 2  , STAGE_BYTES = 8 * HTB, NXCD = 8, WGM = 8;

__host__ __device__ __forceinline__ int lds_byte(int r, int c) { const int st = (r >> 4) * 2 + (c >> 5), rr = r & 15, cc = c & 31, ob = rr * 64 + cc * 2; return st * 1024 + (ob ^ (((ob >> 9) & 1) << 5)); }
__host__ __device__ __forceinline__ void stage_rc(int b, int& R, int& C) { const int st = b / 1024, sb = b % 1024, swz = sb ^ (((sb >> 9) & 1) << 5); R = (st >> 1) * 16 + swz / 64; C = (st & 1) * 32 + (swz % 64) / 2; }
__host__ __device__ __forceinline__ int perm32(int rho) { const int n = rho >> 4, i = rho & 15; return 8 * (i >> 2) + 4 * n + (i & 3); }

struct Unit { int pm, pn; };
struct Gemm { const bf16_t* A; const bf16_t* Bt; int M, N, K, lda, ldb; };

struct StaticOrder {
    int nM, nN, nwg, G, c;
    __host__ __device__ void init(int M, int N, int G_, int c_) { nM = M / BM; nN = N / BM; nwg = nM * nN; G = G_; c = c_; }
    __host__ __device__ bool next(int i, Unit& u) const {
        const long L = (long)i * G + c; if (L >= nwg) return false;
        int wgid = (int)L; { const int q = nwg / NXCD, r = nwg % NXCD, xcd = wgid % NXCD, off = wgid / NXCD; wgid = (xcd < r ? xcd * (q + 1) : r * (q + 1) + (xcd - r) * q) + off; }
        const int nig = WGM * nN, gid = wgid / nig, fm = gid * WGM, gsz = (nM - fm) < WGM ? (nM - fm) : WGM;
        u.pm = fm + ((wgid % nig) % gsz); u.pn = (wgid % nig) / gsz; return true;
    }
    __device__ __forceinline__ void a_ready(const Unit&) const {}
    __device__ __forceinline__ void done(const Unit&) const {}
};

__device__ __forceinline__ unsigned cvt_pk_bf16(float lo, float hi) { unsigned r; asm volatile("v_cvt_pk_bf16_f32 %0, %1, %2" : "=v"(r) : "v"(lo), "v"(hi)); return r; }
typedef float f32x2 __attribute__((ext_vector_type(2)));
template <int ACT  > struct EpiBf16 {
    static constexpr bool PERM = true, AFTER_DRAIN = false;
    bf16_t* O; int ldc;
    __device__ __forceinline__ void operator()(const f32x4 (&acc)[2][2][4][2], const Unit& u, int wr, int wc, int fr, int fq) const {
        const int row0 = u.pm * BM + wr * 64 + fr; const int col0 = u.pn * BM + wc * 32 + 8 * fq;
#pragma unroll
        for (int ai = 0; ai < 2; ++ai)
#pragma unroll
            for (int m = 0; m < 4; ++m) { bf16_t* rowp = O + (size_t)(row0 + ai * HALF + m * 16) * ldc + col0;
#pragma unroll
                for (int bj = 0; bj < 2; ++bj) { f32x4 v0 = acc[ai][bj][m][0], v1 = acc[ai][bj][m][1];
                    if (ACT == 2) {
#pragma unroll
                        for (int e = 0; e < 4; ++e) { float a = v0[e] > 0.f ? v0[e] : 0.f; v0[e] = a * a; float b = v1[e] > 0.f ? v1[e] : 0.f; v1[e] = b * b; } }
                    u32x4 w; w.x = cvt_pk_bf16(v0[0], v0[1]); w.y = cvt_pk_bf16(v0[2], v0[3]); w.z = cvt_pk_bf16(v1[0], v1[1]); w.w = cvt_pk_bf16(v1[2], v1[3]);
                    *(u32x4*)(rowp + bj * HALF) = w; } }
    }
};
struct EpiResid {
    static constexpr bool PERM = false, AFTER_DRAIN = false;
    const float* base_p; const float* base_s; float* out; const float* gate;
    __device__ __forceinline__ void operator()(const f32x4 (&acc)[2][2][4][2], const Unit& u, int wr, int wc, int fr, int fq) const {
        const int row0 = u.pm * BM + wr * 64 + fr; const int col0 = u.pn * BM + wc * 32 + 4 * fq;
        const int cond = u.pm < 16 ? 0 : 1 + ((u.pm - 16) >> 2);
        const float* gp = gate + cond * 6144; const float* bp = u.pm < 16 ? base_p : base_s;
        f32x4 gv[2][2];
#pragma unroll
        for (int bj = 0; bj < 2; ++bj)
#pragma unroll
            for (int n = 0; n < 2; ++n) gv[bj][n] = *(const f32x4*)(gp + col0 + bj * HALF + n * 16);
#pragma unroll
        for (int ai = 0; ai < 2; ++ai)
#pragma unroll
            for (int m = 0; m < 4; ++m) { const size_t off = (size_t)(row0 + ai * HALF + m * 16) * 1024 + col0;
#pragma unroll
                for (int bj = 0; bj < 2; ++bj)
#pragma unroll
                    for (int n = 0; n < 2; ++n) { const f32x4 b = *(const f32x4*)(bp + off + bj * HALF + n * 16);
                        *(f32x4*)(out + off + bj * HALF + n * 16) = b + gv[bj][n] * acc[ai][bj][m][n]; } }
    }
};
struct EpiGlu {
    static constexpr bool PERM = true, AFTER_DRAIN = false;
    const bf16_t* G; bf16_t* O; const float* bias;
    __device__ __forceinline__ void operator()(const f32x4 (&acc)[2][2][4][2], const Unit& u, int wr, int wc, int fr, int fq) const {
        const int row0 = u.pm * BM + wr * 64 + fr; const int col0 = u.pn * BM + wc * 32 + 8 * fq;
        f32x4 bv[2][2];
#pragma unroll
        for (int bj = 0; bj < 2; ++bj)
#pragma unroll
            for (int n = 0; n < 2; ++n) bv[bj][n] = *(const f32x4*)(bias + col0 + bj * HALF + 4 * n);
#pragma unroll
        for (int ai = 0; ai < 2; ++ai)
#pragma unroll
            for (int m = 0; m < 4; ++m) { const size_t row = (size_t)(row0 + ai * HALF + m * 16);
#pragma unroll
                for (int bj = 0; bj < 2; ++bj) { f32x4 v0 = acc[ai][bj][m][0] + bv[bj][0], v1 = acc[ai][bj][m][1] + bv[bj][1];
                    const u32x4 gw = *(const u32x4*)(G + row * 512 + col0 + bj * HALF);
                    float gf[8];
#pragma unroll
                    for (int e = 0; e < 4; ++e) { gf[2 * e] = __uint_as_float(gw[e] << 16); gf[2 * e + 1] = __uint_as_float(gw[e] & 0xffff0000u); }
                    float o[8];
#pragma unroll
                    for (int e = 0; e < 4; ++e) { o[e] = gf[e] / (1.f + __expf(-v0[e])); o[4 + e] = gf[4 + e] / (1.f + __expf(-v1[e])); }
                    u32x4 w; w.x = cvt_pk_bf16(o[0], o[1]); w.y = cvt_pk_bf16(o[2], o[3]); w.z = cvt_pk_bf16(o[4], o[5]); w.w = cvt_pk_bf16(o[6], o[7]);
                    *(u32x4*)(O + row * 1024 + col0 + bj * HALF) = w; } }
    }
};

template <class Epi, class Sched, bool ALIGN_EPI = false, bool SP2 = false>
__device__ __forceinline__ void gemm_phase(PG8_LAS unsigned char* lds, const Gemm g, const Sched& S, const Epi& E) {
    const int tid = threadIdx.x, wid = __builtin_amdgcn_readfirstlane(tid >> 6), lane = tid & 63, wr = wid >> 2, wc = wid & 3, fr = lane & 15, fq = lane >> 4;
    const int K = g.K, nt = K / BK, LDA_ = g.lda, LDB_ = g.ldb;
    unsigned voffA[2], voffB[2];
#pragma unroll
    for (int i = 0; i < 2; ++i) { int R, C; stage_rc(tid * 16 + i * 8192, R, C); const int Rb = Epi::PERM ? ((R & ~31) + perm32(R & 31)) : R;
        voffA[i] = (unsigned)(R * LDA_ + C) * 2u; voffB[i] = (unsigned)(Rb * LDB_ + C) * 2u; }
    const size_t kstep = (size_t)(BK * 2);
    const size_t hstepA = (size_t)HALF * LDA_ * 2, hstepB = (size_t)HALF * LDB_ * 2;
    const size_t tstepA = 2 * hstepA, tstepB = 2 * hstepB;
    const unsigned ldsw = (unsigned)wid * 1024u;
    const int aoff = lds_byte(wr * 64 + fr, fq * 8), boff = lds_byte(wc * 32 + fr, fq * 8);
#define PG8_SA(b, h) (((b) * 2 + (h)) * HTB)
#define PG8_SB(b, h) ((4 + (b) * 2 + (h)) * HTB)
#define PG8_STAGE(bufoff, gbase, voff) do { _Pragma("unroll") for (int _i = 0; _i < 2; ++_i) \
        __builtin_amdgcn_global_load_lds((const unsigned*)((const char*)(gbase) + (voff)[_i]), (PG8_LAS unsigned*)(lds + (bufoff) + ldsw + _i * 8192), 16, 0, 0); } while (0)
#define PG8_LDA(dst, b, h) do { _Pragma("unroll") for (int m = 0; m < 4; ++m) _Pragma("unroll") for (int k = 0; k < 2; ++k) dst[m][k] = *(const PG8_LAS bf16x8*)(lds + PG8_SA(b, h) + aoff + m * 2048 + k * 1024); } while (0)
#define PG8_LDB(dst, b, h) do { _Pragma("unroll") for (int n = 0; n < 2; ++n) _Pragma("unroll") for (int k = 0; k < 2; ++k) dst[n][k] = *(const PG8_LAS bf16x8*)(lds + PG8_SB(b, h) + boff + n * 2048 + k * 1024); } while (0)
#define PG8_MMA(ai, bj, At, Bt) do { __builtin_amdgcn_s_setprio(1); _Pragma("unroll") for (int m = 0; m < 4; ++m) _Pragma("unroll") for (int n = 0; n < 2; ++n) _Pragma("unroll") for (int k = 0; k < 2; ++k) \
        acc[ai][bj][m][n] = __builtin_amdgcn_mfma_f32_16x16x32_bf16(Bt[n][k], At[m][k], acc[ai][bj][m][n], 0, 0, 0); __builtin_amdgcn_s_setprio(0); } while (0)
#define PG8_WAIT_V(n) asm volatile("s_waitcnt vmcnt(" #n ")" ::: "memory")
#define PG8_WAIT_L(n) asm volatile("s_waitcnt lgkmcnt(" #n ")" ::: "memory")
#define PG8_BAR __builtin_amdgcn_s_barrier()
#define PG8_SCHED __builtin_amdgcn_sched_barrier(0)
    Unit cur, nxt; int ui = 0;
    if (!S.next(0, cur)) return;
    f32x4 acc[2][2][4][2];
#pragma unroll
    for (int a = 0; a < 2; ++a)
#pragma unroll
        for (int b = 0; b < 2; ++b)
#pragma unroll
            for (int m = 0; m < 4; ++m)
#pragma unroll
                for (int n = 0; n < 2; ++n) acc[a][b][m][n] = (f32x4){0.f, 0.f, 0.f, 0.f};
    bf16x8 At[4][2], B0[2][2], B1[2][2];
    const char* cA = (const char*)g.A + (size_t)cur.pm * tstepA; const char* cB = (const char*)g.Bt + (size_t)cur.pn * tstepB;
    S.a_ready(cur);
    if constexpr (SP2) {
        PG8_STAGE(PG8_SB(0, 0), cB, voffB); PG8_STAGE(PG8_SB(0, 1), cB + hstepB, voffB); PG8_STAGE(PG8_SA(0, 0), cA, voffA); PG8_STAGE(PG8_SA(0, 1), cA + hstepA, voffA);
        if (wr == 1) PG8_BAR;
        PG8_WAIT_V(2); PG8_BAR;
        PG8_STAGE(PG8_SB(1, 0), cB + kstep, voffB); PG8_STAGE(PG8_SA(1, 0), cA + kstep, voffA); PG8_STAGE(PG8_SB(1, 1), cB + hstepB + kstep, voffB);
        PG8_WAIT_V(6); PG8_BAR;
    } else {
        PG8_STAGE(PG8_SB(0, 0), cB, voffB); PG8_STAGE(PG8_SA(0, 0), cA, voffA); PG8_STAGE(PG8_SB(0, 1), cB + hstepB, voffB); PG8_STAGE(PG8_SA(0, 1), cA + hstepA, voffA);
        if (wr == 1) PG8_BAR;
        PG8_WAIT_V(4); PG8_BAR;
        PG8_STAGE(PG8_SB(1, 0), cB + kstep, voffB); PG8_STAGE(PG8_SA(1, 0), cA + kstep, voffA); PG8_STAGE(PG8_SB(1, 1), cB + hstepB + kstep, voffB);
        PG8_WAIT_V(6); PG8_BAR;
    }
    for (;;) {
        const bool has_next = S.next(ui + 1, nxt);
        const char* nA = has_next ? (const char*)g.A + (size_t)nxt.pm * tstepA : cA; const char* nB = has_next ? (const char*)g.Bt + (size_t)nxt.pn * tstepB : cB;
        for (int t = 0; t < nt; t += 2) {
            const bool last = (t == nt - 2);
            const char* a1 = cA + (size_t)(t + 1) * kstep;
            const char* a2 = last ? nA : cA + (size_t)(t + 2) * kstep; const char* b2 = last ? nB : cB + (size_t)(t + 2) * kstep;
            const char* a3 = a2 + kstep; const char* b3 = b2 + kstep;
            if (last && has_next) S.a_ready(nxt);
            if constexpr (SP2) {
            PG8_LDB(B0, 0, 0); PG8_LDB(B1, 0, 1); PG8_SCHED; PG8_LDA(At, 0, 0); PG8_STAGE(PG8_SA(1, 1), a1 + hstepA, voffA);
            PG8_WAIT_V(8); PG8_WAIT_L(0); PG8_BAR; PG8_MMA(0, 0, At, B0); PG8_MMA(0, 1, At, B1); PG8_BAR; PG8_SCHED;
            PG8_LDA(At, 0, 1); PG8_STAGE(PG8_SB(0, 0), b2, voffB); PG8_STAGE(PG8_SB(0, 1), b2 + hstepB, voffB); PG8_STAGE(PG8_SA(0, 0), a2, voffA);
            PG8_WAIT_V(8); PG8_WAIT_L(0); PG8_BAR; PG8_MMA(1, 0, At, B0); PG8_MMA(1, 1, At, B1); PG8_BAR; PG8_SCHED;
            PG8_LDB(B0, 1, 0); PG8_LDB(B1, 1, 1); PG8_SCHED; PG8_LDA(At, 1, 0); PG8_STAGE(PG8_SA(0, 1), a2 + hstepA, voffA);
            PG8_WAIT_V(8); PG8_WAIT_L(0); PG8_BAR; PG8_MMA(0, 0, At, B0); PG8_MMA(0, 1, At, B1); PG8_BAR; PG8_SCHED;
            PG8_LDA(At, 1, 1); PG8_STAGE(PG8_SB(1, 0), b3, voffB); PG8_STAGE(PG8_SB(1, 1), b3 + hstepB, voffB); PG8_STAGE(PG8_SA(1, 0), a3, voffA);
            PG8_WAIT_V(8); PG8_WAIT_L(0); PG8_BAR; PG8_MMA(1, 0, At, B0); PG8_MMA(1, 1, At, B1); PG8_BAR; PG8_SCHED;
            } else {
            PG8_LDB(B0, 0, 0); PG8_SCHED; PG8_LDA(At, 0, 0); PG8_STAGE(PG8_SA(1, 1), a1 + hstepA, voffA);
            PG8_WAIT_L(8); PG8_BAR; PG8_WAIT_L(0); PG8_MMA(0, 0, At, B0); PG8_BAR; PG8_SCHED;
            PG8_LDB(B1, 0, 1); PG8_STAGE(PG8_SB(0, 0), b2, voffB);
            PG8_BAR; PG8_WAIT_L(0); PG8_MMA(0, 1, At, B1); PG8_BAR;
            PG8_LDA(At, 0, 1); PG8_STAGE(PG8_SA(0, 0), a2, voffA);
            PG8_BAR; PG8_WAIT_L(0); PG8_MMA(1, 0, At, B0); PG8_BAR; PG8_SCHED;
            PG8_STAGE(PG8_SB(0, 1), b2 + hstepB, voffB);
            PG8_WAIT_V(6); PG8_BAR; PG8_MMA(1, 1, At, B1); PG8_BAR;
            PG8_LDB(B0, 1, 0); PG8_SCHED; PG8_LDA(At, 1, 0); PG8_STAGE(PG8_SA(0, 1), a2 + hstepA, voffA);
            PG8_WAIT_L(8); PG8_BAR; PG8_WAIT_L(0); PG8_MMA(0, 0, At, B0); PG8_BAR; PG8_SCHED;
            PG8_LDB(B1, 1, 1); PG8_STAGE(PG8_SB(1, 0), b3, voffB);
            PG8_BAR; PG8_WAIT_L(0); PG8_MMA(0, 1, At, B1); PG8_BAR;
            PG8_LDA(At, 1, 1); PG8_STAGE(PG8_SA(1, 0), a3, voffA);
            PG8_BAR; PG8_WAIT_L(0); PG8_MMA(1, 0, At, B0); PG8_BAR; PG8_SCHED;
            PG8_STAGE(PG8_SB(1, 1), b3 + hstepB, voffB);
            PG8_WAIT_V(6); PG8_BAR; PG8_MMA(1, 1, At, B1); PG8_BAR;
            }
        }
        if constexpr (ALIGN_EPI) { if (wr == 0) PG8_BAR; }
        if constexpr (!Epi::AFTER_DRAIN) { E(acc, cur, wr, wc, fr, fq); S.done(cur); }
        if (!has_next) break;
#pragma unroll
        for (int a = 0; a < 2; ++a)
#pragma unroll
            for (int b = 0; b < 2; ++b)
#pragma unroll
                for (int m = 0; m < 4; ++m)
#pragma unroll
                    for (int n = 0; n < 2; ++n) acc[a][b][m][n] = (f32x4){0.f, 0.f, 0.f, 0.f};
        cur = nxt; cA = nA; cB = nB; ++ui;
        if constexpr (ALIGN_EPI) { if (wr == 1) PG8_BAR; }
    }
    PG8_WAIT_V(0);
    if constexpr (!ALIGN_EPI) { if (wr == 0) PG8_BAR; }
    PG8_BAR;
    if constexpr (Epi::AFTER_DRAIN) { E.fused(acc, cur, wr, wc, fr, fq, lds, wid, lane); S.done(cur); }
#undef PG8_SA
#undef PG8_SB
#undef PG8_STAGE
#undef PG8_LDA
#undef PG8_LDB
#undef PG8_MMA
#undef PG8_WAIT_V
#undef PG8_WAIT_L
#undef PG8_BAR
#undef PG8_SCHED
}
}

namespace att {
using bf16 = __hip_bfloat16;
constexpr int D = 128, NW = 8, QBLK = 32, KVBLK = 64; constexpr float SCALE = 0.088388347648318440f; constexpr float THR = 8.f; constexpr int SDEPTH = 2;
constexpr int LDQ = 1024, LDK = 256, LDO = 1024;
constexpr size_t SHM_V = KVBLK * D * 2, SHM_K = KVBLK * D * 2, SHM_ATTN = 2 * SHM_V + 2 * SHM_K + NW * 64 * 4;
using bf16x8 = __attribute__((ext_vector_type(8))) short;
using s16x4  = __attribute__((ext_vector_type(4))) short;
using f32x16 = __attribute__((ext_vector_type(16))) float;
using f32x8  = __attribute__((ext_vector_type(8))) float;
using u32x4  = __attribute__((ext_vector_type(4))) unsigned;
#define KSWZ(row, colB) ((row) * 256 + ((colB) ^ (((row) & 7) << 4)))
#define SBAR() __builtin_amdgcn_sched_barrier(0)
__device__ __forceinline__ int crow(int r, int hi) { return (r & 3) + 8 * (r >> 2) + 4 * hi; }
__device__ __forceinline__ unsigned cvtpk(float lo, float hi) {
  unsigned r; asm volatile("v_cvt_pk_bf16_f32 %0, %1, %2" : "=v"(r) : "v"(lo), "v"(hi)); return r;
}
template <typename TIn> struct Stage;
template <> struct Stage<bf16>  { using T = bf16x8;
  __device__ static __forceinline__ T ld8(const bf16* p) { return *reinterpret_cast<const bf16x8*>(p); }
  __device__ static __forceinline__ bf16x8 tobf(T x) { return x; } };
template <> struct Stage<float> { using T = f32x8;
  __device__ static __forceinline__ T ld8(const float* p) { return *reinterpret_cast<const f32x8*>(p); }
  __device__ static __forceinline__ bf16x8 tobf(T x) {
    u32x4 w = {cvtpk(x[0], x[1]), cvtpk(x[2], x[3]), cvtpk(x[4], x[5]), cvtpk(x[6], x[7])}; return *reinterpret_cast<bf16x8*>(&w); } };

__device__ __forceinline__ void partialSM(f32x16& p0, f32x16& p1, float& m_reg, float& mn, float& alpha) {
  constexpr float C = SCALE * 1.4426950408889634f;
  float pmax = p0[0]; for (int r = 1; r < 16; ++r) pmax = fmaxf(pmax, p0[r]); for (int r = 0; r < 16; ++r) pmax = fmaxf(pmax, p1[r]);
  { auto rr = __builtin_amdgcn_permlane32_swap(__float_as_uint(pmax), __float_as_uint(pmax), false, false);
    pmax = fmaxf(__uint_as_float(rr[0]), __uint_as_float(rr[1])); }
  if (__builtin_expect(__all(pmax - m_reg <= THR / SCALE), 1)) { mn = m_reg; alpha = 1.f; }
  else { mn = fmaxf(m_reg, pmax); alpha = __builtin_amdgcn_exp2f((m_reg - mn) * C); m_reg = mn; }
  float mnC = -mn * C;
  for (int r = 0; r < 16; ++r) p0[r] = fmaf(p0[r], C, mnC); for (int r = 0; r < 16; ++r) p1[r] = fmaf(p1[r], C, mnC);
  for (int r = 0; r < 16; ++r) p0[r] = __builtin_amdgcn_exp2f(p0[r]);
}
__device__ __forceinline__ void finishSM(f32x16& p0, f32x16& p1, float alpha, float& l_reg, bf16x8& pa0, bf16x8& pa1, bf16x8& pa2, bf16x8& pa3) {
  for (int r = 0; r < 16; ++r) p1[r] = __builtin_amdgcn_exp2f(p1[r]);
  float ps = 0; for (int r = 0; r < 16; ++r) ps += p0[r]; for (int r = 0; r < 16; ++r) ps += p1[r];
  { auto rr = __builtin_amdgcn_permlane32_swap(__float_as_uint(ps), __float_as_uint(ps), false, false);
    ps = __uint_as_float(rr[0]) + __uint_as_float(rr[1]); }
  l_reg = l_reg * alpha + ps;
#define PK4(P, BASE, OUT) do { unsigned a0 = cvtpk(P[BASE + 0], P[BASE + 1]), a1 = cvtpk(P[BASE + 2], P[BASE + 3]);   \
    unsigned b0 = cvtpk(P[BASE + 4], P[BASE + 5]), b1 = cvtpk(P[BASE + 6], P[BASE + 7]);                              \
    auto r0 = __builtin_amdgcn_permlane32_swap(a0, b0, false, false); auto r1 = __builtin_amdgcn_permlane32_swap(a1, b1, false, false); \
    u32x4 w = {r0[0], r1[0], r0[1], r1[1]}; OUT = *reinterpret_cast<bf16x8*>(&w); } while (0)
  PK4(p0, 0, pa0); PK4(p0, 8, pa1); PK4(p1, 0, pa2); PK4(p1, 8, pa3);
#undef PK4
}
__device__ __forceinline__ void qkt(f32x16& p0, f32x16& p1, const bf16* Ks, const bf16x8* qr, int r32, int hi) {
  p0 = f32x16{}; p1 = f32x16{};
  for (int d0 = 0; d0 < 8; ++d0) { int cb = (d0 * 16 + hi * 8) * 2;
    bf16x8 b0 = *reinterpret_cast<const bf16x8*>((const char*)Ks + KSWZ(r32, cb));
    bf16x8 b1 = *reinterpret_cast<const bf16x8*>((const char*)Ks + KSWZ(32 + r32, cb));
    p0 = __builtin_amdgcn_mfma_f32_32x32x16_bf16(b0, qr[d0], p0, 0, 0, 0);
    p1 = __builtin_amdgcn_mfma_f32_32x32x16_bf16(b1, qr[d0], p1, 0, 0, 0); }
}
__device__ __forceinline__ int v_st(int k, int c) { const int kk = (k & ~0xC) | ((k & 4) << 1) | ((k & 8) >> 1); return ((kk >> 3) * 4 + (c >> 5)) * 512 + ((kk & 7) * 32 + (c & 31)) * 2; }
__device__ __forceinline__ int v_rd_base(int lane) { return ((lane & 3) << 3) | (((lane >> 2) & 3) << 6) | (((lane >> 4) & 1) << 5) | (((lane >> 5) & 1) << 8); }
constexpr int v_rd_off(int d0, int ks, int half) { return d0 * 512 + ks * 4096 + half * 2048; }
template <int OFF> __device__ __forceinline__ s16x4 tr_read(int vb) {
  s16x4 r; asm volatile("ds_read_b64_tr_b16 %0, %1 offset:%2" : "=&v"(r) : "v"(vb), "i"(OFF) : "memory"); return r;
}
template <int D0> __device__ __forceinline__ void pv_one(f32x16& od, int vb, bf16x8 pa0, bf16x8 pa1, bf16x8 pa2, bf16x8 pa3) {
  const s16x4 l0 = tr_read<v_rd_off(D0, 0, 0)>(vb), h0 = tr_read<v_rd_off(D0, 0, 1)>(vb), l1 = tr_read<v_rd_off(D0, 1, 0)>(vb), h1 = tr_read<v_rd_off(D0, 1, 1)>(vb);
  const s16x4 l2 = tr_read<v_rd_off(D0, 2, 0)>(vb), h2 = tr_read<v_rd_off(D0, 2, 1)>(vb), l3 = tr_read<v_rd_off(D0, 3, 0)>(vb), h3 = tr_read<v_rd_off(D0, 3, 1)>(vb);
  asm volatile("s_waitcnt lgkmcnt(0)" ::: "memory"); SBAR();
#define PK(L, H) (bf16x8){L[0], L[1], L[2], L[3], H[0], H[1], H[2], H[3]}
  od = __builtin_amdgcn_mfma_f32_32x32x16_bf16(pa0, PK(l0, h0), od, 0, 0, 0);
  od = __builtin_amdgcn_mfma_f32_32x32x16_bf16(pa1, PK(l1, h1), od, 0, 0, 0);
  od = __builtin_amdgcn_mfma_f32_32x32x16_bf16(pa2, PK(l2, h2), od, 0, 0, 0);
  od = __builtin_amdgcn_mfma_f32_32x32x16_bf16(pa3, PK(l3, h3), od, 0, 0, 0);
#undef PK
}
__device__ __forceinline__ void pv_d0(f32x16* o, int vb, bf16x8 pa0, bf16x8 pa1, bf16x8 pa2, bf16x8 pa3) {
  pv_one<0>(o[0], vb, pa0, pa1, pa2, pa3); pv_one<1>(o[1], vb, pa0, pa1, pa2, pa3); pv_one<2>(o[2], vb, pa0, pa1, pa2, pa3); pv_one<3>(o[3], vb, pa0, pa1, pa2, pa3);
}

template <typename TQ>
__device__ __forceinline__ void attn_dense_body(const TQ* __restrict__ Qb, const bf16* __restrict__ Kh, const bf16* __restrict__ Vh,
                                                bf16* __restrict__ Ob, int seq, char* lds) {
  using St = Stage<bf16>; using SQ = Stage<TQ>;
  const int tid = threadIdx.x, wid = tid >> 6, lane = tid & 63, r32 = lane & 31, hi = lane >> 5;
  bf16* V_lds = (bf16*)lds; bf16* K_lds = (bf16*)(lds + 2 * SHM_V);
  float* ws = (float*)(lds + 2 * SHM_V + 2 * SHM_K) + wid * 64; float* li_l = ws; float* al_l = ws + 32;
  float m_reg = -1e30f, l_reg = 0; f32x16 o[4] = {}; bf16x8 qr[8];
  const TQ* Qw = Qb + (long)(wid * QBLK + r32) * LDQ + hi * 8;
#pragma unroll
  for (int d0 = 0; d0 < 8; ++d0) qr[d0] = SQ::tobf(SQ::ld8(Qw + d0 * 16));
  const int sr = tid >> 4, sc = (tid & 15) * 8, vst0 = v_st(sr, sc), vst1 = v_st(32 + sr, sc);
  const int vb0 = (int)(uintptr_t)V_lds + v_rd_base(lane);
  struct { typename St::T vs0, vs1, ks0, ks1; } sr_[SDEPTH];
#define SLOAD(i, k0) do { sr_[i].vs0 = St::ld8(&Vh[(long)((k0) + sr) * LDK + sc]); sr_[i].vs1 = St::ld8(&Vh[(long)((k0) + 32 + sr) * LDK + sc]); \
    sr_[i].ks0 = St::ld8(&Kh[(long)((k0) + sr) * LDK + sc]); sr_[i].ks1 = St::ld8(&Kh[(long)((k0) + 32 + sr) * LDK + sc]); } while (0)
#define SWRITE(b, i) do { *(bf16x8*)((char*)V_lds + (b) * SHM_V + vst0) = St::tobf(sr_[i].vs0);          \
    *(bf16x8*)((char*)V_lds + (b) * SHM_V + vst1) = St::tobf(sr_[i].vs1); int kc = sc * 2;               \
    *(bf16x8*)((char*)K_lds + (b) * SHM_K + KSWZ(sr, kc)) = St::tobf(sr_[i].ks0);                       \
    *(bf16x8*)((char*)K_lds + (b) * SHM_K + KSWZ(32 + sr, kc)) = St::tobf(sr_[i].ks1); } while (0)
#define SWAIT() do { if constexpr (SDEPTH == 2) asm volatile("s_waitcnt vmcnt(4)" ::: "memory"); else asm volatile("s_waitcnt vmcnt(0)" ::: "memory"); } while (0)
#define RESC(a) do { if (__any((a) < 1.f)) { if (hi == 0) al_l[r32] = (a); asm volatile("s_waitcnt lgkmcnt(0)" ::: "memory"); \
    for (int d = 0; d < 4; ++d) for (int r = 0; r < 16; ++r) o[d][r] *= al_l[crow(r, hi)]; } } while (0)
  f32x16 pA0, pA1, pB0, pB1; float mnA, mnB, alA, alB; bf16x8 pa0, pa1, pa2, pa3; const int NT = seq / KVBLK;
  constexpr int SE = 0, SO = SDEPTH - 1;
  SLOAD(SE, 0); asm volatile("s_waitcnt vmcnt(0)" ::: "memory"); SWRITE(0, SE); __syncthreads();
  qkt(pA0, pA1, K_lds, qr, r32, hi); partialSM(pA0, pA1, m_reg, mnA, alA);
  SLOAD(SO, KVBLK); if constexpr (SDEPTH == 2) { if (2 < NT) SLOAD(SE, 2 * KVBLK); }
  SWAIT(); SWRITE(1, SO); __syncthreads();
  for (int j = 1; j + 1 < NT; j += 2) {
    SBAR(); qkt(pB0, pB1, (bf16*)((char*)K_lds + SHM_K), qr, r32, hi);
    finishSM(pA0, pA1, alA, l_reg, pa0, pa1, pa2, pa3); SBAR();
    SLOAD(SO, (j + SDEPTH) * KVBLK); SBAR();
    pv_d0(o, vb0, pa0, pa1, pa2, pa3); partialSM(pB0, pB1, m_reg, mnB, alB);
    __syncthreads(); SWAIT(); SWRITE(0, SE);
    RESC(alB); __syncthreads();
    SBAR(); qkt(pA0, pA1, K_lds, qr, r32, hi);
    finishSM(pB0, pB1, alB, l_reg, pa0, pa1, pa2, pa3); SBAR();
    if (SDEPTH == 1 || j + 3 < NT) SLOAD(SE, (j + 1 + SDEPTH) * KVBLK); SBAR();
    pv_d0(o, vb0 + (int)SHM_V, pa0, pa1, pa2, pa3); partialSM(pA0, pA1, m_reg, mnA, alA);
    __syncthreads(); SWAIT(); SWRITE(1, SO);
    RESC(alA); __syncthreads();
  }
  SBAR(); qkt(pB0, pB1, (bf16*)((char*)K_lds + SHM_K), qr, r32, hi);
  finishSM(pA0, pA1, alA, l_reg, pa0, pa1, pa2, pa3); SBAR();
  pv_d0(o, vb0, pa0, pa1, pa2, pa3); partialSM(pB0, pB1, m_reg, mnB, alB);
  __syncthreads(); RESC(alB);
  finishSM(pB0, pB1, alB, l_reg, pa0, pa1, pa2, pa3); SBAR();
  pv_d0(o, vb0 + (int)SHM_V, pa0, pa1, pa2, pa3);
  if (hi == 0) li_l[r32] = l_reg; asm volatile("s_waitcnt lgkmcnt(0)" ::: "memory");
  float rli[16];
#pragma unroll
  for (int r = 0; r < 16; ++r) rli[r] = __builtin_amdgcn_rcpf(li_l[crow(r, hi)]);
  bf16* Ow = Ob + (long)(wid * QBLK) * LDO;
#pragma unroll
  for (int r = 0; r < 16; ++r) { int orow = crow(r, hi);
    for (int d0 = 0; d0 < 4; ++d0) Ow[(long)orow * LDO + d0 * 32 + r32] = __float2bfloat16(o[d0][r] * rli[r]); }
#undef SLOAD
#undef SWRITE
#undef SWAIT
#undef RESC
}
}

constexpr int NWAVES = 8;
constexpr int DM = 1024, NTOK = 8192, NPR = 4096, FF = 4096, INW = 2048, INE = 2080, QKVW = 1536;
constexpr float EPS = 1e-6f;
constexpr size_t OUT_Y = 0, OUT_S5RE = 8388608, OUT_S5IM = OUT_S5RE + 65536, OUT_GLA = OUT_S5IM + 65536, OUT_NK = OUT_GLA + 1048576, OUT_NV = OUT_NK + 1048576, OUT_END = OUT_NV + 1048576;
constexpr size_t MiB = 1u << 20;
constexpr size_t WS_CTL = 0, CTL_ZERO_BYTES = 64 * 1024;
constexpr size_t WS_ADA = 1 * MiB;
constexpr size_t WS_WIN = 2 * MiB, WS_WGLR = 6 * MiB, WS_WGLU = 6 * MiB + 512 * 1024, WS_WOUT = 7 * MiB, WS_W1 = 9 * MiB, WS_W2 = 25 * MiB, WS_WQKV = 41 * MiB, WS_WO = 44 * MiB;
constexpr size_t WS_H = 46 * MiB, WS_Y = 62 * MiB, WS_SCR = 94 * MiB;
constexpr size_t WS_Z = WS_SCR, WS_GLR = WS_SCR + 32 * MiB, WS_G = WS_SCR + 33 * MiB, WS_YF = WS_SCR + 41 * MiB, WS_SLOC = WS_SCR + 57 * MiB, WS_SIN = WS_SCR + 89 * MiB, WS_DEC = WS_SCR + 105 * MiB, WS_MIX = WS_SCR + 106 * MiB;
constexpr size_t WS_ACT = WS_SCR, WS_XBUF = WS_SCR + 64 * MiB;
constexpr size_t WS_QKV = WS_SCR, WS_QN = WS_SCR + 24 * MiB, WS_KP = WS_SCR + 40 * MiB, WS_KS = WS_SCR + 42 * MiB, WS_VP = WS_SCR + 45 * MiB, WS_VS = WS_SCR + 47 * MiB, WS_OB = WS_SCR + 50 * MiB;
constexpr size_t WS_END = WS_SCR + 122 * MiB;
static_assert(WS_END <= 256 * MiB, "d_ws map");
constexpr int CW_BAR = 1024;
constexpr int RING_BYTES = 131072, LDSCTL_OFF = RING_BYTES, MISC_OFF = LDSCTL_OFF + 320, LDS_BYTES = 147456;

#define GAS __attribute__((address_space(1)))
#define LAS __attribute__((address_space(3)))
typedef unsigned short bf16;
typedef unsigned v4u __attribute__((ext_vector_type(4)));
typedef unsigned v2u __attribute__((ext_vector_type(2)));
typedef float f32x4 __attribute__((ext_vector_type(4)));
typedef float f32x16 __attribute__((ext_vector_type(16)));
typedef short bf16x8 __attribute__((ext_vector_type(8)));
typedef short s16x4 __attribute__((ext_vector_type(4)));
typedef GAS unsigned gu32;
#define RLX_AGENT __ATOMIC_RELAXED, __HIP_MEMORY_SCOPE_AGENT
#define LDS_WAIT() asm volatile("s_waitcnt lgkmcnt(0)" ::: "memory")
#define VM_WAIT() asm volatile("s_waitcnt vmcnt(0)" ::: "memory")
__device__ __forceinline__ unsigned f2bf(float f) { unsigned u = __builtin_bit_cast(unsigned, f); return (u + 0x7fffu + ((u >> 16) & 1u)) >> 16; }
__device__ __forceinline__ unsigned pk2(float lo, float hi) { return f2bf(lo) | (f2bf(hi) << 16); }
__device__ __forceinline__ float bf2f(unsigned short b) { return __uint_as_float(((unsigned)b) << 16); }
__device__ __forceinline__ float bflo(unsigned w) { return __uint_as_float(w << 16); }
__device__ __forceinline__ float bfhi(unsigned w) { return __uint_as_float(w & 0xffff0000u); }
__device__ __forceinline__ float wave_sum(float v) {
#pragma unroll
    for (int o = 1; o < 64; o <<= 1) v += __shfl_xor(v, o);
    return v;
}
__device__ __forceinline__ int crow(int r, int hi) { return (r & 3) + 8 * (r >> 2) + 4 * hi; }
__device__ __forceinline__ s16x4 tr_read4(unsigned addr) { s16x4 r; asm volatile("ds_read_b64_tr_b16 %0, %1" : "=&v"(r) : "v"(addr) : "memory"); return r; }

#define XB_TMO      128
#define XB_XCNT(j)  (256  + 64 * (j))
#define XB_XSUB(j)  (1280 + 64 * (j))
#define XB_XGEN(j)  (2304 + 64 * (j))
#define XB_TOP      3328
#define XB_TOPGEN   3392
#define XCD_BAR_WORDS 3456
#define XB_SPIN_CAP (1u << 18)

__device__ __forceinline__ unsigned xb_ld(unsigned* p)              { return __hip_atomic_load(p, __ATOMIC_RELAXED, __HIP_MEMORY_SCOPE_AGENT); }
__device__ __forceinline__ unsigned xb_add(unsigned* p, unsigned v) { return __hip_atomic_fetch_add(p, v, __ATOMIC_RELAXED, __HIP_MEMORY_SCOPE_AGENT); }
__device__ __forceinline__ unsigned xb_xcc_id() { return (unsigned)__builtin_amdgcn_s_getreg((3 << 11) | 20) & 0xFu; }
#define XB_SPIN(cond, bar) do { unsigned _sp = 0; while (cond) { __builtin_amdgcn_s_sleep(1); \
    if ((++_sp & 255u) == 0u) { if (xb_ld(&(bar)[XB_TMO])) break; if (_sp > XB_SPIN_CAP) { atomicAdd(&(bar)[XB_TMO], 1u); break; } } } } while (0)

struct XcdBarrier {
    unsigned* bar; unsigned x;
    volatile LAS unsigned* st;
};

__device__ __forceinline__ XcdBarrier xcd_barrier_post(unsigned* bar, volatile LAS unsigned* st) {
    XcdBarrier b; b.bar = bar; b.x = xb_xcc_id(); b.st = st;
    if (threadIdx.x == 0) (void)xb_add(&bar[XB_XCNT(b.x)], 1u);
    return b;
}
__device__ __forceinline__ void xcd_barrier_complete(unsigned* bar, unsigned x, unsigned& nloc, unsigned& nx) {
    const unsigned G = gridDim.x * gridDim.y * gridDim.z;
    unsigned sum, cnt, mine, sp = 0u;
    for (;;) {
        sum = 0u; cnt = 0u; mine = 0u;
#pragma unroll
        for (unsigned j = 0; j < 16; ++j) { const unsigned c = xb_ld(&bar[XB_XCNT(j)]); sum += c; cnt += (c > 0u) ? 1u : 0u; mine = (j == x) ? c : mine; }
        if (sum == G) break;
        __builtin_amdgcn_s_sleep(1);
        if ((++sp & 255u) == 0u) { if (xb_ld(&bar[XB_TMO])) break; if (sp > XB_SPIN_CAP) { atomicAdd(&bar[XB_TMO], 1u); break; } }
    }
    nloc = mine > 0u ? mine : 1u; nx = cnt > 0u ? cnt : 1u;
}

__device__ __forceinline__ void xcd_barrier(const XcdBarrier& b) {
    asm volatile("s_waitcnt vmcnt(0)" ::: "memory");
    __syncthreads();
    if (threadIdx.x == 0) {
        unsigned* bar = b.bar;
        __builtin_amdgcn_s_waitcnt(0);
        unsigned nloc = b.st[0], nx = b.st[1];
        if (nloc == 0u) { xcd_barrier_complete(bar, b.x, nloc, nx); b.st[0] = nloc; b.st[1] = nx; }
        const unsigned old = xb_add(&bar[XB_XSUB(b.x)], 1u);
        const unsigned gen = old / nloc;
        if (old + 1u == (gen + 1u) * nloc) {
            __builtin_amdgcn_fence(__ATOMIC_RELEASE, "agent");
            asm volatile("s_waitcnt vmcnt(0)" ::: "memory");
            const unsigned og = xb_add(&bar[XB_TOP], 1u);
            const unsigned tg = og / nx;
            if (og + 1u == (tg + 1u) * nx) xb_add(&bar[XB_TOPGEN], 1u);
            else XB_SPIN(xb_ld(&bar[XB_TOPGEN]) == tg, bar);
            __builtin_amdgcn_fence(__ATOMIC_ACQUIRE, "agent");
            xb_add(&bar[XB_XGEN(b.x)], 1u);
            asm volatile("s_waitcnt vmcnt(0)" ::: "memory");
        } else {
            XB_SPIN(xb_ld(&bar[XB_XGEN(b.x)]) == gen, bar);
            __builtin_amdgcn_fence(__ATOMIC_ACQUIRE, "agent");
            asm volatile("s_waitcnt vmcnt(0)" ::: "memory");
        }
    }
    __syncthreads();
}


struct SplitKOrder { int pm, pn;
    __device__ __forceinline__ bool next(int i, pg8::Unit& u) const { if (i > 0) return false; u.pm = pm; u.pn = pn; return true; }
    __device__ __forceinline__ void a_ready(const pg8::Unit&) const {}
    __device__ __forceinline__ void done(const pg8::Unit&) const {} };
struct EpiResidSplit {
    static constexpr bool PERM = false, AFTER_DRAIN = true;
    const float* base; float* out; const float* gate; float* xbuf; XcdBarrier bar; int kh;
    template <int KH> __device__ __forceinline__ void run(f32x4 (&acc)[2][2][4][2], const pg8::Unit& u, int wr, int wc, int fr, int fq, int tid) const {
        const int tile = u.pm * 4 + u.pn;
        float* xs = xbuf + ((size_t)(tile * 2 + KH) * 16) * 2048 + tid * 4;
#pragma unroll
        for (int bj = 0; bj < 2; ++bj)
#pragma unroll
            for (int m = 0; m < 4; ++m)
#pragma unroll
                for (int n = 0; n < 2; ++n) *(f32x4*)(xs + ((bj * 4 + m) * 2 + n) * 2048) = acc[1 - KH][bj][m][n];
        xcd_barrier(bar);
        const float* xr = xbuf + ((size_t)(tile * 2 + (1 - KH)) * 16) * 2048 + tid * 4;
        const int row0 = u.pm * 256 + KH * 128 + wr * 64 + fr; const int col0 = u.pn * 256 + wc * 32 + 4 * fq;
        const int cond = u.pm < 16 ? 0 : 1 + ((u.pm - 16) >> 2);
        const float* gp = gate + cond * 6144;
        f32x4 gv[2][2];
#pragma unroll
        for (int bj = 0; bj < 2; ++bj)
#pragma unroll
            for (int n = 0; n < 2; ++n) gv[bj][n] = *(const f32x4*)(gp + col0 + bj * 128 + n * 16);
#pragma unroll
        for (int m = 0; m < 4; ++m) { const size_t off = (size_t)(row0 + m * 16) * 1024 + col0;
#pragma unroll
            for (int bj = 0; bj < 2; ++bj)
#pragma unroll
                for (int n = 0; n < 2; ++n) { const f32x4 p = *(const f32x4*)(xr + ((bj * 4 + m) * 2 + n) * 2048); const f32x4 b = *(const f32x4*)(base + off + bj * 128 + n * 16);
                    *(f32x4*)(out + off + bj * 128 + n * 16) = b + gv[bj][n] * (acc[KH][bj][m][n] + p); } }
    }
    __device__ __forceinline__ void fused(f32x4 (&acc)[2][2][4][2], const pg8::Unit& u, int wr, int wc, int fr, int fq, LAS unsigned char*, int wid, int lane) const {
        if (kh == 0) run<0>(acc, u, wr, wc, fr, fq, wid * 64 + lane); else run<1>(acc, u, wr, wc, fr, fq, wid * 64 + lane);
    }
};

struct Args { const float* in[34]; float* out; unsigned char* ws; int ph_lo, ph_hi; };

__device__ __forceinline__ void p0_transpose_item(const float* W, int ld, int K, bf16* WT, int nblk, LAS float* scr, int item, int lane) {
    const int kb = item / nblk, nb = item % nblk, k0 = 64 * kb, n0 = 32 * nb;
#pragma unroll 8
    for (int i = 0; i < 32; ++i) { const int kk = 2 * i + (lane >> 5); scr[kk * 33 + (lane & 31)] = W[(size_t)(k0 + kk) * ld + n0 + (lane & 31)]; }
    LDS_WAIT(); asm volatile("" ::: "memory");
    const int c = lane & 7;
#pragma unroll
    for (int j = 0; j < 4; ++j) { const int n = (lane >> 3) + 8 * j; const LAS float* s = scr + (8 * c) * 33 + n;
        v4u o; o.x = pk2(s[0 * 33], s[1 * 33]); o.y = pk2(s[2 * 33], s[3 * 33]); o.z = pk2(s[4 * 33], s[5 * 33]); o.w = pk2(s[6 * 33], s[7 * 33]);
        *(GAS v4u*)(WT + (size_t)(n0 + n) * K + k0 + 8 * c) = o; }
    LDS_WAIT(); asm volatile("" ::: "memory");
}
__device__ __forceinline__ void p0_prologue(const Args& A, LAS unsigned char* lds, int tid, int lane, int wave) {
    unsigned char* ws = A.ws;
    {
        LAS float* sc = (LAS float*)(lds);
        LAS float* red = (LAS float*)(lds + 20480);
        for (int i = tid; i < 5 * 1024; i += 512) { const int c = i >> 10, k = i & 1023; const float x = c == 0 ? A.in[8][k] : A.in[7][(c - 1) * 1024 + k]; sc[i] = x / (1.f + __expf(-x)); }
        __syncthreads();
        for (int ab = blockIdx.x; ab < 256; ab += gridDim.x) {
        const int layer = ab >> 7, n0 = (ab & 127) * 48;
        const float* W = A.in[11] + (size_t)layer * 1024 * 6144 + n0;
        const int kq = lane / 12, nq = lane % 12;
        f32x4 acc[5];
#pragma unroll
        for (int c = 0; c < 5; ++c) acc[c] = (f32x4){0.f, 0.f, 0.f, 0.f};
        if (kq < 4) {
#pragma unroll 4
            for (int i = 0; i < 32; ++i) { const int k = 128 * wave + 4 * i + kq; const f32x4 w = *(const f32x4*)(W + (size_t)k * 6144 + 4 * nq);
#pragma unroll
                for (int c = 0; c < 5; ++c) acc[c] += w * sc[c * 1024 + k]; }
#pragma unroll
            for (int c = 0; c < 5; ++c) *(LAS f32x4*)(red + ((wave * 4 + kq) * 5 + c) * 48 + 4 * nq) = acc[c];
        }
        __syncthreads();
        if (tid < 240) { const int c = tid / 48, n = tid % 48; float s = 0.f;
#pragma unroll 8
            for (int p = 0; p < 32; ++p) s += red[(p * 5 + c) * 48 + n];
            ((float*)(ws + WS_ADA))[(size_t)(layer * 5 + c) * 6144 + n0 + n] = s + A.in[12][layer * 6144 + n0 + n]; }
        __syncthreads();
        }
    }
    LAS float* scr = (LAS float*)(lds + wave * 16384);
    const int gw = blockIdx.x * NWAVES + wave, NGW = gridDim.x * NWAVES;
    constexpr int I_IN = 16 * 65, I_OUT = 16 * 32, I_GLU = 8 * 16, I_M1 = 16 * 128, I_M2 = 64 * 32, I_QKV = 16 * 48, I_WO = 16 * 32;
    constexpr int NITEMS = I_IN + I_OUT + I_GLU + 2 * I_M1 + 2 * I_M2 + I_QKV + I_WO;
    for (int it = gw; it < NITEMS; it += NGW) {
        int r = it;
        if (r < I_IN) { const int kb = r / 65, nb = r % 65;
            if (nb < 64) p0_transpose_item(A.in[15], INE, 1024, (bf16*)(ws + WS_WIN), 64, scr, kb * 64 + nb, lane);
            else p0_transpose_item(A.in[15] + 2048, INE, 1024, (bf16*)(ws + WS_WGLR), 1, scr, kb, lane);
            continue; } r -= I_IN;
        if (r < I_OUT) { p0_transpose_item(A.in[16], 1024, 1024, (bf16*)(ws + WS_WOUT), 32, scr, r, lane); continue; } r -= I_OUT;
        if (r < I_GLU) { p0_transpose_item(A.in[25], 512, 512, (bf16*)(ws + WS_WGLU), 16, scr, r, lane); continue; } r -= I_GLU;
        if (r < 2 * I_M1) { const int l = r / I_M1; p0_transpose_item(A.in[13] + (size_t)l * 1024 * 4096, 4096, 1024, (bf16*)(ws + WS_W1) + (size_t)l * 4096 * 1024, 128, scr, r % I_M1, lane); continue; } r -= 2 * I_M1;
        if (r < 2 * I_M2) { const int l = r / I_M2; p0_transpose_item(A.in[14] + (size_t)l * 4096 * 1024, 1024, 4096, (bf16*)(ws + WS_W2) + (size_t)l * 1024 * 4096, 32, scr, r % I_M2, lane); continue; } r -= 2 * I_M2;
        if (r < I_QKV) { p0_transpose_item(A.in[30], 1536, 1024, (bf16*)(ws + WS_WQKV), 48, scr, r, lane); continue; } r -= I_QKV;
        p0_transpose_item(A.in[31], 1024, 1024, (bf16*)(ws + WS_WO), 32, scr, r, lane);
    }
}

template <bool GLR>
__device__ __forceinline__ void norm_phase(const Args& A, LAS unsigned char* lds, const float* src_p, const float* src_s, const float* g, const float* ada, int ch_shift, int ch_scale,
                                           int tid, int lane, int wave) {
    unsigned char* ws = A.ws;
    bf16* H = (bf16*)(ws + WS_H);
    for (int blk = blockIdx.x; blk < NTOK / 32; blk += gridDim.x) {
        const int r0 = blk * 32; const int cond = r0 < NPR ? 0 : 1 + ((r0 - NPR) >> 10);
        const float* src = r0 < NPR ? src_p : src_s;
        const float* adc = ada + cond * 6144;
        f32x4 ga[4], gb[4];
#pragma unroll
        for (int j = 0; j < 4; ++j) { const int col = 4 * lane + 256 * j; const f32x4 gg = *(const f32x4*)(g + col), s1 = *(const f32x4*)(adc + ch_scale * 1024 + col); ga[j] = gg * (s1 + 1.0f); gb[j] = *(const f32x4*)(adc + ch_shift * 1024 + col); }
#pragma unroll
        for (int i = 0; i < 4; ++i) { const int row = r0 + wave * 4 + i;
            const GAS f32x4* xr = (const GAS f32x4*)(src + (size_t)row * 1024) + lane;
            f32x4 v[4]; float s = 0.f;
#pragma unroll
            for (int j = 0; j < 4; ++j) { v[j] = xr[64 * j]; s += (v[j].x * v[j].x + v[j].y * v[j].y) + (v[j].z * v[j].z + v[j].w * v[j].w); }
            const float rstd = 1.f / sqrtf(wave_sum(s) * (1.f / 1024.f) + EPS);
            GAS v2u* o8 = (GAS v2u*)(H + (size_t)row * 1024) + lane;
#pragma unroll
            for (int j = 0; j < 4; ++j) { const f32x4 h = v[j] * rstd * ga[j] + gb[j]; v2u w; w.x = pk2(h.x, h.y); w.y = pk2(h.z, h.w); o8[64 * j] = w;
                if (GLR) *(LAS v2u*)(lds + (wave * 4 + i) * 2064 + (4 * lane + 256 * j) * 2) = w; }
        }
        if (GLR) {
            __syncthreads();
            const bf16* WG = (const bf16*)(ws + WS_WGLR);
            const int r32 = lane & 31, hi = lane >> 5;
            f32x16 acc = {};
#pragma unroll
            for (int ks = 0; ks < 8; ++ks) { const int k = wave * 128 + ks * 16 + hi * 8;
                const bf16x8 a = *(const LAS bf16x8*)(lds + r32 * 2064 + k * 2);
                const bf16x8 b = *(const bf16x8*)(WG + (size_t)r32 * 1024 + k);
                acc = __builtin_amdgcn_mfma_f32_32x32x16_bf16(a, b, acc, 0, 0, 0); }
            LAS float* red = (LAS float*)(lds + 69632);
#pragma unroll
            for (int r = 0; r < 16; ++r) red[(wave * 32 + crow(r, hi)) * 32 + r32] = acc[r];
            __syncthreads();
            float* GLRo = (float*)(ws + WS_GLR);
#pragma unroll
            for (int e = 0; e < 2; ++e) { const int idx = tid + 512 * e; float s = 0.f;
#pragma unroll
                for (int w = 0; w < 8; ++w) s += red[w * 1024 + idx];
                GLRo[(size_t)(r0 + (idx >> 5)) * 32 + (idx & 31)] = s; }
            __syncthreads();
        }
    }
}

__device__ __forceinline__ float gelu_tanh(float y) { const float z = 0.7978845608028654f * (y + 0.044715f * y * y * y); const float e = __expf(2.f * z); const float t = 1.f - 2.f / (e + 1.f); return 0.5f * y * (1.f + t); }
__device__ __forceinline__ void s5_wave(const Args& A, LAS unsigned char* wl, LAS float* xch, bool sample, int b, int g, int ck, int pair, int lane) {
    unsigned char* ws = A.ws;
    const bf16* Z = (const bf16*)(ws + WS_Z); float* YF = (float*)(ws + WS_YF); bf16* G = (bf16*)(ws + WS_G);
    const int row0 = sample ? NPR + b * 1024 + ck * 256 : b * 256;
    LAS float* BU = (LAS float*)wl;
    LAS unsigned short* HL = (LAS unsigned short*)(wl + 8448);
    const int fr = lane & 15, fq = lane >> 4;
    bf16x8 cc[4];
#pragma unroll
    for (int ks = 0; ks < 4; ++ks) { const int k = 32 * ks + 8 * fq; const bool im = k >= 64; const float* src = (im ? A.in[23] : A.in[22]) + (size_t)(g * 16 + fr) * 64 + (k & 63);
        const f32x4 a = *(const f32x4*)src, bq = *(const f32x4*)(src + 4); const float sg = im ? -1.f : 1.f;
        v4u w; w.x = pk2(sg * a.x, sg * a.y); w.y = pk2(sg * a.z, sg * a.w); w.z = pk2(sg * bq.x, sg * bq.y); w.w = pk2(sg * bq.z, sg * bq.w); cc[ks] = __builtin_bit_cast(bf16x8, w); }
    const f32x4 dsk = *(const f32x4*)(A.in[24] + g * 16 + 4 * fq);
    float hin_re0 = 0.f, hin_re1 = 0.f, hin_im0 = 0.f, hin_im1 = 0.f;
    for (int pass = sample ? 0 : 1; pass < 2; ++pass) {
        for (int d = 0; d < 2; ++d) {
            const float lre = A.in[17][(d * 32 + g) * 64 + lane], lim = A.in[18][(d * 32 + g) * 64 + lane];
            const float dt = expf(A.in[19][d * 32 + g]);
            const float a_ = lre * dt, th = lim * dt;
            float sn, cs; sincosf(th, &sn, &cs);
            const float ea = expf(a_);
            const float lb_re = ea * cs, lb_im = ea * sn;
            const float sh = sinf(0.5f * th);
            const float nr = expm1f(a_) * cs - 2.f * sh * sh, ni = ea * sn;
            const float den = 1.f / (lre * lre + lim * lim);
            const float cf_re = (nr * lre + ni * lim) * den, cf_im = (ni * lre - nr * lim) * den;
            bf16x8 bb[8];
#pragma unroll
            for (int T = 0; T < 8; ++T) { const int p = 16 * (T & 3) + fr; const float cre = __shfl(cf_re, p), cim = __shfl(cf_im, p);
                v4u w = {0u, 0u, 0u, 0u};
                if (fq < 2) { const float* pr = A.in[20] + (size_t)(g * 64 + p) * 16 + 8 * fq; const float* pi = A.in[21] + (size_t)(g * 64 + p) * 16 + 8 * fq;
                    const f32x4 r0 = *(const f32x4*)pr, r1 = *(const f32x4*)(pr + 4), i0 = *(const f32x4*)pi, i1 = *(const f32x4*)(pi + 4);
                    f32x4 o0, o1;
                    if (T < 4) { o0 = r0 * cre - i0 * cim; o1 = r1 * cre - i1 * cim; } else { o0 = i0 * cre + r0 * cim; o1 = i1 * cre + r1 * cim; }
                    w.x = pk2(o0.x, o0.y); w.y = pk2(o0.z, o0.w); w.z = pk2(o1.x, o1.y); w.w = pk2(o1.z, o1.w); }
                bb[T] = __builtin_bit_cast(bf16x8, w); }
            float h_re, h_im;
            if (pass == 0) { h_re = 0.f; h_im = 0.f; }
            else { h_re = d == 0 ? hin_re0 : hin_re1; h_im = d == 0 ? hin_im0 : hin_im1; }
            for (int sci = 0; sci < 16; ++sci) {
                const int sc = d == 0 ? sci : 15 - sci; const int t0 = row0 + 16 * sc;
                v4u uw = {0u, 0u, 0u, 0u};
                if (fq < 2) uw = *(const v4u*)(Z + (size_t)(t0 + fr) * 2048 + g * 16 + 8 * fq);
                const bf16x8 uf = __builtin_bit_cast(bf16x8, uw);
#pragma unroll
                for (int T = 0; T < 8; ++T) { f32x4 acc = {0.f, 0.f, 0.f, 0.f}; acc = __builtin_amdgcn_mfma_f32_16x16x32_bf16(bb[T], uf, acc, 0, 0, 0);
                    *(LAS f32x4*)(BU + fr * 132 + 16 * T + 4 * fq) = acc; }
                LDS_WAIT();
#pragma unroll
                for (int ii = 0; ii < 16; ++ii) { const int i = d == 0 ? ii : 15 - ii;
                    const float br = BU[i * 132 + lane], bi = BU[i * 132 + 64 + lane];
                    const float nre = fmaf(lb_re, h_re, fmaf(-lb_im, h_im, br)), nim = fmaf(lb_re, h_im, fmaf(lb_im, h_re, bi));
                    h_re = nre; h_im = nim;
                    if (pass == 1) { HL[i * 136 + lane] = (unsigned short)f2bf(h_re); HL[i * 136 + 64 + lane] = (unsigned short)f2bf(h_im);
                        if (!sample && sci == 0 && ii == 0) { A.out[OUT_S5RE + (size_t)((b * 2 + d) * 32 + g) * 64 + lane] = h_re; A.out[OUT_S5IM + (size_t)((b * 2 + d) * 32 + g) * 64 + lane] = h_im; } }
                }
                if (pass == 1) {
                    LDS_WAIT();
                    f32x4 y = {0.f, 0.f, 0.f, 0.f};
#pragma unroll
                    for (int ks = 0; ks < 4; ++ks) { const bf16x8 hf = *(const LAS bf16x8*)((LAS unsigned char*)HL + fr * 272 + (32 * ks + 8 * fq) * 2);
                        y = __builtin_amdgcn_mfma_f32_16x16x32_bf16(cc[ks], hf, y, 0, 0, 0); }
                    float* yfp = YF + (size_t)(t0 + fr) * 512 + g * 16 + 4 * fq;
                    if (d == 0) *(f32x4*)yfp = y;
                    else { const f32x4 yf = *(const f32x4*)yfp; const v2u uu = *(const v2u*)(Z + (size_t)(t0 + fr) * 2048 + g * 16 + 4 * fq);
                        f32x4 u4; u4.x = bflo(uu.x); u4.y = bfhi(uu.x); u4.z = bflo(uu.y); u4.w = bfhi(uu.y);
                        const f32x4 yy = y + yf + dsk * u4;
                        v2u o; o.x = pk2(gelu_tanh(yy.x), gelu_tanh(yy.y)); o.y = pk2(gelu_tanh(yy.z), gelu_tanh(yy.w));
                        *(v2u*)(G + (size_t)(t0 + fr) * 512 + g * 16 + 4 * fq) = o; }
                    LDS_WAIT();
                }
            }
            if (pass == 0) {
                xch[(((pair * 4 + ck) * 2 + d) * 2 + 0) * 64 + lane] = h_re; xch[(((pair * 4 + ck) * 2 + d) * 2 + 1) * 64 + lane] = h_im;
            }
        }
        if (pass == 0) {
            __syncthreads();
            for (int d = 0; d < 2; ++d) {
                const float lre = A.in[17][(d * 32 + g) * 64 + lane], lim = A.in[18][(d * 32 + g) * 64 + lane];
                const float dt = expf(A.in[19][d * 32 + g]);
                float sn, cs; sincosf(lim * dt, &sn, &cs); const float ea = expf(lre * dt);
                float pr = ea * cs, pi = ea * sn;
#pragma unroll
                for (int s = 0; s < 8; ++s) { const float nr = pr * pr - pi * pi, ni = 2.f * pr * pi; pr = nr; pi = ni; }
                float hr = A.in[2][(size_t)((b * 2 + d) * 32 + g) * 64 + lane], hi_ = A.in[3][(size_t)((b * 2 + d) * 32 + g) * 64 + lane];
                if (d == 0) { for (int j = 0; j < ck; ++j) { const float er = xch[(((pair * 4 + j) * 2 + 0) * 2 + 0) * 64 + lane], ei = xch[(((pair * 4 + j) * 2 + 0) * 2 + 1) * 64 + lane];
                        const float nr = pr * hr - pi * hi_ + er, ni = pr * hi_ + pi * hr + ei; hr = nr; hi_ = ni; } }
                else { for (int j = 3; j > ck; --j) { const float er = xch[(((pair * 4 + j) * 2 + 1) * 2 + 0) * 64 + lane], ei = xch[(((pair * 4 + j) * 2 + 1) * 2 + 1) * 64 + lane];
                        const float nr = pr * hr - pi * hi_ + er, ni = pr * hi_ + pi * hr + ei; hr = nr; hi_ = ni; } }
                if (d == 0) { hin_re0 = hr; hin_im0 = hi_; } else { hin_re1 = hr; hin_im1 = hi_; }
            }
        }
    }
}

__device__ __forceinline__ int gla_slot(int bb, int h, int d, int j) { return bb < 16 ? ((bb * 4 + h) * 2 + d) * 4 + j : 512 + (((bb - 16) * 4 + h) * 2 + d) * 16 + j; }
constexpr int GL_V = 0, GL_VROW = 320;
constexpr int GL_KT = 20480, GL_KTROW = 144;
constexpr int GL_TOT = GL_KT + 4 * 9216;
constexpr int GL_PART = GL_TOT + 2048;
constexpr int GL_BYTES = GL_PART + 1024;
template <int MODE>
__device__ __forceinline__ void gla_prep(const Args& A, LAS unsigned char* lds, int bb, int h, int j, int row0, int tid, int lane, int wave) {
    unsigned char* ws = A.ws;
    const bf16* Z = (const bf16*)(ws + WS_Z); const float* GLRi = (const float*)(ws + WS_GLR);
    const int d = wave >> 2, wg = wave & 3;
#pragma unroll
    for (int i = 0; i < 2; ++i) { const int r = (tid >> 4) + 32 * i, c = tid & 15;
        const v4u v = *(const v4u*)(Z + (size_t)(row0 + r) * 2048 + 1024 + h * 128 + 8 * c);
        *(LAS v4u*)(lds + GL_V + r * GL_VROW + c * 16) = v; }
    float wg2[16];
#pragma unroll
    for (int r = 0; r < 16; ++r) wg2[r] = A.in[27][(size_t)(d * 16 + r) * 256 + h * 64 + lane];
    const float bg = A.in[28][d * 256 + h * 64 + lane];
    float gd[16]; float tot = 0.f;
#pragma unroll
    for (int i = 0; i < 16; ++i) { const float* gp = GLRi + (size_t)(row0 + 16 * wg + i) * 32 + 16 * d;
        float x = bg;
#pragma unroll
        for (int r = 0; r < 16; ++r) x = fmaf(gp[r], wg2[r], x);
        const float ls = fminf(x, 0.f) - log1pf(__expf(-fabsf(x)));
        gd[i] = ls * (1.f / 16.f); tot += gd[i]; }
    LAS float* TOT = (LAS float*)(lds + GL_TOT);
    TOT[(d * 4 + wg) * 64 + lane] = tot;
    __syncthreads();
    float off = 0.f, total = 0.f;
#pragma unroll
    for (int w = 0; w < 4; ++w) { const float tw = TOT[(d * 4 + w) * 64 + lane]; total += tw; if (d == 0 ? (w < wg) : (w > wg)) off += tw; }
    float bcum[16];
    if (d == 0) { float s = off;
#pragma unroll
        for (int i = 0; i < 16; ++i) { s += gd[i]; bcum[i] = s; } }
    else { float s = off;
#pragma unroll
        for (int i = 15; i >= 0; --i) { s += gd[i]; bcum[i] = s; } }
    LAS unsigned char* img = lds + GL_KT + d * 2 * 9216;
    if (MODE == 0) {
        unsigned pkk[8];
#pragma unroll
        for (int i = 0; i < 16; i += 2) { const float k0 = bf2f(Z[(size_t)(row0 + 16 * wg + i) * 2048 + 768 + h * 64 + lane]), k1 = bf2f(Z[(size_t)(row0 + 16 * wg + i + 1) * 2048 + 768 + h * 64 + lane]);
            pkk[i >> 1] = pk2(k0 * __expf(total - bcum[i]), k1 * __expf(total - bcum[i + 1])); }
        *(LAS v4u*)(img + lane * GL_KTROW + 32 * wg) = (v4u){pkk[0], pkk[1], pkk[2], pkk[3]};
        *(LAS v4u*)(img + lane * GL_KTROW + 32 * wg + 16) = (v4u){pkk[4], pkk[5], pkk[6], pkk[7]};
        if (wg == 0) ((float*)(ws + WS_DEC))[(size_t)gla_slot(bb, h, d, j) * 64 + lane] = __expf(total);
    } else {
#pragma unroll
        for (int i = 0; i < 16; ++i) { const size_t zr = (size_t)(row0 + 16 * wg + i) * 2048 + h * 64 + lane;
            const float q = bf2f(Z[zr + 512]) * 0.125f, k = bf2f(Z[zr + 768]);
            *(LAS unsigned short*)(img + (16 * wg + i) * GL_KTROW + lane * 2) = (unsigned short)f2bf(q * __expf(bcum[i]));
            *(LAS unsigned short*)(img + 9216 + (16 * wg + i) * GL_KTROW + lane * 2) = (unsigned short)f2bf(k * __expf(-bcum[i])); }
    }
    __syncthreads();
}
__device__ __forceinline__ void gla_task_rows(int task, int& bb, int& h, int& j, int& row0) {
    if (task < 256) { bb = task >> 4; h = (task >> 2) & 3; j = task & 3; row0 = bb * 256 + 64 * j; }
    else { const int t = task - 256; bb = 16 + (t >> 6); h = (t >> 4) & 3; j = t & 15; row0 = NPR + (bb - 16) * 1024 + 64 * j; }
}
__device__ __forceinline__ void gla_a_task(const Args& A, LAS unsigned char* lds, int task, int tid, int lane, int wave) {
    int bb, h, j, row0; gla_task_rows(task, bb, h, j, row0);
    gla_prep<0>(A, lds, bb, h, j, row0, tid, lane, wave);
    const int d = wave >> 2, wg = wave & 3, r32 = lane & 31, hi = lane >> 5;
    const unsigned lbase = (unsigned)(uintptr_t)(lds);
    const unsigned vaddr = lbase + GL_V + (8 * hi + ((lane & 15) >> 2)) * GL_VROW + (32 * wg + 16 * ((lane >> 4) & 1) + 4 * (lane & 3)) * 2;
    LAS unsigned char* img = lds + GL_KT + d * 2 * 9216;
    f32x16 acc0 = {}, acc1 = {};
#pragma unroll
    for (int ks = 0; ks < 4; ++ks) {
        const s16x4 lo = tr_read4(vaddr + (16 * ks) * GL_VROW), hi4 = tr_read4(vaddr + (16 * ks + 4) * GL_VROW);
        const bf16x8 b0 = *(const LAS bf16x8*)(img + r32 * GL_KTROW + (16 * ks + 8 * hi) * 2);
        const bf16x8 b1 = *(const LAS bf16x8*)(img + (32 + r32) * GL_KTROW + (16 * ks + 8 * hi) * 2);
        asm volatile("s_waitcnt lgkmcnt(0)" ::: "memory"); __builtin_amdgcn_sched_barrier(0);
        const bf16x8 a = (bf16x8){lo[0], lo[1], lo[2], lo[3], hi4[0], hi4[1], hi4[2], hi4[3]};
        acc0 = __builtin_amdgcn_mfma_f32_32x32x16_bf16(a, b0, acc0, 0, 0, 0);
        acc1 = __builtin_amdgcn_mfma_f32_32x32x16_bf16(a, b1, acc1, 0, 0, 0);
    }
    float* SL = (float*)(A.ws + WS_SLOC) + (size_t)gla_slot(bb, h, d, j) * 8192;
#pragma unroll
    for (int r = 0; r < 16; ++r) { const int v = 32 * wg + crow(r, hi); SL[v * 64 + r32] = acc0[r]; SL[v * 64 + 32 + r32] = acc1[r]; }
    __syncthreads();
}
__device__ __forceinline__ void gla_b_phase(const Args& A, int gtid, int nthreads) {
    unsigned char* ws = A.ws;
    const float* SL = (const float*)(ws + WS_SLOC); const float* DEC = (const float*)(ws + WS_DEC); bf16* SIN = (bf16*)(ws + WS_SIN);
    for (int it = gtid; it < 160 * 2048; it += nthreads) {
        const int s = it >> 11, e = it & 2047;
        const int grp = s / 5, m = s % 5; const int chain = m == 4 ? 128 + grp : grp * 4 + m;
        const bool samp = chain >= 128; const int ci = samp ? chain - 128 : chain;
        const int bb = (samp ? 16 : 0) + (ci >> 3), h = (ci >> 1) & 3, d = ci & 1, n = samp ? 16 : 4;
        const int v = e >> 4, kk = (e & 15) * 4;
        f32x4 S = {0.f, 0.f, 0.f, 0.f};
        if (samp) { const float* s0 = A.in[4] + (size_t)(((bb - 16) * 2 + d) * 4 + h) * 8192;
#pragma unroll
            for (int q = 0; q < 4; ++q) S[q] = s0[(kk + q) * 128 + v]; }
        for (int i = 0; i < n; ++i) { const int j = d == 0 ? i : n - 1 - i; const size_t slot = (size_t)gla_slot(bb, h, d, j);
            v2u w; w.x = pk2(S.x, S.y); w.y = pk2(S.z, S.w); *(v2u*)(SIN + slot * 8192 + v * 64 + kk) = w;
            const f32x4 dc = *(const f32x4*)(DEC + slot * 64 + kk), sl = *(const f32x4*)(SL + slot * 8192 + v * 64 + kk);
            S = S * dc + sl; }
        if (!samp) { float* o = A.out + OUT_GLA + (size_t)((bb * 2 + d) * 4 + h) * 8192;
#pragma unroll
            for (int q = 0; q < 4; ++q) o[(kk + q) * 128 + v] = S[q]; }
    }
}
__device__ __forceinline__ void gla_c_task(const Args& A, LAS unsigned char* lds, int task, int tid, int lane, int wave) {
    int bb, h, j, row0; gla_task_rows(task, bb, h, j, row0);
    gla_prep<1>(A, lds, bb, h, j, row0, tid, lane, wave);
    unsigned char* ws = A.ws;
    const bf16* Z = (const bf16*)(ws + WS_Z); const bf16* SIN = (const bf16*)(ws + WS_SIN); bf16* MIX = (bf16*)(ws + WS_MIX);
    const int ti = wave >> 2, vi = wave & 3, r32 = lane & 31, hi = lane >> 5;
    const unsigned lbase = (unsigned)(uintptr_t)(lds);
    const unsigned vaddr = lbase + GL_V + (4 * hi + ((lane & 15) >> 2)) * GL_VROW + (32 * vi + 16 * ((lane >> 4) & 1) + 4 * (lane & 3)) * 2;
    f32x16 o = {};
    const int t = 32 * ti + r32;
#pragma unroll
    for (int d = 0; d < 2; ++d) {
        LAS unsigned char* qimg = lds + GL_KT + d * 2 * 9216; LAS unsigned char* kimg = qimg + 9216;
        bf16x8 qf[4];
#pragma unroll
        for (int ks = 0; ks < 4; ++ks) qf[ks] = *(const LAS bf16x8*)(qimg + t * GL_KTROW + (16 * ks + 8 * hi) * 2);
        const bf16* SI = SIN + (size_t)gla_slot(bb, h, d, j) * 8192 + (size_t)(32 * vi + r32) * 64 + 8 * hi;
#pragma unroll
        for (int ks = 0; ks < 4; ++ks) { const bf16x8 sa = *(const bf16x8*)(SI + 16 * ks); o = __builtin_amdgcn_mfma_f32_32x32x16_bf16(sa, qf[ks], o, 0, 0, 0); }
#pragma unroll
        for (int si = 0; si < 2; ++si) {
            f32x16 x = {};
#pragma unroll
            for (int ks = 0; ks < 4; ++ks) { const bf16x8 ka = *(const LAS bf16x8*)(kimg + (32 * si + r32) * GL_KTROW + (16 * ks + 8 * hi) * 2); x = __builtin_amdgcn_mfma_f32_32x32x16_bf16(ka, qf[ks], x, 0, 0, 0); }
            unsigned pw[8];
#pragma unroll
            for (int r = 0; r < 16; r += 2) { const int s0 = 32 * si + crow(r, hi), s1 = s0 + 1;
                const float x0 = (d == 0 ? (s0 <= t) : (s0 >= t)) ? x[r] : 0.f, x1 = (d == 0 ? (s1 <= t) : (s1 >= t)) ? x[r + 1] : 0.f;
                pw[r >> 1] = pk2(x0, x1); }
#pragma unroll
            for (int sp = 0; sp < 2; ++sp) {
                const s16x4 lo = tr_read4(vaddr + (32 * si + 16 * sp) * GL_VROW), hi4 = tr_read4(vaddr + (32 * si + 16 * sp + 8) * GL_VROW);
                asm volatile("s_waitcnt lgkmcnt(0)" ::: "memory"); __builtin_amdgcn_sched_barrier(0);
                const bf16x8 va = (bf16x8){lo[0], lo[1], lo[2], lo[3], hi4[0], hi4[1], hi4[2], hi4[3]};
                const v4u pq = {pw[4 * sp], pw[4 * sp + 1], pw[4 * sp + 2], pw[4 * sp + 3]};
                o = __builtin_amdgcn_mfma_f32_32x32x16_bf16(va, __builtin_bit_cast(bf16x8, pq), o, 0, 0, 0);
            }
        }
    }
    float ss = 0.f;
#pragma unroll
    for (int r = 0; r < 16; ++r) ss += o[r] * o[r];
    ss += __shfl_xor(ss, 32);
    LAS float* PART = (LAS float*)(lds + GL_PART);
    if (hi == 0) PART[(ti * 4 + vi) * 32 + r32] = ss;
    __syncthreads();
    const float tot = PART[(ti * 4 + 0) * 32 + r32] + PART[(ti * 4 + 1) * 32 + r32] + PART[(ti * 4 + 2) * 32 + r32] + PART[(ti * 4 + 3) * 32 + r32];
    const float rstd = 1.f / sqrtf(tot * (1.f / 128.f) + EPS);
    const size_t row = (size_t)(row0 + t);
#pragma unroll
    for (int rq = 0; rq < 4; ++rq) { const int v = 32 * vi + 8 * rq + 4 * hi;
        const v2u rr = *(const v2u*)(Z + row * 2048 + 1536 + h * 128 + v);
        const f32x4 gn = *(const f32x4*)(A.in[29] + v);
        float rv[4] = {bflo(rr.x), bfhi(rr.x), bflo(rr.y), bfhi(rr.y)}; float ov[4];
#pragma unroll
        for (int e = 0; e < 4; ++e) { const float sl = rv[e] / (1.f + __expf(-rv[e])); ov[e] = o[4 * rq + e] * rstd * gn[e] * sl; }
        v2u w; w.x = pk2(ov[0], ov[1]); w.y = pk2(ov[2], ov[3]);
        *(v2u*)(MIX + row * 1024 + 512 + h * 128 + v) = w; }
    __syncthreads();
}

__device__ __forceinline__ void qk_phase(const Args& A, int lane, int gw, int ngw) {
    unsigned char* ws = A.ws;
    const bf16* QKV = (const bf16*)(ws + WS_QKV); bf16* QN = (bf16*)(ws + WS_QN);
    const float qw0 = A.in[32][2 * lane], qw1 = A.in[32][2 * lane + 1], kw0 = A.in[33][2 * lane], kw1 = A.in[33][2 * lane + 1];
    const float inv = __powf(10000.f, -(float)(2 * (lane & 31)) / 64.f);
    for (int row = gw; row < NTOK + 2048; row += ngw) {
        if (row >= NTOK) {
            const int cr = row - NTOK, b = cr >> 9, pl = cr & 511;
            const f32x4 kx = *(const f32x4*)(A.in[5] + (size_t)(b * 512 + pl) * 256 + 4 * lane), vx = *(const f32x4*)(A.in[6] + (size_t)(b * 512 + pl) * 256 + 4 * lane);
            v2u kwd, vwd; kwd.x = pk2(kx.x, kx.y); kwd.y = pk2(kx.z, kx.w); vwd.x = pk2(vx.x, vx.y); vwd.y = pk2(vx.z, vx.w);
            *(v2u*)((bf16*)(ws + WS_KS) + (size_t)(b * 1536 + 1024 + pl) * 256 + 4 * lane) = kwd;
            *(v2u*)((bf16*)(ws + WS_VS) + (size_t)(b * 1536 + 1024 + pl) * 256 + 4 * lane) = vwd;
            continue;
        }
        const bool samp = row >= NPR; const int b = samp ? (row - NPR) >> 10 : row >> 8, t = samp ? (row - NPR) & 1023 : row & 255;
        float cs = 1.f, sn = 0.f;
        if (samp) { const float pos = (float)(lane < 32 ? (t >> 6) : (t & 63)); sincosf(pos * inv, &sn, &cs); }
        const unsigned* src = (const unsigned*)(QKV + (size_t)row * QKVW);
        bf16* kdst = samp ? (bf16*)(ws + WS_KS) + (size_t)(b * 1536 + t) * 256 : (bf16*)(ws + WS_KP) + (size_t)row * 256;
        bf16* vdst = samp ? (bf16*)(ws + WS_VS) + (size_t)(b * 1536 + t) * 256 : (bf16*)(ws + WS_VP) + (size_t)row * 256;
#pragma unroll
        for (int hd = 0; hd < 10; ++hd) {
            const unsigned w = src[hd * 64 + lane]; float x0 = bflo(w), x1 = bfhi(w);
            const float rstd = 1.f / sqrtf(wave_sum(x0 * x0 + x1 * x1) * (1.f / 128.f) + EPS);
            x0 *= rstd * (hd < 8 ? qw0 : kw0); x1 *= rstd * (hd < 8 ? qw1 : kw1);
            if (hd >= 8 && !samp) { float* nk = A.out + OUT_NK + ((size_t)row * 2 + (hd - 8)) * 128 + 2 * lane; nk[0] = x0; nk[1] = x1; }
            const float y0 = x0 * cs - x1 * sn, y1 = x0 * sn + x1 * cs;
            const unsigned ow = pk2(y0, y1);
            if (hd < 8) ((unsigned*)(QN + (size_t)row * 1024))[hd * 64 + lane] = ow;
            else ((unsigned*)kdst)[(hd - 8) * 64 + lane] = ow;
        }
#pragma unroll
        for (int hv = 0; hv < 2; ++hv) { const unsigned w = src[(10 + hv) * 64 + lane]; ((unsigned*)vdst)[hv * 64 + lane] = w;
            if (!samp) { float* nv = A.out + OUT_NV + ((size_t)row * 2 + hv) * 128 + 2 * lane; nv[0] = bflo(w); nv[1] = bfhi(w); } }
    }
}

#ifndef DBL_MASK
#define DBL_MASK 0u
#endif
#ifndef XBAR_N
#define XBAR_N 0
#endif
__global__ void __launch_bounds__(NWAVES * 64, 2) fwd_kernel(Args args) {
    extern __shared__ __attribute__((aligned(16))) unsigned char lds_raw[];
    LAS unsigned char* lds = (LAS unsigned char*)lds_raw;
    volatile LAS unsigned* MISC = (volatile LAS unsigned*)(lds + MISC_OFF);
    const int tid = threadIdx.x, lane = tid & 63, wave = __builtin_amdgcn_readfirstlane(tid >> 6);
    const int G = gridDim.x;
    unsigned char* ws = args.ws;
    gu32* ctl = (gu32*)(ws + WS_CTL);
    for (int u = tid; u < (LDS_BYTES - LDSCTL_OFF) / 4; u += NWAVES * 64) ((LAS unsigned*)(lds + LDSCTL_OFF))[u] = 0u;
    __syncthreads();
    const int lo = args.ph_lo, hi = args.ph_hi;
    const bool use_bar = (hi - lo) > 1;
    XcdBarrier bar; bar.bar = (unsigned*)(ctl + CW_BAR); bar.x = 0; bar.st = nullptr;
    if (use_bar) bar = xcd_barrier_post((unsigned*)(ctl + CW_BAR), MISC + 8);
#define IN(k) (lo <= (k) && (k) < hi)
#define SEAM(k) do { if ((k) + 1 < hi) xcd_barrier(bar); } while (0)
#define REPS(k) (((DBL_MASK >> (k)) & 1u) ? 2 : 1)
#define SEAM2(k) do { if (rep_ + 1 < REPS(k)) xcd_barrier(bar); else SEAM(k); } while (0)
    const float* ADA = (const float*)(ws + WS_ADA);
    bf16* H = (bf16*)(ws + WS_H); float* Y = (float*)(ws + WS_Y);
    const float* xs_off = args.in[1] - (size_t)NPR * 1024;

    if (IN(0)) for (int rep_ = 0; rep_ < REPS(0); ++rep_) { p0_prologue(args, lds, tid, lane, wave); SEAM2(0); }
    for (int xb_ = 0; xb_ < XBAR_N; ++xb_) xcd_barrier(bar);
    if (IN(1)) for (int rep_ = 0; rep_ < REPS(1); ++rep_) { norm_phase<true>(args, lds, args.in[0], xs_off, args.in[9], ADA, 0, 1, tid, lane, wave); SEAM2(1); }
    if (IN(2)) for (int rep_ = 0; rep_ < REPS(2); ++rep_) { pg8::Gemm g{H, (const bf16*)(ws + WS_WIN), NTOK, INW, 1024, 1024, 1024}; pg8::StaticOrder S; S.init(NTOK, INW, G, (int)blockIdx.x);
        pg8::EpiBf16<0> E{(bf16*)(ws + WS_Z), INW};
        pg8::gemm_phase<pg8::EpiBf16<0>, pg8::StaticOrder, true, true>(lds, g, S, E); SEAM2(2); }
    if (IN(3)) for (int rep_ = 0; rep_ < REPS(3); ++rep_) {
        for (int vb = blockIdx.x; vb < 256; vb += G) {
            if (vb < 64) { const int pg = vb * 2 + (wave >> 2); s5_wave(args, lds + wave * 12800, (LAS float*)(lds + 8 * 12800), true, pg >> 5, pg & 31, wave & 3, wave >> 2, lane); __syncthreads(); }
            else if (vb < 128) { const int idx = (vb - 64) * 8 + wave; s5_wave(args, lds + wave * 12800, (LAS float*)(lds + 8 * 12800), false, idx >> 5, idx & 31, 0, 0, lane); __syncthreads(); }
            else { for (int q = 0; q < 4; ++q) gla_a_task(args, lds, (vb - 128) * 4 + q, tid, lane, wave); }
        }
        SEAM2(3); }
    if (IN(4)) for (int rep_ = 0; rep_ < REPS(4); ++rep_) {
        const int ngemm = G >= 128 ? 64 : G;
        if ((int)blockIdx.x < ngemm) { pg8::Gemm g{(const bf16*)(ws + WS_G), (const bf16*)(ws + WS_WGLU), NTOK, 512, 512, 512, 512}; pg8::StaticOrder S; S.init(NTOK, 512, ngemm, (int)blockIdx.x);
            pg8::EpiGlu E{(const bf16*)(ws + WS_G), (bf16*)(ws + WS_MIX), args.in[26]};
            pg8::gemm_phase<pg8::EpiGlu, pg8::StaticOrder, true, true>(lds, g, S, E); }
        if (G < 128 || (int)blockIdx.x >= ngemm) { const int nb = G < 128 ? G : G - ngemm, bi = G < 128 ? (int)blockIdx.x : (int)blockIdx.x - ngemm; gla_b_phase(args, bi * 512 + tid, nb * 512); }
        SEAM2(4); }
    if (IN(5)) for (int rep_ = 0; rep_ < REPS(5); ++rep_) { for (int task = blockIdx.x; task < 512; task += G) gla_c_task(args, lds, task, tid, lane, wave); SEAM2(5); }
    if (IN(6)) for (int rep_ = 0; rep_ < REPS(6); ++rep_) { pg8::Gemm g{(const bf16*)(ws + WS_MIX), (const bf16*)(ws + WS_WOUT), NTOK, 1024, 1024, 1024, 1024}; pg8::StaticOrder S; S.init(NTOK, 1024, G, (int)blockIdx.x);
        pg8::EpiResid E{args.in[0], xs_off, Y, ADA + 2 * 1024};
        pg8::gemm_phase<pg8::EpiResid, pg8::StaticOrder, true, true>(lds, g, S, E); SEAM2(6); }
    if (IN(7)) for (int rep_ = 0; rep_ < REPS(7); ++rep_) { norm_phase<false>(args, lds, Y, Y, args.in[10], ADA, 3, 4, tid, lane, wave); SEAM2(7); }
    if (IN(8)) for (int rep_ = 0; rep_ < REPS(8); ++rep_) { pg8::Gemm g{H, (const bf16*)(ws + WS_W1), NTOK, FF, 1024, 1024, 1024}; pg8::StaticOrder S; S.init(NTOK, FF, G, (int)blockIdx.x);
        pg8::EpiBf16<2> E{(bf16*)(ws + WS_ACT), FF};
        pg8::gemm_phase<pg8::EpiBf16<2>, pg8::StaticOrder, true, true>(lds, g, S, E); SEAM2(8); }
    if (IN(9)) for (int rep_ = 0; rep_ < REPS(9); ++rep_) { const int bx = blockIdx.x, kh = (bx >> 3) & 1, jx = bx >> 4;
        pg8::Gemm g{(const bf16*)(ws + WS_ACT) + kh * 2048, (const bf16*)(ws + WS_W2) + kh * 2048, NTOK, 1024, 2048, FF, FF}; SplitKOrder S{4 * (bx & 7) + (jx >> 2), jx & 3};
        EpiResidSplit E{Y, Y, ADA + 5 * 1024, (float*)(ws + WS_XBUF), bar, kh};
        pg8::gemm_phase<EpiResidSplit, SplitKOrder, false, true>(lds, g, S, E); SEAM2(9); }
    const float* ADA1 = ADA + 5 * 6144;
    if (IN(10)) for (int rep_ = 0; rep_ < REPS(10); ++rep_) { norm_phase<false>(args, lds, Y, Y, args.in[9] + 1024, ADA1, 0, 1, tid, lane, wave); SEAM2(10); }
    if (IN(11)) for (int rep_ = 0; rep_ < REPS(11); ++rep_) { pg8::Gemm g{H, (const bf16*)(ws + WS_WQKV), NTOK, QKVW, 1024, 1024, 1024}; pg8::StaticOrder S; S.init(NTOK, QKVW, G, (int)blockIdx.x);
        pg8::EpiBf16<0> E{(bf16*)(ws + WS_QKV), QKVW};
        pg8::gemm_phase<pg8::EpiBf16<0>, pg8::StaticOrder, true, true>(lds, g, S, E); SEAM2(11); }
    if (IN(12)) for (int rep_ = 0; rep_ < REPS(12); ++rep_) { qk_phase(args, lane, blockIdx.x * NWAVES + wave, G * NWAVES); SEAM2(12); }
    if (IN(13)) for (int rep_ = 0; rep_ < REPS(13); ++rep_) {
        const att::bf16* QN = (const att::bf16*)(ws + WS_QN); att::bf16* OB = (att::bf16*)(ws + WS_OB);
        for (int u = blockIdx.x; u < 256; u += G) {
            if (u < 128) { const int b = u >> 5, hq = (u >> 2) & 7, qb = u & 3; const size_t qrow = (size_t)NPR + b * 1024 + qb * 256;
                att::attn_dense_body<att::bf16>(QN + qrow * 1024 + hq * 128, (const att::bf16*)(ws + WS_KS) + (size_t)b * 1536 * 256 + (hq >> 2) * 128, (const att::bf16*)(ws + WS_VS) + (size_t)b * 1536 * 256 + (hq >> 2) * 128,
                                                OB + qrow * 1024 + hq * 128, 1536, (char*)lds_raw); }
            else { const int v = u - 128, b = v >> 3, hq = v & 7; const size_t qrow = (size_t)b * 256;
                att::attn_dense_body<att::bf16>(QN + qrow * 1024 + hq * 128, (const att::bf16*)(ws + WS_KP) + qrow * 256 + (hq >> 2) * 128, (const att::bf16*)(ws + WS_VP) + qrow * 256 + (hq >> 2) * 128,
                                                OB + qrow * 1024 + hq * 128, 256, (char*)lds_raw); }
            __syncthreads();
        }
        SEAM2(13); }
    if (IN(14)) for (int rep_ = 0; rep_ < REPS(14); ++rep_) { pg8::Gemm g{(const bf16*)(ws + WS_OB), (const bf16*)(ws + WS_WO), NTOK, 1024, 1024, 1024, 1024}; pg8::StaticOrder S; S.init(NTOK, 1024, G, (int)blockIdx.x);
        pg8::EpiResid E{Y, Y, Y, ADA1 + 2 * 1024};
        pg8::gemm_phase<pg8::EpiResid, pg8::StaticOrder, true, true>(lds, g, S, E); SEAM2(14); }
    if (IN(15)) for (int rep_ = 0; rep_ < REPS(15); ++rep_) { norm_phase<false>(args, lds, Y, Y, args.in[10] + 1024, ADA1, 3, 4, tid, lane, wave); SEAM2(15); }
    if (IN(16)) for (int rep_ = 0; rep_ < REPS(16); ++rep_) { pg8::Gemm g{H, (const bf16*)(ws + WS_W1) + (size_t)4096 * 1024, NTOK, FF, 1024, 1024, 1024}; pg8::StaticOrder S; S.init(NTOK, FF, G, (int)blockIdx.x);
        pg8::EpiBf16<2> E{(bf16*)(ws + WS_ACT), FF};
        pg8::gemm_phase<pg8::EpiBf16<2>, pg8::StaticOrder, true, true>(lds, g, S, E); SEAM2(16); }
    if (IN(17)) for (int rep_ = 0; rep_ < REPS(17); ++rep_) { const int bx = blockIdx.x, kh = (bx >> 3) & 1, jx = bx >> 4;
        pg8::Gemm g{(const bf16*)(ws + WS_ACT) + kh * 2048, (const bf16*)(ws + WS_W2) + (size_t)1024 * 4096 + kh * 2048, NTOK, 1024, 2048, FF, FF}; SplitKOrder S{4 * (bx & 7) + (jx >> 2), jx & 3};
        EpiResidSplit E{Y, args.out + OUT_Y, ADA1 + 5 * 1024, (float*)(ws + WS_XBUF), bar, kh};
        pg8::gemm_phase<EpiResidSplit, SplitKOrder, false, true>(lds, g, S, E); SEAM2(17); }
#undef IN
#undef SEAM
}
constexpr int N_PHASES = 18;

#ifndef MK_ONE_LAUNCH
#define MK_ONE_LAUNCH 1
#endif
extern "C" void kernel_launch(void* const* d_in, const int* in_sizes, int n_in, void* d_out, int out_size, void* d_ws, size_t ws_size, hipStream_t stream) {
    static int grid = 0;
    if (grid == 0) {
        if (n_in != 34 || out_size != (int)OUT_END || ws_size < WS_END) { fprintf(stderr, "kernel_launch: unexpected shapes: n_in %d out %d ws %zu\n", n_in, out_size, ws_size); grid = -1; return; }
        int dev = 0, cus = 0, per_cu = 0;
        if (hipGetDevice(&dev) != hipSuccess || hipDeviceGetAttribute(&cus, hipDeviceAttributeMultiprocessorCount, dev) != hipSuccess) { grid = -1; return; }
        if (hipFuncSetAttribute((const void*)fwd_kernel, hipFuncAttributeMaxDynamicSharedMemorySize, LDS_BYTES) != hipSuccess) { fprintf(stderr, "kernel_launch: hipFuncSetAttribute failed\n"); grid = -1; return; }
        if (hipOccupancyMaxActiveBlocksPerMultiprocessor(&per_cu, (const void*)fwd_kernel, NWAVES * 64, LDS_BYTES) != hipSuccess || per_cu < 1) { fprintf(stderr, "kernel_launch: occupancy query says %d blocks per CU\n", per_cu); }
        (void)hipGetLastError();
        grid = cus < 256 ? cus : 256;
        if (grid != 256) { fprintf(stderr, "kernel_launch: this kernel needs a 256-CU device (one workgroup per CU); found %d\n", cus); grid = -1; return; }
    }
    if (grid < 0) return;
    (void)hipMemsetAsync((char*)d_ws + WS_CTL, 0, CTL_ZERO_BYTES, stream);
    Args a{};
    for (int i = 0; i < 34; ++i) a.in[i] = (const float*)d_in[i];
    a.out = (float*)d_out; a.ws = (unsigned char*)d_ws;
#if MK_ONE_LAUNCH
    a.ph_lo = 0; a.ph_hi = N_PHASES;
    hipLaunchKernelGGL(fwd_kernel, dim3(grid), dim3(NWAVES * 64), LDS_BYTES, stream, a);
#else
    for (int p = 0; p < N_PHASES; ++p) { a.ph_lo = p; a.ph_hi = p + 1; hipLaunchKernelGGL(fwd_kernel, dim3(grid), dim3(NWAVES * 64), LDS_BYTES, stream, a); }
#endif
    const hipError_t le = hipPeekAtLastError();
    if (le != hipSuccess) fprintf(stderr, "kernel_launch: launch failed: %s\n", hipGetErrorName(le));
}
```

```cpp
#include <hip/hip_runtime.h>
#include <hip/hip_bf16.h>
#include <cstdio>
#include <cstdint>
#include <cmath>
namespace pg8 {
#define PG8_LAS __attribute__((address_space(3)))
typedef unsigned short bf16_t;
typedef short bf16x8 __attribute__((ext_vector_type(8)));
typedef float f32x4 __attribute__((ext_vector_type(4)));
typedef unsigned u32x4 __attribute__((ext_vector_type(4)));
constexpr int BM = 256, BK = 64, HALF = 128, HTB = HALF * BK * 2  , STAGE_BYTES = 8 * HTB, NXCD = 8, WGM = 8;

__host__ __device__ __forceinline__ int lds_byte(int r, int c) { const int st = (r >> 4) * 2 + (c >> 5), rr = r & 15, cc = c & 31, ob = rr * 64 + cc * 2; return st * 1024 + (ob ^ (((ob >> 9) & 1) << 5)); }
__host__ __device__ __forceinline__ void stage_rc(int b, int& R, int& C) { const int st = b / 1024, sb = b % 1024, swz = sb ^ (((sb >> 9) & 1) << 5); R = (st >> 1) * 16 + swz / 64; C = (st & 1) * 32 + (swz % 64) / 2; }
__host__ __device__ __forceinline__ int perm32(int rho) { const int n = rho >> 4, i = rho & 15; return 8 * (i >> 2) + 4 * n + (i & 3); }

struct Unit { int pm, pn; };
struct Gemm { const bf16_t* A; const bf16_t* Bt; int M, N, K, lda, ldb; };

struct StaticOrder {
    int nM, nN, nwg, G, c;
    __host__ __device__ void init(int M, int N, int G_, int c_) { nM = M / BM; nN = N / BM; nwg = nM * nN; G = G_; c = c_; }
    __host__ __device__ bool next(int i, Unit& u) const {
        const long L = (long)i * G + c; if (L >= nwg) return false;
        int wgid = (int)L; { const int q = nwg / NXCD, r = nwg % NXCD, xcd = wgid % NXCD, off = wgid / NXCD; wgid = (xcd < r ? xcd * (q + 1) : r * (q + 1) + (xcd - r) * q) + off; }
        const int nig = WGM * nN, gid = wgid / nig, fm = gid * WGM, gsz = (nM - fm) < WGM ? (nM - fm) : WGM;
        u.pm = fm + ((wgid % nig) % gsz); u.pn = (wgid % nig) / gsz; return true;
    }
    __device__ __forceinline__ void a_ready(const Unit&) const {}
    __device__ __forceinline__ void done(const Unit&) const {}
};

__device__ __forceinline__ unsigned cvt_pk_bf16(float lo, float hi) { unsigned r; asm volatile("v_cvt_pk_bf16_f32 %0, %1, %2" : "=v"(r) : "v"(lo), "v"(hi)); return r; }
typedef float f32x2 __attribute__((ext_vector_type(2)));
template <int ACT  > struct EpiBf16 {
    static constexpr bool PERM = true, AFTER_DRAIN = false;
    bf16_t* O; int ldc;
    __device__ __forceinline__ void operator()(const f32x4 (&acc)[2][2][4][2], const Unit& u, int wr, int wc, int fr, int fq) const {
        const int row0 = u.pm * BM + wr * 64 + fr; const int col0 = u.pn * BM + wc * 32 + 8 * fq;
#pragma unroll
        for (int ai = 0; ai < 2; ++ai)
#pragma unroll
            for (int m = 0; m < 4; ++m) { bf16_t* rowp = O + (size_t)(row0 + ai * HALF + m * 16) * ldc + col0;
#pragma unroll
                for (int bj = 0; bj < 2; ++bj) { f32x4 v0 = acc[ai][bj][m][0], v1 = acc[ai][bj][m][1];
                    if (ACT == 2) {
#pragma unroll
                        for (int e = 0; e < 4; ++e) { float a = v0[e] > 0.f ? v0[e] : 0.f; v0[e] = a * a; float b = v1[e] > 0.f ? v1[e] : 0.f; v1[e] = b * b; } }
                    u32x4 w; w.x = cvt_pk_bf16(v0[0], v0[1]); w.y = cvt_pk_bf16(v0[2], v0[3]); w.z = cvt_pk_bf16(v1[0], v1[1]); w.w = cvt_pk_bf16(v1[2], v1[3]);
                    *(u32x4*)(rowp + bj * HALF) = w; } }
    }
};
struct EpiResid {
    static constexpr bool PERM = false, AFTER_DRAIN = false;
    const float* base_p; const float* base_s; float* out; const float* gate;
    __device__ __forceinline__ void operator()(const f32x4 (&acc)[2][2][4][2], const Unit& u, int wr, int wc, int fr, int fq) const {
        const int row0 = u.pm * BM + wr * 64 + fr; const int col0 = u.pn * BM + wc * 32 + 4 * fq;
        const int cond = u.pm < 16 ? 0 : 1 + ((u.pm - 16) >> 2);
        const float* gp = gate + cond * 6144; const float* bp = u.pm < 16 ? base_p : base_s;
        f32x4 gv[2][2];
#pragma unroll
        for (int bj = 0; bj < 2; ++bj)
#pragma unroll
            for (int n = 0; n < 2; ++n) gv[bj][n] = *(const f32x4*)(gp + col0 + bj * HALF + n * 16);
#pragma unroll
        for (int ai = 0; ai < 2; ++ai)
#pragma unroll
            for (int m = 0; m < 4; ++m) { const size_t off = (size_t)(row0 + ai * HALF + m * 16) * 1024 + col0;
#pragma unroll
                for (int bj = 0; bj < 2; ++bj)
#pragma unroll
                    for (int n = 0; n < 2; ++n) { const f32x4 b = *(const f32x4*)(bp + off + bj * HALF + n * 16);
                        *(f32x4*)(out + off + bj * HALF + n * 16) = b + gv[bj][n] * acc[ai][bj][m][n]; } }
    }
};
struct EpiGlu {
    static constexpr bool PERM = true, AFTER_DRAIN = false;
    const bf16_t* G; bf16_t* O; const float* bias;
    __device__ __forceinline__ void operator()(const f32x4 (&acc)[2][2][4][2], const Unit& u, int wr, int wc, int fr, int fq) const {
        const int row0 = u.pm * BM + wr * 64 + fr; const int col0 = u.pn * BM + wc * 32 + 8 * fq;
        f32x4 bv[2][2];
#pragma unroll
        for (int bj = 0; bj < 2; ++bj)
#pragma unroll
            for (int n = 0; n < 2; ++n) bv[bj][n] = *(const f32x4*)(bias + col0 + bj * HALF + 4 * n);
#pragma unroll
        for (int ai = 0; ai < 2; ++ai)
#pragma unroll
            for (int m = 0; m < 4; ++m) { const size_t row = (size_t)(row0 + ai * HALF + m * 16);
#pragma unroll
                for (int bj = 0; bj < 2; ++bj) { f32x4 v0 = acc[ai][bj][m][0] + bv[bj][0], v1 = acc[ai][bj][m][1] + bv[bj][1];
                    const u32x4 gw = *(const u32x4*)(G + row * 512 + col0 + bj * HALF);
                    float gf[8];
#pragma unroll
                    for (int e = 0; e < 4; ++e) { gf[2 * e] = __uint_as_float(gw[e] << 16); gf[2 * e + 1] = __uint_as_float(gw[e] & 0xffff0000u); }
                    float o[8];
#pragma unroll
                    for (int e = 0; e < 4; ++e) { o[e] = gf[e] / (1.f + __expf(-v0[e])); o[4 + e] = gf[4 + e] / (1.f + __expf(-v1[e])); }
                    u32x4 w; w.x = cvt_pk_bf16(o[0], o[1]); w.y = cvt_pk_bf16(o[2], o[3]); w.z = cvt_pk_bf16(o[4], o[5]); w.w = cvt_pk_bf16(o[6], o[7]);
                    *(u32x4*)(O + row * 1024 + col0 + bj * HALF) = w; } }
    }
};

template <class Epi, class Sched, bool ALIGN_EPI = false, bool SP2 = false>
__device__ __forceinline__ void gemm_phase(PG8_LAS unsigned char* lds, const Gemm g, const Sched& S, const Epi& E) {
    int tid_ = threadIdx.x; asm volatile("" : "+v"(tid_));
    const int tid = tid_, wid = __builtin_amdgcn_readfirstlane(tid >> 6), lane = tid & 63, wr = wid >> 2, wc = wid & 3, fr = lane & 15, fq = lane >> 4;
    const int K = g.K, nt = K / BK, LDA_ = g.lda, LDB_ = g.ldb;
    unsigned voffA[2], voffB[2];
#pragma unroll
    for (int i = 0; i < 2; ++i) { int R, C; stage_rc(tid * 16 + i * 8192, R, C); const int Rb = Epi::PERM ? ((R & ~31) + perm32(R & 31)) : R;
        voffA[i] = (unsigned)(R * LDA_ + C) * 2u; voffB[i] = (unsigned)(Rb * LDB_ + C) * 2u; }
    const size_t kstep = (size_t)(BK * 2);
    const size_t hstepA = (size_t)HALF * LDA_ * 2, hstepB = (size_t)HALF * LDB_ * 2;
    const size_t tstepA = 2 * hstepA, tstepB = 2 * hstepB;
    const unsigned ldsw = (unsigned)wid * 1024u;
    const int aoff = lds_byte(wr * 64 + fr, fq * 8), boff = lds_byte(wc * 32 + fr, fq * 8);
#define PG8_SA(b, h) (((b) * 2 + (h)) * HTB)
#define PG8_SB(b, h) ((4 + (b) * 2 + (h)) * HTB)
#define PG8_STAGE(bufoff, gbase, voff) do { _Pragma("unroll") for (int _i = 0; _i < 2; ++_i) \
        __builtin_amdgcn_global_load_lds((const unsigned*)((const char*)(gbase) + (voff)[_i]), (PG8_LAS unsigned*)(lds + (bufoff) + ldsw + _i * 8192), 16, 0, 0); } while (0)
#define PG8_LDA(dst, b, h) do { _Pragma("unroll") for (int m = 0; m < 4; ++m) _Pragma("unroll") for (int k = 0; k < 2; ++k) dst[m][k] = *(const PG8_LAS bf16x8*)(lds + PG8_SA(b, h) + aoff + m * 2048 + k * 1024); } while (0)
#define PG8_LDB(dst, b, h) do { _Pragma("unroll") for (int n = 0; n < 2; ++n) _Pragma("unroll") for (int k = 0; k < 2; ++k) dst[n][k] = *(const PG8_LAS bf16x8*)(lds + PG8_SB(b, h) + boff + n * 2048 + k * 1024); } while (0)
#define PG8_MMA(ai, bj, At, Bt) do { __builtin_amdgcn_s_setprio(1); _Pragma("unroll") for (int m = 0; m < 4; ++m) _Pragma("unroll") for (int n = 0; n < 2; ++n) _Pragma("unroll") for (int k = 0; k < 2; ++k) \
        acc[ai][bj][m][n] = __builtin_amdgcn_mfma_f32_16x16x32_bf16(Bt[n][k], At[m][k], acc[ai][bj][m][n], 0, 0, 0); __builtin_amdgcn_s_setprio(0); } while (0)
#define PG8_WAIT_V(n) asm volatile("s_waitcnt vmcnt(" #n ")" ::: "memory")
#define PG8_WAIT_L(n) asm volatile("s_waitcnt lgkmcnt(" #n ")" ::: "memory")
#define PG8_BAR __builtin_amdgcn_s_barrier()
#define PG8_SCHED __builtin_amdgcn_sched_barrier(0)
    Unit cur, nxt; int ui = 0;
    if (!S.next(0, cur)) return;
    f32x4 acc[2][2][4][2];
#pragma unroll
    for (int a = 0; a < 2; ++a)
#pragma unroll
        for (int b = 0; b < 2; ++b)
#pragma unroll
            for (int m = 0; m < 4; ++m)
#pragma unroll
                for (int n = 0; n < 2; ++n) acc[a][b][m][n] = (f32x4){0.f, 0.f, 0.f, 0.f};
    bf16x8 At[4][2], B0[2][2], B1[2][2];
    const char* cA = (const char*)g.A + (size_t)cur.pm * tstepA; const char* cB = (const char*)g.Bt + (size_t)cur.pn * tstepB;
    S.a_ready(cur);
    if constexpr (SP2) {
        PG8_STAGE(PG8_SB(0, 0), cB, voffB); PG8_STAGE(PG8_SB(0, 1), cB + hstepB, voffB); PG8_STAGE(PG8_SA(0, 0), cA, voffA); PG8_STAGE(PG8_SA(0, 1), cA + hstepA, voffA);
        if (wr == 1) PG8_BAR;
        PG8_WAIT_V(2); PG8_BAR;
        PG8_STAGE(PG8_SB(1, 0), cB + kstep, voffB); PG8_STAGE(PG8_SA(1, 0), cA + kstep, voffA); PG8_STAGE(PG8_SB(1, 1), cB + hstepB + kstep, voffB);
        PG8_WAIT_V(6); PG8_BAR;
    } else {
        PG8_STAGE(PG8_SB(0, 0), cB, voffB); PG8_STAGE(PG8_SA(0, 0), cA, voffA); PG8_STAGE(PG8_SB(0, 1), cB + hstepB, voffB); PG8_STAGE(PG8_SA(0, 1), cA + hstepA, voffA);
        if (wr == 1) PG8_BAR;
        PG8_WAIT_V(4); PG8_BAR;
        PG8_STAGE(PG8_SB(1, 0), cB + kstep, voffB); PG8_STAGE(PG8_SA(1, 0), cA + kstep, voffA); PG8_STAGE(PG8_SB(1, 1), cB + hstepB + kstep, voffB);
        PG8_WAIT_V(6); PG8_BAR;
    }
    for (;;) {
        const bool has_next = S.next(ui + 1, nxt);
        const char* nA = has_next ? (const char*)g.A + (size_t)nxt.pm * tstepA : cA; const char* nB = has_next ? (const char*)g.Bt + (size_t)nxt.pn * tstepB : cB;
        for (int t = 0; t < nt; t += 2) {
            const bool last = (t == nt - 2);
            const char* a1 = cA + (size_t)(t + 1) * kstep;
            const char* a2 = last ? nA : cA + (size_t)(t + 2) * kstep; const char* b2 = last ? nB : cB + (size_t)(t + 2) * kstep;
            const char* a3 = a2 + kstep; const char* b3 = b2 + kstep;
            if (last && has_next) S.a_ready(nxt);
            if constexpr (SP2) {
            PG8_LDB(B0, 0, 0); PG8_LDB(B1, 0, 1); PG8_SCHED; PG8_LDA(At, 0, 0); PG8_STAGE(PG8_SA(1, 1), a1 + hstepA, voffA);
            PG8_WAIT_V(8); PG8_WAIT_L(0); PG8_BAR; PG8_MMA(0, 0, At, B0); PG8_MMA(0, 1, At, B1); PG8_BAR; PG8_SCHED;
            PG8_LDA(At, 0, 1); PG8_STAGE(PG8_SB(0, 0), b2, voffB); PG8_STAGE(PG8_SB(0, 1), b2 + hstepB, voffB); PG8_STAGE(PG8_SA(0, 0), a2, voffA);
            PG8_WAIT_V(8); PG8_WAIT_L(0); PG8_BAR; PG8_MMA(1, 0, At, B0); PG8_MMA(1, 1, At, B1); PG8_BAR; PG8_SCHED;
            PG8_LDB(B0, 1, 0); PG8_LDB(B1, 1, 1); PG8_SCHED; PG8_LDA(At, 1, 0); PG8_STAGE(PG8_SA(0, 1), a2 + hstepA, voffA);
            PG8_WAIT_V(8); PG8_WAIT_L(0); PG8_BAR; PG8_MMA(0, 0, At, B0); PG8_MMA(0, 1, At, B1); PG8_BAR; PG8_SCHED;
            PG8_LDA(At, 1, 1); PG8_STAGE(PG8_SB(1, 0), b3, voffB); PG8_STAGE(PG8_SB(1, 1), b3 + hstepB, voffB); PG8_STAGE(PG8_SA(1, 0), a3, voffA);
            PG8_WAIT_V(8); PG8_WAIT_L(0); PG8_BAR; PG8_MMA(1, 0, At, B0); PG8_MMA(1, 1, At, B1); PG8_BAR; PG8_SCHED;
            } else {
            PG8_LDB(B0, 0, 0); PG8_SCHED; PG8_LDA(At, 0, 0); PG8_STAGE(PG8_SA(1, 1), a1 + hstepA, voffA);
            PG8_WAIT_L(8); PG8_BAR; PG8_WAIT_L(0); PG8_MMA(0, 0, At, B0); PG8_BAR; PG8_SCHED;
            PG8_LDB(B1, 0, 1); PG8_STAGE(PG8_SB(0, 0), b2, voffB);
            PG8_BAR; PG8_WAIT_L(0); PG8_MMA(0, 1, At, B1); PG8_BAR;
            PG8_LDA(At, 0, 1); PG8_STAGE(PG8_SA(0, 0), a2, voffA);
            PG8_BAR; PG8_WAIT_L(0); PG8_MMA(1, 0, At, B0); PG8_BAR; PG8_SCHED;
            PG8_STAGE(PG8_SB(0, 1), b2 + hstepB, voffB);
            PG8_WAIT_V(6); PG8_BAR; PG8_MMA(1, 1, At, B1); PG8_BAR;
            PG8_LDB(B0, 1, 0); PG8_SCHED; PG8_LDA(At, 1, 0); PG8_STAGE(PG8_SA(0, 1), a2 + hstepA, voffA);
            PG8_WAIT_L(8); PG8_BAR; PG8_WAIT_L(0); PG8_MMA(0, 0, At, B0); PG8_BAR; PG8_SCHED;
            PG8_LDB(B1, 1, 1); PG8_STAGE(PG8_SB(1, 0), b3, voffB);
            PG8_BAR; PG8_WAIT_L(0); PG8_MMA(0, 1, At, B1); PG8_BAR;
            PG8_LDA(At, 1, 1); PG8_STAGE(PG8_SA(1, 0), a3, voffA);
            PG8_BAR; PG8_WAIT_L(0); PG8_MMA(1, 0, At, B0); PG8_BAR; PG8_SCHED;
            PG8_STAGE(PG8_SB(1, 1), b3 + hstepB, voffB);
            PG8_WAIT_V(6); PG8_BAR; PG8_MMA(1, 1, At, B1); PG8_BAR;
            }
        }
        if constexpr (ALIGN_EPI) { if (wr == 0) PG8_BAR; }
        if constexpr (!Epi::AFTER_DRAIN) { E(acc, cur, wr, wc, fr, fq); S.done(cur); }
        if (!has_next) break;
#pragma unroll
        for (int a = 0; a < 2; ++a)
#pragma unroll
            for (int b = 0; b < 2; ++b)
#pragma unroll
                for (int m = 0; m < 4; ++m)
#pragma unroll
                    for (int n = 0; n < 2; ++n) acc[a][b][m][n] = (f32x4){0.f, 0.f, 0.f, 0.f};
        cur = nxt; cA = nA; cB = nB; ++ui;
        if constexpr (ALIGN_EPI) { if (wr == 1) PG8_BAR; }
    }
    PG8_WAIT_V(0);
    if constexpr (!ALIGN_EPI) { if (wr == 0) PG8_BAR; }
    PG8_BAR;
    if constexpr (Epi::AFTER_DRAIN) { E.fused(acc, cur, wr, wc, fr, fq, lds, wid, lane); S.done(cur); }
#undef PG8_SA
#undef PG8_SB
#undef PG8_STAGE
#undef PG8_LDA
#undef PG8_LDB
#undef PG8_MMA
#undef PG8_WAIT_V
#undef PG8_WAIT_L
#undef PG8_BAR
#undef PG8_SCHED
}
}

namespace att {
using bf16 = __hip_bfloat16;
constexpr int D = 128, NW = 8, QBLK = 32, KVBLK = 64; constexpr float SCALE = 0.088388347648318440f; constexpr float THR = 8.f; constexpr int SDEPTH = 2;
constexpr int LDQ = 1024, LDK = 256, LDO = 1024;
constexpr size_t SHM_V = KVBLK * D * 2, SHM_K = KVBLK * D * 2, SHM_ATTN = 2 * SHM_V + 2 * SHM_K + NW * 64 * 4;
using bf16x8 = __attribute__((ext_vector_type(8))) short;
using s16x4  = __attribute__((ext_vector_type(4))) short;
using f32x16 = __attribute__((ext_vector_type(16))) float;
using f32x8  = __attribute__((ext_vector_type(8))) float;
using u32x4  = __attribute__((ext_vector_type(4))) unsigned;
#define KSWZ(row, colB) ((row) * 256 + ((colB) ^ (((row) & 7) << 4)))
#define SBAR() __builtin_amdgcn_sched_barrier(0)
__device__ __forceinline__ int crow(int r, int hi) { return (r & 3) + 8 * (r >> 2) + 4 * hi; }
__device__ __forceinline__ unsigned cvtpk(float lo, float hi) {
  unsigned r; asm volatile("v_cvt_pk_bf16_f32 %0, %1, %2" : "=v"(r) : "v"(lo), "v"(hi)); return r;
}
template <typename TIn> struct Stage;
template <> struct Stage<bf16>  { using T = bf16x8;
  __device__ static __forceinline__ T ld8(const bf16* p) { return *reinterpret_cast<const bf16x8*>(p); }
  __device__ static __forceinline__ bf16x8 tobf(T x) { return x; } };
template <> struct Stage<float> { using T = f32x8;
  __device__ static __forceinline__ T ld8(const float* p) { return *reinterpret_cast<const f32x8*>(p); }
  __device__ static __forceinline__ bf16x8 tobf(T x) {
    u32x4 w = {cvtpk(x[0], x[1]), cvtpk(x[2], x[3]), cvtpk(x[4], x[5]), cvtpk(x[6], x[7])}; return *reinterpret_cast<bf16x8*>(&w); } };

__device__ __forceinline__ void partialSM(f32x16& p0, f32x16& p1, float& m_reg, float& mn, float& alpha) {
  constexpr float C = SCALE * 1.4426950408889634f;
  float pmax = p0[0]; for (int r = 1; r < 16; ++r) pmax = fmaxf(pmax, p0[r]); for (int r = 0; r < 16; ++r) pmax = fmaxf(pmax, p1[r]);
  { auto rr = __builtin_amdgcn_permlane32_swap(__float_as_uint(pmax), __float_as_uint(pmax), false, false);
    pmax = fmaxf(__uint_as_float(rr[0]), __uint_as_float(rr[1])); }
  if (__builtin_expect(__all(pmax - m_reg <= THR / SCALE), 1)) { mn = m_reg; alpha = 1.f; }
  else { mn = fmaxf(m_reg, pmax); alpha = __builtin_amdgcn_exp2f((m_reg - mn) * C); m_reg = mn; }
  float mnC = -mn * C;
  for (int r = 0; r < 16; ++r) p0[r] = fmaf(p0[r], C, mnC); for (int r = 0; r < 16; ++r) p1[r] = fmaf(p1[r], C, mnC);
  for (int r = 0; r < 16; ++r) p0[r] = __builtin_amdgcn_exp2f(p0[r]);
}
__device__ __forceinline__ void finishSM(f32x16& p0, f32x16& p1, float alpha, float& l_reg, bf16x8& pa0, bf16x8& pa1, bf16x8& pa2, bf16x8& pa3) {
  for (int r = 0; r < 16; ++r) p1[r] = __builtin_amdgcn_exp2f(p1[r]);
  float ps = 0; for (int r = 0; r < 16; ++r) ps += p0[r]; for (int r = 0; r < 16; ++r) ps += p1[r];
  { auto rr = __builtin_amdgcn_permlane32_swap(__float_as_uint(ps), __float_as_uint(ps), false, false);
    ps = __uint_as_float(rr[0]) + __uint_as_float(rr[1]); }
  l_reg = l_reg * alpha + ps;
#define PK4(P, BASE, OUT) do { unsigned a0 = cvtpk(P[BASE + 0], P[BASE + 1]), a1 = cvtpk(P[BASE + 2], P[BASE + 3]);   \
    unsigned b0 = cvtpk(P[BASE + 4], P[BASE + 5]), b1 = cvtpk(P[BASE + 6], P[BASE + 7]);                              \
    auto r0 = __builtin_amdgcn_permlane32_swap(a0, b0, false, false); auto r1 = __builtin_amdgcn_permlane32_swap(a1, b1, false, false); \
    u32x4 w = {r0[0], r1[0], r0[1], r1[1]}; OUT = *reinterpret_cast<bf16x8*>(&w); } while (0)
  PK4(p0, 0, pa0); PK4(p0, 8, pa1); PK4(p1, 0, pa2); PK4(p1, 8, pa3);
#undef PK4
}
__device__ __forceinline__ void qkt(f32x16& p0, f32x16& p1, const bf16* Ks, const bf16x8* qr, int r32, int hi) {
  p0 = f32x16{}; p1 = f32x16{};
  for (int d0 = 0; d0 < 8; ++d0) { int cb = (d0 * 16 + hi * 8) * 2;
    bf16x8 b0 = *reinterpret_cast<const bf16x8*>((const char*)Ks + KSWZ(r32, cb));
    bf16x8 b1 = *reinterpret_cast<const bf16x8*>((const char*)Ks + KSWZ(32 + r32, cb));
    p0 = __builtin_amdgcn_mfma_f32_32x32x16_bf16(b0, qr[d0], p0, 0, 0, 0);
    p1 = __builtin_amdgcn_mfma_f32_32x32x16_bf16(b1, qr[d0], p1, 0, 0, 0); }
}
__device__ __forceinline__ int v_st(int k, int c) { const int kk = (k & ~0xC) | ((k & 4) << 1) | ((k & 8) >> 1); return ((kk >> 3) * 4 + (c >> 5)) * 512 + ((kk & 7) * 32 + (c & 31)) * 2; }
__device__ __forceinline__ int v_rd_base(int lane) { return ((lane & 3) << 3) | (((lane >> 2) & 3) << 6) | (((lane >> 4) & 1) << 5) | (((lane >> 5) & 1) << 8); }
constexpr int v_rd_off(int d0, int ks, int half) { return d0 * 512 + ks * 4096 + half * 2048; }
template <int OFF> __device__ __forceinline__ s16x4 tr_read(int vb) {
  s16x4 r; asm volatile("ds_read_b64_tr_b16 %0, %1 offset:%2" : "=&v"(r) : "v"(vb), "i"(OFF) : "memory"); return r;
}
template <int D0> __device__ __forceinline__ void pv_one(f32x16& od, int vb, bf16x8 pa0, bf16x8 pa1, bf16x8 pa2, bf16x8 pa3) {
  const s16x4 l0 = tr_read<v_rd_off(D0, 0, 0)>(vb), h0 = tr_read<v_rd_off(D0, 0, 1)>(vb), l1 = tr_read<v_rd_off(D0, 1, 0)>(vb), h1 = tr_read<v_rd_off(D0, 1, 1)>(vb);
  const s16x4 l2 = tr_read<v_rd_off(D0, 2, 0)>(vb), h2 = tr_read<v_rd_off(D0, 2, 1)>(vb), l3 = tr_read<v_rd_off(D0, 3, 0)>(vb), h3 = tr_read<v_rd_off(D0, 3, 1)>(vb);
  asm volatile("s_waitcnt lgkmcnt(0)" ::: "memory"); SBAR();
#define PK(L, H) (bf16x8){L[0], L[1], L[2], L[3], H[0], H[1], H[2], H[3]}
  od = __builtin_amdgcn_mfma_f32_32x32x16_bf16(pa0, PK(l0, h0), od, 0, 0, 0);
  od = __builtin_amdgcn_mfma_f32_32x32x16_bf16(pa1, PK(l1, h1), od, 0, 0, 0);
  od = __builtin_amdgcn_mfma_f32_32x32x16_bf16(pa2, PK(l2, h2), od, 0, 0, 0);
  od = __builtin_amdgcn_mfma_f32_32x32x16_bf16(pa3, PK(l3, h3), od, 0, 0, 0);
#undef PK
}
__device__ __forceinline__ void pv_d0(f32x16* o, int vb, bf16x8 pa0, bf16x8 pa1, bf16x8 pa2, bf16x8 pa3) {
  pv_one<0>(o[0], vb, pa0, pa1, pa2, pa3); pv_one<1>(o[1], vb, pa0, pa1, pa2, pa3); pv_one<2>(o[2], vb, pa0, pa1, pa2, pa3); pv_one<3>(o[3], vb, pa0, pa1, pa2, pa3);
}

template <typename TQ>
__device__ __forceinline__ void attn_dense_body(const TQ* __restrict__ Qb, const bf16* __restrict__ Kh, const bf16* __restrict__ Vh,
                                                bf16* __restrict__ Ob, int seq, char* lds) {
  using St = Stage<bf16>; using SQ = Stage<TQ>;
  int tid_ = threadIdx.x; asm volatile("" : "+v"(tid_));
  const int tid = tid_, wid = tid >> 6, lane = tid & 63, r32 = lane & 31, hi = lane >> 5;
  bf16* V_lds = (bf16*)lds; bf16* K_lds = (bf16*)(lds + 2 * SHM_V);
  float* ws = (float*)(lds + 2 * SHM_V + 2 * SHM_K) + wid * 64; float* li_l = ws; float* al_l = ws + 32;
  float m_reg = -1e30f, l_reg = 0; f32x16 o[4] = {}; bf16x8 qr[8];
  const TQ* Qw = Qb + (long)(wid * QBLK + r32) * LDQ + hi * 8;
#pragma unroll
  for (int d0 = 0; d0 < 8; ++d0) qr[d0] = SQ::tobf(SQ::ld8(Qw + d0 * 16));
  const int sr = tid >> 4, sc = (tid & 15) * 8, vst0 = v_st(sr, sc), vst1 = v_st(32 + sr, sc);
  const int vb0 = (int)(uintptr_t)V_lds + v_rd_base(lane);
  struct { typename St::T vs0, vs1, ks0, ks1; } sr_[SDEPTH];
#define SLOAD(i, k0) do { sr_[i].vs0 = St::ld8(&Vh[(long)((k0) + sr) * LDK + sc]); sr_[i].vs1 = St::ld8(&Vh[(long)((k0) + 32 + sr) * LDK + sc]); \
    sr_[i].ks0 = St::ld8(&Kh[(long)((k0) + sr) * LDK + sc]); sr_[i].ks1 = St::ld8(&Kh[(long)((k0) + 32 + sr) * LDK + sc]); } while (0)
#define SWRITE(b, i) do { *(bf16x8*)((char*)V_lds + (b) * SHM_V + vst0) = St::tobf(sr_[i].vs0);          \
    *(bf16x8*)((char*)V_lds + (b) * SHM_V + vst1) = St::tobf(sr_[i].vs1); int kc = sc * 2;               \
    *(bf16x8*)((char*)K_lds + (b) * SHM_K + KSWZ(sr, kc)) = St::tobf(sr_[i].ks0);                       \
    *(bf16x8*)((char*)K_lds + (b) * SHM_K + KSWZ(32 + sr, kc)) = St::tobf(sr_[i].ks1); } while (0)
#define SWAIT() do { if constexpr (SDEPTH == 2) asm volatile("s_waitcnt vmcnt(4)" ::: "memory"); else asm volatile("s_waitcnt vmcnt(0)" ::: "memory"); } while (0)
#define RESC(a) do { if (__any((a) < 1.f)) { if (hi == 0) al_l[r32] = (a); asm volatile("s_waitcnt lgkmcnt(0)" ::: "memory"); \
    for (int d = 0; d < 4; ++d) for (int r = 0; r < 16; ++r) o[d][r] *= al_l[crow(r, hi)]; } } while (0)
  f32x16 pA0, pA1, pB0, pB1; float mnA, mnB, alA, alB; bf16x8 pa0, pa1, pa2, pa3; const int NT = seq / KVBLK;
  constexpr int SE = 0, SO = SDEPTH - 1;
  SLOAD(SE, 0); asm volatile("s_waitcnt vmcnt(0)" ::: "memory"); SWRITE(0, SE); __syncthreads();
  qkt(pA0, pA1, K_lds, qr, r32, hi); partialSM(pA0, pA1, m_reg, mnA, alA);
  SLOAD(SO, KVBLK); if constexpr (SDEPTH == 2) { if (2 < NT) SLOAD(SE, 2 * KVBLK); }
  SWAIT(); SWRITE(1, SO); __syncthreads();
  for (int j = 1; j + 1 < NT; j += 2) {
    SBAR(); qkt(pB0, pB1, (bf16*)((char*)K_lds + SHM_K), qr, r32, hi);
    finishSM(pA0, pA1, alA, l_reg, pa0, pa1, pa2, pa3); SBAR();
    SLOAD(SO, (j + SDEPTH) * KVBLK); SBAR();
    pv_d0(o, vb0, pa0, pa1, pa2, pa3); partialSM(pB0, pB1, m_reg, mnB, alB);
    __syncthreads(); SWAIT(); SWRITE(0, SE);
    RESC(alB); __syncthreads();
    SBAR(); qkt(pA0, pA1, K_lds, qr, r32, hi);
    finishSM(pB0, pB1, alB, l_reg, pa0, pa1, pa2, pa3); SBAR();
    if (SDEPTH == 1 || j + 3 < NT) SLOAD(SE, (j + 1 + SDEPTH) * KVBLK); SBAR();
    pv_d0(o, vb0 + (int)SHM_V, pa0, pa1, pa2, pa3); partialSM(pA0, pA1, m_reg, mnA, alA);
    __syncthreads(); SWAIT(); SWRITE(1, SO);
    RESC(alA); __syncthreads();
  }
  SBAR(); qkt(pB0, pB1, (bf16*)((char*)K_lds + SHM_K), qr, r32, hi);
  finishSM(pA0, pA1, alA, l_reg, pa0, pa1, pa2, pa3); SBAR();
  pv_d0(o, vb0, pa0, pa1, pa2, pa3); partialSM(pB0, pB1, m_reg, mnB, alB);
  __syncthreads(); RESC(alB);
  finishSM(pB0, pB1, alB, l_reg, pa0, pa1, pa2, pa3); SBAR();
  pv_d0(o, vb0 + (int)SHM_V, pa0, pa1, pa2, pa3);
  if (hi == 0) li_l[r32] = l_reg; asm volatile("s_waitcnt lgkmcnt(0)" ::: "memory");
  float rli[16];
#pragma unroll
  for (int r = 0; r < 16; ++r) rli[r] = __builtin_amdgcn_rcpf(li_l[crow(r, hi)]);
  bf16* Ow = Ob + (long)(wid * QBLK) * LDO;
#pragma unroll
  for (int r = 0; r < 16; ++r) { int orow = crow(r, hi);
    for (int d0 = 0; d0 < 4; ++d0) Ow[(long)orow * LDO + d0 * 32 + r32] = __float2bfloat16(o[d0][r] * rli[r]); }
#undef SLOAD
#undef SWRITE
#undef SWAIT
#undef RESC
}
}

constexpr int NWAVES = 8;
constexpr int DM = 1024, NTOK = 8192, NPR = 4096, FF = 4096, INW = 2048, INE = 2080, QKVW = 1536;
constexpr float EPS = 1e-6f;
constexpr size_t OUT_Y = 0, OUT_S5RE = 8388608, OUT_S5IM = OUT_S5RE + 65536, OUT_GLA = OUT_S5IM + 65536, OUT_NK = OUT_GLA + 1048576, OUT_NV = OUT_NK + 1048576, OUT_END = OUT_NV + 1048576;
constexpr size_t MiB = 1u << 20;
constexpr size_t WS_CTL = 0, CTL_ZERO_BYTES = 64 * 1024;
constexpr size_t WS_ADA = 1 * MiB;
constexpr size_t WS_WIN = 2 * MiB, WS_WGLR = 6 * MiB, WS_WGLU = 6 * MiB + 512 * 1024, WS_WOUT = 7 * MiB, WS_W1 = 9 * MiB, WS_W2 = 25 * MiB, WS_WQKV = 41 * MiB, WS_WO = 44 * MiB;
constexpr size_t WS_H = 46 * MiB, WS_Y = 62 * MiB, WS_SCR = 94 * MiB;
constexpr size_t WS_Z = WS_SCR, WS_GD = WS_SCR + 32 * MiB, WS_G = WS_SCR + 48 * MiB, WS_UH = WS_SCR + 56 * MiB, WS_SLOC = WS_SCR + 72 * MiB, WS_SIN = WS_SCR + 104 * MiB, WS_DEC = WS_SCR + 120 * MiB,
                 WS_MIX = WS_SCR + 121 * MiB, WS_EBUF = WS_MIX  , WS_WY = WS_SCR + 137 * MiB, WS_WE = WS_SCR + 145 * MiB  , WS_BB = WS_SCR + 153 * MiB, WS_KB = WS_SCR + 154 * MiB;
constexpr size_t WS_ACT = WS_SCR, WS_XBUF = WS_SCR + 64 * MiB;
constexpr size_t WS_QKV = WS_SCR, WS_QN = WS_SCR + 24 * MiB, WS_KP = WS_SCR + 40 * MiB, WS_KS = WS_SCR + 42 * MiB, WS_VP = WS_SCR + 45 * MiB, WS_VS = WS_SCR + 47 * MiB, WS_OB = WS_SCR + 50 * MiB;
constexpr size_t WS_END = WS_SCR + 155 * MiB;
static_assert(WS_END <= 256 * MiB, "d_ws map");
constexpr int CW_BAR = 1024;
constexpr int RING_BYTES = 131072, LDSCTL_OFF = RING_BYTES, MISC_OFF = LDSCTL_OFF + 320, LDS_BYTES = 147456;

#define GAS __attribute__((address_space(1)))
#define LAS __attribute__((address_space(3)))
typedef unsigned short bf16;
typedef unsigned v4u __attribute__((ext_vector_type(4)));
typedef unsigned v2u __attribute__((ext_vector_type(2)));
typedef float f32x4 __attribute__((ext_vector_type(4)));
typedef float f32x16 __attribute__((ext_vector_type(16)));
typedef short bf16x8 __attribute__((ext_vector_type(8)));
typedef short s16x4 __attribute__((ext_vector_type(4)));
typedef GAS unsigned gu32;
#define RLX_AGENT __ATOMIC_RELAXED, __HIP_MEMORY_SCOPE_AGENT
#define LDS_WAIT() asm volatile("s_waitcnt lgkmcnt(0)" ::: "memory")
#define VM_WAIT() asm volatile("s_waitcnt vmcnt(0)" ::: "memory")
__device__ __forceinline__ unsigned f2bf(float f) { unsigned u = __builtin_bit_cast(unsigned, f); return (u + 0x7fffu + ((u >> 16) & 1u)) >> 16; }
__device__ __forceinline__ unsigned pk2(float lo, float hi) { return f2bf(lo) | (f2bf(hi) << 16); }
__device__ __forceinline__ float bf2f(unsigned short b) { return __uint_as_float(((unsigned)b) << 16); }
__device__ __forceinline__ float bflo(unsigned w) { return __uint_as_float(w << 16); }
__device__ __forceinline__ float bfhi(unsigned w) { return __uint_as_float(w & 0xffff0000u); }
__device__ __forceinline__ float wave_sum(float v) {
#pragma unroll
    for (int o = 1; o < 64; o <<= 1) v += __shfl_xor(v, o);
    return v;
}
__device__ __forceinline__ int crow(int r, int hi) { return (r & 3) + 8 * (r >> 2) + 4 * hi; }
__device__ __forceinline__ s16x4 tr_read4(unsigned addr) { s16x4 r; asm volatile("ds_read_b64_tr_b16 %0, %1" : "=&v"(r) : "v"(addr) : "memory"); return r; }

#define XB_TMO      128
#define XB_XCNT(j)  (256  + 64 * (j))
#define XB_XSUB(j)  (1280 + 64 * (j))
#define XB_XGEN(j)  (2304 + 64 * (j))
#define XB_TOP      3328
#define XB_TOPGEN   3392
#define XCD_BAR_WORDS 3456
#define XB_SPIN_CAP (1u << 18)

__device__ __forceinline__ unsigned xb_ld(unsigned* p)              { return __hip_atomic_load(p, __ATOMIC_RELAXED, __HIP_MEMORY_SCOPE_AGENT); }
__device__ __forceinline__ unsigned xb_add(unsigned* p, unsigned v) { return __hip_atomic_fetch_add(p, v, __ATOMIC_RELAXED, __HIP_MEMORY_SCOPE_AGENT); }
__device__ __forceinline__ unsigned xb_xcc_id() { return (unsigned)__builtin_amdgcn_s_getreg((3 << 11) | 20) & 0xFu; }
#define XB_SPIN(cond, bar) do { unsigned _sp = 0; while (cond) { __builtin_amdgcn_s_sleep(1); \
    if ((++_sp & 255u) == 0u) { if (xb_ld(&(bar)[XB_TMO])) break; if (_sp > XB_SPIN_CAP) { atomicAdd(&(bar)[XB_TMO], 1u); break; } } } } while (0)

struct XcdBarrier {
    unsigned* bar; unsigned x;
    volatile LAS unsigned* st;
};

__device__ __forceinline__ XcdBarrier xcd_barrier_post(unsigned* bar, volatile LAS unsigned* st) {
    XcdBarrier b; b.bar = bar; b.x = xb_xcc_id(); b.st = st;
    if (threadIdx.x == 0) (void)xb_add(&bar[XB_XCNT(b.x)], 1u);
    return b;
}
__device__ __forceinline__ void xcd_barrier_complete(unsigned* bar, unsigned x, unsigned& nloc, unsigned& nx) {
    const unsigned G = gridDim.x * gridDim.y * gridDim.z;
    unsigned sum, cnt, mine, sp = 0u;
    for (;;) {
        sum = 0u; cnt = 0u; mine = 0u;
#pragma unroll
        for (unsigned j = 0; j < 16; ++j) { const unsigned c = xb_ld(&bar[XB_XCNT(j)]); sum += c; cnt += (c > 0u) ? 1u : 0u; mine = (j == x) ? c : mine; }
        if (sum == G) break;
        __builtin_amdgcn_s_sleep(1);
        if ((++sp & 255u) == 0u) { if (xb_ld(&bar[XB_TMO])) break; if (sp > XB_SPIN_CAP) { atomicAdd(&bar[XB_TMO], 1u); break; } }
    }
    nloc = mine > 0u ? mine : 1u; nx = cnt > 0u ? cnt : 1u;
}

__device__ __forceinline__ void xcd_barrier(const XcdBarrier& b) {
    asm volatile("s_waitcnt vmcnt(0)" ::: "memory");
    __syncthreads();
    if (threadIdx.x == 0) {
        unsigned* bar = b.bar;
        __builtin_amdgcn_s_waitcnt(0);
        unsigned nloc = b.st[0], nx = b.st[1];
        if (nloc == 0u) { xcd_barrier_complete(bar, b.x, nloc, nx); b.st[0] = nloc; b.st[1] = nx; }
        const unsigned old = xb_add(&bar[XB_XSUB(b.x)], 1u);
        const unsigned gen = old / nloc;
        if (old + 1u == (gen + 1u) * nloc) {
            __builtin_amdgcn_fence(__ATOMIC_RELEASE, "agent");
            asm volatile("s_waitcnt vmcnt(0)" ::: "memory");
            const unsigned og = xb_add(&bar[XB_TOP], 1u);
            const unsigned tg = og / nx;
            if (og + 1u == (tg + 1u) * nx) xb_add(&bar[XB_TOPGEN], 1u);
            else XB_SPIN(xb_ld(&bar[XB_TOPGEN]) == tg, bar);
            __builtin_amdgcn_fence(__ATOMIC_ACQUIRE, "agent");
            xb_add(&bar[XB_XGEN(b.x)], 1u);
            asm volatile("s_waitcnt vmcnt(0)" ::: "memory");
        } else {
            XB_SPIN(xb_ld(&bar[XB_XGEN(b.x)]) == gen, bar);
            __builtin_amdgcn_fence(__ATOMIC_ACQUIRE, "agent");
            asm volatile("s_waitcnt vmcnt(0)" ::: "memory");
        }
    }
    __syncthreads();
}


struct SplitKOrder { int pm, pn;
    __device__ __forceinline__ bool next(int i, pg8::Unit& u) const { if (i > 0) return false; u.pm = pm; u.pn = pn; return true; }
    __device__ __forceinline__ void a_ready(const pg8::Unit&) const {}
    __device__ __forceinline__ void done(const pg8::Unit&) const {} };
struct EpiResidSplit {
    static constexpr bool PERM = false, AFTER_DRAIN = true;
    const float* base; float* out; const float* gate; float* xbuf; XcdBarrier bar; int kh;
    template <int KH> __device__ __forceinline__ void run(f32x4 (&acc)[2][2][4][2], const pg8::Unit& u, int wr, int wc, int fr, int fq, int tid) const {
        const int tile = u.pm * 4 + u.pn;
        float* xs = xbuf + ((size_t)(tile * 2 + KH) * 16) * 2048 + tid * 4;
#pragma unroll
        for (int bj = 0; bj < 2; ++bj)
#pragma unroll
            for (int m = 0; m < 4; ++m)
#pragma unroll
                for (int n = 0; n < 2; ++n) *(f32x4*)(xs + ((bj * 4 + m) * 2 + n) * 2048) = acc[1 - KH][bj][m][n];
        xcd_barrier(bar);
        const float* xr = xbuf + ((size_t)(tile * 2 + (1 - KH)) * 16) * 2048 + tid * 4;
        const int row0 = u.pm * 256 + KH * 128 + wr * 64 + fr; const int col0 = u.pn * 256 + wc * 32 + 4 * fq;
        const int cond = u.pm < 16 ? 0 : 1 + ((u.pm - 16) >> 2);
        const float* gp = gate + cond * 6144;
        f32x4 gv[2][2];
#pragma unroll
        for (int bj = 0; bj < 2; ++bj)
#pragma unroll
            for (int n = 0; n < 2; ++n) gv[bj][n] = *(const f32x4*)(gp + col0 + bj * 128 + n * 16);
#pragma unroll
        for (int m = 0; m < 4; ++m) { const size_t off = (size_t)(row0 + m * 16) * 1024 + col0;
#pragma unroll
            for (int bj = 0; bj < 2; ++bj)
#pragma unroll
                for (int n = 0; n < 2; ++n) { const f32x4 p = *(const f32x4*)(xr + ((bj * 4 + m) * 2 + n) * 2048); const f32x4 b = *(const f32x4*)(base + off + bj * 128 + n * 16);
                    *(f32x4*)(out + off + bj * 128 + n * 16) = b + gv[bj][n] * (acc[KH][bj][m][n] + p); } }
    }
    __device__ __forceinline__ void fused(f32x4 (&acc)[2][2][4][2], const pg8::Unit& u, int wr, int wc, int fr, int fq, LAS unsigned char*, int wid, int lane) const {
        if (kh == 0) run<0>(acc, u, wr, wc, fr, fq, wid * 64 + lane); else run<1>(acc, u, wr, wc, fr, fq, wid * 64 + lane);
    }
};

struct Args { const float* in[34]; float* out; unsigned char* ws; int ph_lo, ph_hi; };
typedef const __attribute__((address_space(4))) Args CArgs;
__device__ __forceinline__ CArgs* kargs() { CArgs* p = (CArgs*)__builtin_amdgcn_kernarg_segment_ptr(); asm volatile("" : "+s"(p)); return p; }
#define KA (*kargs())
__device__ __forceinline__ int tid_opaque() { int t = threadIdx.x; asm volatile("" : "+v"(t)); return t; }

__device__ __forceinline__ void p0_transpose_item(const float* W, int ld, int K, bf16* WT, int nblk, LAS float* scr, int item, int lane) {
    const int kb = item / nblk, nb = item % nblk, k0 = 64 * kb, n0 = 32 * nb;
#pragma unroll 8
    for (int i = 0; i < 32; ++i) { const int kk = 2 * i + (lane >> 5); scr[kk * 33 + (lane & 31)] = W[(size_t)(k0 + kk) * ld + n0 + (lane & 31)]; }
    LDS_WAIT(); asm volatile("" ::: "memory");
    const int c = lane & 7;
#pragma unroll
    for (int j = 0; j < 4; ++j) { const int n = (lane >> 3) + 8 * j; const LAS float* s = scr + (8 * c) * 33 + n;
        v4u o; o.x = pk2(s[0 * 33], s[1 * 33]); o.y = pk2(s[2 * 33], s[3 * 33]); o.z = pk2(s[4 * 33], s[5 * 33]); o.w = pk2(s[6 * 33], s[7 * 33]);
        *(GAS v4u*)(WT + (size_t)(n0 + n) * K + k0 + 8 * c) = o; }
    LDS_WAIT(); asm volatile("" ::: "memory");
}
__device__ __forceinline__ void p0_prologue(CArgs& A, LAS unsigned char* lds, int tid, int lane, int wave) {
    unsigned char* ws = A.ws;
    {
        LAS float* sc = (LAS float*)(lds);
        LAS float* red = (LAS float*)(lds + 20480);
        for (int i = tid; i < 5 * 1024; i += 512) { const int c = i >> 10, k = i & 1023; const float x = c == 0 ? A.in[8][k] : A.in[7][(c - 1) * 1024 + k]; sc[i] = x / (1.f + __expf(-x)); }
        __syncthreads();
        for (int ab = blockIdx.x; ab < 256; ab += gridDim.x) {
        const int layer = ab >> 7, n0 = (ab & 127) * 48;
        const float* W = A.in[11] + (size_t)layer * 1024 * 6144 + n0;
        const int kq = lane / 12, nq = lane % 12;
        f32x4 acc[5];
#pragma unroll
        for (int c = 0; c < 5; ++c) acc[c] = (f32x4){0.f, 0.f, 0.f, 0.f};
        if (kq < 4) {
#pragma unroll 4
            for (int i = 0; i < 32; ++i) { const int k = 128 * wave + 4 * i + kq; const f32x4 w = *(const f32x4*)(W + (size_t)k * 6144 + 4 * nq);
#pragma unroll
                for (int c = 0; c < 5; ++c) acc[c] += w * sc[c * 1024 + k]; }
#pragma unroll
            for (int c = 0; c < 5; ++c) *(LAS f32x4*)(red + ((wave * 4 + kq) * 5 + c) * 48 + 4 * nq) = acc[c];
        }
        __syncthreads();
        if (tid < 240) { const int c = tid / 48, n = tid % 48; float s = 0.f;
#pragma unroll 8
            for (int p = 0; p < 32; ++p) s += red[(p * 5 + c) * 48 + n];
            ((float*)(ws + WS_ADA))[(size_t)(layer * 5 + c) * 6144 + n0 + n] = s + A.in[12][layer * 6144 + n0 + n]; }
        __syncthreads();
        }
    }
    LAS float* scr = (LAS float*)(lds + wave * 16384);
    const int gw = blockIdx.x * NWAVES + wave, NGW = gridDim.x * NWAVES;
    constexpr int I_IN = 16 * 65, I_OUT = 16 * 32, I_GLU = 8 * 16, I_M1 = 16 * 128, I_M2 = 64 * 32, I_QKV = 16 * 48, I_WO = 16 * 32;
    constexpr int NITEMS = I_IN + I_OUT + I_GLU + 2 * I_M1 + 2 * I_M2 + I_QKV + I_WO;
    for (int it = gw; it < NITEMS; it += NGW) {
        int r = it;
        if (r < I_IN) { const int kb = r / 65, nb = r % 65;
            if (nb < 64) p0_transpose_item(A.in[15], INE, 1024, (bf16*)(ws + WS_WIN), 64, scr, kb * 64 + nb, lane);
            else p0_transpose_item(A.in[15] + 2048, INE, 1024, (bf16*)(ws + WS_WGLR), 1, scr, kb, lane);
            continue; } r -= I_IN;
        if (r < I_OUT) { p0_transpose_item(A.in[16], 1024, 1024, (bf16*)(ws + WS_WOUT), 32, scr, r, lane); continue; } r -= I_OUT;
        if (r < I_GLU) { p0_transpose_item(A.in[25], 512, 512, (bf16*)(ws + WS_WGLU), 16, scr, r, lane); continue; } r -= I_GLU;
        if (r < 2 * I_M1) { const int l = r / I_M1; p0_transpose_item(A.in[13] + (size_t)l * 1024 * 4096, 4096, 1024, (bf16*)(ws + WS_W1) + (size_t)l * 4096 * 1024, 128, scr, r % I_M1, lane); continue; } r -= 2 * I_M1;
        if (r < 2 * I_M2) { const int l = r / I_M2; p0_transpose_item(A.in[14] + (size_t)l * 4096 * 1024, 1024, 4096, (bf16*)(ws + WS_W2) + (size_t)l * 1024 * 4096, 32, scr, r % I_M2, lane); continue; } r -= 2 * I_M2;
        if (r < I_QKV) { p0_transpose_item(A.in[30], 1536, 1024, (bf16*)(ws + WS_WQKV), 48, scr, r, lane); continue; } r -= I_QKV;
        p0_transpose_item(A.in[31], 1024, 1024, (bf16*)(ws + WS_WO), 32, scr, r, lane);
    }
}

template <bool GLR>
__device__ __forceinline__ void norm_phase(CArgs& A, LAS unsigned char* lds, const float* src_p, const float* src_s, const float* g, const float* ada, int ch_shift, int ch_scale,
                                           int tid, int lane, int wave) {
    unsigned char* ws = A.ws;
    bf16* H = (bf16*)(ws + WS_H);
    for (int blk = blockIdx.x; blk < NTOK / 32; blk += gridDim.x) {
        const int r0 = blk * 32; const int cond = r0 < NPR ? 0 : 1 + ((r0 - NPR) >> 10);
        const float* src = r0 < NPR ? src_p : src_s;
        const float* adc = ada + cond * 6144;
        f32x4 ga[4], gb[4];
#pragma unroll
        for (int j = 0; j < 4; ++j) { const int col = 4 * lane + 256 * j; const f32x4 gg = *(const f32x4*)(g + col), s1 = *(const f32x4*)(adc + ch_scale * 1024 + col); ga[j] = gg * (s1 + 1.0f); gb[j] = *(const f32x4*)(adc + ch_shift * 1024 + col); }
#pragma unroll
        for (int i = 0; i < 4; ++i) { const int row = r0 + wave * 4 + i;
            const GAS f32x4* xr = (const GAS f32x4*)(src + (size_t)row * 1024) + lane;
            f32x4 v[4]; float s = 0.f;
#pragma unroll
            for (int j = 0; j < 4; ++j) { v[j] = xr[64 * j]; s += (v[j].x * v[j].x + v[j].y * v[j].y) + (v[j].z * v[j].z + v[j].w * v[j].w); }
            const float rstd = 1.f / sqrtf(wave_sum(s) * (1.f / 1024.f) + EPS);
            GAS v2u* o8 = (GAS v2u*)(H + (size_t)row * 1024) + lane;
#pragma unroll
            for (int j = 0; j < 4; ++j) { const f32x4 h = v[j] * rstd * ga[j] + gb[j]; v2u w; w.x = pk2(h.x, h.y); w.y = pk2(h.z, h.w); o8[64 * j] = w;
                if (GLR) *(LAS v2u*)(lds + (wave * 4 + i) * 2064 + (4 * lane + 256 * j) * 2) = w; }
        }
        if (GLR) {
            __syncthreads();
            const bf16* WG = (const bf16*)(ws + WS_WGLR);
            const int r32 = lane & 31, hi = lane >> 5;
            f32x16 acc = {};
#pragma unroll
            for (int ks = 0; ks < 8; ++ks) { const int k = wave * 128 + ks * 16 + hi * 8;
                const bf16x8 a = *(const LAS bf16x8*)(lds + r32 * 2064 + k * 2);
                const bf16x8 b = *(const bf16x8*)(WG + (size_t)r32 * 1024 + k);
                acc = __builtin_amdgcn_mfma_f32_32x32x16_bf16(a, b, acc, 0, 0, 0); }
            LAS float* red = (LAS float*)(lds + 69632);
#pragma unroll
            for (int r = 0; r < 16; ++r) red[(wave * 32 + crow(r, hi)) * 32 + r32] = acc[r];
            __syncthreads();
            LAS float* glrs = (LAS float*)(lds + 69632 + 32768);
#pragma unroll
            for (int e = 0; e < 2; ++e) { const int idx = tid + 512 * e; float s = 0.f;
#pragma unroll
                for (int w = 0; w < 8; ++w) s += red[w * 1024 + idx];
                glrs[idx] = s; }
            __syncthreads();
            { const int dcol = tid >> 8, hk = tid & 255; float wg2[16];
#pragma unroll
                for (int r = 0; r < 16; ++r) wg2[r] = A.in[27][(size_t)(dcol * 16 + r) * 256 + hk];
                const float bg = A.in[28][dcol * 256 + hk];
                float* GDo = (float*)(ws + WS_GD);
                for (int row = 0; row < 32; ++row) { float x = bg;
#pragma unroll
                    for (int r = 0; r < 16; ++r) x = fmaf(glrs[row * 32 + 16 * dcol + r], wg2[r], x);
                    const float ls = fminf(x, 0.f) - log1pf(__expf(-fabsf(x)));
                    GDo[(size_t)(r0 + row) * 512 + tid] = ls * (1.f / 16.f); } }
            __syncthreads();
        }
    }
}

__device__ __forceinline__ float gelu_tanh(float y) { const float z = 0.7978845608028654f * (y + 0.044715f * y * y * y); const float e = __expf(2.f * z); const float t = 1.f - 2.f / (e + 1.f); return 0.5f * y * (1.f + t); }
#define S5_PW(lds) ((LAS float*)(lds))
#define S5_BB(lds) (S5_PW(lds) + 2 * 17 * 64 * 2)
#define S5_CL(lds) (S5_BB(lds) + 2 * 64 * 16 * 2)
#define S5_KL(lds) (S5_CL(lds) + 16 * 64 * 2)
__device__ __forceinline__ void s5_small(CArgs& A, LAS unsigned char* lds, int g, bool write_bb, int tid) {
    unsigned char* ws = A.ws;
    LAS float* Pw = S5_PW(lds); LAS float* BBl = S5_BB(lds); LAS float* Cl = S5_CL(lds);
    if (tid < 128) { const int d = tid >> 6, p = tid & 63;
        const float lre = A.in[17][(d * 32 + g) * 64 + p], lim = A.in[18][(d * 32 + g) * 64 + p];
        const float dt = expf(A.in[19][d * 32 + g]);
        const float a_ = lre * dt, th = lim * dt;
        float sn, cs; sincosf(th, &sn, &cs);
        const float ea = expf(a_);
        const float lb_re = ea * cs, lb_im = ea * sn;
        const float sh = sinf(0.5f * th);
        const float nr = expm1f(a_) * cs - 2.f * sh * sh, ni = ea * sn;
        const float den = 1.f / (lre * lre + lim * lim);
        const float cf_re = (nr * lre + ni * lim) * den, cf_im = (ni * lre - nr * lim) * den;
        float pr = 1.f, pi = 0.f;
        for (int t = 0; t <= 16; ++t) { Pw[((d * 17 + t) * 64 + p) * 2] = pr; Pw[((d * 17 + t) * 64 + p) * 2 + 1] = pi; const float n0 = pr * lb_re - pi * lb_im, n1 = pr * lb_im + pi * lb_re; pr = n0; pi = n1; }
        float* BBg = (float*)(ws + WS_BB) + (size_t)(g * 2 + d) * 2048;
#pragma unroll
        for (int c = 0; c < 16; ++c) { const float br = A.in[20][(size_t)(g * 64 + p) * 16 + c], bi = A.in[21][(size_t)(g * 64 + p) * 16 + c];
            const float vr = cf_re * br - cf_im * bi, vi = cf_re * bi + cf_im * br;
            BBl[((d * 64 + p) * 16 + c) * 2] = vr; BBl[((d * 64 + p) * 16 + c) * 2 + 1] = vi; if (write_bb) { BBg[p * 16 + c] = vr; BBg[1024 + p * 16 + c] = vi; } }
    } else { for (int i = tid - 128; i < 1024; i += 384) { Cl[i * 2] = A.in[22][(size_t)g * 1024 + i]; Cl[i * 2 + 1] = A.in[23][(size_t)g * 1024 + i]; } }
    __syncthreads();
}
__device__ __forceinline__ void s5_k_slice(CArgs& A, LAS unsigned char* lds, int g, int q, int tid) {
    LAS float* Pw = S5_PW(lds); LAS float* BBl = S5_BB(lds); LAS float* Cl = S5_CL(lds);
    float* KB = (float*)(A.ws + WS_KB) + (size_t)g * 8192;
#pragma unroll
    for (int e = 0; e < 2; ++e) { const int o = q * 1024 + tid + 512 * e; const int d = o >> 12, tau = (o >> 8) & 15, c = (o >> 4) & 15, c2 = o & 15; float s = 0.f;
#pragma unroll 4
        for (int p = 0; p < 64; ++p) { const float cr = Cl[(c * 64 + p) * 2], ci = Cl[(c * 64 + p) * 2 + 1], pr = Pw[((d * 17 + tau) * 64 + p) * 2], pi = Pw[((d * 17 + tau) * 64 + p) * 2 + 1];
            const float zr = cr * pr - ci * pi, zi = cr * pi + ci * pr; s += zr * BBl[((d * 64 + p) * 16 + c2) * 2] - zi * BBl[((d * 64 + p) * 16 + c2) * 2 + 1]; }
        KB[o] = s; }
    __syncthreads();
}
__device__ __forceinline__ void s5_expand(CArgs& A, LAS unsigned char* lds, int g, int q, int tid) {
    unsigned char* ws = A.ws;
    LAS float* Pw = S5_PW(lds); LAS float* BBl = S5_BB(lds); LAS float* Cl = S5_CL(lds); LAS float* Kl = S5_KL(lds);
    { const float* KB = (const float*)(ws + WS_KB) + (size_t)g * 8192;
        for (int i = tid; i < 2048; i += 512) *(LAS f32x4*)(Kl + 4 * i) = *(const f32x4*)(KB + 4 * i); }
    __syncthreads();
    unsigned* WYg = (unsigned*)((bf16*)(ws + WS_WY) + (size_t)g * 256 * 512);
    for (int i = q * 32 * 256 + tid; i < (q + 1) * 32 * 256; i += 512) { const int n = i >> 8, k0 = (i & 255) * 2; const int t = n >> 4, c = n & 15; float v[2];
#pragma unroll
        for (int e = 0; e < 2; ++e) { const int k = k0 + e;
            if (k < 256) { const int s_ = k >> 4, c2 = k & 15;
                if (s_ < t) v[e] = Kl[((0 * 16 + (t - s_)) * 16 + c) * 16 + c2];
                else if (s_ > t) v[e] = Kl[((1 * 16 + (s_ - t)) * 16 + c) * 16 + c2];
                else v[e] = Kl[((0 * 16 + 0) * 16 + c) * 16 + c2] + Kl[((1 * 16 + 0) * 16 + c) * 16 + c2] + (c == c2 ? A.in[24][g * 16 + c] : 0.f);
            } else { const int kk = k - 256, d = kk >> 7, im = (kk >> 6) & 1, p = kk & 63; const int tau = d == 0 ? t + 1 : 16 - t;
                const float cr = Cl[(c * 64 + p) * 2], ci = Cl[(c * 64 + p) * 2 + 1], pr = Pw[((d * 17 + tau) * 64 + p) * 2], pi = Pw[((d * 17 + tau) * 64 + p) * 2 + 1];
                v[e] = im ? -(cr * pi + ci * pr) : (cr * pr - ci * pi); } }
        WYg[i] = pk2(v[0], v[1]); }
    unsigned* WEg = (unsigned*)((bf16*)(ws + WS_WE) + (size_t)g * 256 * 512);
    for (int i = q * 32 * 128 + tid; i < (q + 1) * 32 * 128; i += 512) { const int n = i >> 7, k0 = (i & 127) * 2; const int d = n >> 7, im = (n >> 6) & 1, p = n & 63; float v[2];
#pragma unroll
        for (int e = 0; e < 2; ++e) { const int k = k0 + e, s_ = k >> 4, c2 = k & 15; const int tau = d == 0 ? 15 - s_ : s_;
            const float pr = Pw[((d * 17 + tau) * 64 + p) * 2], pi = Pw[((d * 17 + tau) * 64 + p) * 2 + 1], br = BBl[((d * 64 + p) * 16 + c2) * 2], bi = BBl[((d * 64 + p) * 16 + c2) * 2 + 1];
            v[e] = im ? (pr * bi + pi * br) : (pr * br - pi * bi); }
        WEg[n * 256 + (i & 127)] = pk2(v[0], v[1]); }
    __syncthreads();
}
__device__ __forceinline__ void s5_recur(CArgs& A, LAS unsigned char* lds, int g, int mt, int tid) {
    unsigned char* ws = A.ws;
    const float* EB = (const float*)(ws + WS_EBUF) + (size_t)(g * 512 + mt * 256) * 256;
    bf16* UHg = (bf16*)(ws + WS_UH) + (size_t)(g * 512 + mt * 256) * 512;
    LAS float* El = (LAS float*)lds;
    const int nrow = mt == 0 ? 16 : 64;
    for (int d = 0; d < 2; ++d) {
        for (int i = tid; i < 256 * 32; i += 512) { const int r = i >> 5, q = i & 31; *(LAS f32x4*)(El + r * 128 + 4 * q) = *(const f32x4*)(EB + (size_t)r * 256 + d * 128 + 4 * q); }
        __syncthreads();
        const int nseq = mt == 0 ? 16 : 4;
        for (int idx = tid; idx < nseq * 64; idx += 512) { const int p = idx & 63, b = idx >> 6;
            const float lre = A.in[17][(d * 32 + g) * 64 + p], lim = A.in[18][(d * 32 + g) * 64 + p];
            const float dt = expf(A.in[19][d * 32 + g]);
            float sn, cs; sincosf(lim * dt, &sn, &cs); const float ea = expf(lre * dt);
            float pr = ea * cs, pi = ea * sn;
#pragma unroll
            for (int s_ = 0; s_ < 4; ++s_) { const float n0 = pr * pr - pi * pi, n1 = 2.f * pr * pi; pr = n0; pi = n1; }
            float hr = 0.f, hi_ = 0.f;
            if (mt == 1) { hr = A.in[2][(size_t)((b * 2 + d) * 32 + g) * 64 + p]; hi_ = A.in[3][(size_t)((b * 2 + d) * 32 + g) * 64 + p]; }
            for (int st = 0; st < nrow; ++st) { const int r = b * nrow + (d == 0 ? st : nrow - 1 - st);
                bf16* up = UHg + (size_t)r * 512 + 256 + d * 128 + p; up[0] = (bf16)f2bf(hr); up[64] = (bf16)f2bf(hi_);
                const float er = El[r * 128 + p], ei = El[r * 128 + 64 + p];
                const float n0 = pr * hr - pi * hi_ + er, n1 = pr * hi_ + pi * hr + ei; hr = n0; hi_ = n1; }
            if (mt == 0) {
                const int r = b * 16 + (d == 0 ? 0 : 15), s_ = d == 0 ? 0 : 15;
                const float* BBg = (const float*)(ws + WS_BB) + (size_t)(g * 2 + d) * 2048 + p * 16; const bf16* up = UHg + (size_t)r * 512 + s_ * 16;
                float fr_ = 0.f, fi_ = 0.f;
#pragma unroll
                for (int c = 0; c < 16; ++c) { const float u = bf2f(up[c]); fr_ = fmaf(BBg[c], u, fr_); fi_ = fmaf(BBg[1024 + c], u, fi_); }
                A.out[OUT_S5RE + (size_t)((b * 2 + d) * 32 + g) * 64 + p] = fr_; A.out[OUT_S5IM + (size_t)((b * 2 + d) * 32 + g) * 64 + p] = fi_; }
        }
        __syncthreads();
    }
    VM_WAIT(); __syncthreads();
}
struct GroupOrder { int c, G_;
    __device__ __forceinline__ bool next(int i, pg8::Unit& u) const { const int L = i * G_ + c; if (L >= 64) return false; u.pm = L; u.pn = L >> 1; return true; }
    __device__ __forceinline__ void a_ready(const pg8::Unit&) const {}
    __device__ __forceinline__ void done(const pg8::Unit&) const {} };
struct EpiF32 {
    static constexpr bool PERM = false, AFTER_DRAIN = false; float* O;
    __device__ __forceinline__ void operator()(const f32x4 (&acc)[2][2][4][2], const pg8::Unit& u, int wr, int wc, int fr, int fq) const {
        const int row0 = u.pm * 256 + wr * 64 + fr, col0 = wc * 32 + 4 * fq;
#pragma unroll
        for (int ai = 0; ai < 2; ++ai)
#pragma unroll
            for (int m = 0; m < 4; ++m)
#pragma unroll
                for (int bj = 0; bj < 2; ++bj)
#pragma unroll
                    for (int n = 0; n < 2; ++n) *(f32x4*)(O + (size_t)(row0 + ai * 128 + m * 16) * 256 + col0 + bj * 128 + n * 16) = acc[ai][bj][m][n];
    }
};
struct EpiS5Y {
    static constexpr bool PERM = true, AFTER_DRAIN = false; bf16* Gp;
    __device__ __forceinline__ void operator()(const f32x4 (&acc)[2][2][4][2], const pg8::Unit& u, int wr, int wc, int fr, int fq) const {
        const int g = u.pm >> 1, jj0 = (u.pm & 1) * 256 + wr * 64 + fr, col0 = wc * 32 + 8 * fq;
#pragma unroll
        for (int ai = 0; ai < 2; ++ai)
#pragma unroll
            for (int m = 0; m < 4; ++m) { const int jj = jj0 + ai * 128 + m * 16;
#pragma unroll
                for (int bj = 0; bj < 2; ++bj) { const int n = col0 + bj * 128, t = n >> 4, c0 = n & 15; const f32x4 v0 = acc[ai][bj][m][0], v1 = acc[ai][bj][m][1];
                    v4u w; w.x = pk2(gelu_tanh(v0[0]), gelu_tanh(v0[1])); w.y = pk2(gelu_tanh(v0[2]), gelu_tanh(v0[3])); w.z = pk2(gelu_tanh(v1[0]), gelu_tanh(v1[1])); w.w = pk2(gelu_tanh(v1[2]), gelu_tanh(v1[3]));
                    *(v4u*)(Gp + (size_t)(16 * jj + t) * 512 + g * 16 + c0) = w; } }
    }
};
struct EpiZU {
    static constexpr bool PERM = true, AFTER_DRAIN = false; bf16* Zp; bf16* UHp;
    __device__ __forceinline__ void operator()(const f32x4 (&acc)[2][2][4][2], const pg8::Unit& u, int wr, int wc, int fr, int fq) const {
        const int row0 = u.pm * 256 + wr * 64 + fr; const int col0 = u.pn * 256 + wc * 32 + 8 * fq;
#pragma unroll
        for (int ai = 0; ai < 2; ++ai)
#pragma unroll
            for (int m = 0; m < 4; ++m) { const int row = row0 + ai * 128 + m * 16;
#pragma unroll
                for (int bj = 0; bj < 2; ++bj) { const f32x4 v0 = acc[ai][bj][m][0], v1 = acc[ai][bj][m][1]; const int col = col0 + bj * 128;
                    v4u w; w.x = pk2(v0[0], v0[1]); w.y = pk2(v0[2], v0[3]); w.z = pk2(v1[0], v1[1]); w.w = pk2(v1[2], v1[3]);
                    if (u.pn < 2) *(v4u*)(UHp + ((size_t)(col >> 4) * 512 + (row >> 4)) * 512 + (row & 15) * 16 + (col & 15)) = w;
                    else *(v4u*)(Zp + (size_t)row * 2048 + col) = w; } }
    }
};

__device__ __forceinline__ int gla_slot(int bb, int h, int d, int j) { return bb < 16 ? ((bb * 4 + h) * 2 + d) * 4 + j : 512 + (((bb - 16) * 4 + h) * 2 + d) * 16 + j; }
constexpr int GL_V = 0, GL_VROW = 320;
constexpr int GL_KT = 20480, GL_KTROW = 144;
constexpr int GL_TOT = GL_KT + 4 * 9216;
constexpr int GL_PART = GL_TOT + 2048;
constexpr int GL_BYTES = GL_PART + 1024;
template <int MODE>
__device__ __forceinline__ void gla_prep(CArgs& A, LAS unsigned char* lds, int bb, int h, int j, int row0, int tid, int lane, int wave) {
    unsigned char* ws = A.ws;
    const bf16* Z = (const bf16*)(ws + WS_Z); const float* GDi = (const float*)(ws + WS_GD);
    const int d = wave >> 2, wg = wave & 3;
#pragma unroll
    for (int i = 0; i < 2; ++i) { const int r = (tid >> 4) + 32 * i, c = tid & 15;
        const v4u v = *(const v4u*)(Z + (size_t)(row0 + r) * 2048 + 1024 + h * 128 + 8 * c);
        *(LAS v4u*)(lds + GL_V + r * GL_VROW + c * 16) = v; }
    float gd[16]; float tot = 0.f;
#pragma unroll
    for (int i = 0; i < 16; ++i) { gd[i] = GDi[(size_t)(row0 + 16 * wg + i) * 512 + d * 256 + h * 64 + lane]; tot += gd[i]; }
    LAS float* TOT = (LAS float*)(lds + GL_TOT);
    TOT[(d * 4 + wg) * 64 + lane] = tot;
    __syncthreads();
    float off = 0.f, total = 0.f;
#pragma unroll
    for (int w = 0; w < 4; ++w) { const float tw = TOT[(d * 4 + w) * 64 + lane]; total += tw; if (d == 0 ? (w < wg) : (w > wg)) off += tw; }
    float bcum[16];
    if (d == 0) { float s = off;
#pragma unroll
        for (int i = 0; i < 16; ++i) { s += gd[i]; bcum[i] = s; } }
    else { float s = off;
#pragma unroll
        for (int i = 15; i >= 0; --i) { s += gd[i]; bcum[i] = s; } }
    LAS unsigned char* img = lds + GL_KT + d * 2 * 9216;
    if (MODE == 0) {
        unsigned pkk[8];
#pragma unroll
        for (int i = 0; i < 16; i += 2) { const float k0 = bf2f(Z[(size_t)(row0 + 16 * wg + i) * 2048 + 768 + h * 64 + lane]), k1 = bf2f(Z[(size_t)(row0 + 16 * wg + i + 1) * 2048 + 768 + h * 64 + lane]);
            pkk[i >> 1] = pk2(k0 * __expf(total - bcum[i]), k1 * __expf(total - bcum[i + 1])); }
        *(LAS v4u*)(img + lane * GL_KTROW + 32 * wg) = (v4u){pkk[0], pkk[1], pkk[2], pkk[3]};
        *(LAS v4u*)(img + lane * GL_KTROW + 32 * wg + 16) = (v4u){pkk[4], pkk[5], pkk[6], pkk[7]};
        if (wg == 0) ((float*)(ws + WS_DEC))[(size_t)gla_slot(bb, h, d, j) * 64 + lane] = __expf(total);
    } else {
#pragma unroll
        for (int i = 0; i < 16; ++i) { const size_t zr = (size_t)(row0 + 16 * wg + i) * 2048 + h * 64 + lane;
            const float q = bf2f(Z[zr + 512]) * 0.125f, k = bf2f(Z[zr + 768]);
            *(LAS unsigned short*)(img + (16 * wg + i) * GL_KTROW + lane * 2) = (unsigned short)f2bf(q * __expf(bcum[i]));
            *(LAS unsigned short*)(img + 9216 + (16 * wg + i) * GL_KTROW + lane * 2) = (unsigned short)f2bf(k * __expf(-bcum[i])); }
    }
    __syncthreads();
}
__device__ __forceinline__ void gla_task_rows(int task, int& bb, int& h, int& j, int& row0) {
    if (task < 256) { bb = task >> 4; h = (task >> 2) & 3; j = task & 3; row0 = bb * 256 + 64 * j; }
    else { const int t = task - 256; bb = 16 + (t >> 6); h = (t >> 4) & 3; j = t & 15; row0 = NPR + (bb - 16) * 1024 + 64 * j; }
}
__device__ __forceinline__ void gla_a_task(CArgs& A, LAS unsigned char* lds, int task, int tid, int lane, int wave) {
    int bb, h, j, row0; gla_task_rows(task, bb, h, j, row0);
    gla_prep<0>(A, lds, bb, h, j, row0, tid, lane, wave);
    const int d = wave >> 2, wg = wave & 3, r32 = lane & 31, hi = lane >> 5;
    const unsigned lbase = (unsigned)(uintptr_t)(lds);
    const unsigned vaddr = lbase + GL_V + (8 * hi + ((lane & 15) >> 2)) * GL_VROW + (32 * wg + 16 * ((lane >> 4) & 1) + 4 * (lane & 3)) * 2;
    LAS unsigned char* img = lds + GL_KT + d * 2 * 9216;
    f32x16 acc0 = {}, acc1 = {};
#pragma unroll
    for (int ks = 0; ks < 4; ++ks) {
        const s16x4 lo = tr_read4(vaddr + (16 * ks) * GL_VROW), hi4 = tr_read4(vaddr + (16 * ks + 4) * GL_VROW);
        const bf16x8 b0 = *(const LAS bf16x8*)(img + r32 * GL_KTROW + (16 * ks + 8 * hi) * 2);
        const bf16x8 b1 = *(const LAS bf16x8*)(img + (32 + r32) * GL_KTROW + (16 * ks + 8 * hi) * 2);
        asm volatile("s_waitcnt lgkmcnt(0)" ::: "memory"); __builtin_amdgcn_sched_barrier(0);
        const bf16x8 a = (bf16x8){lo[0], lo[1], lo[2], lo[3], hi4[0], hi4[1], hi4[2], hi4[3]};
        acc0 = __builtin_amdgcn_mfma_f32_32x32x16_bf16(a, b0, acc0, 0, 0, 0);
        acc1 = __builtin_amdgcn_mfma_f32_32x32x16_bf16(a, b1, acc1, 0, 0, 0);
    }
    float* SL = (float*)(A.ws + WS_SLOC) + (size_t)gla_slot(bb, h, d, j) * 8192;
    { float* slp = SL + (32 * wg + 4 * hi) * 64 + r32;
#pragma unroll
    for (int r = 0; r < 16; ++r) { slp[((r & 3) + 8 * (r >> 2)) * 64] = acc0[r]; slp[((r & 3) + 8 * (r >> 2)) * 64 + 32] = acc1[r]; } }
    __syncthreads();
}
template <int N>
__device__ __forceinline__ void gla_b_chain(CArgs& A, int bb, int h, int d, int v, int kk, bool samp) {
    unsigned char* ws = A.ws;
    const float* SL = (const float*)(ws + WS_SLOC); const float* DEC = (const float*)(ws + WS_DEC); bf16* SIN = (bf16*)(ws + WS_SIN);
    f32x4 dc[N], sl[N];
#pragma unroll
    for (int i = 0; i < N; ++i) { const int j = d == 0 ? i : N - 1 - i; const size_t slot = (size_t)gla_slot(bb, h, d, j);
        dc[i] = *(const f32x4*)(DEC + slot * 64 + kk); sl[i] = *(const f32x4*)(SL + slot * 8192 + v * 64 + kk); }
    f32x4 S = {0.f, 0.f, 0.f, 0.f};
    if (samp) { const float* s0 = A.in[4] + (size_t)(((bb - 16) * 2 + d) * 4 + h) * 8192;
#pragma unroll
        for (int q = 0; q < 4; ++q) S[q] = s0[(kk + q) * 128 + v]; }
#pragma unroll
    for (int i = 0; i < N; ++i) { const int j = d == 0 ? i : N - 1 - i; const size_t slot = (size_t)gla_slot(bb, h, d, j);
        v2u w; w.x = pk2(S.x, S.y); w.y = pk2(S.z, S.w); *(v2u*)(SIN + slot * 8192 + v * 64 + kk) = w;
        S = S * dc[i] + sl[i]; }
    if (!samp) { float* o = A.out + OUT_GLA + (size_t)((bb * 2 + d) * 4 + h) * 8192;
#pragma unroll
        for (int q = 0; q < 4; ++q) o[(kk + q) * 128 + v] = S[q]; }
}
__device__ __forceinline__ void gla_b_phase(CArgs& A, int gtid, int nthreads) {
    for (int it = gtid; it < 160 * 2048; it += nthreads) {
        const int s = it >> 11, e = it & 2047;
        const int grp = s / 5, m = s % 5; const int chain = m == 4 ? 128 + grp : grp * 4 + m;
        const bool samp = chain >= 128; const int ci = samp ? chain - 128 : chain;
        const int bb = (samp ? 16 : 0) + (ci >> 3), h = (ci >> 1) & 3, d = ci & 1;
        const int v = e >> 4, kk = (e & 15) * 4;
        if (samp) gla_b_chain<16>(A, bb, h, d, v, kk, true); else gla_b_chain<4>(A, bb, h, d, v, kk, false);
    }
}
__device__ __forceinline__ void gla_c_task(CArgs& A, LAS unsigned char* lds, int task, int tid, int lane, int wave) {
    int bb, h, j, row0; gla_task_rows(task, bb, h, j, row0);
    gla_prep<1>(A, lds, bb, h, j, row0, tid, lane, wave);
    unsigned char* ws = A.ws;
    const bf16* Z = (const bf16*)(ws + WS_Z); const bf16* SIN = (const bf16*)(ws + WS_SIN); bf16* MIX = (bf16*)(ws + WS_MIX);
    const int ti = wave >> 2, vi = wave & 3, r32 = lane & 31, hi = lane >> 5;
    const unsigned lbase = (unsigned)(uintptr_t)(lds);
    const unsigned vaddr = lbase + GL_V + (4 * hi + ((lane & 15) >> 2)) * GL_VROW + (32 * vi + 16 * ((lane >> 4) & 1) + 4 * (lane & 3)) * 2;
    f32x16 o = {};
    const int t = 32 * ti + r32;
#pragma unroll
    for (int d = 0; d < 2; ++d) {
        LAS unsigned char* qimg = lds + GL_KT + d * 2 * 9216; LAS unsigned char* kimg = qimg + 9216;
        bf16x8 qf[4];
#pragma unroll
        for (int ks = 0; ks < 4; ++ks) qf[ks] = *(const LAS bf16x8*)(qimg + t * GL_KTROW + (16 * ks + 8 * hi) * 2);
        const bf16* SI = SIN + (size_t)gla_slot(bb, h, d, j) * 8192 + (size_t)(32 * vi + r32) * 64 + 8 * hi;
#pragma unroll
        for (int ks = 0; ks < 4; ++ks) { const bf16x8 sa = *(const bf16x8*)(SI + 16 * ks); o = __builtin_amdgcn_mfma_f32_32x32x16_bf16(sa, qf[ks], o, 0, 0, 0); }
#pragma unroll
        for (int si = 0; si < 2; ++si) {
            f32x16 x = {};
#pragma unroll
            for (int ks = 0; ks < 4; ++ks) { const bf16x8 ka = *(const LAS bf16x8*)(kimg + (32 * si + r32) * GL_KTROW + (16 * ks + 8 * hi) * 2); x = __builtin_amdgcn_mfma_f32_32x32x16_bf16(ka, qf[ks], x, 0, 0, 0); }
            unsigned pw[8];
#pragma unroll
            for (int r = 0; r < 16; r += 2) { const int s0 = 32 * si + crow(r, hi), s1 = s0 + 1;
                const float x0 = (d == 0 ? (s0 <= t) : (s0 >= t)) ? x[r] : 0.f, x1 = (d == 0 ? (s1 <= t) : (s1 >= t)) ? x[r + 1] : 0.f;
                pw[r >> 1] = pk2(x0, x1); }
#pragma unroll
            for (int sp = 0; sp < 2; ++sp) {
                const s16x4 lo = tr_read4(vaddr + (32 * si + 16 * sp) * GL_VROW), hi4 = tr_read4(vaddr + (32 * si + 16 * sp + 8) * GL_VROW);
                asm volatile("s_waitcnt lgkmcnt(0)" ::: "memory"); __builtin_amdgcn_sched_barrier(0);
                const bf16x8 va = (bf16x8){lo[0], lo[1], lo[2], lo[3], hi4[0], hi4[1], hi4[2], hi4[3]};
                const v4u pq = {pw[4 * sp], pw[4 * sp + 1], pw[4 * sp + 2], pw[4 * sp + 3]};
                o = __builtin_amdgcn_mfma_f32_32x32x16_bf16(va, __builtin_bit_cast(bf16x8, pq), o, 0, 0, 0);
            }
        }
    }
    float ss = 0.f;
#pragma unroll
    for (int r = 0; r < 16; ++r) ss += o[r] * o[r];
    ss += __shfl_xor(ss, 32);
    LAS float* PART = (LAS float*)(lds + GL_PART);
    if (hi == 0) PART[(ti * 4 + vi) * 32 + r32] = ss;
    __syncthreads();
    const float tot = PART[(ti * 4 + 0) * 32 + r32] + PART[(ti * 4 + 1) * 32 + r32] + PART[(ti * 4 + 2) * 32 + r32] + PART[(ti * 4 + 3) * 32 + r32];
    const float rstd = 1.f / sqrtf(tot * (1.f / 128.f) + EPS);
    const size_t row = (size_t)(row0 + t);
#pragma unroll
    for (int rq = 0; rq < 4; ++rq) { const int v = 32 * vi + 8 * rq + 4 * hi;
        const v2u rr = *(const v2u*)(Z + row * 2048 + 1536 + h * 128 + v);
        const f32x4 gn = *(const f32x4*)(A.in[29] + v);
        float rv[4] = {bflo(rr.x), bfhi(rr.x), bflo(rr.y), bfhi(rr.y)}; float ov[4];
#pragma unroll
        for (int e = 0; e < 4; ++e) { const float sl = rv[e] / (1.f + __expf(-rv[e])); ov[e] = o[4 * rq + e] * rstd * gn[e] * sl; }
        v2u w; w.x = pk2(ov[0], ov[1]); w.y = pk2(ov[2], ov[3]);
        *(v2u*)(MIX + row * 1024 + 512 + h * 128 + v) = w; }
    __syncthreads();
}

__device__ __forceinline__ void qk_phase(CArgs& A, int lane, int gw, int ngw) {
    unsigned char* ws = A.ws;
    const bf16* QKV = (const bf16*)(ws + WS_QKV); bf16* QN = (bf16*)(ws + WS_QN);
    const float qw0 = A.in[32][2 * lane], qw1 = A.in[32][2 * lane + 1], kw0 = A.in[33][2 * lane], kw1 = A.in[33][2 * lane + 1];
    const float inv = __powf(10000.f, -(float)(2 * (lane & 31)) / 64.f);
    for (int row = gw; row < NTOK + 2048; row += ngw) {
        if (row >= NTOK) {
            const int cr = row - NTOK, b = cr >> 9, pl = cr & 511;
            const f32x4 kx = *(const f32x4*)(A.in[5] + (size_t)(b * 512 + pl) * 256 + 4 * lane), vx = *(const f32x4*)(A.in[6] + (size_t)(b * 512 + pl) * 256 + 4 * lane);
            v2u kwd, vwd; kwd.x = pk2(kx.x, kx.y); kwd.y = pk2(kx.z, kx.w); vwd.x = pk2(vx.x, vx.y); vwd.y = pk2(vx.z, vx.w);
            *(v2u*)((bf16*)(ws + WS_KS) + (size_t)(b * 1536 + 1024 + pl) * 256 + 4 * lane) = kwd;
            *(v2u*)((bf16*)(ws + WS_VS) + (size_t)(b * 1536 + 1024 + pl) * 256 + 4 * lane) = vwd;
            continue;
        }
        const bool samp = row >= NPR; const int b = samp ? (row - NPR) >> 10 : row >> 8, t = samp ? (row - NPR) & 1023 : row & 255;
        float cs = 1.f, sn = 0.f;
        if (samp) { const float pos = (float)(lane < 32 ? (t >> 6) : (t & 63)); sincosf(pos * inv, &sn, &cs); }
        const unsigned* src = (const unsigned*)(QKV + (size_t)row * QKVW);
        bf16* kdst = samp ? (bf16*)(ws + WS_KS) + (size_t)(b * 1536 + t) * 256 : (bf16*)(ws + WS_KP) + (size_t)row * 256;
        bf16* vdst = samp ? (bf16*)(ws + WS_VS) + (size_t)(b * 1536 + t) * 256 : (bf16*)(ws + WS_VP) + (size_t)row * 256;
#pragma unroll
        for (int hd = 0; hd < 10; ++hd) {
            const unsigned w = src[hd * 64 + lane]; float x0 = bflo(w), x1 = bfhi(w);
            const float rstd = 1.f / sqrtf(wave_sum(x0 * x0 + x1 * x1) * (1.f / 128.f) + EPS);
            x0 *= rstd * (hd < 8 ? qw0 : kw0); x1 *= rstd * (hd < 8 ? qw1 : kw1);
            if (hd >= 8 && !samp) { float* nk = A.out + OUT_NK + ((size_t)row * 2 + (hd - 8)) * 128 + 2 * lane; nk[0] = x0; nk[1] = x1; }
            const float y0 = x0 * cs - x1 * sn, y1 = x0 * sn + x1 * cs;
            const unsigned ow = pk2(y0, y1);
            if (hd < 8) ((unsigned*)(QN + (size_t)row * 1024))[hd * 64 + lane] = ow;
            else ((unsigned*)kdst)[(hd - 8) * 64 + lane] = ow;
        }
#pragma unroll
        for (int hv = 0; hv < 2; ++hv) { const unsigned w = src[(10 + hv) * 64 + lane]; ((unsigned*)vdst)[hv * 64 + lane] = w;
            if (!samp) { float* nv = A.out + OUT_NV + ((size_t)row * 2 + hv) * 128 + 2 * lane; nv[0] = bflo(w); nv[1] = bfhi(w); } }
    }
}

#ifndef DBL_MASK
#define DBL_MASK 0u
#endif
#ifndef XBAR_N
#define XBAR_N 0
#endif
__global__ void __launch_bounds__(NWAVES * 64, 2) fwd_kernel(Args args_unused) {
    extern __shared__ __attribute__((aligned(16))) unsigned char lds_raw[];
#define lds ((LAS unsigned char*)lds_raw)
#define MISC ((volatile LAS unsigned*)(lds + MISC_OFF))
#define tid (tid_opaque())
#define lane (tid_opaque() & 63)
#define wave (__builtin_amdgcn_readfirstlane(tid_opaque() >> 6))
#define G ((int)gridDim.x)
#define ws (kargs()->ws)
#define ADA ((const float*)(ws + WS_ADA))
#define H ((bf16*)(ws + WS_H))
#define Y ((float*)(ws + WS_Y))
#define xs_off (KA.in[1] - (size_t)NPR * 1024)
#define ADA1 (ADA + 5 * 6144)
    for (int u = tid; u < (LDS_BYTES - LDSCTL_OFF) / 4; u += NWAVES * 64) ((LAS unsigned*)(lds + LDSCTL_OFF))[u] = 0u;
    __syncthreads();
    (void)xcd_barrier_post((unsigned*)((gu32*)(ws + WS_CTL) + CW_BAR), MISC + 8);
#define MKBAR() XcdBarrier bar; bar.bar = (unsigned*)((gu32*)(ws + WS_CTL) + CW_BAR); bar.x = xb_xcc_id(); bar.st = MISC + 8;
#define IN(k) (KA.ph_lo <= (k) && (k) < KA.ph_hi)
#define SEAM(k) do { if ((k) + 1 < KA.ph_hi) { MKBAR(); xcd_barrier(bar); } } while (0)
#define REPS(k) (((DBL_MASK >> (k)) & 1u) ? 2 : 1)
#define SEAM2(k) do { if (rep_ + 1 < REPS(k)) { MKBAR(); xcd_barrier(bar); } else SEAM(k); } while (0)

    if (IN(0)) for (int rep_ = 0; rep_ < REPS(0); ++rep_) { p0_prologue(KA, lds, tid, lane, wave); __syncthreads(); s5_small(KA, lds, (int)blockIdx.x >> 3, ((int)blockIdx.x & 7) == 0, tid); s5_k_slice(KA, lds, (int)blockIdx.x >> 3, (int)blockIdx.x & 7, tid); SEAM2(0); }
    for (int xb_ = 0; xb_ < XBAR_N; ++xb_) { MKBAR(); xcd_barrier(bar); }
    if (IN(1)) for (int rep_ = 0; rep_ < REPS(1); ++rep_) { norm_phase<true>(KA, lds, KA.in[0], xs_off, KA.in[9], ADA, 0, 1, tid, lane, wave); __syncthreads(); s5_small(KA, lds, (int)blockIdx.x >> 3, false, tid); s5_expand(KA, lds, (int)blockIdx.x >> 3, (int)blockIdx.x & 7, tid); SEAM2(1); }
    if (IN(2)) for (int rep_ = 0; rep_ < REPS(2); ++rep_) { pg8::Gemm g{H, (const bf16*)(ws + WS_WIN), NTOK, INW, 1024, 1024, 1024}; pg8::StaticOrder S; S.init(NTOK, INW, G, (int)blockIdx.x);
        EpiZU E{(bf16*)(ws + WS_Z), (bf16*)(ws + WS_UH)};
        pg8::gemm_phase<EpiZU, pg8::StaticOrder, true, true>(lds, g, S, E); SEAM2(2); }
    if (IN(3)) for (int rep_ = 0; rep_ < REPS(3); ++rep_) {
        if ((int)blockIdx.x < 64) { pg8::Gemm g{(const bf16*)(ws + WS_UH), (const bf16*)(ws + WS_WE), 16384, 8192, 256, 512, 512}; GroupOrder S{(int)blockIdx.x, 64};
            EpiF32 E{(float*)(ws + WS_EBUF)};
            pg8::gemm_phase<EpiF32, GroupOrder, true, true>(lds, g, S, E);
            { int task_ = (int)blockIdx.x; asm volatile("" : "+s"(task_)); gla_a_task(KA, lds, task_, tid, lane, wave); } }
        else { for (int task = (int)blockIdx.x; task < 512; task += 192) gla_a_task(KA, lds, task, tid, lane, wave); }
        SEAM2(3); }
    if (IN(4)) for (int rep_ = 0; rep_ < REPS(4); ++rep_) {
        if ((int)blockIdx.x < 64) { s5_recur(KA, lds, (int)blockIdx.x >> 1, (int)blockIdx.x & 1, tid);
            pg8::Gemm g{(const bf16*)(ws + WS_UH), (const bf16*)(ws + WS_WY), 16384, 8192, 512, 512, 512}; GroupOrder S{(int)blockIdx.x, 64};
            EpiS5Y E{(bf16*)(ws + WS_G)};
            pg8::gemm_phase<EpiS5Y, GroupOrder, true, true>(lds, g, S, E); }
        else gla_b_phase(KA, ((int)blockIdx.x - 64) * 512 + tid, 192 * 512);
        SEAM2(4); }
    if (IN(5)) for (int rep_ = 0; rep_ < REPS(5); ++rep_) {
        if ((int)blockIdx.x < 64) { pg8::Gemm g{(const bf16*)(ws + WS_G), (const bf16*)(ws + WS_WGLU), NTOK, 512, 512, 512, 512}; pg8::StaticOrder S; S.init(NTOK, 512, 64, (int)blockIdx.x);
            pg8::EpiGlu E{(const bf16*)(ws + WS_G), (bf16*)(ws + WS_MIX), KA.in[26]};
            pg8::gemm_phase<pg8::EpiGlu, pg8::StaticOrder, true, true>(lds, g, S, E);
            { int task_ = (int)blockIdx.x; asm volatile("" : "+s"(task_)); gla_c_task(KA, lds, task_, tid, lane, wave); } }
        else { for (int task = (int)blockIdx.x; task < 512; task += 192) gla_c_task(KA, lds, task, tid, lane, wave); }
        SEAM2(5); }
    if (IN(6)) for (int rep_ = 0; rep_ < REPS(6); ++rep_) { pg8::Gemm g{(const bf16*)(ws + WS_MIX), (const bf16*)(ws + WS_WOUT), NTOK, 1024, 1024, 1024, 1024}; pg8::StaticOrder S; S.init(NTOK, 1024, G, (int)blockIdx.x);
        pg8::EpiResid E{KA.in[0], xs_off, Y, ADA + 2 * 1024};
        pg8::gemm_phase<pg8::EpiResid, pg8::StaticOrder, true, true>(lds, g, S, E); SEAM2(6); }
    if (IN(7)) for (int rep_ = 0; rep_ < REPS(7); ++rep_) { norm_phase<false>(KA, lds, Y, Y, KA.in[10], ADA, 3, 4, tid, lane, wave); SEAM2(7); }
    if (IN(8)) for (int rep_ = 0; rep_ < REPS(8); ++rep_) { pg8::Gemm g{H, (const bf16*)(ws + WS_W1), NTOK, FF, 1024, 1024, 1024}; pg8::StaticOrder S; S.init(NTOK, FF, G, (int)blockIdx.x);
        pg8::EpiBf16<2> E{(bf16*)(ws + WS_ACT), FF};
        pg8::gemm_phase<pg8::EpiBf16<2>, pg8::StaticOrder, true, true>(lds, g, S, E); SEAM2(8); }
    if (IN(9)) for (int rep_ = 0; rep_ < REPS(9); ++rep_) { const int bx = blockIdx.x, kh = (bx >> 3) & 1, jx = bx >> 4;
        pg8::Gemm g{(const bf16*)(ws + WS_ACT) + kh * 2048, (const bf16*)(ws + WS_W2) + kh * 2048, NTOK, 1024, 2048, FF, FF}; SplitKOrder S{4 * (bx & 7) + (jx >> 2), jx & 3};
        MKBAR(); EpiResidSplit E{Y, Y, ADA + 5 * 1024, (float*)(ws + WS_XBUF), bar, kh};
        pg8::gemm_phase<EpiResidSplit, SplitKOrder, false, true>(lds, g, S, E); SEAM2(9); }
    if (IN(10)) for (int rep_ = 0; rep_ < REPS(10); ++rep_) { norm_phase<false>(KA, lds, Y, Y, KA.in[9] + 1024, ADA1, 0, 1, tid, lane, wave); SEAM2(10); }
    if (IN(11)) for (int rep_ = 0; rep_ < REPS(11); ++rep_) { pg8::Gemm g{H, (const bf16*)(ws + WS_WQKV), NTOK, QKVW, 1024, 1024, 1024}; pg8::StaticOrder S; S.init(NTOK, QKVW, G, (int)blockIdx.x);
        pg8::EpiBf16<0> E{(bf16*)(ws + WS_QKV), QKVW};
        pg8::gemm_phase<pg8::EpiBf16<0>, pg8::StaticOrder, true, true>(lds, g, S, E); SEAM2(11); }
    if (IN(12)) for (int rep_ = 0; rep_ < REPS(12); ++rep_) { qk_phase(KA, lane, blockIdx.x * NWAVES + wave, G * NWAVES); SEAM2(12); }
    if (IN(13)) for (int rep_ = 0; rep_ < REPS(13); ++rep_) {
        const att::bf16* QN = (const att::bf16*)(ws + WS_QN); att::bf16* OB = (att::bf16*)(ws + WS_OB);
        for (int u = blockIdx.x; u < 256; u += G) {
            if (u < 128) { const int b = u >> 5, hq = (u >> 2) & 7, qb = u & 3; const size_t qrow = (size_t)NPR + b * 1024 + qb * 256;
                att::attn_dense_body<att::bf16>(QN + qrow * 1024 + hq * 128, (const att::bf16*)(ws + WS_KS) + (size_t)b * 1536 * 256 + (hq >> 2) * 128, (const att::bf16*)(ws + WS_VS) + (size_t)b * 1536 * 256 + (hq >> 2) * 128,
                                                OB + qrow * 1024 + hq * 128, 1536, (char*)lds_raw); }
            else { const int v = u - 128, b = v >> 3, hq = v & 7; const size_t qrow = (size_t)b * 256;
                att::attn_dense_body<att::bf16>(QN + qrow * 1024 + hq * 128, (const att::bf16*)(ws + WS_KP) + qrow * 256 + (hq >> 2) * 128, (const att::bf16*)(ws + WS_VP) + qrow * 256 + (hq >> 2) * 128,
                                                OB + qrow * 1024 + hq * 128, 256, (char*)lds_raw); }
            __syncthreads();
        }
        SEAM2(13); }
    if (IN(14)) for (int rep_ = 0; rep_ < REPS(14); ++rep_) { pg8::Gemm g{(const bf16*)(ws + WS_OB), (const bf16*)(ws + WS_WO), NTOK, 1024, 1024, 1024, 1024}; pg8::StaticOrder S; S.init(NTOK, 1024, G, (int)blockIdx.x);
        pg8::EpiResid E{Y, Y, Y, ADA1 + 2 * 1024};
        pg8::gemm_phase<pg8::EpiResid, pg8::StaticOrder, true, true>(lds, g, S, E); SEAM2(14); }
    if (IN(15)) for (int rep_ = 0; rep_ < REPS(15); ++rep_) { norm_phase<false>(KA, lds, Y, Y, KA.in[10] + 1024, ADA1, 3, 4, tid, lane, wave); SEAM2(15); }
    if (IN(16)) for (int rep_ = 0; rep_ < REPS(16); ++rep_) { pg8::Gemm g{H, (const bf16*)(ws + WS_W1) + (size_t)4096 * 1024, NTOK, FF, 1024, 1024, 1024}; pg8::StaticOrder S; S.init(NTOK, FF, G, (int)blockIdx.x);
        pg8::EpiBf16<2> E{(bf16*)(ws + WS_ACT), FF};
        pg8::gemm_phase<pg8::EpiBf16<2>, pg8::StaticOrder, true, true>(lds, g, S, E); SEAM2(16); }
    if (IN(17)) for (int rep_ = 0; rep_ < REPS(17); ++rep_) { const int bx = blockIdx.x, kh = (bx >> 3) & 1, jx = bx >> 4;
        pg8::Gemm g{(const bf16*)(ws + WS_ACT) + kh * 2048, (const bf16*)(ws + WS_W2) + (size_t)1024 * 4096 + kh * 2048, NTOK, 1024, 2048, FF, FF}; SplitKOrder S{4 * (bx & 7) + (jx >> 2), jx & 3};
        MKBAR(); EpiResidSplit E{Y, KA.out + OUT_Y, ADA1 + 5 * 1024, (float*)(ws + WS_XBUF), bar, kh};
        pg8::gemm_phase<EpiResidSplit, SplitKOrder, false, true>(lds, g, S, E); SEAM2(17); }
#undef IN
#undef SEAM
#undef lds
#undef MISC
#undef tid
#undef lane
#undef wave
#undef G
#undef ws
#undef ADA
#undef H
#undef Y
#undef xs_off
#undef ADA1
}
constexpr int N_PHASES = 18;

#ifndef MK_ONE_LAUNCH
#define MK_ONE_LAUNCH 1
#endif
extern "C" void kernel_launch(void* const* d_in, const int* in_sizes, int n_in, void* d_out, int out_size, void* d_ws, size_t ws_size, hipStream_t stream) {
    static int grid = 0;
    if (grid == 0) {
        if (n_in != 34 || out_size != (int)OUT_END || ws_size < WS_END) { fprintf(stderr, "kernel_launch: unexpected shapes: n_in %d out %d ws %zu\n", n_in, out_size, ws_size); grid = -1; return; }
        int dev = 0, cus = 0, per_cu = 0;
        if (hipGetDevice(&dev) != hipSuccess || hipDeviceGetAttribute(&cus, hipDeviceAttributeMultiprocessorCount, dev) != hipSuccess) { grid = -1; return; }
        if (hipFuncSetAttribute((const void*)fwd_kernel, hipFuncAttributeMaxDynamicSharedMemorySize, LDS_BYTES) != hipSuccess) { fprintf(stderr, "kernel_launch: hipFuncSetAttribute failed\n"); grid = -1; return; }
        if (hipOccupancyMaxActiveBlocksPerMultiprocessor(&per_cu, (const void*)fwd_kernel, NWAVES * 64, LDS_BYTES) != hipSuccess || per_cu < 1) { fprintf(stderr, "kernel_launch: occupancy query says %d blocks per CU\n", per_cu); }
        (void)hipGetLastError();
        grid = cus < 256 ? cus : 256;
        if (grid != 256) { fprintf(stderr, "kernel_launch: this kernel needs a 256-CU device (one workgroup per CU); found %d\n", cus); grid = -1; return; }
    }
    if (grid < 0) return;
    (void)hipMemsetAsync((char*)d_ws + WS_CTL, 0, CTL_ZERO_BYTES, stream);
    Args a{};
    for (int i = 0; i < 34; ++i) a.in[i] = (const float*)d_in[i];
    a.out = (float*)d_out; a.ws = (unsigned char*)d_ws;
#if MK_ONE_LAUNCH
    a.ph_lo = 0; a.ph_hi = N_PHASES;
    hipLaunchKernelGGL(fwd_kernel, dim3(grid), dim3(NWAVES * 64), LDS_BYTES, stream, a);
#else
    for (int p = 0; p < N_PHASES; ++p) { a.ph_lo = p; a.ph_hi = p + 1; hipLaunchKernelGGL(fwd_kernel, dim3(grid), dim3(NWAVES * 64), LDS_BYTES, stream, a); }
#endif
    const hipError_t le = hipPeekAtLastError();
    if (le != hipSuccess) fprintf(stderr, "kernel_launch: launch failed: %s\n", hipGetErrorName(le));
}
```

```cpp
#include <hip/hip_runtime.h>
#include <hip/hip_bf16.h>
#include <cstdio>
#include <cstdint>
#include <cmath>
namespace pg8 {
#define PG8_LAS __attribute__((address_space(3)))
typedef unsigned short bf16_t;
typedef short bf16x8 __attribute__((ext_vector_type(8)));
typedef float f32x4 __attribute__((ext_vector_type(4)));
typedef unsigned u32x4 __attribute__((ext_vector_type(4)));
constexpr int BM = 256, BK = 64, HALF = 128, HTB = HALF * BK * 2  , STAGE_BYTES = 8 * HTB, NXCD = 8, WGM = 8;

__host__ __device__ __forceinline__ int lds_byte(int r, int c) { const int st = (r >> 4) * 2 + (c >> 5), rr = r & 15, cc = c & 31, ob = rr * 64 + cc * 2; return st * 1024 + (ob ^ (((ob >> 9) & 1) << 5)); }
__host__ __device__ __forceinline__ void stage_rc(int b, int& R, int& C) { const int st = b / 1024, sb = b % 1024, swz = sb ^ (((sb >> 9) & 1) << 5); R = (st >> 1) * 16 + swz / 64; C = (st & 1) * 32 + (swz % 64) / 2; }
__host__ __device__ __forceinline__ int perm32(int rho) { const int n = rho >> 4, i = rho & 15; return 8 * (i >> 2) + 4 * n + (i & 3); }

struct Unit { int pm, pn; };
struct Gemm { const bf16_t* A; const bf16_t* Bt; int M, N, K, lda, ldb; };

struct StaticOrder {
    int nM, nN, nwg, G, c;
    __host__ __device__ void init(int M, int N, int G_, int c_) { nM = M / BM; nN = N / BM; nwg = nM * nN; G = G_; c = c_; }
    __host__ __device__ bool next(int i, Unit& u) const {
        const long L = (long)i * G + c; if (L >= nwg) return false;
        int wgid = (int)L; { const int q = nwg / NXCD, r = nwg % NXCD, xcd = wgid % NXCD, off = wgid / NXCD; wgid = (xcd < r ? xcd * (q + 1) : r * (q + 1) + (xcd - r) * q) + off; }
        const int nig = WGM * nN, gid = wgid / nig, fm = gid * WGM, gsz = (nM - fm) < WGM ? (nM - fm) : WGM;
        u.pm = fm + ((wgid % nig) % gsz); u.pn = (wgid % nig) / gsz; return true;
    }
    __device__ __forceinline__ void a_ready(const Unit&) const {}
    __device__ __forceinline__ void done(const Unit&) const {}
};

__device__ __forceinline__ unsigned cvt_pk_bf16(float lo, float hi) { unsigned r; asm volatile("v_cvt_pk_bf16_f32 %0, %1, %2" : "=v"(r) : "v"(lo), "v"(hi)); return r; }
typedef float f32x2 __attribute__((ext_vector_type(2)));
template <int ACT  , bool NORM = false> struct EpiBf16 {
    static constexpr bool PERM = true, AFTER_DRAIN = false;
    bf16_t* O; int ldc; const float* rsw; const float* cv; int ncv;
    __device__ __forceinline__ void operator()(const f32x4 (&acc)[2][2][4][2], const Unit& u, int wr, int wc, int fr, int fq) const {
        const int row0 = u.pm * BM + wr * 64 + fr; const int col0 = u.pn * BM + wc * 32 + 8 * fq;
        f32x4 cvv[2][2];
        if (NORM) { const int cond = u.pm < 16 ? 0 : 1 + ((u.pm - 16) >> 2);
#pragma unroll
            for (int bj = 0; bj < 2; ++bj)
#pragma unroll
                for (int n = 0; n < 2; ++n) cvv[bj][n] = *(const f32x4*)(cv + (size_t)cond * ncv + col0 + bj * HALF + 4 * n); }
#pragma unroll
        for (int ai = 0; ai < 2; ++ai)
#pragma unroll
            for (int m = 0; m < 4; ++m) { const int row = row0 + ai * HALF + m * 16; bf16_t* rowp = O + (size_t)row * ldc + col0;
                float rstd = 1.f;
                if (NORM) { const f32x4* rp = (const f32x4*)(rsw + (size_t)row * 16); const f32x4 s4 = (rp[0] + rp[1]) + (rp[2] + rp[3]); rstd = 1.0f / sqrtf(((s4[0] + s4[1]) + (s4[2] + s4[3])) * (1.f / 1024.f) + 1e-6f); }
#pragma unroll
                for (int bj = 0; bj < 2; ++bj) { f32x4 v0 = acc[ai][bj][m][0], v1 = acc[ai][bj][m][1];
                    if (NORM) { v0 = v0 * rstd + cvv[bj][0]; v1 = v1 * rstd + cvv[bj][1]; }
                    if (ACT == 2) {
#pragma unroll
                        for (int e = 0; e < 4; ++e) { float a = v0[e] > 0.f ? v0[e] : 0.f; v0[e] = a * a; float b = v1[e] > 0.f ? v1[e] : 0.f; v1[e] = b * b; } }
                    u32x4 w; w.x = cvt_pk_bf16(v0[0], v0[1]); w.y = cvt_pk_bf16(v0[2], v0[3]); w.z = cvt_pk_bf16(v1[0], v1[1]); w.w = cvt_pk_bf16(v1[2], v1[3]);
                    *(u32x4*)(rowp + bj * HALF) = w; } }
    }
};
template <bool NEXT> struct EpiResidT {
    static constexpr bool PERM = false, AFTER_DRAIN = false;
    const float* base_p; const float* base_s; float* out; const float* gate;
    bf16_t* Hn; const float* nw; const float* nsc; float* rsw;
    __device__ __forceinline__ void operator()(const f32x4 (&acc)[2][2][4][2], const Unit& u, int wr, int wc, int fr, int fq) const {
        const int row0 = u.pm * BM + wr * 64 + fr; const int col0 = u.pn * BM + wc * 32 + 4 * fq;
        const int cond = u.pm < 16 ? 0 : 1 + ((u.pm - 16) >> 2);
        const float* gp = gate + cond * 6144; const float* bp = u.pm < 16 ? base_p : base_s;
        f32x4 gv[2][2];
#pragma unroll
        for (int bj = 0; bj < 2; ++bj)
#pragma unroll
            for (int n = 0; n < 2; ++n) gv[bj][n] = *(const f32x4*)(gp + col0 + bj * HALF + n * 16);
        f32x4 (&y)[2][2][4][2] = const_cast<f32x4 (&)[2][2][4][2]>(acc);
#pragma unroll
        for (int ai = 0; ai < 2; ++ai)
#pragma unroll
            for (int m = 0; m < 4; ++m) { const size_t off = (size_t)(row0 + ai * HALF + m * 16) * 1024 + col0;
#pragma unroll
                for (int bj = 0; bj < 2; ++bj)
#pragma unroll
                    for (int n = 0; n < 2; ++n) { const f32x4 b = *(const f32x4*)(bp + off + bj * HALF + n * 16); const f32x4 yy = b + gv[bj][n] * acc[ai][bj][m][n];
                        *(f32x4*)(out + off + bj * HALF + n * 16) = yy; if (NEXT) y[ai][bj][m][n] = yy; } }
        if (NEXT) {
            asm volatile("" ::: "memory");
            f32x4 av[2][2];
#pragma unroll
            for (int bj = 0; bj < 2; ++bj)
#pragma unroll
                for (int n = 0; n < 2; ++n) av[bj][n] = *(const f32x4*)(nw + col0 + bj * HALF + n * 16) * (*(const f32x4*)(nsc + cond * 6144 + col0 + bj * HALF + n * 16) + 1.0f);
#pragma unroll
            for (int ai = 0; ai < 2; ++ai)
#pragma unroll
                for (int m = 0; m < 4; ++m) { const int row = row0 + ai * HALF + m * 16; const size_t off = (size_t)row * 1024 + col0; float ss = 0.f;
#pragma unroll
                    for (int bj = 0; bj < 2; ++bj)
#pragma unroll
                        for (int n = 0; n < 2; ++n) { const f32x4 yy = y[ai][bj][m][n]; ss += (yy[0] * yy[0] + yy[1] * yy[1]) + (yy[2] * yy[2] + yy[3] * yy[3]); const f32x4 h = yy * av[bj][n];
                            typedef unsigned u32x2 __attribute__((ext_vector_type(2))); u32x2 w; w.x = cvt_pk_bf16(h[0], h[1]); w.y = cvt_pk_bf16(h[2], h[3]); *(u32x2*)(Hn + off + bj * HALF + n * 16) = w; }
                    ss += __shfl_xor(ss, 16); ss += __shfl_xor(ss, 32); if (fq == 0) rsw[(size_t)row * 16 + u.pn * 4 + wc] = ss; }
        }
    }
};
typedef EpiResidT<false> EpiResid;
struct EpiGlu {
    static constexpr bool PERM = true, AFTER_DRAIN = false;
    const bf16_t* G; bf16_t* O; const float* bias;
    __device__ __forceinline__ void operator()(const f32x4 (&acc)[2][2][4][2], const Unit& u, int wr, int wc, int fr, int fq) const {
        const int row0 = u.pm * BM + wr * 64 + fr; const int col0 = u.pn * BM + wc * 32 + 8 * fq;
        f32x4 bv[2][2];
#pragma unroll
        for (int bj = 0; bj < 2; ++bj)
#pragma unroll
            for (int n = 0; n < 2; ++n) bv[bj][n] = *(const f32x4*)(bias + col0 + bj * HALF + 4 * n);
#pragma unroll
        for (int ai = 0; ai < 2; ++ai)
#pragma unroll
            for (int m = 0; m < 4; ++m) { const size_t row = (size_t)(row0 + ai * HALF + m * 16);
#pragma unroll
                for (int bj = 0; bj < 2; ++bj) { f32x4 v0 = acc[ai][bj][m][0] + bv[bj][0], v1 = acc[ai][bj][m][1] + bv[bj][1];
                    const u32x4 gw = *(const u32x4*)(G + row * 512 + col0 + bj * HALF);
                    float gf[8];
#pragma unroll
                    for (int e = 0; e < 4; ++e) { gf[2 * e] = __uint_as_float(gw[e] << 16); gf[2 * e + 1] = __uint_as_float(gw[e] & 0xffff0000u); }
                    float o[8];
#pragma unroll
                    for (int e = 0; e < 4; ++e) { o[e] = gf[e] / (1.f + __expf(-v0[e])); o[4 + e] = gf[4 + e] / (1.f + __expf(-v1[e])); }
                    u32x4 w; w.x = cvt_pk_bf16(o[0], o[1]); w.y = cvt_pk_bf16(o[2], o[3]); w.z = cvt_pk_bf16(o[4], o[5]); w.w = cvt_pk_bf16(o[6], o[7]);
                    *(u32x4*)(O + row * 1024 + col0 + bj * HALF) = w; } }
    }
};

template <class Epi, class Sched, bool ALIGN_EPI = false, bool SP2 = false>
__device__ __forceinline__ void gemm_phase(PG8_LAS unsigned char* lds, const Gemm g, const Sched& S, const Epi& E) {
    int tid_ = threadIdx.x; asm volatile("" : "+v"(tid_));
    const int tid = tid_, wid = __builtin_amdgcn_readfirstlane(tid >> 6), lane = tid & 63, wr = wid >> 2, wc = wid & 3, fr = lane & 15, fq = lane >> 4;
    const int K = g.K, nt = K / BK, LDA_ = g.lda, LDB_ = g.ldb;
    unsigned voffA[2], voffB[2];
#pragma unroll
    for (int i = 0; i < 2; ++i) { int R, C; stage_rc(tid * 16 + i * 8192, R, C); const int Rb = Epi::PERM ? ((R & ~31) + perm32(R & 31)) : R;
        voffA[i] = (unsigned)(R * LDA_ + C) * 2u; voffB[i] = (unsigned)(Rb * LDB_ + C) * 2u; }
    const size_t kstep = (size_t)(BK * 2);
    const size_t hstepA = (size_t)HALF * LDA_ * 2, hstepB = (size_t)HALF * LDB_ * 2;
    const size_t tstepA = 2 * hstepA, tstepB = 2 * hstepB;
    const unsigned ldsw = (unsigned)wid * 1024u;
    const int aoff = lds_byte(wr * 64 + fr, fq * 8), boff = lds_byte(wc * 32 + fr, fq * 8);
#define PG8_SA(b, h) (((b) * 2 + (h)) * HTB)
#define PG8_SB(b, h) ((4 + (b) * 2 + (h)) * HTB)
#define PG8_STAGE(bufoff, gbase, voff) do { _Pragma("unroll") for (int _i = 0; _i < 2; ++_i) \
        __builtin_amdgcn_global_load_lds((const unsigned*)((const char*)(gbase) + (voff)[_i]), (PG8_LAS unsigned*)(lds + (bufoff) + ldsw + _i * 8192), 16, 0, 0); } while (0)
#define PG8_LDA(dst, b, h) do { _Pragma("unroll") for (int m = 0; m < 4; ++m) _Pragma("unroll") for (int k = 0; k < 2; ++k) dst[m][k] = *(const PG8_LAS bf16x8*)(lds + PG8_SA(b, h) + aoff + m * 2048 + k * 1024); } while (0)
#define PG8_LDB(dst, b, h) do { _Pragma("unroll") for (int n = 0; n < 2; ++n) _Pragma("unroll") for (int k = 0; k < 2; ++k) dst[n][k] = *(const PG8_LAS bf16x8*)(lds + PG8_SB(b, h) + boff + n * 2048 + k * 1024); } while (0)
#define PG8_MMA(ai, bj, At, Bt) do { __builtin_amdgcn_s_setprio(1); _Pragma("unroll") for (int m = 0; m < 4; ++m) _Pragma("unroll") for (int n = 0; n < 2; ++n) _Pragma("unroll") for (int k = 0; k < 2; ++k) \
        acc[ai][bj][m][n] = __builtin_amdgcn_mfma_f32_16x16x32_bf16(Bt[n][k], At[m][k], acc[ai][bj][m][n], 0, 0, 0); __builtin_amdgcn_s_setprio(0); } while (0)
#define PG8_WAIT_V(n) asm volatile("s_waitcnt vmcnt(" #n ")" ::: "memory")
#define PG8_WAIT_L(n) asm volatile("s_waitcnt lgkmcnt(" #n ")" ::: "memory")
#define PG8_BAR __builtin_amdgcn_s_barrier()
#define PG8_SCHED __builtin_amdgcn_sched_barrier(0)
    Unit cur, nxt; int ui = 0;
    if (!S.next(0, cur)) return;
    f32x4 acc[2][2][4][2];
#pragma unroll
    for (int a = 0; a < 2; ++a)
#pragma unroll
        for (int b = 0; b < 2; ++b)
#pragma unroll
            for (int m = 0; m < 4; ++m)
#pragma unroll
                for (int n = 0; n < 2; ++n) acc[a][b][m][n] = (f32x4){0.f, 0.f, 0.f, 0.f};
    bf16x8 At[4][2], B0[2][2], B1[2][2];
    const char* cA = (const char*)g.A + (size_t)cur.pm * tstepA; const char* cB = (const char*)g.Bt + (size_t)cur.pn * tstepB;
    S.a_ready(cur);
    if constexpr (SP2) {
        PG8_STAGE(PG8_SB(0, 0), cB, voffB); PG8_STAGE(PG8_SB(0, 1), cB + hstepB, voffB); PG8_STAGE(PG8_SA(0, 0), cA, voffA); PG8_STAGE(PG8_SA(0, 1), cA + hstepA, voffA);
        if (wr == 1) PG8_BAR;
        PG8_WAIT_V(2); PG8_BAR;
        PG8_STAGE(PG8_SB(1, 0), cB + kstep, voffB); PG8_STAGE(PG8_SA(1, 0), cA + kstep, voffA); PG8_STAGE(PG8_SB(1, 1), cB + hstepB + kstep, voffB);
        PG8_WAIT_V(6); PG8_BAR;
    } else {
        PG8_STAGE(PG8_SB(0, 0), cB, voffB); PG8_STAGE(PG8_SA(0, 0), cA, voffA); PG8_STAGE(PG8_SB(0, 1), cB + hstepB, voffB); PG8_STAGE(PG8_SA(0, 1), cA + hstepA, voffA);
        if (wr == 1) PG8_BAR;
        PG8_WAIT_V(4); PG8_BAR;
        PG8_STAGE(PG8_SB(1, 0), cB + kstep, voffB); PG8_STAGE(PG8_SA(1, 0), cA + kstep, voffA); PG8_STAGE(PG8_SB(1, 1), cB + hstepB + kstep, voffB);
        PG8_WAIT_V(6); PG8_BAR;
    }
    for (;;) {
        const bool has_next = S.next(ui + 1, nxt);
        const char* nA = has_next ? (const char*)g.A + (size_t)nxt.pm * tstepA : cA; const char* nB = has_next ? (const char*)g.Bt + (size_t)nxt.pn * tstepB : cB;
        for (int t = 0; t < nt; t += 2) {
            const bool last = (t == nt - 2);
            const char* a1 = cA + (size_t)(t + 1) * kstep;
            const char* a2 = last ? nA : cA + (size_t)(t + 2) * kstep; const char* b2 = last ? nB : cB + (size_t)(t + 2) * kstep;
            const char* a3 = a2 + kstep; const char* b3 = b2 + kstep;
            if (last && has_next) S.a_ready(nxt);
            if constexpr (SP2) {
            PG8_LDB(B0, 0, 0); PG8_LDB(B1, 0, 1); PG8_SCHED; PG8_LDA(At, 0, 0); PG8_STAGE(PG8_SA(1, 1), a1 + hstepA, voffA);
            PG8_WAIT_V(8); PG8_WAIT_L(0); PG8_BAR; PG8_MMA(0, 0, At, B0); PG8_MMA(0, 1, At, B1); PG8_BAR; PG8_SCHED;
            PG8_LDA(At, 0, 1); PG8_STAGE(PG8_SB(0, 0), b2, voffB); PG8_STAGE(PG8_SB(0, 1), b2 + hstepB, voffB); PG8_STAGE(PG8_SA(0, 0), a2, voffA);
            PG8_WAIT_V(8); PG8_WAIT_L(0); PG8_BAR; PG8_MMA(1, 0, At, B0); PG8_MMA(1, 1, At, B1); PG8_BAR; PG8_SCHED;
            PG8_LDB(B0, 1, 0); PG8_LDB(B1, 1, 1); PG8_SCHED; PG8_LDA(At, 1, 0); PG8_STAGE(PG8_SA(0, 1), a2 + hstepA, voffA);
            PG8_WAIT_V(8); PG8_WAIT_L(0); PG8_BAR; PG8_MMA(0, 0, At, B0); PG8_MMA(0, 1, At, B1); PG8_BAR; PG8_SCHED;
            PG8_LDA(At, 1, 1); PG8_STAGE(PG8_SB(1, 0), b3, voffB); PG8_STAGE(PG8_SB(1, 1), b3 + hstepB, voffB); PG8_STAGE(PG8_SA(1, 0), a3, voffA);
            PG8_WAIT_V(8); PG8_WAIT_L(0); PG8_BAR; PG8_MMA(1, 0, At, B0); PG8_MMA(1, 1, At, B1); PG8_BAR; PG8_SCHED;
            } else {
            PG8_LDB(B0, 0, 0); PG8_SCHED; PG8_LDA(At, 0, 0); PG8_STAGE(PG8_SA(1, 1), a1 + hstepA, voffA);
            PG8_WAIT_L(8); PG8_BAR; PG8_WAIT_L(0); PG8_MMA(0, 0, At, B0); PG8_BAR; PG8_SCHED;
            PG8_LDB(B1, 0, 1); PG8_STAGE(PG8_SB(0, 0), b2, voffB);
            PG8_BAR; PG8_WAIT_L(0); PG8_MMA(0, 1, At, B1); PG8_BAR;
            PG8_LDA(At, 0, 1); PG8_STAGE(PG8_SA(0, 0), a2, voffA);
            PG8_BAR; PG8_WAIT_L(0); PG8_MMA(1, 0, At, B0); PG8_BAR; PG8_SCHED;
            PG8_STAGE(PG8_SB(0, 1), b2 + hstepB, voffB);
            PG8_WAIT_V(6); PG8_BAR; PG8_MMA(1, 1, At, B1); PG8_BAR;
            PG8_LDB(B0, 1, 0); PG8_SCHED; PG8_LDA(At, 1, 0); PG8_STAGE(PG8_SA(0, 1), a2 + hstepA, voffA);
            PG8_WAIT_L(8); PG8_BAR; PG8_WAIT_L(0); PG8_MMA(0, 0, At, B0); PG8_BAR; PG8_SCHED;
            PG8_LDB(B1, 1, 1); PG8_STAGE(PG8_SB(1, 0), b3, voffB);
            PG8_BAR; PG8_WAIT_L(0); PG8_MMA(0, 1, At, B1); PG8_BAR;
            PG8_LDA(At, 1, 1); PG8_STAGE(PG8_SA(1, 0), a3, voffA);
            PG8_BAR; PG8_WAIT_L(0); PG8_MMA(1, 0, At, B0); PG8_BAR; PG8_SCHED;
            PG8_STAGE(PG8_SB(1, 1), b3 + hstepB, voffB);
            PG8_WAIT_V(6); PG8_BAR; PG8_MMA(1, 1, At, B1); PG8_BAR;
            }
        }
        if constexpr (ALIGN_EPI) { if (wr == 0) PG8_BAR; }
        if constexpr (!Epi::AFTER_DRAIN) { E(acc, cur, wr, wc, fr, fq); S.done(cur); }
        if (!has_next) break;
#pragma unroll
        for (int a = 0; a < 2; ++a)
#pragma unroll
            for (int b = 0; b < 2; ++b)
#pragma unroll
                for (int m = 0; m < 4; ++m)
#pragma unroll
                    for (int n = 0; n < 2; ++n) acc[a][b][m][n] = (f32x4){0.f, 0.f, 0.f, 0.f};
        cur = nxt; cA = nA; cB = nB; ++ui;
        if constexpr (ALIGN_EPI) { if (wr == 1) PG8_BAR; }
    }
    PG8_WAIT_V(0);
    if constexpr (!ALIGN_EPI) { if (wr == 0) PG8_BAR; }
    PG8_BAR;
    if constexpr (Epi::AFTER_DRAIN) { E.fused(acc, cur, wr, wc, fr, fq, lds, wid, lane); S.done(cur); }
#undef PG8_SA
#undef PG8_SB
#undef PG8_STAGE
#undef PG8_LDA
#undef PG8_LDB
#undef PG8_MMA
#undef PG8_WAIT_V
#undef PG8_WAIT_L
#undef PG8_BAR
#undef PG8_SCHED
}
}

namespace att {
using bf16 = __hip_bfloat16;
constexpr int D = 128, NW = 8, QBLK = 32, KVBLK = 64; constexpr float SCALE = 0.088388347648318440f; constexpr float THR = 8.f; constexpr int SDEPTH = 2;
constexpr int LDQ = 1024, LDK = 256, LDO = 1024;
constexpr size_t SHM_V = KVBLK * D * 2, SHM_K = KVBLK * D * 2, SHM_ATTN = 2 * SHM_V + 2 * SHM_K + NW * 64 * 4;
using bf16x8 = __attribute__((ext_vector_type(8))) short;
using s16x4  = __attribute__((ext_vector_type(4))) short;
using f32x16 = __attribute__((ext_vector_type(16))) float;
using f32x8  = __attribute__((ext_vector_type(8))) float;
using u32x4  = __attribute__((ext_vector_type(4))) unsigned;
#define KSWZ(row, colB) ((row) * 256 + ((colB) ^ (((row) & 7) << 4)))
#define SBAR() __builtin_amdgcn_sched_barrier(0)
__device__ __forceinline__ int crow(int r, int hi) { return (r & 3) + 8 * (r >> 2) + 4 * hi; }
__device__ __forceinline__ unsigned cvtpk(float lo, float hi) {
  unsigned r; asm volatile("v_cvt_pk_bf16_f32 %0, %1, %2" : "=v"(r) : "v"(lo), "v"(hi)); return r;
}
template <typename TIn> struct Stage;
template <> struct Stage<bf16>  { using T = bf16x8;
  __device__ static __forceinline__ T ld8(const bf16* p) { return *reinterpret_cast<const bf16x8*>(p); }
  __device__ static __forceinline__ bf16x8 tobf(T x) { return x; } };
template <> struct Stage<float> { using T = f32x8;
  __device__ static __forceinline__ T ld8(const float* p) { return *reinterpret_cast<const f32x8*>(p); }
  __device__ static __forceinline__ bf16x8 tobf(T x) {
    u32x4 w = {cvtpk(x[0], x[1]), cvtpk(x[2], x[3]), cvtpk(x[4], x[5]), cvtpk(x[6], x[7])}; return *reinterpret_cast<bf16x8*>(&w); } };

__device__ __forceinline__ void partialSM(f32x16& p0, f32x16& p1, float& m_reg, float& mn, float& alpha) {
  constexpr float C = SCALE * 1.4426950408889634f;
  float pmax = p0[0]; for (int r = 1; r < 16; ++r) pmax = fmaxf(pmax, p0[r]); for (int r = 0; r < 16; ++r) pmax = fmaxf(pmax, p1[r]);
  { auto rr = __builtin_amdgcn_permlane32_swap(__float_as_uint(pmax), __float_as_uint(pmax), false, false);
    pmax = fmaxf(__uint_as_float(rr[0]), __uint_as_float(rr[1])); }
  if (__builtin_expect(__all(pmax - m_reg <= THR / SCALE), 1)) { mn = m_reg; alpha = 1.f; }
  else { mn = fmaxf(m_reg, pmax); alpha = __builtin_amdgcn_exp2f((m_reg - mn) * C); m_reg = mn; }
  float mnC = -mn * C;
  for (int r = 0; r < 16; ++r) p0[r] = fmaf(p0[r], C, mnC); for (int r = 0; r < 16; ++r) p1[r] = fmaf(p1[r], C, mnC);
  for (int r = 0; r < 16; ++r) p0[r] = __builtin_amdgcn_exp2f(p0[r]);
}
__device__ __forceinline__ void finishSM(f32x16& p0, f32x16& p1, float alpha, float& l_reg, bf16x8& pa0, bf16x8& pa1, bf16x8& pa2, bf16x8& pa3) {
  for (int r = 0; r < 16; ++r) p1[r] = __builtin_amdgcn_exp2f(p1[r]);
  float ps = 0; for (int r = 0; r < 16; ++r) ps += p0[r]; for (int r = 0; r < 16; ++r) ps += p1[r];
  { auto rr = __builtin_amdgcn_permlane32_swap(__float_as_uint(ps), __float_as_uint(ps), false, false);
    ps = __uint_as_float(rr[0]) + __uint_as_float(rr[1]); }
  l_reg = l_reg * alpha + ps;
#define PK4(P, BASE, OUT) do { unsigned a0 = cvtpk(P[BASE + 0], P[BASE + 1]), a1 = cvtpk(P[BASE + 2], P[BASE + 3]);   \
    unsigned b0 = cvtpk(P[BASE + 4], P[BASE + 5]), b1 = cvtpk(P[BASE + 6], P[BASE + 7]);                              \
    auto r0 = __builtin_amdgcn_permlane32_swap(a0, b0, false, false); auto r1 = __builtin_amdgcn_permlane32_swap(a1, b1, false, false); \
    u32x4 w = {r0[0], r1[0], r0[1], r1[1]}; OUT = *reinterpret_cast<bf16x8*>(&w); } while (0)
  PK4(p0, 0, pa0); PK4(p0, 8, pa1); PK4(p1, 0, pa2); PK4(p1, 8, pa3);
#undef PK4
}
__device__ __forceinline__ void qkt(f32x16& p0, f32x16& p1, const bf16* Ks, const bf16x8* qr, int r32, int hi) {
  p0 = f32x16{}; p1 = f32x16{};
  for (int d0 = 0; d0 < 8; ++d0) { int cb = (d0 * 16 + hi * 8) * 2;
    bf16x8 b0 = *reinterpret_cast<const bf16x8*>((const char*)Ks + KSWZ(r32, cb));
    bf16x8 b1 = *reinterpret_cast<const bf16x8*>((const char*)Ks + KSWZ(32 + r32, cb));
    p0 = __builtin_amdgcn_mfma_f32_32x32x16_bf16(b0, qr[d0], p0, 0, 0, 0);
    p1 = __builtin_amdgcn_mfma_f32_32x32x16_bf16(b1, qr[d0], p1, 0, 0, 0); }
}
__device__ __forceinline__ int v_st(int k, int c) { const int kk = (k & ~0xC) | ((k & 4) << 1) | ((k & 8) >> 1); return ((kk >> 3) * 4 + (c >> 5)) * 512 + ((kk & 7) * 32 + (c & 31)) * 2; }
__device__ __forceinline__ int v_rd_base(int lane) { return ((lane & 3) << 3) | (((lane >> 2) & 3) << 6) | (((lane >> 4) & 1) << 5) | (((lane >> 5) & 1) << 8); }
constexpr int v_rd_off(int d0, int ks, int half) { return d0 * 512 + ks * 4096 + half * 2048; }
template <int OFF> __device__ __forceinline__ s16x4 tr_read(int vb) {
  s16x4 r; asm volatile("ds_read_b64_tr_b16 %0, %1 offset:%2" : "=&v"(r) : "v"(vb), "i"(OFF) : "memory"); return r;
}
template <int D0> __device__ __forceinline__ void pv_one(f32x16& od, int vb, bf16x8 pa0, bf16x8 pa1, bf16x8 pa2, bf16x8 pa3) {
  const s16x4 l0 = tr_read<v_rd_off(D0, 0, 0)>(vb), h0 = tr_read<v_rd_off(D0, 0, 1)>(vb), l1 = tr_read<v_rd_off(D0, 1, 0)>(vb), h1 = tr_read<v_rd_off(D0, 1, 1)>(vb);
  const s16x4 l2 = tr_read<v_rd_off(D0, 2, 0)>(vb), h2 = tr_read<v_rd_off(D0, 2, 1)>(vb), l3 = tr_read<v_rd_off(D0, 3, 0)>(vb), h3 = tr_read<v_rd_off(D0, 3, 1)>(vb);
  asm volatile("s_waitcnt lgkmcnt(0)" ::: "memory"); SBAR();
#define PK(L, H) (bf16x8){L[0], L[1], L[2], L[3], H[0], H[1], H[2], H[3]}
  od = __builtin_amdgcn_mfma_f32_32x32x16_bf16(pa0, PK(l0, h0), od, 0, 0, 0);
  od = __builtin_amdgcn_mfma_f32_32x32x16_bf16(pa1, PK(l1, h1), od, 0, 0, 0);
  od = __builtin_amdgcn_mfma_f32_32x32x16_bf16(pa2, PK(l2, h2), od, 0, 0, 0);
  od = __builtin_amdgcn_mfma_f32_32x32x16_bf16(pa3, PK(l3, h3), od, 0, 0, 0);
#undef PK
}
__device__ __forceinline__ void pv_d0(f32x16* o, int vb, bf16x8 pa0, bf16x8 pa1, bf16x8 pa2, bf16x8 pa3) {
  pv_one<0>(o[0], vb, pa0, pa1, pa2, pa3); pv_one<1>(o[1], vb, pa0, pa1, pa2, pa3); pv_one<2>(o[2], vb, pa0, pa1, pa2, pa3); pv_one<3>(o[3], vb, pa0, pa1, pa2, pa3);
}

template <typename TQ>
__device__ __forceinline__ void attn_dense_body(const TQ* __restrict__ Qb, const bf16* __restrict__ Kh, const bf16* __restrict__ Vh,
                                                bf16* __restrict__ Ob, int seq, char* lds) {
  using St = Stage<bf16>; using SQ = Stage<TQ>;
  int tid_ = threadIdx.x; asm volatile("" : "+v"(tid_));
  const int tid = tid_, wid = tid >> 6, lane = tid & 63, r32 = lane & 31, hi = lane >> 5;
  bf16* V_lds = (bf16*)lds; bf16* K_lds = (bf16*)(lds + 2 * SHM_V);
  float* ws = (float*)(lds + 2 * SHM_V + 2 * SHM_K) + wid * 64; float* li_l = ws; float* al_l = ws + 32;
  float m_reg = -1e30f, l_reg = 0; f32x16 o[4] = {}; bf16x8 qr[8];
  const TQ* Qw = Qb + (long)(wid * QBLK + r32) * LDQ + hi * 8;
#pragma unroll
  for (int d0 = 0; d0 < 8; ++d0) qr[d0] = SQ::tobf(SQ::ld8(Qw + d0 * 16));
  const int sr = tid >> 4, sc = (tid & 15) * 8, vst0 = v_st(sr, sc), vst1 = v_st(32 + sr, sc);
  const int vb0 = (int)(uintptr_t)V_lds + v_rd_base(lane);
  struct { typename St::T vs0, vs1, ks0, ks1; } sr_[SDEPTH];
#define SLOAD(i, k0) do { sr_[i].vs0 = St::ld8(&Vh[(long)((k0) + sr) * LDK + sc]); sr_[i].vs1 = St::ld8(&Vh[(long)((k0) + 32 + sr) * LDK + sc]); \
    sr_[i].ks0 = St::ld8(&Kh[(long)((k0) + sr) * LDK + sc]); sr_[i].ks1 = St::ld8(&Kh[(long)((k0) + 32 + sr) * LDK + sc]); } while (0)
#define SWRITE(b, i) do { *(bf16x8*)((char*)V_lds + (b) * SHM_V + vst0) = St::tobf(sr_[i].vs0);          \
    *(bf16x8*)((char*)V_lds + (b) * SHM_V + vst1) = St::tobf(sr_[i].vs1); int kc = sc * 2;               \
    *(bf16x8*)((char*)K_lds + (b) * SHM_K + KSWZ(sr, kc)) = St::tobf(sr_[i].ks0);                       \
    *(bf16x8*)((char*)K_lds + (b) * SHM_K + KSWZ(32 + sr, kc)) = St::tobf(sr_[i].ks1); } while (0)
#define SWAIT() do { if constexpr (SDEPTH == 2) asm volatile("s_waitcnt vmcnt(4)" ::: "memory"); else asm volatile("s_waitcnt vmcnt(0)" ::: "memory"); } while (0)
#define RESC(a) do { if (__any((a) < 1.f)) { if (hi == 0) al_l[r32] = (a); asm volatile("s_waitcnt lgkmcnt(0)" ::: "memory"); \
    for (int d = 0; d < 4; ++d) for (int r = 0; r < 16; ++r) o[d][r] *= al_l[crow(r, hi)]; } } while (0)
  f32x16 pA0, pA1, pB0, pB1; float mnA, mnB, alA, alB; bf16x8 pa0, pa1, pa2, pa3; const int NT = seq / KVBLK;
  constexpr int SE = 0, SO = SDEPTH - 1;
  SLOAD(SE, 0); asm volatile("s_waitcnt vmcnt(0)" ::: "memory"); SWRITE(0, SE); __syncthreads();
  qkt(pA0, pA1, K_lds, qr, r32, hi); partialSM(pA0, pA1, m_reg, mnA, alA);
  SLOAD(SO, KVBLK); if constexpr (SDEPTH == 2) { if (2 < NT) SLOAD(SE, 2 * KVBLK); }
  SWAIT(); SWRITE(1, SO); __syncthreads();
  for (int j = 1; j + 1 < NT; j += 2) {
    SBAR(); qkt(pB0, pB1, (bf16*)((char*)K_lds + SHM_K), qr, r32, hi);
    finishSM(pA0, pA1, alA, l_reg, pa0, pa1, pa2, pa3); SBAR();
    SLOAD(SO, (j + SDEPTH) * KVBLK); SBAR();
    pv_d0(o, vb0, pa0, pa1, pa2, pa3); partialSM(pB0, pB1, m_reg, mnB, alB);
    __syncthreads(); SWAIT(); SWRITE(0, SE);
    RESC(alB); __syncthreads();
    SBAR(); qkt(pA0, pA1, K_lds, qr, r32, hi);
    finishSM(pB0, pB1, alB, l_reg, pa0, pa1, pa2, pa3); SBAR();
    if (SDEPTH == 1 || j + 3 < NT) SLOAD(SE, (j + 1 + SDEPTH) * KVBLK); SBAR();
    pv_d0(o, vb0 + (int)SHM_V, pa0, pa1, pa2, pa3); partialSM(pA0, pA1, m_reg, mnA, alA);
    __syncthreads(); SWAIT(); SWRITE(1, SO);
    RESC(alA); __syncthreads();
  }
  SBAR(); qkt(pB0, pB1, (bf16*)((char*)K_lds + SHM_K), qr, r32, hi);
  finishSM(pA0, pA1, alA, l_reg, pa0, pa1, pa2, pa3); SBAR();
  pv_d0(o, vb0, pa0, pa1, pa2, pa3); partialSM(pB0, pB1, m_reg, mnB, alB);
  __syncthreads(); RESC(alB);
  finishSM(pB0, pB1, alB, l_reg, pa0, pa1, pa2, pa3); SBAR();
  pv_d0(o, vb0 + (int)SHM_V, pa0, pa1, pa2, pa3);
  if (hi == 0) li_l[r32] = l_reg; asm volatile("s_waitcnt lgkmcnt(0)" ::: "memory");
  float rli[16];
#pragma unroll
  for (int r = 0; r < 16; ++r) rli[r] = __builtin_amdgcn_rcpf(li_l[crow(r, hi)]);
  bf16* Ow = Ob + (long)(wid * QBLK) * LDO;
#pragma unroll
  for (int r = 0; r < 16; ++r) { int orow = crow(r, hi);
    for (int d0 = 0; d0 < 4; ++d0) Ow[(long)orow * LDO + d0 * 32 + r32] = __float2bfloat16(o[d0][r] * rli[r]); }
#undef SLOAD
#undef SWRITE
#undef SWAIT
#undef RESC
}
}

constexpr int NWAVES = 8;
constexpr int DM = 1024, NTOK = 8192, NPR = 4096, FF = 4096, INW = 2048, INE = 2080, QKVW = 1536;
constexpr float EPS = 1e-6f;
constexpr size_t OUT_Y = 0, OUT_S5RE = 8388608, OUT_S5IM = OUT_S5RE + 65536, OUT_GLA = OUT_S5IM + 65536, OUT_NK = OUT_GLA + 1048576, OUT_NV = OUT_NK + 1048576, OUT_END = OUT_NV + 1048576;
constexpr size_t MiB = 1u << 20;
constexpr size_t WS_CTL = 0, CTL_ZERO_BYTES = 64 * 1024;
constexpr size_t WS_ADA = 1 * MiB;
constexpr size_t WS_CV = WS_ADA + 512 * 1024;
constexpr size_t WS_WIN = 2 * MiB, WS_WGLR = 6 * MiB, WS_WGLU = 6 * MiB + 512 * 1024, WS_WOUT = 7 * MiB, WS_W1 = 9 * MiB, WS_W2 = 25 * MiB, WS_WQKV = 41 * MiB, WS_WO = 44 * MiB;
constexpr size_t WS_H = 46 * MiB, WS_Y = 62 * MiB, WS_SCR = 94 * MiB;
constexpr size_t WS_Z = WS_SCR, WS_GD = WS_SCR + 32 * MiB, WS_G = WS_SCR + 48 * MiB, WS_UH = WS_SCR + 56 * MiB, WS_SLOC = WS_SCR + 72 * MiB, WS_SIN = WS_SCR + 104 * MiB, WS_DEC = WS_SCR + 120 * MiB,
                 WS_MIX = WS_SCR + 121 * MiB, WS_EBUF = WS_MIX  , WS_WY = WS_SCR + 137 * MiB, WS_WE = WS_SCR + 145 * MiB  , WS_BB = WS_SCR + 153 * MiB, WS_KB = WS_SCR + 154 * MiB, WS_RSW = WS_SCR + 155 * MiB  ;
constexpr size_t WS_ACT = WS_SCR, WS_XBUF = WS_SCR + 72 * MiB;
constexpr size_t WS_QKV = WS_SCR, WS_QN = WS_SCR + 24 * MiB, WS_KP = WS_SCR + 40 * MiB, WS_KS = WS_SCR + 42 * MiB, WS_VP = WS_SCR + 45 * MiB, WS_VS = WS_SCR + 47 * MiB, WS_OB = WS_SCR + 50 * MiB;
constexpr size_t WS_END = WS_SCR + 156 * MiB;
static_assert(WS_END <= 256 * MiB, "d_ws map");
constexpr int CW_BAR = 1024;
constexpr int RING_BYTES = 131072, LDSCTL_OFF = RING_BYTES, MISC_OFF = LDSCTL_OFF + 320, LDS_BYTES = 147456;

#define GAS __attribute__((address_space(1)))
#define LAS __attribute__((address_space(3)))
typedef unsigned short bf16;
typedef unsigned v4u __attribute__((ext_vector_type(4)));
typedef unsigned v2u __attribute__((ext_vector_type(2)));
typedef float f32x4 __attribute__((ext_vector_type(4)));
typedef float f32x16 __attribute__((ext_vector_type(16)));
typedef short bf16x8 __attribute__((ext_vector_type(8)));
typedef short s16x4 __attribute__((ext_vector_type(4)));
typedef GAS unsigned gu32;
#define RLX_AGENT __ATOMIC_RELAXED, __HIP_MEMORY_SCOPE_AGENT
#define LDS_WAIT() asm volatile("s_waitcnt lgkmcnt(0)" ::: "memory")
#define VM_WAIT() asm volatile("s_waitcnt vmcnt(0)" ::: "memory")
__device__ __forceinline__ unsigned f2bf(float f) { unsigned u = __builtin_bit_cast(unsigned, f); return (u + 0x7fffu + ((u >> 16) & 1u)) >> 16; }
__device__ __forceinline__ unsigned pk2(float lo, float hi) { return f2bf(lo) | (f2bf(hi) << 16); }
__device__ __forceinline__ float bf2f(unsigned short b) { return __uint_as_float(((unsigned)b) << 16); }
__device__ __forceinline__ float bflo(unsigned w) { return __uint_as_float(w << 16); }
__device__ __forceinline__ float bfhi(unsigned w) { return __uint_as_float(w & 0xffff0000u); }
__device__ __forceinline__ float wave_sum(float v) {
#pragma unroll
    for (int o = 1; o < 64; o <<= 1) v += __shfl_xor(v, o);
    return v;
}
__device__ __forceinline__ int crow(int r, int hi) { return (r & 3) + 8 * (r >> 2) + 4 * hi; }
__device__ __forceinline__ s16x4 tr_read4(unsigned addr) { s16x4 r; asm volatile("ds_read_b64_tr_b16 %0, %1" : "=&v"(r) : "v"(addr) : "memory"); return r; }

#define XB_TMO      128
#define XB_XCNT(j)  (256  + 64 * (j))
#define XB_XSUB(j)  (1280 + 64 * (j))
#define XB_XGEN(j)  (2304 + 64 * (j))
#define XB_TOP      3328
#define XB_TOPGEN   3392
#define XCD_BAR_WORDS 3456
#define XB_SPIN_CAP (1u << 18)

__device__ __forceinline__ unsigned xb_ld(unsigned* p)              { return __hip_atomic_load(p, __ATOMIC_RELAXED, __HIP_MEMORY_SCOPE_AGENT); }
__device__ __forceinline__ unsigned xb_add(unsigned* p, unsigned v) { return __hip_atomic_fetch_add(p, v, __ATOMIC_RELAXED, __HIP_MEMORY_SCOPE_AGENT); }
__device__ __forceinline__ unsigned xb_xcc_id() { return (unsigned)__builtin_amdgcn_s_getreg((3 << 11) | 20) & 0xFu; }
#define XB_SPIN(cond, bar) do { unsigned _sp = 0; while (cond) { __builtin_amdgcn_s_sleep(1); \
    if ((++_sp & 255u) == 0u) { if (xb_ld(&(bar)[XB_TMO])) break; if (_sp > XB_SPIN_CAP) { atomicAdd(&(bar)[XB_TMO], 1u); break; } } } } while (0)

struct XcdBarrier {
    unsigned* bar; unsigned x;
    volatile LAS unsigned* st;
};

__device__ __forceinline__ XcdBarrier xcd_barrier_post(unsigned* bar, volatile LAS unsigned* st) {
    XcdBarrier b; b.bar = bar; b.x = xb_xcc_id(); b.st = st;
    if (threadIdx.x == 0) (void)xb_add(&bar[XB_XCNT(b.x)], 1u);
    return b;
}
__device__ __forceinline__ void xcd_barrier_complete(unsigned* bar, unsigned x, unsigned& nloc, unsigned& nx) {
    const unsigned G = gridDim.x * gridDim.y * gridDim.z;
    unsigned sum, cnt, mine, sp = 0u;
    for (;;) {
        sum = 0u; cnt = 0u; mine = 0u;
#pragma unroll
        for (unsigned j = 0; j < 16; ++j) { const unsigned c = xb_ld(&bar[XB_XCNT(j)]); sum += c; cnt += (c > 0u) ? 1u : 0u; mine = (j == x) ? c : mine; }
        if (sum == G) break;
        __builtin_amdgcn_s_sleep(1);
        if ((++sp & 255u) == 0u) { if (xb_ld(&bar[XB_TMO])) break; if (sp > XB_SPIN_CAP) { atomicAdd(&bar[XB_TMO], 1u); break; } }
    }
    nloc = mine > 0u ? mine : 1u; nx = cnt > 0u ? cnt : 1u;
}

__device__ __forceinline__ void xcd_barrier(const XcdBarrier& b) {
    asm volatile("s_waitcnt vmcnt(0)" ::: "memory");
    __syncthreads();
    if (threadIdx.x == 0) {
        unsigned* bar = b.bar;
        __builtin_amdgcn_s_waitcnt(0);
        unsigned nloc = b.st[0], nx = b.st[1];
        if (nloc == 0u) { xcd_barrier_complete(bar, b.x, nloc, nx); b.st[0] = nloc; b.st[1] = nx; }
        const unsigned old = xb_add(&bar[XB_XSUB(b.x)], 1u);
        const unsigned gen = old / nloc;
        if (old + 1u == (gen + 1u) * nloc) {
            __builtin_amdgcn_fence(__ATOMIC_RELEASE, "agent");
            asm volatile("s_waitcnt vmcnt(0)" ::: "memory");
            const unsigned og = xb_add(&bar[XB_TOP], 1u);
            const unsigned tg = og / nx;
            if (og + 1u == (tg + 1u) * nx) xb_add(&bar[XB_TOPGEN], 1u);
            else XB_SPIN(xb_ld(&bar[XB_TOPGEN]) == tg, bar);
            __builtin_amdgcn_fence(__ATOMIC_ACQUIRE, "agent");
            xb_add(&bar[XB_XGEN(b.x)], 1u);
            asm volatile("s_waitcnt vmcnt(0)" ::: "memory");
        } else {
            XB_SPIN(xb_ld(&bar[XB_XGEN(b.x)]) == gen, bar);
            __builtin_amdgcn_fence(__ATOMIC_ACQUIRE, "agent");
            asm volatile("s_waitcnt vmcnt(0)" ::: "memory");
        }
    }
    __syncthreads();
}


struct SplitKOrder { int pm, pn;
    __device__ __forceinline__ bool next(int i, pg8::Unit& u) const { if (i > 0) return false; u.pm = pm; u.pn = pn; return true; }
    __device__ __forceinline__ void a_ready(const pg8::Unit&) const {}
    __device__ __forceinline__ void done(const pg8::Unit&) const {} };
template <bool NEXT> struct EpiResidSplitT {
    static constexpr bool PERM = false, AFTER_DRAIN = true;
    const float* base_p; const float* base_s; float* out; const float* gate; bf16* xbuf; XcdBarrier bar; int kh;
    bf16* Hn; const float* nw; const float* nsc; float* rsw;
    template <int KH> __device__ __forceinline__ void run(f32x4 (&acc)[2][2][4][2], const pg8::Unit& u, int wr, int wc, int fr, int fq, int tid) const {
        const int tile = u.pm * 4 + u.pn;
        bf16* xs = xbuf + ((size_t)(tile * 2 + KH) * 16) * 2048 + tid * 4;
#pragma unroll
        for (int bj = 0; bj < 2; ++bj)
#pragma unroll
            for (int m = 0; m < 4; ++m)
#pragma unroll
                for (int n = 0; n < 2; ++n) { const f32x4 a = acc[1 - KH][bj][m][n]; v2u w; w.x = pk2(a[0], a[1]); w.y = pk2(a[2], a[3]); *(v2u*)(xs + ((bj * 4 + m) * 2 + n) * 2048) = w; }
        xcd_barrier(bar);
        const bf16* xr = xbuf + ((size_t)(tile * 2 + (1 - KH)) * 16) * 2048 + tid * 4; const float* base = u.pm < 16 ? base_p : base_s;
        const int row0 = u.pm * 256 + KH * 128 + wr * 64 + fr; const int col0 = u.pn * 256 + wc * 32 + 4 * fq;
        const int cond = u.pm < 16 ? 0 : 1 + ((u.pm - 16) >> 2);
        const float* gp = gate + cond * 6144;
        f32x4 gv[2][2];
#pragma unroll
        for (int bj = 0; bj < 2; ++bj)
#pragma unroll
            for (int n = 0; n < 2; ++n) gv[bj][n] = *(const f32x4*)(gp + col0 + bj * 128 + n * 16);
#pragma unroll
        for (int m = 0; m < 4; ++m) { const size_t off = (size_t)(row0 + m * 16) * 1024 + col0;
#pragma unroll
            for (int bj = 0; bj < 2; ++bj)
#pragma unroll
                for (int n = 0; n < 2; ++n) { const v2u pw = *(const v2u*)(xr + ((bj * 4 + m) * 2 + n) * 2048); const f32x4 p = {bflo(pw.x), bfhi(pw.x), bflo(pw.y), bfhi(pw.y)}; const f32x4 b = *(const f32x4*)(base + off + bj * 128 + n * 16);
                    const f32x4 y = b + gv[bj][n] * (acc[KH][bj][m][n] + p);
                    *(f32x4*)(out + off + bj * 128 + n * 16) = y; if (NEXT) acc[KH][bj][m][n] = y; } }
        if (NEXT) {
            asm volatile("" ::: "memory");
            f32x4 av[2][2];
#pragma unroll
            for (int bj = 0; bj < 2; ++bj)
#pragma unroll
                for (int n = 0; n < 2; ++n) av[bj][n] = *(const f32x4*)(nw + col0 + bj * 128 + n * 16) * (*(const f32x4*)(nsc + cond * 6144 + col0 + bj * 128 + n * 16) + 1.0f);
#pragma unroll
            for (int m = 0; m < 4; ++m) { const int row = row0 + m * 16; const size_t off = (size_t)row * 1024 + col0; float ss = 0.f;
#pragma unroll
                for (int bj = 0; bj < 2; ++bj)
#pragma unroll
                    for (int n = 0; n < 2; ++n) { const f32x4 y = acc[KH][bj][m][n]; ss += (y[0] * y[0] + y[1] * y[1]) + (y[2] * y[2] + y[3] * y[3]); const f32x4 h = y * av[bj][n];
                        v2u w; w.x = pk2(h[0], h[1]); w.y = pk2(h[2], h[3]); *(v2u*)(Hn + off + bj * 128 + n * 16) = w; }
                ss += __shfl_xor(ss, 16); ss += __shfl_xor(ss, 32); if (fq == 0) rsw[(size_t)row * 16 + u.pn * 4 + wc] = ss; }
        }
    }
    __device__ __forceinline__ void fused(f32x4 (&acc)[2][2][4][2], const pg8::Unit& u, int wr, int wc, int fr, int fq, LAS unsigned char*, int wid, int lane) const {
        if (kh == 0) run<0>(acc, u, wr, wc, fr, fq, wid * 64 + lane); else run<1>(acc, u, wr, wc, fr, fq, wid * 64 + lane);
    }
};

struct Args { const float* in[34]; float* out; unsigned char* ws; int ph_lo, ph_hi; };
typedef const __attribute__((address_space(4))) Args CArgs;
__device__ __forceinline__ CArgs* kargs() { CArgs* p = (CArgs*)__builtin_amdgcn_kernarg_segment_ptr(); asm volatile("" : "+s"(p)); return p; }
#define KA (*kargs())
__device__ __forceinline__ int tid_opaque() { int t = threadIdx.x; asm volatile("" : "+v"(t)); return t; }

__device__ __forceinline__ void p0_transpose_item(const float* W, int ld, int K, bf16* WT, int nblk, LAS float* scr, int item, int lane) {
    const int kb = item / nblk, nb = item % nblk, k0 = 64 * kb, n0 = 32 * nb;
#pragma unroll 8
    for (int i = 0; i < 32; ++i) { const int kk = 2 * i + (lane >> 5); scr[kk * 33 + (lane & 31)] = W[(size_t)(k0 + kk) * ld + n0 + (lane & 31)]; }
    LDS_WAIT(); asm volatile("" ::: "memory");
    const int c = lane & 7;
#pragma unroll
    for (int j = 0; j < 4; ++j) { const int n = (lane >> 3) + 8 * j; const LAS float* s = scr + (8 * c) * 33 + n;
        v4u o; o.x = pk2(s[0 * 33], s[1 * 33]); o.y = pk2(s[2 * 33], s[3 * 33]); o.z = pk2(s[4 * 33], s[5 * 33]); o.w = pk2(s[6 * 33], s[7 * 33]);
        *(GAS v4u*)(WT + (size_t)(n0 + n) * K + k0 + 8 * c) = o; }
    LDS_WAIT(); asm volatile("" ::: "memory");
}
__device__ __forceinline__ void p0_prologue(CArgs& A, LAS unsigned char* lds, int tid, int lane, int wave) {
    unsigned char* ws = A.ws;
    {
        LAS float* sc = (LAS float*)(lds);
        LAS float* red = (LAS float*)(lds + 20480);
        for (int i = tid; i < 5 * 1024; i += 512) { const int c = i >> 10, k = i & 1023; const float x = c == 0 ? A.in[8][k] : A.in[7][(c - 1) * 1024 + k]; sc[i] = x / (1.f + __expf(-x)); }
        __syncthreads();
        for (int ab = blockIdx.x; ab < 256; ab += gridDim.x) {
        const int layer = ab >> 7, n0 = (ab & 127) * 48;
        const float* W = A.in[11] + (size_t)layer * 1024 * 6144 + n0;
        const int kq = lane / 12, nq = lane % 12;
        f32x4 acc[5];
#pragma unroll
        for (int c = 0; c < 5; ++c) acc[c] = (f32x4){0.f, 0.f, 0.f, 0.f};
        if (kq < 4) {
#pragma unroll 4
            for (int i = 0; i < 32; ++i) { const int k = 128 * wave + 4 * i + kq; const f32x4 w = *(const f32x4*)(W + (size_t)k * 6144 + 4 * nq);
#pragma unroll
                for (int c = 0; c < 5; ++c) acc[c] += w * sc[c * 1024 + k]; }
#pragma unroll
            for (int c = 0; c < 5; ++c) *(LAS f32x4*)(red + ((wave * 4 + kq) * 5 + c) * 48 + 4 * nq) = acc[c];
        }
        __syncthreads();
        if (tid < 240) { const int c = tid / 48, n = tid % 48; float s = 0.f;
#pragma unroll 8
            for (int p = 0; p < 32; ++p) s += red[(p * 5 + c) * 48 + n];
            ((float*)(ws + WS_ADA))[(size_t)(layer * 5 + c) * 6144 + n0 + n] = s + A.in[12][layer * 6144 + n0 + n]; }
        __syncthreads();
        }
    }
    LAS float* scr = (LAS float*)(lds + wave * 16384);
    const int gw = blockIdx.x * NWAVES + wave, NGW = gridDim.x * NWAVES;
    constexpr int I_IN = 16 * 65, I_OUT = 16 * 32, I_GLU = 8 * 16, I_M1 = 16 * 128, I_M2 = 64 * 32, I_QKV = 16 * 48, I_WO = 16 * 32;
    constexpr int NITEMS = I_IN + I_OUT + I_GLU + 2 * I_M1 + 2 * I_M2 + I_QKV + I_WO;
    for (int it = gw; it < NITEMS; it += NGW) {
        int r = it;
        if (r < I_IN) { const int kb = r / 65, nb = r % 65;
            if (nb < 64) p0_transpose_item(A.in[15], INE, 1024, (bf16*)(ws + WS_WIN), 64, scr, kb * 64 + nb, lane);
            else p0_transpose_item(A.in[15] + 2048, INE, 1024, (bf16*)(ws + WS_WGLR), 1, scr, kb, lane);
            continue; } r -= I_IN;
        if (r < I_OUT) { p0_transpose_item(A.in[16], 1024, 1024, (bf16*)(ws + WS_WOUT), 32, scr, r, lane); continue; } r -= I_OUT;
        if (r < I_GLU) { p0_transpose_item(A.in[25], 512, 512, (bf16*)(ws + WS_WGLU), 16, scr, r, lane); continue; } r -= I_GLU;
        if (r < 2 * I_M1) { const int l = r / I_M1; p0_transpose_item(A.in[13] + (size_t)l * 1024 * 4096, 4096, 1024, (bf16*)(ws + WS_W1) + (size_t)l * 4096 * 1024, 128, scr, r % I_M1, lane); continue; } r -= 2 * I_M1;
        if (r < 2 * I_M2) { const int l = r / I_M2; p0_transpose_item(A.in[14] + (size_t)l * 4096 * 1024, 1024, 4096, (bf16*)(ws + WS_W2) + (size_t)l * 1024 * 4096, 32, scr, r % I_M2, lane); continue; } r -= 2 * I_M2;
        if (r < I_QKV) { p0_transpose_item(A.in[30], 1536, 1024, (bf16*)(ws + WS_WQKV), 48, scr, r, lane); continue; } r -= I_QKV;
        p0_transpose_item(A.in[31], 1024, 1024, (bf16*)(ws + WS_WO), 32, scr, r, lane);
    }
}

template <bool GLR>
__device__ __forceinline__ void norm_phase(CArgs& A, LAS unsigned char* lds, const float* src_p, const float* src_s, const float* g, const float* ada, int ch_shift, int ch_scale,
                                           int tid, int lane, int wave) {
    unsigned char* ws = A.ws;
    bf16* H = (bf16*)(ws + WS_H);
    for (int blk = blockIdx.x; blk < NTOK / 32; blk += gridDim.x) {
        const int r0 = blk * 32; const int cond = r0 < NPR ? 0 : 1 + ((r0 - NPR) >> 10);
        const float* src = r0 < NPR ? src_p : src_s;
        const float* adc = ada + cond * 6144;
        f32x4 ga[4], gb[4];
#pragma unroll
        for (int j = 0; j < 4; ++j) { const int col = 4 * lane + 256 * j; const f32x4 gg = *(const f32x4*)(g + col), s1 = *(const f32x4*)(adc + ch_scale * 1024 + col); ga[j] = gg * (s1 + 1.0f); gb[j] = *(const f32x4*)(adc + ch_shift * 1024 + col); }
#pragma unroll
        for (int i = 0; i < 4; ++i) { const int row = r0 + wave * 4 + i;
            const GAS f32x4* xr = (const GAS f32x4*)(src + (size_t)row * 1024) + lane;
            f32x4 v[4]; float s = 0.f;
#pragma unroll
            for (int j = 0; j < 4; ++j) { v[j] = xr[64 * j]; s += (v[j].x * v[j].x + v[j].y * v[j].y) + (v[j].z * v[j].z + v[j].w * v[j].w); }
            const float rstd = 1.f / sqrtf(wave_sum(s) * (1.f / 1024.f) + EPS);
            GAS v2u* o8 = (GAS v2u*)(H + (size_t)row * 1024) + lane;
#pragma unroll
            for (int j = 0; j < 4; ++j) { const f32x4 h = v[j] * rstd * ga[j] + gb[j]; v2u w; w.x = pk2(h.x, h.y); w.y = pk2(h.z, h.w); o8[64 * j] = w;
                if (GLR) *(LAS v2u*)(lds + (wave * 4 + i) * 2064 + (4 * lane + 256 * j) * 2) = w; }
        }
        if (GLR) {
            __syncthreads();
            const bf16* WG = (const bf16*)(ws + WS_WGLR);
            const int r32 = lane & 31, hi = lane >> 5;
            f32x16 acc = {};
#pragma unroll
            for (int ks = 0; ks < 8; ++ks) { const int k = wave * 128 + ks * 16 + hi * 8;
                const bf16x8 a = *(const LAS bf16x8*)(lds + r32 * 2064 + k * 2);
                const bf16x8 b = *(const bf16x8*)(WG + (size_t)r32 * 1024 + k);
                acc = __builtin_amdgcn_mfma_f32_32x32x16_bf16(a, b, acc, 0, 0, 0); }
            LAS float* red = (LAS float*)(lds + 69632);
#pragma unroll
            for (int r = 0; r < 16; ++r) red[(wave * 32 + crow(r, hi)) * 32 + r32] = acc[r];
            __syncthreads();
            LAS float* glrs = (LAS float*)(lds + 69632 + 32768);
#pragma unroll
            for (int e = 0; e < 2; ++e) { const int idx = tid + 512 * e; float s = 0.f;
#pragma unroll
                for (int w = 0; w < 8; ++w) s += red[w * 1024 + idx];
                glrs[idx] = s; }
            __syncthreads();
            { const int dcol = tid >> 8, hk = tid & 255; float wg2[16];
#pragma unroll
                for (int r = 0; r < 16; ++r) wg2[r] = A.in[27][(size_t)(dcol * 16 + r) * 256 + hk];
                const float bg = A.in[28][dcol * 256 + hk];
                float* GDo = (float*)(ws + WS_GD);
                for (int row = 0; row < 32; ++row) { float x = bg;
#pragma unroll
                    for (int r = 0; r < 16; ++r) x = fmaf(glrs[row * 32 + 16 * dcol + r], wg2[r], x);
                    const float ls = fminf(x, 0.f) - log1pf(__expf(-fabsf(x)));
                    GDo[(size_t)(r0 + row) * 512 + tid] = ls * (1.f / 16.f); } }
            __syncthreads();
        }
    }
}

__device__ __forceinline__ float gelu_tanh(float y) { const float z = 0.7978845608028654f * (y + 0.044715f * y * y * y); const float e = __expf(2.f * z); const float t = 1.f - 2.f / (e + 1.f); return 0.5f * y * (1.f + t); }
#define S5_PW(lds) ((LAS float*)(lds))
#define S5_BB(lds) (S5_PW(lds) + 2 * 17 * 64 * 2)
#define S5_CL(lds) (S5_BB(lds) + 2 * 64 * 16 * 2)
#define S5_KL(lds) (S5_CL(lds) + 16 * 64 * 2)
__device__ __forceinline__ void s5_small(CArgs& A, LAS unsigned char* lds, int g, bool write_bb, int tid) {
    unsigned char* ws = A.ws;
    LAS float* Pw = S5_PW(lds); LAS float* BBl = S5_BB(lds); LAS float* Cl = S5_CL(lds);
    if (tid < 128) { const int d = tid >> 6, p = tid & 63;
        const float lre = A.in[17][(d * 32 + g) * 64 + p], lim = A.in[18][(d * 32 + g) * 64 + p];
        const float dt = __expf(A.in[19][d * 32 + g]);
        const float a_ = lre * dt, th = lim * dt;
        const float sn = __sinf(th), cs = __cosf(th);
        const float ea = __expf(a_);
        const float lb_re = ea * cs, lb_im = ea * sn;
        const float sh = __sinf(0.5f * th);
        const float em1 = a_ * (1.f + a_ * (0.5f + a_ * (0.16666667f + a_ * (0.041666668f + a_ * 0.0083333338f))));
        const float nr = em1 * cs - 2.f * sh * sh, ni = ea * sn;
        const float den = 1.f / (lre * lre + lim * lim);
        const float cf_re = (nr * lre + ni * lim) * den, cf_im = (ni * lre - nr * lim) * den;
        float pr = 1.f, pi = 0.f;
        for (int t = 0; t <= 16; ++t) { Pw[((d * 17 + t) * 64 + p) * 2] = pr; Pw[((d * 17 + t) * 64 + p) * 2 + 1] = pi; const float n0 = pr * lb_re - pi * lb_im, n1 = pr * lb_im + pi * lb_re; pr = n0; pi = n1; }
        float* BBg = (float*)(ws + WS_BB) + (size_t)(g * 2 + d) * 2048;
#pragma unroll
        for (int c = 0; c < 16; ++c) { const float br = A.in[20][(size_t)(g * 64 + p) * 16 + c], bi = A.in[21][(size_t)(g * 64 + p) * 16 + c];
            const float vr = cf_re * br - cf_im * bi, vi = cf_re * bi + cf_im * br;
            BBl[((d * 64 + p) * 16 + c) * 2] = vr; BBl[((d * 64 + p) * 16 + c) * 2 + 1] = vi; if (write_bb) { BBg[p * 16 + c] = vr; BBg[1024 + p * 16 + c] = vi; } }
    } else { for (int i = tid - 128; i < 1024; i += 384) { Cl[i * 2] = A.in[22][(size_t)g * 1024 + i]; Cl[i * 2 + 1] = A.in[23][(size_t)g * 1024 + i]; } }
    __syncthreads();
}
__device__ __forceinline__ void s5_k_slice(CArgs& A, LAS unsigned char* lds, int g, int q, int tid) {
    LAS float* Pw = S5_PW(lds); LAS float* BBl = S5_BB(lds); LAS float* Cl = S5_CL(lds);
    float* KB = (float*)(A.ws + WS_KB) + (size_t)g * 8192;
#pragma unroll
    for (int e = 0; e < 2; ++e) { const int o = q * 1024 + tid + 512 * e; const int d = o >> 12, tau = (o >> 8) & 15, c = (o >> 4) & 15, c2 = o & 15; float s = 0.f;
#pragma unroll 4
        for (int p = 0; p < 64; ++p) { const float cr = Cl[(c * 64 + p) * 2], ci = Cl[(c * 64 + p) * 2 + 1], pr = Pw[((d * 17 + tau) * 64 + p) * 2], pi = Pw[((d * 17 + tau) * 64 + p) * 2 + 1];
            const float zr = cr * pr - ci * pi, zi = cr * pi + ci * pr; s += zr * BBl[((d * 64 + p) * 16 + c2) * 2] - zi * BBl[((d * 64 + p) * 16 + c2) * 2 + 1]; }
        KB[o] = s; }
    __syncthreads();
}
__device__ __forceinline__ void s5_expand(CArgs& A, LAS unsigned char* lds, int g, int q, int tid) {
    unsigned char* ws = A.ws;
    LAS float* Pw = S5_PW(lds); LAS float* BBl = S5_BB(lds); LAS float* Cl = S5_CL(lds); LAS float* Kl = S5_KL(lds);
    { const float* KB = (const float*)(ws + WS_KB) + (size_t)g * 8192;
        for (int i = tid; i < 2048; i += 512) *(LAS f32x4*)(Kl + 4 * i) = *(const f32x4*)(KB + 4 * i); }
    __syncthreads();
    unsigned* WYg = (unsigned*)((bf16*)(ws + WS_WY) + (size_t)g * 256 * 512);
    for (int i = q * 32 * 256 + tid; i < (q + 1) * 32 * 256; i += 512) { const int n = i >> 8, k0 = (i & 255) * 2; const int t = n >> 4, c = n & 15; float v[2];
#pragma unroll
        for (int e = 0; e < 2; ++e) { const int k = k0 + e;
            if (k < 256) { const int s_ = k >> 4, c2 = k & 15;
                if (s_ < t) v[e] = Kl[((0 * 16 + (t - s_)) * 16 + c) * 16 + c2];
                else if (s_ > t) v[e] = Kl[((1 * 16 + (s_ - t)) * 16 + c) * 16 + c2];
                else v[e] = Kl[((0 * 16 + 0) * 16 + c) * 16 + c2] + Kl[((1 * 16 + 0) * 16 + c) * 16 + c2] + (c == c2 ? A.in[24][g * 16 + c] : 0.f);
            } else { const int kk = k - 256, d = kk >> 7, im = (kk >> 6) & 1, p = kk & 63; const int tau = d == 0 ? t + 1 : 16 - t;
                const float cr = Cl[(c * 64 + p) * 2], ci = Cl[(c * 64 + p) * 2 + 1], pr = Pw[((d * 17 + tau) * 64 + p) * 2], pi = Pw[((d * 17 + tau) * 64 + p) * 2 + 1];
                v[e] = im ? -(cr * pi + ci * pr) : (cr * pr - ci * pi); } }
        WYg[i] = pk2(v[0], v[1]); }
    unsigned* WEg = (unsigned*)((bf16*)(ws + WS_WE) + (size_t)g * 256 * 512);
    for (int i = q * 32 * 128 + tid; i < (q + 1) * 32 * 128; i += 512) { const int n = i >> 7, k0 = (i & 127) * 2; const int d = n >> 7, im = (n >> 6) & 1, p = n & 63; float v[2];
#pragma unroll
        for (int e = 0; e < 2; ++e) { const int k = k0 + e, s_ = k >> 4, c2 = k & 15; const int tau = d == 0 ? 15 - s_ : s_;
            const float pr = Pw[((d * 17 + tau) * 64 + p) * 2], pi = Pw[((d * 17 + tau) * 64 + p) * 2 + 1], br = BBl[((d * 64 + p) * 16 + c2) * 2], bi = BBl[((d * 64 + p) * 16 + c2) * 2 + 1];
            v[e] = im ? (pr * bi + pi * br) : (pr * br - pi * bi); }
        WEg[n * 256 + (i & 127)] = pk2(v[0], v[1]); }
    __syncthreads();
}
__device__ __forceinline__ void s5_recur(CArgs& A, LAS unsigned char* lds, int g, int mt, int tid) {
    unsigned char* ws = A.ws;
    const float* EB = (const float*)(ws + WS_EBUF) + (size_t)(g * 512 + mt * 256) * 256;
    bf16* UHg = (bf16*)(ws + WS_UH) + (size_t)(g * 512 + mt * 256) * 512;
    LAS float* El = (LAS float*)lds;
    const int nrow = mt == 0 ? 16 : 64;
    for (int d = 0; d < 2; ++d) {
        for (int i = tid; i < 256 * 32; i += 512) { const int r = i >> 5, q = i & 31; *(LAS f32x4*)(El + r * 128 + 4 * q) = *(const f32x4*)(EB + (size_t)r * 256 + d * 128 + 4 * q); }
        __syncthreads();
        const int nseq = mt == 0 ? 16 : 4;
        for (int idx = tid; idx < nseq * 64; idx += 512) { const int p = idx & 63, b = idx >> 6;
            const float lre = A.in[17][(d * 32 + g) * 64 + p], lim = A.in[18][(d * 32 + g) * 64 + p];
            const float dt = __expf(A.in[19][d * 32 + g]);
            const float sn = __sinf(lim * dt), cs = __cosf(lim * dt); const float ea = __expf(lre * dt);
            float pr = ea * cs, pi = ea * sn;
#pragma unroll
            for (int s_ = 0; s_ < 4; ++s_) { const float n0 = pr * pr - pi * pi, n1 = 2.f * pr * pi; pr = n0; pi = n1; }
            float hr = 0.f, hi_ = 0.f;
            if (mt == 1) { hr = A.in[2][(size_t)((b * 2 + d) * 32 + g) * 64 + p]; hi_ = A.in[3][(size_t)((b * 2 + d) * 32 + g) * 64 + p]; }
            for (int st = 0; st < nrow; ++st) { const int r = b * nrow + (d == 0 ? st : nrow - 1 - st);
                bf16* up = UHg + (size_t)r * 512 + 256 + d * 128 + p; up[0] = (bf16)f2bf(hr); up[64] = (bf16)f2bf(hi_);
                const float er = El[r * 128 + p], ei = El[r * 128 + 64 + p];
                const float n0 = pr * hr - pi * hi_ + er, n1 = pr * hi_ + pi * hr + ei; hr = n0; hi_ = n1; }
            if (mt == 0) {
                const int r = b * 16 + (d == 0 ? 0 : 15), s_ = d == 0 ? 0 : 15;
                const float* BBg = (const float*)(ws + WS_BB) + (size_t)(g * 2 + d) * 2048 + p * 16; const bf16* up = UHg + (size_t)r * 512 + s_ * 16;
                float fr_ = 0.f, fi_ = 0.f;
#pragma unroll
                for (int c = 0; c < 16; ++c) { const float u = bf2f(up[c]); fr_ = fmaf(BBg[c], u, fr_); fi_ = fmaf(BBg[1024 + c], u, fi_); }
                A.out[OUT_S5RE + (size_t)((b * 2 + d) * 32 + g) * 64 + p] = fr_; A.out[OUT_S5IM + (size_t)((b * 2 + d) * 32 + g) * 64 + p] = fi_; }
        }
        __syncthreads();
    }
    VM_WAIT(); __syncthreads();
}
struct GroupOrder { int c, G_;
    __device__ __forceinline__ bool next(int i, pg8::Unit& u) const { const int L = i * G_ + c; if (L >= 64) return false; u.pm = L; u.pn = L >> 1; return true; }
    __device__ __forceinline__ void a_ready(const pg8::Unit&) const {}
    __device__ __forceinline__ void done(const pg8::Unit&) const {} };
struct EpiF32 {
    static constexpr bool PERM = false, AFTER_DRAIN = false; float* O;
    __device__ __forceinline__ void operator()(const f32x4 (&acc)[2][2][4][2], const pg8::Unit& u, int wr, int wc, int fr, int fq) const {
        const int row0 = u.pm * 256 + wr * 64 + fr, col0 = wc * 32 + 4 * fq;
#pragma unroll
        for (int ai = 0; ai < 2; ++ai)
#pragma unroll
            for (int m = 0; m < 4; ++m)
#pragma unroll
                for (int bj = 0; bj < 2; ++bj)
#pragma unroll
                    for (int n = 0; n < 2; ++n) *(f32x4*)(O + (size_t)(row0 + ai * 128 + m * 16) * 256 + col0 + bj * 128 + n * 16) = acc[ai][bj][m][n];
    }
};
struct EpiS5Y {
    static constexpr bool PERM = true, AFTER_DRAIN = false; bf16* Gp;
    __device__ __forceinline__ void operator()(const f32x4 (&acc)[2][2][4][2], const pg8::Unit& u, int wr, int wc, int fr, int fq) const {
        const int g = u.pm >> 1, jj0 = (u.pm & 1) * 256 + wr * 64 + fr, col0 = wc * 32 + 8 * fq;
#pragma unroll
        for (int ai = 0; ai < 2; ++ai)
#pragma unroll
            for (int m = 0; m < 4; ++m) { const int jj = jj0 + ai * 128 + m * 16;
#pragma unroll
                for (int bj = 0; bj < 2; ++bj) { const int n = col0 + bj * 128, t = n >> 4, c0 = n & 15; const f32x4 v0 = acc[ai][bj][m][0], v1 = acc[ai][bj][m][1];
                    v4u w; w.x = pk2(gelu_tanh(v0[0]), gelu_tanh(v0[1])); w.y = pk2(gelu_tanh(v0[2]), gelu_tanh(v0[3])); w.z = pk2(gelu_tanh(v1[0]), gelu_tanh(v1[1])); w.w = pk2(gelu_tanh(v1[2]), gelu_tanh(v1[3]));
                    *(v4u*)(Gp + (size_t)(16 * jj + t) * 512 + g * 16 + c0) = w; } }
    }
};
struct EpiZU {
    static constexpr bool PERM = true, AFTER_DRAIN = false; bf16* Zp; bf16* UHp;
    __device__ __forceinline__ void operator()(const f32x4 (&acc)[2][2][4][2], const pg8::Unit& u, int wr, int wc, int fr, int fq) const {
        const int row0 = u.pm * 256 + wr * 64 + fr; const int col0 = u.pn * 256 + wc * 32 + 8 * fq;
#pragma unroll
        for (int ai = 0; ai < 2; ++ai)
#pragma unroll
            for (int m = 0; m < 4; ++m) { const int row = row0 + ai * 128 + m * 16;
#pragma unroll
                for (int bj = 0; bj < 2; ++bj) { const f32x4 v0 = acc[ai][bj][m][0], v1 = acc[ai][bj][m][1]; const int col = col0 + bj * 128;
                    v4u w; w.x = pk2(v0[0], v0[1]); w.y = pk2(v0[2], v0[3]); w.z = pk2(v1[0], v1[1]); w.w = pk2(v1[2], v1[3]);
                    if (u.pn < 2) *(v4u*)(UHp + ((size_t)(col >> 4) * 512 + (row >> 4)) * 512 + (row & 15) * 16 + (col & 15)) = w;
                    else *(v4u*)(Zp + (size_t)row * 2048 + col) = w; } }
    }
};

__device__ __forceinline__ int gla_slot(int bb, int h, int d, int j) { return bb < 16 ? ((bb * 4 + h) * 2 + d) * 4 + j : 512 + (((bb - 16) * 4 + h) * 2 + d) * 16 + j; }
constexpr int GL_V = 0, GL_VROW = 320;
constexpr int GL_KT = 20480, GL_KTROW = 144;
constexpr int GL_TOT = GL_KT + 4 * 9216;
constexpr int GL_PART = GL_TOT + 2048;
constexpr int GL_BYTES = GL_PART + 1024;
template <int MODE>
__device__ __forceinline__ void gla_prep(CArgs& A, LAS unsigned char* lds, int bb, int h, int j, int row0, int tid, int lane, int wave) {
    unsigned char* ws = A.ws;
    const bf16* Z = (const bf16*)(ws + WS_Z); const float* GDi = (const float*)(ws + WS_GD);
    const int d = wave >> 2, wg = wave & 3;
#pragma unroll
    for (int i = 0; i < 2; ++i) { const int r = (tid >> 4) + 32 * i, c = tid & 15;
        const v4u v = *(const v4u*)(Z + (size_t)(row0 + r) * 2048 + 1024 + h * 128 + 8 * c);
        *(LAS v4u*)(lds + GL_V + r * GL_VROW + c * 16) = v; }
    float gd[16]; float tot = 0.f;
#pragma unroll
    for (int i = 0; i < 16; ++i) { gd[i] = GDi[(size_t)(row0 + 16 * wg + i) * 512 + d * 256 + h * 64 + lane]; tot += gd[i]; }
    LAS float* TOT = (LAS float*)(lds + GL_TOT);
    TOT[(d * 4 + wg) * 64 + lane] = tot;
    __syncthreads();
    float off = 0.f, total = 0.f;
#pragma unroll
    for (int w = 0; w < 4; ++w) { const float tw = TOT[(d * 4 + w) * 64 + lane]; total += tw; if (d == 0 ? (w < wg) : (w > wg)) off += tw; }
    float bcum[16];
    if (d == 0) { float s = off;
#pragma unroll
        for (int i = 0; i < 16; ++i) { s += gd[i]; bcum[i] = s; } }
    else { float s = off;
#pragma unroll
        for (int i = 15; i >= 0; --i) { s += gd[i]; bcum[i] = s; } }
    LAS unsigned char* img = lds + GL_KT + d * 2 * 9216;
    if (MODE == 0) {
        unsigned pkk[8];
#pragma unroll
        for (int i = 0; i < 16; i += 2) { const float k0 = bf2f(Z[(size_t)(row0 + 16 * wg + i) * 2048 + 768 + h * 64 + lane]), k1 = bf2f(Z[(size_t)(row0 + 16 * wg + i + 1) * 2048 + 768 + h * 64 + lane]);
            pkk[i >> 1] = pk2(k0 * __expf(total - bcum[i]), k1 * __expf(total - bcum[i + 1])); }
        *(LAS v4u*)(img + lane * GL_KTROW + 32 * wg) = (v4u){pkk[0], pkk[1], pkk[2], pkk[3]};
        *(LAS v4u*)(img + lane * GL_KTROW + 32 * wg + 16) = (v4u){pkk[4], pkk[5], pkk[6], pkk[7]};
        if (wg == 0) ((float*)(ws + WS_DEC))[(size_t)gla_slot(bb, h, d, j) * 64 + lane] = __expf(total);
    } else {
#pragma unroll
        for (int i = 0; i < 16; ++i) { const size_t zr = (size_t)(row0 + 16 * wg + i) * 2048 + h * 64 + lane;
            const float q = bf2f(Z[zr + 512]) * 0.125f, k = bf2f(Z[zr + 768]);
            *(LAS unsigned short*)(img + (16 * wg + i) * GL_KTROW + lane * 2) = (unsigned short)f2bf(q * __expf(bcum[i]));
            *(LAS unsigned short*)(img + 9216 + (16 * wg + i) * GL_KTROW + lane * 2) = (unsigned short)f2bf(k * __expf(-bcum[i])); }
    }
    __syncthreads();
}
__device__ __forceinline__ void gla_task_rows(int task, int& bb, int& h, int& j, int& row0) {
    if (task < 256) { bb = task >> 4; h = (task >> 2) & 3; j = task & 3; row0 = bb * 256 + 64 * j; }
    else { const int t = task - 256; bb = 16 + (t >> 6); h = (t >> 4) & 3; j = t & 15; row0 = NPR + (bb - 16) * 1024 + 64 * j; }
}
__device__ __forceinline__ void gla_a_task(CArgs& A, LAS unsigned char* lds, int task, int tid, int lane, int wave) {
    int bb, h, j, row0; gla_task_rows(task, bb, h, j, row0);
    gla_prep<0>(A, lds, bb, h, j, row0, tid, lane, wave);
    const int d = wave >> 2, wg = wave & 3, r32 = lane & 31, hi = lane >> 5;
    const unsigned lbase = (unsigned)(uintptr_t)(lds);
    const unsigned vaddr = lbase + GL_V + (8 * hi + ((lane & 15) >> 2)) * GL_VROW + (32 * wg + 16 * ((lane >> 4) & 1) + 4 * (lane & 3)) * 2;
    LAS unsigned char* img = lds + GL_KT + d * 2 * 9216;
    f32x16 acc0 = {}, acc1 = {};
#pragma unroll
    for (int ks = 0; ks < 4; ++ks) {
        const s16x4 lo = tr_read4(vaddr + (16 * ks) * GL_VROW), hi4 = tr_read4(vaddr + (16 * ks + 4) * GL_VROW);
        const bf16x8 b0 = *(const LAS bf16x8*)(img + r32 * GL_KTROW + (16 * ks + 8 * hi) * 2);
        const bf16x8 b1 = *(const LAS bf16x8*)(img + (32 + r32) * GL_KTROW + (16 * ks + 8 * hi) * 2);
        asm volatile("s_waitcnt lgkmcnt(0)" ::: "memory"); __builtin_amdgcn_sched_barrier(0);
        const bf16x8 a = (bf16x8){lo[0], lo[1], lo[2], lo[3], hi4[0], hi4[1], hi4[2], hi4[3]};
        acc0 = __builtin_amdgcn_mfma_f32_32x32x16_bf16(a, b0, acc0, 0, 0, 0);
        acc1 = __builtin_amdgcn_mfma_f32_32x32x16_bf16(a, b1, acc1, 0, 0, 0);
    }
    float* SL = (float*)(A.ws + WS_SLOC) + (size_t)gla_slot(bb, h, d, j) * 8192;
    { float* slp = SL + (32 * wg + 4 * hi) * 64 + r32;
#pragma unroll
    for (int r = 0; r < 16; ++r) { slp[((r & 3) + 8 * (r >> 2)) * 64] = acc0[r]; slp[((r & 3) + 8 * (r >> 2)) * 64 + 32] = acc1[r]; } }
    __syncthreads();
}
template <int N>
__device__ __forceinline__ void gla_b_chain(CArgs& A, int bb, int h, int d, int v, int kk, bool samp) {
    unsigned char* ws = A.ws;
    const float* SL = (const float*)(ws + WS_SLOC); const float* DEC = (const float*)(ws + WS_DEC); bf16* SIN = (bf16*)(ws + WS_SIN);
    f32x4 dc[N], sl[N];
#pragma unroll
    for (int i = 0; i < N; ++i) { const int j = d == 0 ? i : N - 1 - i; const size_t slot = (size_t)gla_slot(bb, h, d, j);
        dc[i] = *(const f32x4*)(DEC + slot * 64 + kk); sl[i] = *(const f32x4*)(SL + slot * 8192 + v * 64 + kk); }
    f32x4 S = {0.f, 0.f, 0.f, 0.f};
    if (samp) { const float* s0 = A.in[4] + (size_t)(((bb - 16) * 2 + d) * 4 + h) * 8192;
#pragma unroll
        for (int q = 0; q < 4; ++q) S[q] = s0[(kk + q) * 128 + v]; }
#pragma unroll
    for (int i = 0; i < N; ++i) { const int j = d == 0 ? i : N - 1 - i; const size_t slot = (size_t)gla_slot(bb, h, d, j);
        v2u w; w.x = pk2(S.x, S.y); w.y = pk2(S.z, S.w); *(v2u*)(SIN + slot * 8192 + v * 64 + kk) = w;
        S = S * dc[i] + sl[i]; }
    if (!samp) { float* o = A.out + OUT_GLA + (size_t)((bb * 2 + d) * 4 + h) * 8192;
#pragma unroll
        for (int q = 0; q < 4; ++q) o[(kk + q) * 128 + v] = S[q]; }
}
__device__ __forceinline__ void gla_b_phase(CArgs& A, int gtid, int nthreads) {
    for (int it = gtid; it < 160 * 2048; it += nthreads) {
        const int s = it >> 11, e = it & 2047;
        const int grp = s / 5, m = s % 5; const int chain = m == 4 ? 128 + grp : grp * 4 + m;
        const bool samp = chain >= 128; const int ci = samp ? chain - 128 : chain;
        const int bb = (samp ? 16 : 0) + (ci >> 3), h = (ci >> 1) & 3, d = ci & 1;
        const int v = e >> 4, kk = (e & 15) * 4;
        if (samp) gla_b_chain<16>(A, bb, h, d, v, kk, true); else gla_b_chain<4>(A, bb, h, d, v, kk, false);
    }
}
__device__ __forceinline__ void gla_c_task(CArgs& A, LAS unsigned char* lds, int task, int tid, int lane, int wave) {
    int bb, h, j, row0; gla_task_rows(task, bb, h, j, row0);
    gla_prep<1>(A, lds, bb, h, j, row0, tid, lane, wave);
    unsigned char* ws = A.ws;
    const bf16* Z = (const bf16*)(ws + WS_Z); const bf16* SIN = (const bf16*)(ws + WS_SIN); bf16* MIX = (bf16*)(ws + WS_MIX);
    const int ti = wave >> 2, vi = wave & 3, r32 = lane & 31, hi = lane >> 5;
    const unsigned lbase = (unsigned)(uintptr_t)(lds);
    const unsigned vaddr = lbase + GL_V + (4 * hi + ((lane & 15) >> 2)) * GL_VROW + (32 * vi + 16 * ((lane >> 4) & 1) + 4 * (lane & 3)) * 2;
    f32x16 o = {};
    const int t = 32 * ti + r32;
#pragma unroll
    for (int d = 0; d < 2; ++d) {
        LAS unsigned char* qimg = lds + GL_KT + d * 2 * 9216; LAS unsigned char* kimg = qimg + 9216;
        bf16x8 qf[4];
#pragma unroll
        for (int ks = 0; ks < 4; ++ks) qf[ks] = *(const LAS bf16x8*)(qimg + t * GL_KTROW + (16 * ks + 8 * hi) * 2);
        const bf16* SI = SIN + (size_t)gla_slot(bb, h, d, j) * 8192 + (size_t)(32 * vi + r32) * 64 + 8 * hi;
#pragma unroll
        for (int ks = 0; ks < 4; ++ks) { const bf16x8 sa = *(const bf16x8*)(SI + 16 * ks); o = __builtin_amdgcn_mfma_f32_32x32x16_bf16(sa, qf[ks], o, 0, 0, 0); }
#pragma unroll
        for (int si = 0; si < 2; ++si) {
            f32x16 x = {};
#pragma unroll
            for (int ks = 0; ks < 4; ++ks) { const bf16x8 ka = *(const LAS bf16x8*)(kimg + (32 * si + r32) * GL_KTROW + (16 * ks + 8 * hi) * 2); x = __builtin_amdgcn_mfma_f32_32x32x16_bf16(ka, qf[ks], x, 0, 0, 0); }
            unsigned pw[8];
#pragma unroll
            for (int r = 0; r < 16; r += 2) { const int s0 = 32 * si + crow(r, hi), s1 = s0 + 1;
                const float x0 = (d == 0 ? (s0 <= t) : (s0 >= t)) ? x[r] : 0.f, x1 = (d == 0 ? (s1 <= t) : (s1 >= t)) ? x[r + 1] : 0.f;
                pw[r >> 1] = pk2(x0, x1); }
#pragma unroll
            for (int sp = 0; sp < 2; ++sp) {
                const s16x4 lo = tr_read4(vaddr + (32 * si + 16 * sp) * GL_VROW), hi4 = tr_read4(vaddr + (32 * si + 16 * sp + 8) * GL_VROW);
                asm volatile("s_waitcnt lgkmcnt(0)" ::: "memory"); __builtin_amdgcn_sched_barrier(0);
                const bf16x8 va = (bf16x8){lo[0], lo[1], lo[2], lo[3], hi4[0], hi4[1], hi4[2], hi4[3]};
                const v4u pq = {pw[4 * sp], pw[4 * sp + 1], pw[4 * sp + 2], pw[4 * sp + 3]};
                o = __builtin_amdgcn_mfma_f32_32x32x16_bf16(va, __builtin_bit_cast(bf16x8, pq), o, 0, 0, 0);
            }
        }
    }
    float ss = 0.f;
#pragma unroll
    for (int r = 0; r < 16; ++r) ss += o[r] * o[r];
    ss += __shfl_xor(ss, 32);
    LAS float* PART = (LAS float*)(lds + GL_PART);
    if (hi == 0) PART[(ti * 4 + vi) * 32 + r32] = ss;
    __syncthreads();
    const float tot = PART[(ti * 4 + 0) * 32 + r32] + PART[(ti * 4 + 1) * 32 + r32] + PART[(ti * 4 + 2) * 32 + r32] + PART[(ti * 4 + 3) * 32 + r32];
    const float rstd = 1.f / sqrtf(tot * (1.f / 128.f) + EPS);
    const size_t row = (size_t)(row0 + t);
#pragma unroll
    for (int rq = 0; rq < 4; ++rq) { const int v = 32 * vi + 8 * rq + 4 * hi;
        const v2u rr = *(const v2u*)(Z + row * 2048 + 1536 + h * 128 + v);
        const f32x4 gn = *(const f32x4*)(A.in[29] + v);
        float rv[4] = {bflo(rr.x), bfhi(rr.x), bflo(rr.y), bfhi(rr.y)}; float ov[4];
#pragma unroll
        for (int e = 0; e < 4; ++e) { const float sl = rv[e] / (1.f + __expf(-rv[e])); ov[e] = o[4 * rq + e] * rstd * gn[e] * sl; }
        v2u w; w.x = pk2(ov[0], ov[1]); w.y = pk2(ov[2], ov[3]);
        *(v2u*)(MIX + row * 1024 + 512 + h * 128 + v) = w; }
    __syncthreads();
}

__device__ __forceinline__ void qk_phase(CArgs& A, int lane, int gw, int ngw) {
    unsigned char* ws = A.ws;
    const bf16* QKV = (const bf16*)(ws + WS_QKV); bf16* QN = (bf16*)(ws + WS_QN);
    const float qw0 = A.in[32][2 * lane], qw1 = A.in[32][2 * lane + 1], kw0 = A.in[33][2 * lane], kw1 = A.in[33][2 * lane + 1];
    const float inv = __powf(10000.f, -(float)(2 * (lane & 31)) / 64.f);
    for (int cr = gw; cr < 2048; cr += ngw) {
        const int b = cr >> 9, pl = cr & 511;
        const f32x4 kx = *(const f32x4*)(A.in[5] + (size_t)(b * 512 + pl) * 256 + 4 * lane), vx = *(const f32x4*)(A.in[6] + (size_t)(b * 512 + pl) * 256 + 4 * lane);
        v2u kwd, vwd; kwd.x = pk2(kx.x, kx.y); kwd.y = pk2(kx.z, kx.w); vwd.x = pk2(vx.x, vx.y); vwd.y = pk2(vx.z, vx.w);
        *(v2u*)((bf16*)(ws + WS_KS) + (size_t)(b * 1536 + 1024 + pl) * 256 + 4 * lane) = kwd;
        *(v2u*)((bf16*)(ws + WS_VS) + (size_t)(b * 1536 + 1024 + pl) * 256 + 4 * lane) = vwd;
    }
    for (int base = gw; base < NTOK; base += 4 * ngw) {
      unsigned wq[4][12];
#pragma unroll
      for (int r = 0; r < 4; ++r) { const int row = base + r * ngw; const unsigned* src = (const unsigned*)(QKV + (size_t)(row < NTOK ? row : base) * QKVW);
#pragma unroll
          for (int hd = 0; hd < 12; ++hd) wq[r][hd] = src[hd * 64 + lane]; }
#pragma unroll
      for (int r = 0; r < 4; ++r) { const int row = base + r * ngw; if (row >= NTOK) continue;
        const bool samp = row >= NPR; const int b = samp ? (row - NPR) >> 10 : row >> 8, t = samp ? (row - NPR) & 1023 : row & 255;
        float cs = 1.f, sn = 0.f;
        if (samp) { const float pos = (float)(lane < 32 ? (t >> 6) : (t & 63)); sn = __sinf(pos * inv); cs = __cosf(pos * inv); }
        bf16* kdst = samp ? (bf16*)(ws + WS_KS) + (size_t)(b * 1536 + t) * 256 : (bf16*)(ws + WS_KP) + (size_t)row * 256;
        bf16* vdst = samp ? (bf16*)(ws + WS_VS) + (size_t)(b * 1536 + t) * 256 : (bf16*)(ws + WS_VP) + (size_t)row * 256;
        float xa[10], xb[10], ssq[10];
#pragma unroll
        for (int hd = 0; hd < 10; ++hd) { const unsigned w = wq[r][hd]; xa[hd] = bflo(w); xb[hd] = bfhi(w); ssq[hd] = xa[hd] * xa[hd] + xb[hd] * xb[hd]; }
#pragma unroll
        for (int of = 1; of < 64; of <<= 1) {
#pragma unroll
            for (int hd = 0; hd < 10; ++hd) ssq[hd] += __shfl_xor(ssq[hd], of); }
#pragma unroll
        for (int hd = 0; hd < 10; ++hd) {
            float x0 = xa[hd], x1 = xb[hd];
            const float rstd = 1.f / sqrtf(ssq[hd] * (1.f / 128.f) + EPS);
            x0 *= rstd * (hd < 8 ? qw0 : kw0); x1 *= rstd * (hd < 8 ? qw1 : kw1);
            if (hd >= 8 && !samp) { float* nk = A.out + OUT_NK + ((size_t)row * 2 + (hd - 8)) * 128 + 2 * lane; nk[0] = x0; nk[1] = x1; }
            const float y0 = x0 * cs - x1 * sn, y1 = x0 * sn + x1 * cs;
            const unsigned ow = pk2(y0, y1);
            if (hd < 8) ((unsigned*)(QN + (size_t)row * 1024))[hd * 64 + lane] = ow;
            else ((unsigned*)kdst)[(hd - 8) * 64 + lane] = ow;
        }
#pragma unroll
        for (int hv = 0; hv < 2; ++hv) { const unsigned w = wq[r][10 + hv]; ((unsigned*)vdst)[hv * 64 + lane] = w;
            if (!samp) { float* nv = A.out + OUT_NV + ((size_t)row * 2 + hv) * 128 + 2 * lane; nv[0] = bflo(w); nv[1] = bfhi(w); } }
      }
    }
}


struct EpiQKV {
    static constexpr bool PERM = true, AFTER_DRAIN = true;
    const float* rsw; const float* cv; const float* qn; const float* kn; unsigned char* wsb; float* outp;
    __device__ __forceinline__ void fused(f32x4 (&acc)[2][2][4][2], const pg8::Unit& u, int wr, int wc, int fr, int fq, LAS unsigned char* lds, int wid, int lane) const {
        const int row0 = u.pm * 256 + wr * 64 + fr, d0 = wc * 32 + 8 * fq;
        const int cond = u.pm < 16 ? 0 : 1 + ((u.pm - 16) >> 2); const bool samp = u.pm >= 16;
        f32x4 cvv[2][2];
#pragma unroll
        for (int bj = 0; bj < 2; ++bj)
#pragma unroll
            for (int n = 0; n < 2; ++n) cvv[bj][n] = *(const f32x4*)(cv + (size_t)cond * 1536 + u.pn * 256 + bj * 128 + d0 + 4 * n);
#pragma unroll
        for (int ai = 0; ai < 2; ++ai)
#pragma unroll
            for (int m = 0; m < 4; ++m) { const int row = row0 + ai * 128 + m * 16;
                const f32x4* rp = (const f32x4*)(rsw + (size_t)row * 16); const f32x4 s4 = (rp[0] + rp[1]) + (rp[2] + rp[3]);
                const float rstd = 1.0f / sqrtf(((s4[0] + s4[1]) + (s4[2] + s4[3])) * (1.f / 1024.f) + EPS);
#pragma unroll
                for (int bj = 0; bj < 2; ++bj)
#pragma unroll
                    for (int n = 0; n < 2; ++n) acc[ai][bj][m][n] = acc[ai][bj][m][n] * rstd + cvv[bj][n]; }
        if (u.pn == 5) {
#pragma unroll
            for (int ai = 0; ai < 2; ++ai)
#pragma unroll
                for (int m = 0; m < 4; ++m) { const int row = row0 + ai * 128 + m * 16;
                    bf16* vdst = samp ? (bf16*)(wsb + WS_VS) + (size_t)(((row - NPR) >> 10) * 1536 + ((row - NPR) & 1023)) * 256 : (bf16*)(wsb + WS_VP) + (size_t)row * 256;
#pragma unroll
                    for (int bj = 0; bj < 2; ++bj) { const f32x4 v0 = acc[ai][bj][m][0], v1 = acc[ai][bj][m][1];
                        v4u w; w.x = pk2(v0[0], v0[1]); w.y = pk2(v0[2], v0[3]); w.z = pk2(v1[0], v1[1]); w.w = pk2(v1[2], v1[3]);
                        *(v4u*)(vdst + bj * 128 + d0) = w;
                        if (!samp) { float* nv = outp + OUT_NV + ((size_t)row * 2 + bj) * 128 + d0; *(f32x4*)nv = (f32x4){bflo(w.x), bfhi(w.x), bflo(w.y), bfhi(w.y)}; *(f32x4*)(nv + 4) = (f32x4){bflo(w.z), bfhi(w.z), bflo(w.w), bfhi(w.w)}; } } }
            return;
        }
        LAS float* part = (LAS float*)lds;
#pragma unroll
        for (int ai = 0; ai < 2; ++ai)
#pragma unroll
            for (int m = 0; m < 4; ++m)
#pragma unroll
                for (int bj = 0; bj < 2; ++bj) { const f32x4 v0 = acc[ai][bj][m][0], v1 = acc[ai][bj][m][1];
                    float ss = ((v0[0] * v0[0] + v0[1] * v0[1]) + (v0[2] * v0[2] + v0[3] * v0[3])) + ((v1[0] * v1[0] + v1[1] * v1[1]) + (v1[2] * v1[2] + v1[3] * v1[3]));
                    ss += __shfl_xor(ss, 16); ss += __shfl_xor(ss, 32);
                    if (fq == 0) part[((ai * 128 + wr * 64 + m * 16 + fr) * 2 + bj) * 4 + wc] = ss; }
        __syncthreads();
        const bool isk = u.pn == 4; const float* nwp = (isk ? kn : qn) + d0;
        const f32x4 w0 = *(const f32x4*)nwp, w1 = *(const f32x4*)(nwp + 4);
        float inv[4];
#pragma unroll
        for (int e = 0; e < 4; ++e) inv[e] = __builtin_amdgcn_exp2f(-(float)(((d0 >> 1) + e) & 31) * (13.287712379549449f / 32.f));
#pragma unroll
        for (int ai = 0; ai < 2; ++ai)
#pragma unroll
            for (int m = 0; m < 4; ++m) { const int rl = ai * 128 + wr * 64 + m * 16 + fr, row = u.pm * 256 + rl;
                const int t = samp ? (row - NPR) & 1023 : 0; const float pos = (float)((d0 >> 1) < 32 ? (t >> 6) : (t & 63));
                float cs[4], sn[4];
#pragma unroll
                for (int e = 0; e < 4; ++e) { if (samp) { sn[e] = __sinf(pos * inv[e]); cs[e] = __cosf(pos * inv[e]); } else { sn[e] = 0.f; cs[e] = 1.f; } }
#pragma unroll
                for (int bj = 0; bj < 2; ++bj) { const f32x4 pt = *(const LAS f32x4*)(part + (rl * 2 + bj) * 4);
                    const float rstd = 1.0f / sqrtf(((pt[0] + pt[1]) + (pt[2] + pt[3])) * (1.f / 128.f) + EPS);
                    const f32x4 x0 = acc[ai][bj][m][0] * rstd * w0, x1 = acc[ai][bj][m][1] * rstd * w1;
                    const int head = u.pn * 2 + bj;
                    if (isk && !samp) { float* nk = outp + OUT_NK + ((size_t)row * 2 + bj) * 128 + d0; *(f32x4*)nk = x0; *(f32x4*)(nk + 4) = x1; }
                    v4u w; w.x = pk2(x0[0] * cs[0] - x0[1] * sn[0], x0[0] * sn[0] + x0[1] * cs[0]); w.y = pk2(x0[2] * cs[1] - x0[3] * sn[1], x0[2] * sn[1] + x0[3] * cs[1]);
                    w.z = pk2(x1[0] * cs[2] - x1[1] * sn[2], x1[0] * sn[2] + x1[1] * cs[2]); w.w = pk2(x1[2] * cs[3] - x1[3] * sn[3], x1[2] * sn[3] + x1[3] * cs[3]);
                    if (!isk) *(v4u*)((bf16*)(wsb + WS_QN) + (size_t)row * 1024 + head * 128 + d0) = w;
                    else { bf16* kdst = samp ? (bf16*)(wsb + WS_KS) + (size_t)(((row - NPR) >> 10) * 1536 + t) * 256 : (bf16*)(wsb + WS_KP) + (size_t)row * 256; *(v4u*)(kdst + bj * 128 + d0) = w; } } }
    }
};
__device__ __forceinline__ void kv_cache_rows(CArgs& A, int lane, int gw, int ngw) {
    unsigned char* ws = A.ws;
    for (int cr = gw; cr < 2048; cr += ngw) { const int b = cr >> 9, pl = cr & 511;
        const f32x4 kx = *(const f32x4*)(A.in[5] + (size_t)(b * 512 + pl) * 256 + 4 * lane), vx = *(const f32x4*)(A.in[6] + (size_t)(b * 512 + pl) * 256 + 4 * lane);
        v2u kwd, vwd; kwd.x = pk2(kx.x, kx.y); kwd.y = pk2(kx.z, kx.w); vwd.x = pk2(vx.x, vx.y); vwd.y = pk2(vx.z, vx.w);
        *(v2u*)((bf16*)(ws + WS_KS) + (size_t)(b * 1536 + 1024 + pl) * 256 + 4 * lane) = kwd;
        *(v2u*)((bf16*)(ws + WS_VS) + (size_t)(b * 1536 + 1024 + pl) * 256 + 4 * lane) = vwd; }
}

__device__ __forceinline__ void cv_phase(CArgs& A, int lane, int gw, int ngw) {
    unsigned char* ws = A.ws; const float* ADAp = (const float*)(ws + WS_ADA); float* CV = (float*)(ws + WS_CV);
    for (int c = gw; c < 4096 + 1536 + 4096; c += ngw) {
        const bf16* wrow; const float* sh; float* o; int ncv;
        if (c < 4096) { wrow = (const bf16*)(ws + WS_W1) + (size_t)c * 1024; sh = ADAp + 3 * 1024; o = CV + c; ncv = 4096; }
        else if (c < 5632) { wrow = (const bf16*)(ws + WS_WQKV) + (size_t)(c - 4096) * 1024; sh = ADAp + 5 * 6144; o = CV + 5 * 4096 + (c - 4096); ncv = 1536; }
        else { wrow = (const bf16*)(ws + WS_W1) + (size_t)4096 * 1024 + (size_t)(c - 5632) * 1024; sh = ADAp + 5 * 6144 + 3 * 1024; o = CV + 5 * 4096 + 5 * 1536 + (c - 5632); ncv = 4096; }
        const v4u w0 = *(const v4u*)(wrow + 16 * lane), w1 = *(const v4u*)(wrow + 16 * lane + 8);
        float wf[16];
#pragma unroll
        for (int e = 0; e < 4; ++e) { wf[2 * e] = bflo(w0[e]); wf[2 * e + 1] = bfhi(w0[e]); wf[8 + 2 * e] = bflo(w1[e]); wf[8 + 2 * e + 1] = bfhi(w1[e]); }
        float ps[5];
#pragma unroll
        for (int cond = 0; cond < 5; ++cond) { const f32x4* sp = (const f32x4*)(sh + cond * 6144 + 16 * lane); float s = 0.f;
#pragma unroll
            for (int q = 0; q < 4; ++q) { const f32x4 s4 = sp[q]; s += (s4[0] * wf[4 * q] + s4[1] * wf[4 * q + 1]) + (s4[2] * wf[4 * q + 2] + s4[3] * wf[4 * q + 3]); }
            ps[cond] = s; }
#pragma unroll
        for (int of = 1; of < 64; of <<= 1) {
#pragma unroll
            for (int cond = 0; cond < 5; ++cond) ps[cond] += __shfl_xor(ps[cond], of); }
        if (lane < 5) { float v = ps[0];
#pragma unroll
            for (int cond = 1; cond < 5; ++cond) v = lane == cond ? ps[cond] : v;
            o[(size_t)lane * ncv] = v; }
    }
}

#ifndef DBL_MASK
#define DBL_MASK 0u
#endif
#ifndef XBAR_N
#define XBAR_N 0
#endif
__global__ void __launch_bounds__(NWAVES * 64, 2) fwd_kernel(Args args_unused) {
    extern __shared__ __attribute__((aligned(16))) unsigned char lds_raw[];
#define lds ((LAS unsigned char*)lds_raw)
#define MISC ((volatile LAS unsigned*)(lds + MISC_OFF))
#define tid (tid_opaque())
#define lane (tid_opaque() & 63)
#define wave (__builtin_amdgcn_readfirstlane(tid_opaque() >> 6))
#define G ((int)gridDim.x)
#define ws (kargs()->ws)
#define ADA ((const float*)(ws + WS_ADA))
#define H ((bf16*)(ws + WS_H))
#define Y ((float*)(ws + WS_Y))
#define xs_off (KA.in[1] - (size_t)NPR * 1024)
#define ADA1 (ADA + 5 * 6144)
    for (int u = tid; u < (LDS_BYTES - LDSCTL_OFF) / 4; u += NWAVES * 64) ((LAS unsigned*)(lds + LDSCTL_OFF))[u] = 0u;
    __syncthreads();
    (void)xcd_barrier_post((unsigned*)((gu32*)(ws + WS_CTL) + CW_BAR), MISC + 8);
#define MKBAR() XcdBarrier bar; bar.bar = (unsigned*)((gu32*)(ws + WS_CTL) + CW_BAR); bar.x = xb_xcc_id(); bar.st = MISC + 8;
#define IN(k) (KA.ph_lo <= (k) && (k) < KA.ph_hi)
#define SEAM(k) do { if ((k) + 1 < KA.ph_hi) { MKBAR(); xcd_barrier(bar); } } while (0)
#define REPS(k) (((DBL_MASK >> (k)) & 1u) ? 2 : 1)
#define SEAM2(k) do { if (rep_ + 1 < REPS(k)) { MKBAR(); xcd_barrier(bar); } else SEAM(k); } while (0)

    if (IN(0)) for (int rep_ = 0; rep_ < REPS(0); ++rep_) { p0_prologue(KA, lds, tid, lane, wave); __syncthreads(); s5_small(KA, lds, (int)blockIdx.x >> 3, ((int)blockIdx.x & 7) == 0, tid); s5_k_slice(KA, lds, (int)blockIdx.x >> 3, (int)blockIdx.x & 7, tid); SEAM2(0); }
    for (int xb_ = 0; xb_ < XBAR_N; ++xb_) { MKBAR(); xcd_barrier(bar); }
    if (IN(1)) for (int rep_ = 0; rep_ < REPS(1); ++rep_) { norm_phase<true>(KA, lds, KA.in[0], xs_off, KA.in[9], ADA, 0, 1, tid, lane, wave); __syncthreads(); s5_small(KA, lds, (int)blockIdx.x >> 3, false, tid); s5_expand(KA, lds, (int)blockIdx.x >> 3, (int)blockIdx.x & 7, tid); SEAM2(1); }
    if (IN(2)) for (int rep_ = 0; rep_ < REPS(2); ++rep_) { pg8::Gemm g{H, (const bf16*)(ws + WS_WIN), NTOK, INW, 1024, 1024, 1024}; pg8::StaticOrder S; S.init(NTOK, INW, G, (int)blockIdx.x);
        EpiZU E{(bf16*)(ws + WS_Z), (bf16*)(ws + WS_UH)};
        pg8::gemm_phase<EpiZU, pg8::StaticOrder, true, true>(lds, g, S, E); SEAM2(2); }
    if (IN(3)) for (int rep_ = 0; rep_ < REPS(3); ++rep_) {
        if ((int)blockIdx.x < 64) { pg8::Gemm g{(const bf16*)(ws + WS_UH), (const bf16*)(ws + WS_WE), 16384, 8192, 256, 512, 512}; GroupOrder S{(int)blockIdx.x, 64};
            EpiF32 E{(float*)(ws + WS_EBUF)};
            pg8::gemm_phase<EpiF32, GroupOrder, true, true>(lds, g, S, E);
            { int task_ = (int)blockIdx.x; asm volatile("" : "+s"(task_)); gla_a_task(KA, lds, task_, tid, lane, wave); } }
        else { for (int task = (int)blockIdx.x; task < 512; task += 192) gla_a_task(KA, lds, task, tid, lane, wave); }
        SEAM2(3); }
    if (IN(4)) for (int rep_ = 0; rep_ < REPS(4); ++rep_) {
        if ((int)blockIdx.x < 64) { s5_recur(KA, lds, (int)blockIdx.x >> 1, (int)blockIdx.x & 1, tid);
            pg8::Gemm g{(const bf16*)(ws + WS_UH), (const bf16*)(ws + WS_WY), 16384, 8192, 512, 512, 512}; GroupOrder S{(int)blockIdx.x, 64};
            EpiS5Y E{(bf16*)(ws + WS_G)};
            pg8::gemm_phase<EpiS5Y, GroupOrder, true, true>(lds, g, S, E); }
        else gla_b_phase(KA, ((int)blockIdx.x - 64) * 512 + tid, 192 * 512);
        SEAM2(4); }
    if (IN(5)) for (int rep_ = 0; rep_ < REPS(5); ++rep_) {
        if ((int)blockIdx.x < 64) { pg8::Gemm g{(const bf16*)(ws + WS_G), (const bf16*)(ws + WS_WGLU), NTOK, 512, 512, 512, 512}; pg8::StaticOrder S; S.init(NTOK, 512, 64, (int)blockIdx.x);
            pg8::EpiGlu E{(const bf16*)(ws + WS_G), (bf16*)(ws + WS_MIX), KA.in[26]};
            pg8::gemm_phase<pg8::EpiGlu, pg8::StaticOrder, true, true>(lds, g, S, E);
            { int task_ = (int)blockIdx.x; asm volatile("" : "+s"(task_)); gla_c_task(KA, lds, task_, tid, lane, wave); } }
        else { for (int task = (int)blockIdx.x; task < 512; task += 192) gla_c_task(KA, lds, task, tid, lane, wave);
            if ((int)blockIdx.x >= 128) cv_phase(KA, lane, ((int)blockIdx.x - 128) * NWAVES + wave, 128 * NWAVES); }
        SEAM2(5); }
    if (IN(6)) for (int rep_ = 0; rep_ < REPS(6); ++rep_) { const int bx = blockIdx.x, kh = (bx >> 3) & 1, jx = bx >> 4;
        pg8::Gemm g{(const bf16*)(ws + WS_MIX) + kh * 512, (const bf16*)(ws + WS_WOUT) + kh * 512, NTOK, 1024, 512, 1024, 1024}; SplitKOrder S{4 * (bx & 7) + (jx >> 2), jx & 3};
        MKBAR(); EpiResidSplitT<true> E{KA.in[0], xs_off, Y, ADA + 2 * 1024, (bf16*)(ws + WS_XBUF), bar, kh, H, KA.in[10], ADA + 4 * 1024, (float*)(ws + WS_RSW)};
        pg8::gemm_phase<EpiResidSplitT<true>, SplitKOrder, false, true>(lds, g, S, E); SEAM2(6); }
    if (IN(8)) for (int rep_ = 0; rep_ < REPS(8); ++rep_) { pg8::Gemm g{H, (const bf16*)(ws + WS_W1), NTOK, FF, 1024, 1024, 1024}; pg8::StaticOrder S; S.init(NTOK, FF, G, (int)blockIdx.x);
        pg8::EpiBf16<2, true> E{(bf16*)(ws + WS_ACT), FF, (const float*)(ws + WS_RSW), (const float*)(ws + WS_CV), 4096};
        pg8::gemm_phase<pg8::EpiBf16<2, true>, pg8::StaticOrder, true, true>(lds, g, S, E); SEAM2(8); }
    if (IN(9)) for (int rep_ = 0; rep_ < REPS(9); ++rep_) { const int bx = blockIdx.x, kh = (bx >> 3) & 1, jx = bx >> 4;
        pg8::Gemm g{(const bf16*)(ws + WS_ACT) + kh * 2048, (const bf16*)(ws + WS_W2) + kh * 2048, NTOK, 1024, 2048, FF, FF}; SplitKOrder S{4 * (bx & 7) + (jx >> 2), jx & 3};
        MKBAR(); EpiResidSplitT<true> E{Y, Y, Y, ADA + 5 * 1024, (bf16*)(ws + WS_XBUF), bar, kh, H, KA.in[9] + 1024, ADA1 + 1 * 1024, (float*)(ws + WS_RSW)};
        pg8::gemm_phase<EpiResidSplitT<true>, SplitKOrder, false, true>(lds, g, S, E); SEAM2(9); }
    if (IN(11)) for (int rep_ = 0; rep_ < REPS(11); ++rep_) { pg8::Gemm g{H, (const bf16*)(ws + WS_WQKV), NTOK, QKVW, 1024, 1024, 1024}; pg8::StaticOrder S; S.init(NTOK, QKVW, G, (int)blockIdx.x);
        EpiQKV E{(const float*)(ws + WS_RSW), (const float*)(ws + WS_CV) + 5 * 4096, KA.in[32], KA.in[33], ws, KA.out};
        pg8::gemm_phase<EpiQKV, pg8::StaticOrder, false, true>(lds, g, S, E);
        if ((int)blockIdx.x >= 192) kv_cache_rows(KA, lane, ((int)blockIdx.x - 192) * NWAVES + wave, 64 * NWAVES);
        SEAM2(11); }
    if (IN(13)) for (int rep_ = 0; rep_ < REPS(13); ++rep_) {
        const att::bf16* QN = (const att::bf16*)(ws + WS_QN); att::bf16* OB = (att::bf16*)(ws + WS_OB);
        for (int u = blockIdx.x; u < 256; u += G) {
            if (u < 128) { const int b = u >> 5, hq = (u >> 2) & 7, qb = u & 3; const size_t qrow = (size_t)NPR + b * 1024 + qb * 256;
                att::attn_dense_body<att::bf16>(QN + qrow * 1024 + hq * 128, (const att::bf16*)(ws + WS_KS) + (size_t)b * 1536 * 256 + (hq >> 2) * 128, (const att::bf16*)(ws + WS_VS) + (size_t)b * 1536 * 256 + (hq >> 2) * 128,
                                                OB + qrow * 1024 + hq * 128, 1536, (char*)lds_raw); }
            else { const int v = u - 128, b = v >> 3, hq = v & 7; const size_t qrow = (size_t)b * 256;
                att::attn_dense_body<att::bf16>(QN + qrow * 1024 + hq * 128, (const att::bf16*)(ws + WS_KP) + qrow * 256 + (hq >> 2) * 128, (const att::bf16*)(ws + WS_VP) + qrow * 256 + (hq >> 2) * 128,
                                                OB + qrow * 1024 + hq * 128, 256, (char*)lds_raw); }
            __syncthreads();
        }
        SEAM2(13); }
    if (IN(14)) for (int rep_ = 0; rep_ < REPS(14); ++rep_) { const int bx = blockIdx.x, kh = (bx >> 3) & 1, jx = bx >> 4;
        pg8::Gemm g{(const bf16*)(ws + WS_OB) + kh * 512, (const bf16*)(ws + WS_WO) + kh * 512, NTOK, 1024, 512, 1024, 1024}; SplitKOrder S{4 * (bx & 7) + (jx >> 2), jx & 3};
        MKBAR(); EpiResidSplitT<true> E{Y, Y, Y, ADA1 + 2 * 1024, (bf16*)(ws + WS_XBUF), bar, kh, H, KA.in[10] + 1024, ADA1 + 4 * 1024, (float*)(ws + WS_RSW)};
        pg8::gemm_phase<EpiResidSplitT<true>, SplitKOrder, false, true>(lds, g, S, E); SEAM2(14); }
    if (IN(16)) for (int rep_ = 0; rep_ < REPS(16); ++rep_) { pg8::Gemm g{H, (const bf16*)(ws + WS_W1) + (size_t)4096 * 1024, NTOK, FF, 1024, 1024, 1024}; pg8::StaticOrder S; S.init(NTOK, FF, G, (int)blockIdx.x);
        pg8::EpiBf16<2, true> E{(bf16*)(ws + WS_ACT), FF, (const float*)(ws + WS_RSW), (const float*)(ws + WS_CV) + 5 * 4096 + 5 * 1536, 4096};
        pg8::gemm_phase<pg8::EpiBf16<2, true>, pg8::StaticOrder, true, true>(lds, g, S, E); SEAM2(16); }
    if (IN(17)) for (int rep_ = 0; rep_ < REPS(17); ++rep_) { const int bx = blockIdx.x, kh = (bx >> 3) & 1, jx = bx >> 4;
        pg8::Gemm g{(const bf16*)(ws + WS_ACT) + kh * 2048, (const bf16*)(ws + WS_W2) + (size_t)1024 * 4096 + kh * 2048, NTOK, 1024, 2048, FF, FF}; SplitKOrder S{4 * (bx & 7) + (jx >> 2), jx & 3};
        MKBAR(); EpiResidSplitT<false> E{Y, Y, KA.out + OUT_Y, ADA1 + 5 * 1024, (bf16*)(ws + WS_XBUF), bar, kh, nullptr, nullptr, nullptr, nullptr};
        pg8::gemm_phase<EpiResidSplitT<false>, SplitKOrder, false, true>(lds, g, S, E); SEAM2(17); }
#undef IN
#undef SEAM
#undef lds
#undef MISC
#undef tid
#undef lane
#undef wave
#undef G
#undef ws
#undef ADA
#undef H
#undef Y
#undef xs_off
#undef ADA1
}
constexpr int N_PHASES = 18;

#ifndef MK_ONE_LAUNCH
#define MK_ONE_LAUNCH 1
#endif
extern "C" void kernel_launch(void* const* d_in, const int* in_sizes, int n_in, void* d_out, int out_size, void* d_ws, size_t ws_size, hipStream_t stream) {
    static int grid = 0;
    if (grid == 0) {
        if (n_in != 34 || out_size != (int)OUT_END || ws_size < WS_END) { fprintf(stderr, "kernel_launch: unexpected shapes: n_in %d out %d ws %zu\n", n_in, out_size, ws_size); grid = -1; return; }
        int dev = 0, cus = 0, per_cu = 0;
        if (hipGetDevice(&dev) != hipSuccess || hipDeviceGetAttribute(&cus, hipDeviceAttributeMultiprocessorCount, dev) != hipSuccess) { grid = -1; return; }
        if (hipFuncSetAttribute((const void*)fwd_kernel, hipFuncAttributeMaxDynamicSharedMemorySize, LDS_BYTES) != hipSuccess) { fprintf(stderr, "kernel_launch: hipFuncSetAttribute failed\n"); grid = -1; return; }
        if (hipOccupancyMaxActiveBlocksPerMultiprocessor(&per_cu, (const void*)fwd_kernel, NWAVES * 64, LDS_BYTES) != hipSuccess || per_cu < 1) { fprintf(stderr, "kernel_launch: occupancy query says %d blocks per CU\n", per_cu); }
        (void)hipGetLastError();
        grid = cus < 256 ? cus : 256;
        if (grid != 256) { fprintf(stderr, "kernel_launch: this kernel needs a 256-CU device (one workgroup per CU); found %d\n", cus); grid = -1; return; }
    }
    if (grid < 0) return;
    (void)hipMemsetAsync((char*)d_ws + WS_CTL, 0, CTL_ZERO_BYTES, stream);
    Args a{};
    for (int i = 0; i < 34; ++i) a.in[i] = (const float*)d_in[i];
    a.out = (float*)d_out; a.ws = (unsigned char*)d_ws;
#if MK_ONE_LAUNCH
    a.ph_lo = 0; a.ph_hi = N_PHASES;
    hipLaunchKernelGGL(fwd_kernel, dim3(grid), dim3(NWAVES * 64), LDS_BYTES, stream, a);
#else
    for (int p = 0; p < N_PHASES; ++p) { a.ph_lo = p; a.ph_hi = p + 1; hipLaunchKernelGGL(fwd_kernel, dim3(grid), dim3(NWAVES * 64), LDS_BYTES, stream, a); }
#endif
    const hipError_t le = hipPeekAtLastError();
    if (le != hipSuccess) fprintf(stderr, "kernel_launch: launch failed: %s\n", hipGetErrorName(le));
}
```

```cpp
#include <hip/hip_runtime.h>
#include <hip/hip_bf16.h>
#include <cstdio>
#include <cstdint>
#include <cmath>
namespace pg8 {
#define PG8_LAS __attribute__((address_space(3)))
typedef unsigned short bf16_t;
typedef short bf16x8 __attribute__((ext_vector_type(8)));
typedef float f32x4 __attribute__((ext_vector_type(4)));
typedef unsigned u32x4 __attribute__((ext_vector_type(4)));
constexpr int BM = 256, BK = 64, HALF = 128, HTB = HALF * BK * 2  , STAGE_BYTES = 8 * HTB, NXCD = 8, WGM = 8;

__host__ __device__ __forceinline__ int lds_byte(int r, int c) { const int st = (r >> 4) * 2 + (c >> 5), rr = r & 15, cc = c & 31, ob = rr * 64 + cc * 2; return st * 1024 + (ob ^ (((ob >> 9) & 1) << 5)); }
__host__ __device__ __forceinline__ void stage_rc(int b, int& R, int& C) { const int st = b / 1024, sb = b % 1024, swz = sb ^ (((sb >> 9) & 1) << 5); R = (st >> 1) * 16 + swz / 64; C = (st & 1) * 32 + (swz % 64) / 2; }
__host__ __device__ __forceinline__ int perm32(int rho) { const int n = rho >> 4, i = rho & 15; return 8 * (i >> 2) + 4 * n + (i & 3); }

struct Unit { int pm, pn; };
struct Gemm { const bf16_t* A; const bf16_t* Bt; int M, N, K, lda, ldb; };

struct StaticOrder {
    int nM, nN, nwg, G, c;
    __host__ __device__ void init(int M, int N, int G_, int c_) { nM = M / BM; nN = N / BM; nwg = nM * nN; G = G_; c = c_; }
    __host__ __device__ bool next(int i, Unit& u) const {
        const long L = (long)i * G + c; if (L >= nwg) return false;
        int wgid = (int)L; { const int q = nwg / NXCD, r = nwg % NXCD, xcd = wgid % NXCD, off = wgid / NXCD; wgid = (xcd < r ? xcd * (q + 1) : r * (q + 1) + (xcd - r) * q) + off; }
        const int nig = WGM * nN, gid = wgid / nig, fm = gid * WGM, gsz = (nM - fm) < WGM ? (nM - fm) : WGM;
        u.pm = fm + ((wgid % nig) % gsz); u.pn = (wgid % nig) / gsz; return true;
    }
    __device__ __forceinline__ void a_ready(const Unit&) const {}
    __device__ __forceinline__ void done(const Unit&) const {}
};

__device__ __forceinline__ unsigned cvt_pk_bf16(float lo, float hi) { unsigned r; asm volatile("v_cvt_pk_bf16_f32 %0, %1, %2" : "=v"(r) : "v"(lo), "v"(hi)); return r; }
typedef float f32x2 __attribute__((ext_vector_type(2)));
template <int ACT  , bool NORM = false> struct EpiBf16 {
    static constexpr bool PERM = true, AFTER_DRAIN = false;
    bf16_t* O; int ldc; const float* rsw; const float* cv; int ncv;
    __device__ __forceinline__ void operator()(const f32x4 (&acc)[2][2][4][2], const Unit& u, int wr, int wc, int fr, int fq) const {
        const int row0 = u.pm * BM + wr * 64 + fr; const int col0 = u.pn * BM + wc * 32 + 8 * fq;
        f32x4 cvv[2][2];
        if (NORM) { const int cond = u.pm < 16 ? 0 : 1 + ((u.pm - 16) >> 2);
#pragma unroll
            for (int bj = 0; bj < 2; ++bj)
#pragma unroll
                for (int n = 0; n < 2; ++n) cvv[bj][n] = *(const f32x4*)(cv + (size_t)cond * ncv + col0 + bj * HALF + 4 * n); }
#pragma unroll
        for (int ai = 0; ai < 2; ++ai)
#pragma unroll
            for (int m = 0; m < 4; ++m) { const int row = row0 + ai * HALF + m * 16; bf16_t* rowp = O + (size_t)row * ldc + col0;
                float rstd = 1.f;
                if (NORM) { const f32x4* rp = (const f32x4*)(rsw + (size_t)row * 16); const f32x4 s4 = (rp[0] + rp[1]) + (rp[2] + rp[3]); rstd = 1.0f / sqrtf(((s4[0] + s4[1]) + (s4[2] + s4[3])) * (1.f / 1024.f) + 1e-6f); }
#pragma unroll
                for (int bj = 0; bj < 2; ++bj) { f32x4 v0 = acc[ai][bj][m][0], v1 = acc[ai][bj][m][1];
                    if (NORM) { v0 = v0 * rstd + cvv[bj][0]; v1 = v1 * rstd + cvv[bj][1]; }
                    if (ACT == 2) {
#pragma unroll
                        for (int e = 0; e < 4; ++e) { float a = v0[e] > 0.f ? v0[e] : 0.f; v0[e] = a * a; float b = v1[e] > 0.f ? v1[e] : 0.f; v1[e] = b * b; } }
                    u32x4 w; w.x = cvt_pk_bf16(v0[0], v0[1]); w.y = cvt_pk_bf16(v0[2], v0[3]); w.z = cvt_pk_bf16(v1[0], v1[1]); w.w = cvt_pk_bf16(v1[2], v1[3]);
                    *(u32x4*)(rowp + bj * HALF) = w; } }
    }
};
template <bool NEXT> struct EpiResidT {
    static constexpr bool PERM = false, AFTER_DRAIN = false;
    const float* base_p; const float* base_s; float* out; const float* gate;
    bf16_t* Hn; const float* nw; const float* nsc; float* rsw;
    __device__ __forceinline__ void operator()(const f32x4 (&acc)[2][2][4][2], const Unit& u, int wr, int wc, int fr, int fq) const {
        const int row0 = u.pm * BM + wr * 64 + fr; const int col0 = u.pn * BM + wc * 32 + 4 * fq;
        const int cond = u.pm < 16 ? 0 : 1 + ((u.pm - 16) >> 2);
        const float* gp = gate + cond * 6144; const float* bp = u.pm < 16 ? base_p : base_s;
        f32x4 gv[2][2];
#pragma unroll
        for (int bj = 0; bj < 2; ++bj)
#pragma unroll
            for (int n = 0; n < 2; ++n) gv[bj][n] = *(const f32x4*)(gp + col0 + bj * HALF + n * 16);
        f32x4 (&y)[2][2][4][2] = const_cast<f32x4 (&)[2][2][4][2]>(acc);
#pragma unroll
        for (int ai = 0; ai < 2; ++ai)
#pragma unroll
            for (int m = 0; m < 4; ++m) { const size_t off = (size_t)(row0 + ai * HALF + m * 16) * 1024 + col0;
#pragma unroll
                for (int bj = 0; bj < 2; ++bj)
#pragma unroll
                    for (int n = 0; n < 2; ++n) { const f32x4 b = *(const f32x4*)(bp + off + bj * HALF + n * 16); const f32x4 yy = b + gv[bj][n] * acc[ai][bj][m][n];
                        *(f32x4*)(out + off + bj * HALF + n * 16) = yy; if (NEXT) y[ai][bj][m][n] = yy; } }
        if (NEXT) {
            asm volatile("" ::: "memory");
            f32x4 av[2][2];
#pragma unroll
            for (int bj = 0; bj < 2; ++bj)
#pragma unroll
                for (int n = 0; n < 2; ++n) av[bj][n] = *(const f32x4*)(nw + col0 + bj * HALF + n * 16) * (*(const f32x4*)(nsc + cond * 6144 + col0 + bj * HALF + n * 16) + 1.0f);
#pragma unroll
            for (int ai = 0; ai < 2; ++ai)
#pragma unroll
                for (int m = 0; m < 4; ++m) { const int row = row0 + ai * HALF + m * 16; const size_t off = (size_t)row * 1024 + col0; float ss = 0.f;
#pragma unroll
                    for (int bj = 0; bj < 2; ++bj)
#pragma unroll
                        for (int n = 0; n < 2; ++n) { const f32x4 yy = y[ai][bj][m][n]; ss += (yy[0] * yy[0] + yy[1] * yy[1]) + (yy[2] * yy[2] + yy[3] * yy[3]); const f32x4 h = yy * av[bj][n];
                            typedef unsigned u32x2 __attribute__((ext_vector_type(2))); u32x2 w; w.x = cvt_pk_bf16(h[0], h[1]); w.y = cvt_pk_bf16(h[2], h[3]); *(u32x2*)(Hn + off + bj * HALF + n * 16) = w; }
                    ss += __shfl_xor(ss, 16); ss += __shfl_xor(ss, 32); if (fq == 0) rsw[(size_t)row * 16 + u.pn * 4 + wc] = ss; }
        }
    }
};
typedef EpiResidT<false> EpiResid;
struct EpiGlu {
    static constexpr bool PERM = true, AFTER_DRAIN = false;
    const bf16_t* G; bf16_t* O; const float* bias;
    __device__ __forceinline__ void operator()(const f32x4 (&acc)[2][2][4][2], const Unit& u, int wr, int wc, int fr, int fq) const {
        const int row0 = u.pm * BM + wr * 64 + fr; const int col0 = u.pn * BM + wc * 32 + 8 * fq;
        f32x4 bv[2][2];
#pragma unroll
        for (int bj = 0; bj < 2; ++bj)
#pragma unroll
            for (int n = 0; n < 2; ++n) bv[bj][n] = *(const f32x4*)(bias + col0 + bj * HALF + 4 * n);
#pragma unroll
        for (int ai = 0; ai < 2; ++ai)
#pragma unroll
            for (int m = 0; m < 4; ++m) { const size_t row = (size_t)(row0 + ai * HALF + m * 16);
#pragma unroll
                for (int bj = 0; bj < 2; ++bj) { f32x4 v0 = acc[ai][bj][m][0] + bv[bj][0], v1 = acc[ai][bj][m][1] + bv[bj][1];
                    const u32x4 gw = *(const u32x4*)(G + row * 512 + col0 + bj * HALF);
                    float gf[8];
#pragma unroll
                    for (int e = 0; e < 4; ++e) { gf[2 * e] = __uint_as_float(gw[e] << 16); gf[2 * e + 1] = __uint_as_float(gw[e] & 0xffff0000u); }
                    float o[8];
#pragma unroll
                    for (int e = 0; e < 4; ++e) { o[e] = gf[e] / (1.f + __expf(-v0[e])); o[4 + e] = gf[4 + e] / (1.f + __expf(-v1[e])); }
                    u32x4 w; w.x = cvt_pk_bf16(o[0], o[1]); w.y = cvt_pk_bf16(o[2], o[3]); w.z = cvt_pk_bf16(o[4], o[5]); w.w = cvt_pk_bf16(o[6], o[7]);
                    *(u32x4*)(O + row * 1024 + col0 + bj * HALF) = w; } }
    }
};

template <class Epi, class Sched, bool ALIGN_EPI = false, bool SP2 = false>
__device__ __forceinline__ void gemm_phase(PG8_LAS unsigned char* lds, const Gemm g, const Sched& S, const Epi& E) {
    int tid_ = threadIdx.x; asm volatile("" : "+v"(tid_));
    const int tid = tid_, wid = __builtin_amdgcn_readfirstlane(tid >> 6), lane = tid & 63, wr = wid >> 2, wc = wid & 3, fr = lane & 15, fq = lane >> 4;
    const int K = g.K, nt = K / BK, LDA_ = g.lda, LDB_ = g.ldb;
    unsigned voffA[2], voffB[2];
#pragma unroll
    for (int i = 0; i < 2; ++i) { int R, C; stage_rc(tid * 16 + i * 8192, R, C); const int Rb = Epi::PERM ? ((R & ~31) + perm32(R & 31)) : R;
        voffA[i] = (unsigned)(R * LDA_ + C) * 2u; voffB[i] = (unsigned)(Rb * LDB_ + C) * 2u; }
    const size_t kstep = (size_t)(BK * 2);
    const size_t hstepA = (size_t)HALF * LDA_ * 2, hstepB = (size_t)HALF * LDB_ * 2;
    const size_t tstepA = 2 * hstepA, tstepB = 2 * hstepB;
    const unsigned ldsw = (unsigned)wid * 1024u;
    const int aoff = lds_byte(wr * 64 + fr, fq * 8), boff = lds_byte(wc * 32 + fr, fq * 8);
#define PG8_SA(b, h) (((b) * 2 + (h)) * HTB)
#define PG8_SB(b, h) ((4 + (b) * 2 + (h)) * HTB)
#define PG8_STAGE(bufoff, gbase, voff) do { _Pragma("unroll") for (int _i = 0; _i < 2; ++_i) \
        __builtin_amdgcn_global_load_lds((const unsigned*)((const char*)(gbase) + (voff)[_i]), (PG8_LAS unsigned*)(lds + (bufoff) + ldsw + _i * 8192), 16, 0, 0); } while (0)
#define PG8_LDA(dst, b, h) do { _Pragma("unroll") for (int m = 0; m < 4; ++m) _Pragma("unroll") for (int k = 0; k < 2; ++k) dst[m][k] = *(const PG8_LAS bf16x8*)(lds + PG8_SA(b, h) + aoff + m * 2048 + k * 1024); } while (0)
#define PG8_LDB(dst, b, h) do { _Pragma("unroll") for (int n = 0; n < 2; ++n) _Pragma("unroll") for (int k = 0; k < 2; ++k) dst[n][k] = *(const PG8_LAS bf16x8*)(lds + PG8_SB(b, h) + boff + n * 2048 + k * 1024); } while (0)
#define PG8_MMA(ai, bj, At, Bt) do { __builtin_amdgcn_s_setprio(1); _Pragma("unroll") for (int m = 0; m < 4; ++m) _Pragma("unroll") for (int n = 0; n < 2; ++n) _Pragma("unroll") for (int k = 0; k < 2; ++k) \
        acc[ai][bj][m][n] = __builtin_amdgcn_mfma_f32_16x16x32_bf16(Bt[n][k], At[m][k], acc[ai][bj][m][n], 0, 0, 0); __builtin_amdgcn_s_setprio(0); } while (0)
#define PG8_WAIT_V(n) asm volatile("s_waitcnt vmcnt(" #n ")" ::: "memory")
#define PG8_WAIT_L(n) asm volatile("s_waitcnt lgkmcnt(" #n ")" ::: "memory")
#define PG8_BAR __builtin_amdgcn_s_barrier()
#define PG8_SCHED __builtin_amdgcn_sched_barrier(0)
    Unit cur, nxt; int ui = 0;
    if (!S.next(0, cur)) return;
    f32x4 acc[2][2][4][2];
#pragma unroll
    for (int a = 0; a < 2; ++a)
#pragma unroll
        for (int b = 0; b < 2; ++b)
#pragma unroll
            for (int m = 0; m < 4; ++m)
#pragma unroll
                for (int n = 0; n < 2; ++n) acc[a][b][m][n] = (f32x4){0.f, 0.f, 0.f, 0.f};
    bf16x8 At[4][2], B0[2][2], B1[2][2];
    const char* cA = (const char*)g.A + (size_t)cur.pm * tstepA; const char* cB = (const char*)g.Bt + (size_t)cur.pn * tstepB;
    S.a_ready(cur);
    if constexpr (SP2) {
        PG8_STAGE(PG8_SB(0, 0), cB, voffB); PG8_STAGE(PG8_SB(0, 1), cB + hstepB, voffB); PG8_STAGE(PG8_SA(0, 0), cA, voffA); PG8_STAGE(PG8_SA(0, 1), cA + hstepA, voffA);
        if (wr == 1) PG8_BAR;
        PG8_WAIT_V(2); PG8_BAR;
        PG8_STAGE(PG8_SB(1, 0), cB + kstep, voffB); PG8_STAGE(PG8_SA(1, 0), cA + kstep, voffA); PG8_STAGE(PG8_SB(1, 1), cB + hstepB + kstep, voffB);
        PG8_WAIT_V(6); PG8_BAR;
    } else {
        PG8_STAGE(PG8_SB(0, 0), cB, voffB); PG8_STAGE(PG8_SA(0, 0), cA, voffA); PG8_STAGE(PG8_SB(0, 1), cB + hstepB, voffB); PG8_STAGE(PG8_SA(0, 1), cA + hstepA, voffA);
        if (wr == 1) PG8_BAR;
        PG8_WAIT_V(4); PG8_BAR;
        PG8_STAGE(PG8_SB(1, 0), cB + kstep, voffB); PG8_STAGE(PG8_SA(1, 0), cA + kstep, voffA); PG8_STAGE(PG8_SB(1, 1), cB + hstepB + kstep, voffB);
        PG8_WAIT_V(6); PG8_BAR;
    }
    for (;;) {
        const bool has_next = S.next(ui + 1, nxt);
        const char* nA = has_next ? (const char*)g.A + (size_t)nxt.pm * tstepA : cA; const char* nB = has_next ? (const char*)g.Bt + (size_t)nxt.pn * tstepB : cB;
        for (int t = 0; t < nt; t += 2) {
            const bool last = (t == nt - 2);
            const char* a1 = cA + (size_t)(t + 1) * kstep;
            const char* a2 = last ? nA : cA + (size_t)(t + 2) * kstep; const char* b2 = last ? nB : cB + (size_t)(t + 2) * kstep;
            const char* a3 = a2 + kstep; const char* b3 = b2 + kstep;
            if (last && has_next) S.a_ready(nxt);
            if constexpr (SP2) {
            PG8_LDB(B0, 0, 0); PG8_LDB(B1, 0, 1); PG8_SCHED; PG8_LDA(At, 0, 0); PG8_STAGE(PG8_SA(1, 1), a1 + hstepA, voffA);
            PG8_WAIT_V(8); PG8_WAIT_L(0); PG8_BAR; PG8_MMA(0, 0, At, B0); PG8_MMA(0, 1, At, B1); PG8_BAR; PG8_SCHED;
            PG8_LDA(At, 0, 1); PG8_STAGE(PG8_SB(0, 0), b2, voffB); PG8_STAGE(PG8_SB(0, 1), b2 + hstepB, voffB); PG8_STAGE(PG8_SA(0, 0), a2, voffA);
            PG8_WAIT_V(8); PG8_WAIT_L(0); PG8_BAR; PG8_MMA(1, 0, At, B0); PG8_MMA(1, 1, At, B1); PG8_BAR; PG8_SCHED;
            PG8_LDB(B0, 1, 0); PG8_LDB(B1, 1, 1); PG8_SCHED; PG8_LDA(At, 1, 0); PG8_STAGE(PG8_SA(0, 1), a2 + hstepA, voffA);
            PG8_WAIT_V(8); PG8_WAIT_L(0); PG8_BAR; PG8_MMA(0, 0, At, B0); PG8_MMA(0, 1, At, B1); PG8_BAR; PG8_SCHED;
            PG8_LDA(At, 1, 1); PG8_STAGE(PG8_SB(1, 0), b3, voffB); PG8_STAGE(PG8_SB(1, 1), b3 + hstepB, voffB); PG8_STAGE(PG8_SA(1, 0), a3, voffA);
            PG8_WAIT_V(8); PG8_WAIT_L(0); PG8_BAR; PG8_MMA(1, 0, At, B0); PG8_MMA(1, 1, At, B1); PG8_BAR; PG8_SCHED;
            } else {
            PG8_LDB(B0, 0, 0); PG8_SCHED; PG8_LDA(At, 0, 0); PG8_STAGE(PG8_SA(1, 1), a1 + hstepA, voffA);
            PG8_WAIT_L(8); PG8_BAR; PG8_WAIT_L(0); PG8_MMA(0, 0, At, B0); PG8_BAR; PG8_SCHED;
            PG8_LDB(B1, 0, 1); PG8_STAGE(PG8_SB(0, 0), b2, voffB);
            PG8_BAR; PG8_WAIT_L(0); PG8_MMA(0, 1, At, B1); PG8_BAR;
            PG8_LDA(At, 0, 1); PG8_STAGE(PG8_SA(0, 0), a2, voffA);
            PG8_BAR; PG8_WAIT_L(0); PG8_MMA(1, 0, At, B0); PG8_BAR; PG8_SCHED;
            PG8_STAGE(PG8_SB(0, 1), b2 + hstepB, voffB);
            PG8_WAIT_V(6); PG8_BAR; PG8_MMA(1, 1, At, B1); PG8_BAR;
            PG8_LDB(B0, 1, 0); PG8_SCHED; PG8_LDA(At, 1, 0); PG8_STAGE(PG8_SA(0, 1), a2 + hstepA, voffA);
            PG8_WAIT_L(8); PG8_BAR; PG8_WAIT_L(0); PG8_MMA(0, 0, At, B0); PG8_BAR; PG8_SCHED;
            PG8_LDB(B1, 1, 1); PG8_STAGE(PG8_SB(1, 0), b3, voffB);
            PG8_BAR; PG8_WAIT_L(0); PG8_MMA(0, 1, At, B1); PG8_BAR;
            PG8_LDA(At, 1, 1); PG8_STAGE(PG8_SA(1, 0), a3, voffA);
            PG8_BAR; PG8_WAIT_L(0); PG8_MMA(1, 0, At, B0); PG8_BAR; PG8_SCHED;
            PG8_STAGE(PG8_SB(1, 1), b3 + hstepB, voffB);
            PG8_WAIT_V(6); PG8_BAR; PG8_MMA(1, 1, At, B1); PG8_BAR;
            }
        }
        if constexpr (ALIGN_EPI) { if (wr == 0) PG8_BAR; }
        if constexpr (!Epi::AFTER_DRAIN) { E(acc, cur, wr, wc, fr, fq); S.done(cur); }
        if (!has_next) break;
#pragma unroll
        for (int a = 0; a < 2; ++a)
#pragma unroll
            for (int b = 0; b < 2; ++b)
#pragma unroll
                for (int m = 0; m < 4; ++m)
#pragma unroll
                    for (int n = 0; n < 2; ++n) acc[a][b][m][n] = (f32x4){0.f, 0.f, 0.f, 0.f};
        cur = nxt; cA = nA; cB = nB; ++ui;
        if constexpr (ALIGN_EPI) { if (wr == 1) PG8_BAR; }
    }
    PG8_WAIT_V(0);
    if constexpr (!ALIGN_EPI) { if (wr == 0) PG8_BAR; }
    PG8_BAR;
    if constexpr (Epi::AFTER_DRAIN) { E.fused(acc, cur, wr, wc, fr, fq, lds, wid, lane); S.done(cur); }
#undef PG8_SA
#undef PG8_SB
#undef PG8_STAGE
#undef PG8_LDA
#undef PG8_LDB
#undef PG8_MMA
#undef PG8_WAIT_V
#undef PG8_WAIT_L
#undef PG8_BAR
#undef PG8_SCHED
}
}

namespace att {
using bf16 = __hip_bfloat16;
constexpr int D = 128, NW = 8, QBLK = 32, KVBLK = 64; constexpr float SCALE = 0.088388347648318440f; constexpr float THR = 8.f; constexpr int SDEPTH = 2;
constexpr int LDQ = 1024, LDK = 256, LDO = 1024;
constexpr size_t SHM_V = KVBLK * D * 2, SHM_K = KVBLK * D * 2, SHM_ATTN = 2 * SHM_V + 2 * SHM_K + NW * 64 * 4;
using bf16x8 = __attribute__((ext_vector_type(8))) short;
using s16x4  = __attribute__((ext_vector_type(4))) short;
using f32x16 = __attribute__((ext_vector_type(16))) float;
using f32x8  = __attribute__((ext_vector_type(8))) float;
using u32x4  = __attribute__((ext_vector_type(4))) unsigned;
#define KSWZ(row, colB) ((row) * 256 + ((colB) ^ (((row) & 7) << 4)))
#define SBAR() __builtin_amdgcn_sched_barrier(0)
__device__ __forceinline__ int crow(int r, int hi) { return (r & 3) + 8 * (r >> 2) + 4 * hi; }
__device__ __forceinline__ unsigned cvtpk(float lo, float hi) {
  unsigned r; asm volatile("v_cvt_pk_bf16_f32 %0, %1, %2" : "=v"(r) : "v"(lo), "v"(hi)); return r;
}
template <typename TIn> struct Stage;
template <> struct Stage<bf16>  { using T = bf16x8;
  __device__ static __forceinline__ T ld8(const bf16* p) { return *reinterpret_cast<const bf16x8*>(p); }
  __device__ static __forceinline__ bf16x8 tobf(T x) { return x; } };
template <> struct Stage<float> { using T = f32x8;
  __device__ static __forceinline__ T ld8(const float* p) { return *reinterpret_cast<const f32x8*>(p); }
  __device__ static __forceinline__ bf16x8 tobf(T x) {
    u32x4 w = {cvtpk(x[0], x[1]), cvtpk(x[2], x[3]), cvtpk(x[4], x[5]), cvtpk(x[6], x[7])}; return *reinterpret_cast<bf16x8*>(&w); } };

__device__ __forceinline__ void partialSM(f32x16& p0, f32x16& p1, float& m_reg, float& mn, float& alpha) {
  constexpr float C = SCALE * 1.4426950408889634f;
  float pmax = p0[0]; for (int r = 1; r < 16; ++r) pmax = fmaxf(pmax, p0[r]); for (int r = 0; r < 16; ++r) pmax = fmaxf(pmax, p1[r]);
  { auto rr = __builtin_amdgcn_permlane32_swap(__float_as_uint(pmax), __float_as_uint(pmax), false, false);
    pmax = fmaxf(__uint_as_float(rr[0]), __uint_as_float(rr[1])); }
  if (__builtin_expect(__all(pmax - m_reg <= THR / SCALE), 1)) { mn = m_reg; alpha = 1.f; }
  else { mn = fmaxf(m_reg, pmax); alpha = __builtin_amdgcn_exp2f((m_reg - mn) * C); m_reg = mn; }
  float mnC = -mn * C;
  for (int r = 0; r < 16; ++r) p0[r] = fmaf(p0[r], C, mnC); for (int r = 0; r < 16; ++r) p1[r] = fmaf(p1[r], C, mnC);
  for (int r = 0; r < 16; ++r) p0[r] = __builtin_amdgcn_exp2f(p0[r]);
}
__device__ __forceinline__ void finishSM(f32x16& p0, f32x16& p1, float alpha, float& l_reg, bf16x8& pa0, bf16x8& pa1, bf16x8& pa2, bf16x8& pa3) {
  for (int r = 0; r < 16; ++r) p1[r] = __builtin_amdgcn_exp2f(p1[r]);
  float ps = 0; for (int r = 0; r < 16; ++r) ps += p0[r]; for (int r = 0; r < 16; ++r) ps += p1[r];
  { auto rr = __builtin_amdgcn_permlane32_swap(__float_as_uint(ps), __float_as_uint(ps), false, false);
    ps = __uint_as_float(rr[0]) + __uint_as_float(rr[1]); }
  l_reg = l_reg * alpha + ps;
#define PK4(P, BASE, OUT) do { unsigned a0 = cvtpk(P[BASE + 0], P[BASE + 1]), a1 = cvtpk(P[BASE + 2], P[BASE + 3]);   \
    unsigned b0 = cvtpk(P[BASE + 4], P[BASE + 5]), b1 = cvtpk(P[BASE + 6], P[BASE + 7]);                              \
    auto r0 = __builtin_amdgcn_permlane32_swap(a0, b0, false, false); auto r1 = __builtin_amdgcn_permlane32_swap(a1, b1, false, false); \
    u32x4 w = {r0[0], r1[0], r0[1], r1[1]}; OUT = *reinterpret_cast<bf16x8*>(&w); } while (0)
  PK4(p0, 0, pa0); PK4(p0, 8, pa1); PK4(p1, 0, pa2); PK4(p1, 8, pa3);
#undef PK4
}
__device__ __forceinline__ void qkt(f32x16& p0, f32x16& p1, const bf16* Ks, const bf16x8* qr, int r32, int hi) {
  p0 = f32x16{}; p1 = f32x16{};
  for (int d0 = 0; d0 < 8; ++d0) { int cb = (d0 * 16 + hi * 8) * 2;
    bf16x8 b0 = *reinterpret_cast<const bf16x8*>((const char*)Ks + KSWZ(r32, cb));
    bf16x8 b1 = *reinterpret_cast<const bf16x8*>((const char*)Ks + KSWZ(32 + r32, cb));
    p0 = __builtin_amdgcn_mfma_f32_32x32x16_bf16(b0, qr[d0], p0, 0, 0, 0);
    p1 = __builtin_amdgcn_mfma_f32_32x32x16_bf16(b1, qr[d0], p1, 0, 0, 0); }
}
__device__ __forceinline__ int v_st(int k, int c) { const int kk = (k & ~0xC) | ((k & 4) << 1) | ((k & 8) >> 1); return ((kk >> 3) * 4 + (c >> 5)) * 512 + ((kk & 7) * 32 + (c & 31)) * 2; }
__device__ __forceinline__ int v_rd_base(int lane) { return ((lane & 3) << 3) | (((lane >> 2) & 3) << 6) | (((lane >> 4) & 1) << 5) | (((lane >> 5) & 1) << 8); }
constexpr int v_rd_off(int d0, int ks, int half) { return d0 * 512 + ks * 4096 + half * 2048; }
template <int OFF> __device__ __forceinline__ s16x4 tr_read(int vb) {
  s16x4 r; asm volatile("ds_read_b64_tr_b16 %0, %1 offset:%2" : "=&v"(r) : "v"(vb), "i"(OFF) : "memory"); return r;
}
template <int D0> __device__ __forceinline__ void pv_one(f32x16& od, int vb, bf16x8 pa0, bf16x8 pa1, bf16x8 pa2, bf16x8 pa3) {
  const s16x4 l0 = tr_read<v_rd_off(D0, 0, 0)>(vb), h0 = tr_read<v_rd_off(D0, 0, 1)>(vb), l1 = tr_read<v_rd_off(D0, 1, 0)>(vb), h1 = tr_read<v_rd_off(D0, 1, 1)>(vb);
  const s16x4 l2 = tr_read<v_rd_off(D0, 2, 0)>(vb), h2 = tr_read<v_rd_off(D0, 2, 1)>(vb), l3 = tr_read<v_rd_off(D0, 3, 0)>(vb), h3 = tr_read<v_rd_off(D0, 3, 1)>(vb);
  asm volatile("s_waitcnt lgkmcnt(0)" ::: "memory"); SBAR();
#define PK(L, H) (bf16x8){L[0], L[1], L[2], L[3], H[0], H[1], H[2], H[3]}
  od = __builtin_amdgcn_mfma_f32_32x32x16_bf16(pa0, PK(l0, h0), od, 0, 0, 0);
  od = __builtin_amdgcn_mfma_f32_32x32x16_bf16(pa1, PK(l1, h1), od, 0, 0, 0);
  od = __builtin_amdgcn_mfma_f32_32x32x16_bf16(pa2, PK(l2, h2), od, 0, 0, 0);
  od = __builtin_amdgcn_mfma_f32_32x32x16_bf16(pa3, PK(l3, h3), od, 0, 0, 0);
#undef PK
}
__device__ __forceinline__ void pv_d0(f32x16* o, int vb, bf16x8 pa0, bf16x8 pa1, bf16x8 pa2, bf16x8 pa3) {
  pv_one<0>(o[0], vb, pa0, pa1, pa2, pa3); pv_one<1>(o[1], vb, pa0, pa1, pa2, pa3); pv_one<2>(o[2], vb, pa0, pa1, pa2, pa3); pv_one<3>(o[3], vb, pa0, pa1, pa2, pa3);
}

template <typename TQ>
__device__ __forceinline__ void attn_dense_body(const TQ* __restrict__ Qb, const bf16* __restrict__ Kh, const bf16* __restrict__ Vh,
                                                bf16* __restrict__ Ob, int seq, char* lds) {
  using St = Stage<bf16>; using SQ = Stage<TQ>;
  int tid_ = threadIdx.x; asm volatile("" : "+v"(tid_));
  const int tid = tid_, wid = tid >> 6, lane = tid & 63, r32 = lane & 31, hi = lane >> 5;
  bf16* V_lds = (bf16*)lds; bf16* K_lds = (bf16*)(lds + 2 * SHM_V);
  float* ws = (float*)(lds + 2 * SHM_V + 2 * SHM_K) + wid * 64; float* li_l = ws; float* al_l = ws + 32;
  float m_reg = -1e30f, l_reg = 0; f32x16 o[4] = {}; bf16x8 qr[8];
  const TQ* Qw = Qb + (long)(wid * QBLK + r32) * LDQ + hi * 8;
#pragma unroll
  for (int d0 = 0; d0 < 8; ++d0) qr[d0] = SQ::tobf(SQ::ld8(Qw + d0 * 16));
  const int sr = tid >> 4, sc = (tid & 15) * 8, vst0 = v_st(sr, sc), vst1 = v_st(32 + sr, sc);
  const int vb0 = (int)(uintptr_t)V_lds + v_rd_base(lane);
  struct { typename St::T vs0, vs1, ks0, ks1; } sr_[SDEPTH];
#define SLOAD(i, k0) do { sr_[i].vs0 = St::ld8(&Vh[(long)((k0) + sr) * LDK + sc]); sr_[i].vs1 = St::ld8(&Vh[(long)((k0) + 32 + sr) * LDK + sc]); \
    sr_[i].ks0 = St::ld8(&Kh[(long)((k0) + sr) * LDK + sc]); sr_[i].ks1 = St::ld8(&Kh[(long)((k0) + 32 + sr) * LDK + sc]); } while (0)
#define SWRITE(b, i) do { *(bf16x8*)((char*)V_lds + (b) * SHM_V + vst0) = St::tobf(sr_[i].vs0);          \
    *(bf16x8*)((char*)V_lds + (b) * SHM_V + vst1) = St::tobf(sr_[i].vs1); int kc = sc * 2;               \
    *(bf16x8*)((char*)K_lds + (b) * SHM_K + KSWZ(sr, kc)) = St::tobf(sr_[i].ks0);                       \
    *(bf16x8*)((char*)K_lds + (b) * SHM_K + KSWZ(32 + sr, kc)) = St::tobf(sr_[i].ks1); } while (0)
#define SWAIT() do { if constexpr (SDEPTH == 2) asm volatile("s_waitcnt vmcnt(4)" ::: "memory"); else asm volatile("s_waitcnt vmcnt(0)" ::: "memory"); } while (0)
#define RESC(a) do { if (__any((a) < 1.f)) { if (hi == 0) al_l[r32] = (a); asm volatile("s_waitcnt lgkmcnt(0)" ::: "memory"); \
    for (int d = 0; d < 4; ++d) for (int r = 0; r < 16; ++r) o[d][r] *= al_l[crow(r, hi)]; } } while (0)
  f32x16 pA0, pA1, pB0, pB1; float mnA, mnB, alA, alB; bf16x8 pa0, pa1, pa2, pa3; const int NT = seq / KVBLK;
  constexpr int SE = 0, SO = SDEPTH - 1;
  SLOAD(SE, 0); asm volatile("s_waitcnt vmcnt(0)" ::: "memory"); SWRITE(0, SE); __syncthreads();
  qkt(pA0, pA1, K_lds, qr, r32, hi); partialSM(pA0, pA1, m_reg, mnA, alA);
  SLOAD(SO, KVBLK); if constexpr (SDEPTH == 2) { if (2 < NT) SLOAD(SE, 2 * KVBLK); }
  SWAIT(); SWRITE(1, SO); __syncthreads();
  for (int j = 1; j + 1 < NT; j += 2) {
    SBAR(); qkt(pB0, pB1, (bf16*)((char*)K_lds + SHM_K), qr, r32, hi);
    finishSM(pA0, pA1, alA, l_reg, pa0, pa1, pa2, pa3); SBAR();
    SLOAD(SO, (j + SDEPTH) * KVBLK); SBAR();
    pv_d0(o, vb0, pa0, pa1, pa2, pa3); partialSM(pB0, pB1, m_reg, mnB, alB);
    __syncthreads(); SWAIT(); SWRITE(0, SE);
    RESC(alB); __syncthreads();
    SBAR(); qkt(pA0, pA1, K_lds, qr, r32, hi);
    finishSM(pB0, pB1, alB, l_reg, pa0, pa1, pa2, pa3); SBAR();
    if (SDEPTH == 1 || j + 3 < NT) SLOAD(SE, (j + 1 + SDEPTH) * KVBLK); SBAR();
    pv_d0(o, vb0 + (int)SHM_V, pa0, pa1, pa2, pa3); partialSM(pA0, pA1, m_reg, mnA, alA);
    __syncthreads(); SWAIT(); SWRITE(1, SO);
    RESC(alA); __syncthreads();
  }
  SBAR(); qkt(pB0, pB1, (bf16*)((char*)K_lds + SHM_K), qr, r32, hi);
  finishSM(pA0, pA1, alA, l_reg, pa0, pa1, pa2, pa3); SBAR();
  pv_d0(o, vb0, pa0, pa1, pa2, pa3); partialSM(pB0, pB1, m_reg, mnB, alB);
  __syncthreads(); RESC(alB);
  finishSM(pB0, pB1, alB, l_reg, pa0, pa1, pa2, pa3); SBAR();
  pv_d0(o, vb0 + (int)SHM_V, pa0, pa1, pa2, pa3);
  if (hi == 0) li_l[r32] = l_reg; asm volatile("s_waitcnt lgkmcnt(0)" ::: "memory");
  float rli[16];
#pragma unroll
  for (int r = 0; r < 16; ++r) rli[r] = __builtin_amdgcn_rcpf(li_l[crow(r, hi)]);
  bf16* Ow = Ob + (long)(wid * QBLK) * LDO;
#pragma unroll
  for (int r = 0; r < 16; ++r) { int orow = crow(r, hi);
    for (int d0 = 0; d0 < 4; ++d0) Ow[(long)orow * LDO + d0 * 32 + r32] = __float2bfloat16(o[d0][r] * rli[r]); }
#undef SLOAD
#undef SWRITE
#undef SWAIT
#undef RESC
}
}

constexpr int NWAVES = 8;
constexpr int DM = 1024, NTOK = 8192, NPR = 4096, FF = 4096, INW = 2048, INE = 2080, QKVW = 1536;
constexpr float EPS = 1e-6f;
constexpr size_t OUT_Y = 0, OUT_S5RE = 8388608, OUT_S5IM = OUT_S5RE + 65536, OUT_GLA = OUT_S5IM + 65536, OUT_NK = OUT_GLA + 1048576, OUT_NV = OUT_NK + 1048576, OUT_END = OUT_NV + 1048576;
constexpr size_t MiB = 1u << 20;
constexpr size_t WS_CTL = 0, CTL_ZERO_BYTES = 64 * 1024;
constexpr size_t WS_ADA = 1 * MiB;
constexpr size_t WS_CV = WS_ADA + 512 * 1024;
constexpr size_t WS_WIN = 2 * MiB, WS_WGLR = 6 * MiB, WS_WGLU = 6 * MiB + 512 * 1024, WS_WOUT = 7 * MiB, WS_W1 = 9 * MiB, WS_W2 = 25 * MiB, WS_WQKV = 41 * MiB, WS_WO = 44 * MiB;
constexpr size_t WS_H = 46 * MiB, WS_Y = 62 * MiB, WS_SCR = 94 * MiB;
constexpr size_t WS_Z = WS_SCR, WS_GD = WS_SCR + 32 * MiB, WS_G = WS_SCR + 48 * MiB, WS_UH = WS_SCR + 56 * MiB, WS_SLOC = WS_SCR + 72 * MiB, WS_SIN = WS_SCR + 104 * MiB, WS_DEC = WS_SCR + 120 * MiB,
                 WS_MIX = WS_SCR + 121 * MiB, WS_EBUF = WS_MIX  , WS_WY = WS_SCR + 137 * MiB, WS_WE = WS_SCR + 145 * MiB  , WS_BB = WS_SCR + 153 * MiB, WS_KB = WS_SCR + 154 * MiB, WS_RSW = WS_SCR + 155 * MiB  ;
constexpr size_t WS_ACT = WS_SCR, WS_XBUF = WS_SCR + 72 * MiB;
constexpr size_t WS_QKV = WS_SCR, WS_QN = WS_SCR + 24 * MiB, WS_KP = WS_SCR + 40 * MiB, WS_KS = WS_SCR + 42 * MiB, WS_VP = WS_SCR + 45 * MiB, WS_VS = WS_SCR + 47 * MiB, WS_OB = WS_SCR + 50 * MiB;
constexpr size_t WS_END = WS_SCR + 156 * MiB;
static_assert(WS_END <= 256 * MiB, "d_ws map");
constexpr int CW_BAR = 1024;
constexpr int RING_BYTES = 131072, LDSCTL_OFF = RING_BYTES, MISC_OFF = LDSCTL_OFF + 320, LDS_BYTES = 147456;

#define GAS __attribute__((address_space(1)))
#define LAS __attribute__((address_space(3)))
typedef unsigned short bf16;
typedef unsigned v4u __attribute__((ext_vector_type(4)));
typedef unsigned v2u __attribute__((ext_vector_type(2)));
typedef float f32x4 __attribute__((ext_vector_type(4)));
typedef float f32x16 __attribute__((ext_vector_type(16)));
typedef short bf16x8 __attribute__((ext_vector_type(8)));
typedef short s16x4 __attribute__((ext_vector_type(4)));
typedef GAS unsigned gu32;
#define RLX_AGENT __ATOMIC_RELAXED, __HIP_MEMORY_SCOPE_AGENT
#define LDS_WAIT() asm volatile("s_waitcnt lgkmcnt(0)" ::: "memory")
#define VM_WAIT() asm volatile("s_waitcnt vmcnt(0)" ::: "memory")
__device__ __forceinline__ unsigned f2bf(float f) { unsigned u = __builtin_bit_cast(unsigned, f); return (u + 0x7fffu + ((u >> 16) & 1u)) >> 16; }
__device__ __forceinline__ unsigned pk2(float lo, float hi) { return f2bf(lo) | (f2bf(hi) << 16); }
__device__ __forceinline__ float bf2f(unsigned short b) { return __uint_as_float(((unsigned)b) << 16); }
__device__ __forceinline__ float bflo(unsigned w) { return __uint_as_float(w << 16); }
__device__ __forceinline__ float bfhi(unsigned w) { return __uint_as_float(w & 0xffff0000u); }
__device__ __forceinline__ float wave_sum(float v) {
#pragma unroll
    for (int o = 1; o < 64; o <<= 1) v += __shfl_xor(v, o);
    return v;
}
__device__ __forceinline__ int crow(int r, int hi) { return (r & 3) + 8 * (r >> 2) + 4 * hi; }
__device__ __forceinline__ s16x4 tr_read4(unsigned addr) { s16x4 r; asm volatile("ds_read_b64_tr_b16 %0, %1" : "=&v"(r) : "v"(addr) : "memory"); return r; }

#define XB_TMO      128
#define XB_XCNT(j)  (256  + 64 * (j))
#define XB_XSUB(j)  (1280 + 64 * (j))
#define XB_XGEN(j)  (2304 + 64 * (j))
#define XB_TOP      3328
#define XB_TOPGEN   3392
#define XCD_BAR_WORDS 3456
#define XB_SPIN_CAP (1u << 18)

__device__ __forceinline__ unsigned xb_ld(unsigned* p)              { return __hip_atomic_load(p, __ATOMIC_RELAXED, __HIP_MEMORY_SCOPE_AGENT); }
__device__ __forceinline__ unsigned xb_add(unsigned* p, unsigned v) { return __hip_atomic_fetch_add(p, v, __ATOMIC_RELAXED, __HIP_MEMORY_SCOPE_AGENT); }
__device__ __forceinline__ unsigned xb_xcc_id() { return (unsigned)__builtin_amdgcn_s_getreg((3 << 11) | 20) & 0xFu; }
#define XB_SPIN(cond, bar) do { unsigned _sp = 0; while (cond) { __builtin_amdgcn_s_sleep(1); \
    if ((++_sp & 255u) == 0u) { if (xb_ld(&(bar)[XB_TMO])) break; if (_sp > XB_SPIN_CAP) { atomicAdd(&(bar)[XB_TMO], 1u); break; } } } } while (0)

struct XcdBarrier {
    unsigned* bar; unsigned x;
    volatile LAS unsigned* st;
};

__device__ __forceinline__ XcdBarrier xcd_barrier_post(unsigned* bar, volatile LAS unsigned* st) {
    XcdBarrier b; b.bar = bar; b.x = xb_xcc_id(); b.st = st;
    if (threadIdx.x == 0) (void)xb_add(&bar[XB_XCNT(b.x)], 1u);
    return b;
}
__device__ __forceinline__ void xcd_barrier_complete(unsigned* bar, unsigned x, unsigned& nloc, unsigned& nx) {
    const unsigned G = gridDim.x * gridDim.y * gridDim.z;
    unsigned sum, cnt, mine, sp = 0u;
    for (;;) {
        sum = 0u; cnt = 0u; mine = 0u;
#pragma unroll
        for (unsigned j = 0; j < 16; ++j) { const unsigned c = xb_ld(&bar[XB_XCNT(j)]); sum += c; cnt += (c > 0u) ? 1u : 0u; mine = (j == x) ? c : mine; }
        if (sum == G) break;
        __builtin_amdgcn_s_sleep(1);
        if ((++sp & 255u) == 0u) { if (xb_ld(&bar[XB_TMO])) break; if (sp > XB_SPIN_CAP) { atomicAdd(&bar[XB_TMO], 1u); break; } }
    }
    nloc = mine > 0u ? mine : 1u; nx = cnt > 0u ? cnt : 1u;
}

__device__ __forceinline__ void xcd_barrier(const XcdBarrier& b) {
    asm volatile("s_waitcnt vmcnt(0)" ::: "memory");
    __syncthreads();
    if (threadIdx.x == 0) {
        unsigned* bar = b.bar;
        __builtin_amdgcn_s_waitcnt(0);
        unsigned nloc = b.st[0], nx = b.st[1];
        if (nloc == 0u) { xcd_barrier_complete(bar, b.x, nloc, nx); b.st[0] = nloc; b.st[1] = nx; }
        const unsigned old = xb_add(&bar[XB_XSUB(b.x)], 1u);
        const unsigned gen = old / nloc;
        if (old + 1u == (gen + 1u) * nloc) {
            __builtin_amdgcn_fence(__ATOMIC_RELEASE, "agent");
            asm volatile("s_waitcnt vmcnt(0)" ::: "memory");
            const unsigned og = xb_add(&bar[XB_TOP], 1u);
            const unsigned tg = og / nx;
            if (og + 1u == (tg + 1u) * nx) xb_add(&bar[XB_TOPGEN], 1u);
            else XB_SPIN(xb_ld(&bar[XB_TOPGEN]) == tg, bar);
            __builtin_amdgcn_fence(__ATOMIC_ACQUIRE, "agent");
            xb_add(&bar[XB_XGEN(b.x)], 1u);
            asm volatile("s_waitcnt vmcnt(0)" ::: "memory");
        } else {
            XB_SPIN(xb_ld(&bar[XB_XGEN(b.x)]) == gen, bar);
            __builtin_amdgcn_fence(__ATOMIC_ACQUIRE, "agent");
            asm volatile("s_waitcnt vmcnt(0)" ::: "memory");
        }
    }
    __syncthreads();
}


struct SplitKOrder { int pm, pn;
    __device__ __forceinline__ bool next(int i, pg8::Unit& u) const { if (i > 0) return false; u.pm = pm; u.pn = pn; return true; }
    __device__ __forceinline__ void a_ready(const pg8::Unit&) const {}
    __device__ __forceinline__ void done(const pg8::Unit&) const {} };
template <bool NEXT, bool BASE_BF16, bool OUT_BF16> struct EpiResidSplitT {
    static constexpr bool PERM = false, AFTER_DRAIN = true;
    const void* base_p; const void* base_s; void* out; const float* gate; bf16* xbuf; XcdBarrier bar; int kh;
    bf16* Hn; const float* nw; const float* nsc; float* rsw;
    template <int KH> __device__ __forceinline__ void run(f32x4 (&acc)[2][2][4][2], const pg8::Unit& u, int wr, int wc, int fr, int fq, int tid) const {
        const int tile = u.pm * 4 + u.pn;
        bf16* xs = xbuf + ((size_t)(tile * 2 + KH) * 16) * 2048 + tid * 4;
#pragma unroll
        for (int bj = 0; bj < 2; ++bj)
#pragma unroll
            for (int m = 0; m < 4; ++m)
#pragma unroll
                for (int n = 0; n < 2; ++n) { const f32x4 a = acc[1 - KH][bj][m][n]; v2u w; w.x = pk2(a[0], a[1]); w.y = pk2(a[2], a[3]); *(v2u*)(xs + ((bj * 4 + m) * 2 + n) * 2048) = w; }
        xcd_barrier(bar);
        const bf16* xr = xbuf + ((size_t)(tile * 2 + (1 - KH)) * 16) * 2048 + tid * 4; const void* base = u.pm < 16 ? base_p : base_s;
        const int row0 = u.pm * 256 + KH * 128 + wr * 64 + fr; const int col0 = u.pn * 256 + wc * 32 + 4 * fq;
        const int cond = u.pm < 16 ? 0 : 1 + ((u.pm - 16) >> 2);
        const float* gp = gate + cond * 6144;
        f32x4 gv[2][2];
#pragma unroll
        for (int bj = 0; bj < 2; ++bj)
#pragma unroll
            for (int n = 0; n < 2; ++n) gv[bj][n] = *(const f32x4*)(gp + col0 + bj * 128 + n * 16);
#pragma unroll
        for (int m = 0; m < 4; ++m) { const size_t off = (size_t)(row0 + m * 16) * 1024 + col0;
#pragma unroll
            for (int bj = 0; bj < 2; ++bj)
#pragma unroll
                for (int n = 0; n < 2; ++n) { const v2u pw = *(const v2u*)(xr + ((bj * 4 + m) * 2 + n) * 2048); const f32x4 p = {bflo(pw.x), bfhi(pw.x), bflo(pw.y), bfhi(pw.y)}; const size_t eo = off + bj * 128 + n * 16;
                    f32x4 b; if (BASE_BF16) { const v2u bw = *(const v2u*)((const bf16*)base + eo); b = (f32x4){bflo(bw.x), bfhi(bw.x), bflo(bw.y), bfhi(bw.y)}; } else b = *(const f32x4*)((const float*)base + eo);
                    const f32x4 y = b + gv[bj][n] * (acc[KH][bj][m][n] + p);
                    if (OUT_BF16) { v2u ow; ow.x = pk2(y[0], y[1]); ow.y = pk2(y[2], y[3]); *(v2u*)((bf16*)out + eo) = ow; } else *(f32x4*)((float*)out + eo) = y;
                    if (NEXT) acc[KH][bj][m][n] = y; }
            asm volatile("" ::: "memory"); }
        if (NEXT) {
            asm volatile("" ::: "memory");
            int row0b = row0, col0b = col0; asm volatile("" : "+v"(row0b), "+v"(col0b));
            f32x4 av[2][2];
#pragma unroll
            for (int bj = 0; bj < 2; ++bj)
#pragma unroll
                for (int n = 0; n < 2; ++n) av[bj][n] = *(const f32x4*)(nw + col0b + bj * 128 + n * 16) * (*(const f32x4*)(nsc + cond * 6144 + col0b + bj * 128 + n * 16) + 1.0f);
#pragma unroll
            for (int m = 0; m < 4; ++m) { const int row = row0b + m * 16; const size_t off = (size_t)row * 1024 + col0b; float ss = 0.f;
#pragma unroll
                for (int bj = 0; bj < 2; ++bj)
#pragma unroll
                    for (int n = 0; n < 2; ++n) { const f32x4 y = acc[KH][bj][m][n]; ss += (y[0] * y[0] + y[1] * y[1]) + (y[2] * y[2] + y[3] * y[3]); const f32x4 h = y * av[bj][n];
                        v2u w; w.x = pk2(h[0], h[1]); w.y = pk2(h[2], h[3]); *(v2u*)(Hn + off + bj * 128 + n * 16) = w; }
                ss += __shfl_xor(ss, 16); ss += __shfl_xor(ss, 32); if (fq == 0) rsw[(size_t)row * 16 + u.pn * 4 + wc] = ss; }
        }
    }
    __device__ __forceinline__ void fused(f32x4 (&acc)[2][2][4][2], const pg8::Unit& u, int wr, int wc, int fr, int fq, LAS unsigned char*, int wid, int lane) const {
        if (kh == 0) run<0>(acc, u, wr, wc, fr, fq, wid * 64 + lane); else run<1>(acc, u, wr, wc, fr, fq, wid * 64 + lane);
    }
};

struct Args { const float* in[34]; float* out; unsigned char* ws; int ph_lo, ph_hi; };
typedef const __attribute__((address_space(4))) Args CArgs;
__device__ __forceinline__ CArgs* kargs() { CArgs* p = (CArgs*)__builtin_amdgcn_kernarg_segment_ptr(); asm volatile("" : "+s"(p)); return p; }
#define KA (*kargs())
__device__ __forceinline__ int tid_opaque() { int t = threadIdx.x; asm volatile("" : "+v"(t)); return t; }

__device__ __forceinline__ void p0_transpose_item(const float* W, int ld, int K, bf16* WT, int nblk, LAS float* scr, int item, int lane) {
    const int kb = item / nblk, nb = item % nblk, k0 = 64 * kb, n0 = 32 * nb;
#pragma unroll 8
    for (int i = 0; i < 32; ++i) { const int kk = 2 * i + (lane >> 5); scr[kk * 33 + (lane & 31)] = W[(size_t)(k0 + kk) * ld + n0 + (lane & 31)]; }
    LDS_WAIT(); asm volatile("" ::: "memory");
    const int c = lane & 7;
#pragma unroll
    for (int j = 0; j < 4; ++j) { const int n = (lane >> 3) + 8 * j; const LAS float* s = scr + (8 * c) * 33 + n;
        v4u o; o.x = pk2(s[0 * 33], s[1 * 33]); o.y = pk2(s[2 * 33], s[3 * 33]); o.z = pk2(s[4 * 33], s[5 * 33]); o.w = pk2(s[6 * 33], s[7 * 33]);
        *(GAS v4u*)(WT + (size_t)(n0 + n) * K + k0 + 8 * c) = o; }
    LDS_WAIT(); asm volatile("" ::: "memory");
}
__device__ __forceinline__ void p0_prologue(CArgs& A, LAS unsigned char* lds, int tid, int lane, int wave) {
    unsigned char* ws = A.ws;
    {
        LAS float* sc = (LAS float*)(lds);
        LAS float* red = (LAS float*)(lds + 20480);
        for (int i = tid; i < 5 * 1024; i += 512) { const int c = i >> 10, k = i & 1023; const float x = c == 0 ? A.in[8][k] : A.in[7][(c - 1) * 1024 + k]; sc[i] = x / (1.f + __expf(-x)); }
        __syncthreads();
        for (int ab = blockIdx.x; ab < 256; ab += gridDim.x) {
        const int layer = ab >> 7, n0 = (ab & 127) * 48;
        const float* W = A.in[11] + (size_t)layer * 1024 * 6144 + n0;
        const int kq = lane / 12, nq = lane % 12;
        f32x4 acc[5];
#pragma unroll
        for (int c = 0; c < 5; ++c) acc[c] = (f32x4){0.f, 0.f, 0.f, 0.f};
        if (kq < 4) {
#pragma unroll 4
            for (int i = 0; i < 32; ++i) { const int k = 128 * wave + 4 * i + kq; const f32x4 w = *(const f32x4*)(W + (size_t)k * 6144 + 4 * nq);
#pragma unroll
                for (int c = 0; c < 5; ++c) acc[c] += w * sc[c * 1024 + k]; }
#pragma unroll
            for (int c = 0; c < 5; ++c) *(LAS f32x4*)(red + ((wave * 4 + kq) * 5 + c) * 48 + 4 * nq) = acc[c];
        }
        __syncthreads();
        if (tid < 240) { const int c = tid / 48, n = tid % 48; float s = 0.f;
#pragma unroll 8
            for (int p = 0; p < 32; ++p) s += red[(p * 5 + c) * 48 + n];
            ((float*)(ws + WS_ADA))[(size_t)(layer * 5 + c) * 6144 + n0 + n] = s + A.in[12][layer * 6144 + n0 + n]; }
        __syncthreads();
        }
    }
    LAS float* scr = (LAS float*)(lds + wave * 16384);
    const int gw = blockIdx.x * NWAVES + wave, NGW = gridDim.x * NWAVES;
    constexpr int I_IN = 16 * 65, I_OUT = 16 * 32, I_GLU = 8 * 16, I_M1 = 16 * 128, I_M2 = 64 * 32, I_QKV = 16 * 48, I_WO = 16 * 32;
    constexpr int NITEMS = I_IN + I_OUT + I_GLU + 2 * I_M1 + 2 * I_M2 + I_QKV + I_WO;
    for (int it = gw; it < NITEMS; it += NGW) {
        int r = it;
        if (r < I_IN) { const int kb = r / 65, nb = r % 65;
            if (nb < 64) p0_transpose_item(A.in[15], INE, 1024, (bf16*)(ws + WS_WIN), 64, scr, kb * 64 + nb, lane);
            else p0_transpose_item(A.in[15] + 2048, INE, 1024, (bf16*)(ws + WS_WGLR), 1, scr, kb, lane);
            continue; } r -= I_IN;
        if (r < I_OUT) { p0_transpose_item(A.in[16], 1024, 1024, (bf16*)(ws + WS_WOUT), 32, scr, r, lane); continue; } r -= I_OUT;
        if (r < I_GLU) { p0_transpose_item(A.in[25], 512, 512, (bf16*)(ws + WS_WGLU), 16, scr, r, lane); continue; } r -= I_GLU;
        if (r < 2 * I_M1) { const int l = r / I_M1; p0_transpose_item(A.in[13] + (size_t)l * 1024 * 4096, 4096, 1024, (bf16*)(ws + WS_W1) + (size_t)l * 4096 * 1024, 128, scr, r % I_M1, lane); continue; } r -= 2 * I_M1;
        if (r < 2 * I_M2) { const int l = r / I_M2; p0_transpose_item(A.in[14] + (size_t)l * 4096 * 1024, 1024, 4096, (bf16*)(ws + WS_W2) + (size_t)l * 1024 * 4096, 32, scr, r % I_M2, lane); continue; } r -= 2 * I_M2;
        if (r < I_QKV) { p0_transpose_item(A.in[30], 1536, 1024, (bf16*)(ws + WS_WQKV), 48, scr, r, lane); continue; } r -= I_QKV;
        p0_transpose_item(A.in[31], 1024, 1024, (bf16*)(ws + WS_WO), 32, scr, r, lane);
    }
}

template <bool GLR>
__device__ __forceinline__ void norm_phase(CArgs& A, LAS unsigned char* lds, const float* src_p, const float* src_s, const float* g, const float* ada, int ch_shift, int ch_scale,
                                           int tid, int lane, int wave) {
    unsigned char* ws = A.ws;
    bf16* H = (bf16*)(ws + WS_H);
    for (int blk = blockIdx.x; blk < NTOK / 32; blk += gridDim.x) {
        const int r0 = blk * 32; const int cond = r0 < NPR ? 0 : 1 + ((r0 - NPR) >> 10);
        const float* src = r0 < NPR ? src_p : src_s;
        const float* adc = ada + cond * 6144;
        f32x4 ga[4], gb[4];
#pragma unroll
        for (int j = 0; j < 4; ++j) { const int col = 4 * lane + 256 * j; const f32x4 gg = *(const f32x4*)(g + col), s1 = *(const f32x4*)(adc + ch_scale * 1024 + col); ga[j] = gg * (s1 + 1.0f); gb[j] = *(const f32x4*)(adc + ch_shift * 1024 + col); }
#pragma unroll
        for (int i = 0; i < 4; ++i) { const int row = r0 + wave * 4 + i;
            const GAS f32x4* xr = (const GAS f32x4*)(src + (size_t)row * 1024) + lane;
            f32x4 v[4]; float s = 0.f;
#pragma unroll
            for (int j = 0; j < 4; ++j) { v[j] = xr[64 * j]; s += (v[j].x * v[j].x + v[j].y * v[j].y) + (v[j].z * v[j].z + v[j].w * v[j].w); }
            const float rstd = 1.f / sqrtf(wave_sum(s) * (1.f / 1024.f) + EPS);
            GAS v2u* o8 = (GAS v2u*)(H + (size_t)row * 1024) + lane;
#pragma unroll
            for (int j = 0; j < 4; ++j) { const f32x4 h = v[j] * rstd * ga[j] + gb[j]; v2u w; w.x = pk2(h.x, h.y); w.y = pk2(h.z, h.w); o8[64 * j] = w;
                if (GLR) *(LAS v2u*)(lds + (wave * 4 + i) * 2064 + (4 * lane + 256 * j) * 2) = w; }
        }
        if (GLR) {
            __syncthreads();
            const bf16* WG = (const bf16*)(ws + WS_WGLR);
            const int r32 = lane & 31, hi = lane >> 5;
            f32x16 acc = {};
#pragma unroll
            for (int ks = 0; ks < 8; ++ks) { const int k = wave * 128 + ks * 16 + hi * 8;
                const bf16x8 a = *(const LAS bf16x8*)(lds + r32 * 2064 + k * 2);
                const bf16x8 b = *(const bf16x8*)(WG + (size_t)r32 * 1024 + k);
                acc = __builtin_amdgcn_mfma_f32_32x32x16_bf16(a, b, acc, 0, 0, 0); }
            LAS float* red = (LAS float*)(lds + 69632);
#pragma unroll
            for (int r = 0; r < 16; ++r) red[(wave * 32 + crow(r, hi)) * 32 + r32] = acc[r];
            __syncthreads();
            LAS float* glrs = (LAS float*)(lds + 69632 + 32768);
#pragma unroll
            for (int e = 0; e < 2; ++e) { const int idx = tid + 512 * e; float s = 0.f;
#pragma unroll
                for (int w = 0; w < 8; ++w) s += red[w * 1024 + idx];
                glrs[idx] = s; }
            __syncthreads();
            { const int dcol = tid >> 8, hk = tid & 255; float wg2[16];
#pragma unroll
                for (int r = 0; r < 16; ++r) wg2[r] = A.in[27][(size_t)(dcol * 16 + r) * 256 + hk];
                const float bg = A.in[28][dcol * 256 + hk];
                bf16* GDo = (bf16*)(ws + WS_GD);
                for (int row = 0; row < 32; ++row) { float x = bg;
#pragma unroll
                    for (int r = 0; r < 16; ++r) x = fmaf(glrs[row * 32 + 16 * dcol + r], wg2[r], x);
                    const float ls = fminf(x, 0.f) - __logf(1.f + __expf(-fabsf(x)));
                    GDo[(size_t)(r0 + row) * 512 + tid] = (bf16)f2bf(ls * (1.f / 16.f)); } }
            __syncthreads();
        }
    }
}

__device__ __forceinline__ float gelu_tanh(float y) { const float z = 0.7978845608028654f * (y + 0.044715f * y * y * y); const float e = __expf(2.f * z); const float t = 1.f - 2.f / (e + 1.f); return 0.5f * y * (1.f + t); }
#define S5_PW(lds) ((LAS float*)(lds))
#define S5_BB(lds) (S5_PW(lds) + 2 * 17 * 64 * 2)
#define S5_CL(lds) (S5_BB(lds) + 2 * 64 * 16 * 2)
#define S5_KL(lds) (S5_CL(lds) + 16 * 64 * 2)
__device__ __forceinline__ void s5_small(CArgs& A, LAS unsigned char* lds, int g, bool write_bb, int tid) {
    unsigned char* ws = A.ws;
    LAS float* Pw = S5_PW(lds); LAS float* BBl = S5_BB(lds); LAS float* Cl = S5_CL(lds);
    if (tid < 128) { const int d = tid >> 6, p = tid & 63;
        const float lre = A.in[17][(d * 32 + g) * 64 + p], lim = A.in[18][(d * 32 + g) * 64 + p];
        const float dt = __expf(A.in[19][d * 32 + g]);
        const float a_ = lre * dt, th = lim * dt;
        const float sn = __sinf(th), cs = __cosf(th);
        const float ea = __expf(a_);
        const float lb_re = ea * cs, lb_im = ea * sn;
        const float sh = __sinf(0.5f * th);
        const float em1 = a_ * (1.f + a_ * (0.5f + a_ * (0.16666667f + a_ * (0.041666668f + a_ * 0.0083333338f))));
        const float nr = em1 * cs - 2.f * sh * sh, ni = ea * sn;
        const float den = 1.f / (lre * lre + lim * lim);
        const float cf_re = (nr * lre + ni * lim) * den, cf_im = (ni * lre - nr * lim) * den;
        float pr = 1.f, pi = 0.f;
        for (int t = 0; t <= 16; ++t) { Pw[((d * 17 + t) * 64 + p) * 2] = pr; Pw[((d * 17 + t) * 64 + p) * 2 + 1] = pi; const float n0 = pr * lb_re - pi * lb_im, n1 = pr * lb_im + pi * lb_re; pr = n0; pi = n1; }
        float* BBg = (float*)(ws + WS_BB) + (size_t)(g * 2 + d) * 2048;
#pragma unroll
        for (int c = 0; c < 16; ++c) { const float br = A.in[20][(size_t)(g * 64 + p) * 16 + c], bi = A.in[21][(size_t)(g * 64 + p) * 16 + c];
            const float vr = cf_re * br - cf_im * bi, vi = cf_re * bi + cf_im * br;
            BBl[((d * 64 + p) * 16 + c) * 2] = vr; BBl[((d * 64 + p) * 16 + c) * 2 + 1] = vi; if (write_bb) { BBg[p * 16 + c] = vr; BBg[1024 + p * 16 + c] = vi; } }
    } else { for (int i = tid - 128; i < 1024; i += 384) { Cl[i * 2] = A.in[22][(size_t)g * 1024 + i]; Cl[i * 2 + 1] = A.in[23][(size_t)g * 1024 + i]; } }
    __syncthreads();
}
__device__ __forceinline__ void s5_k_slice(CArgs& A, LAS unsigned char* lds, int g, int q, int tid) {
    LAS float* Pw = S5_PW(lds); LAS float* BBl = S5_BB(lds); LAS float* Cl = S5_CL(lds);
    float* KB = (float*)(A.ws + WS_KB) + (size_t)g * 8192;
#pragma unroll
    for (int e = 0; e < 2; ++e) { const int o = q * 1024 + tid + 512 * e; const int d = o >> 12, tau = (o >> 8) & 15, c = (o >> 4) & 15, c2 = o & 15; float s = 0.f;
#pragma unroll 4
        for (int p = 0; p < 64; ++p) { const float cr = Cl[(c * 64 + p) * 2], ci = Cl[(c * 64 + p) * 2 + 1], pr = Pw[((d * 17 + tau) * 64 + p) * 2], pi = Pw[((d * 17 + tau) * 64 + p) * 2 + 1];
            const float zr = cr * pr - ci * pi, zi = cr * pi + ci * pr; s += zr * BBl[((d * 64 + p) * 16 + c2) * 2] - zi * BBl[((d * 64 + p) * 16 + c2) * 2 + 1]; }
        KB[o] = s; }
    __syncthreads();
}
__device__ __forceinline__ void s5_expand(CArgs& A, LAS unsigned char* lds, int g, int q, int tid) {
    unsigned char* ws = A.ws;
    LAS float* Pw = S5_PW(lds); LAS float* BBl = S5_BB(lds); LAS float* Cl = S5_CL(lds); LAS float* Kl = S5_KL(lds);
    { const float* KB = (const float*)(ws + WS_KB) + (size_t)g * 8192;
        for (int i = tid; i < 2048; i += 512) *(LAS f32x4*)(Kl + 4 * i) = *(const f32x4*)(KB + 4 * i); }
    __syncthreads();
    unsigned* WYg = (unsigned*)((bf16*)(ws + WS_WY) + (size_t)g * 256 * 512);
    for (int i = q * 32 * 256 + tid; i < (q + 1) * 32 * 256; i += 512) { const int n = i >> 8, k0 = (i & 255) * 2; const int t = n >> 4, c = n & 15; float v[2];
#pragma unroll
        for (int e = 0; e < 2; ++e) { const int k = k0 + e;
            if (k < 256) { const int s_ = k >> 4, c2 = k & 15;
                if (s_ < t) v[e] = Kl[((0 * 16 + (t - s_)) * 16 + c) * 16 + c2];
                else if (s_ > t) v[e] = Kl[((1 * 16 + (s_ - t)) * 16 + c) * 16 + c2];
                else v[e] = Kl[((0 * 16 + 0) * 16 + c) * 16 + c2] + Kl[((1 * 16 + 0) * 16 + c) * 16 + c2] + (c == c2 ? A.in[24][g * 16 + c] : 0.f);
            } else { const int kk = k - 256, d = kk >> 7, im = (kk >> 6) & 1, p = kk & 63; const int tau = d == 0 ? t + 1 : 16 - t;
                const float cr = Cl[(c * 64 + p) * 2], ci = Cl[(c * 64 + p) * 2 + 1], pr = Pw[((d * 17 + tau) * 64 + p) * 2], pi = Pw[((d * 17 + tau) * 64 + p) * 2 + 1];
                v[e] = im ? -(cr * pi + ci * pr) : (cr * pr - ci * pi); } }
        WYg[i] = pk2(v[0], v[1]); }
    unsigned* WEg = (unsigned*)((bf16*)(ws + WS_WE) + (size_t)g * 256 * 512);
    for (int i = q * 32 * 128 + tid; i < (q + 1) * 32 * 128; i += 512) { const int n = i >> 7, k0 = (i & 127) * 2; const int d = n >> 7, im = (n >> 6) & 1, p = n & 63; float v[2];
#pragma unroll
        for (int e = 0; e < 2; ++e) { const int k = k0 + e, s_ = k >> 4, c2 = k & 15; const int tau = d == 0 ? 15 - s_ : s_;
            const float pr = Pw[((d * 17 + tau) * 64 + p) * 2], pi = Pw[((d * 17 + tau) * 64 + p) * 2 + 1], br = BBl[((d * 64 + p) * 16 + c2) * 2], bi = BBl[((d * 64 + p) * 16 + c2) * 2 + 1];
            v[e] = im ? (pr * bi + pi * br) : (pr * br - pi * bi); }
        WEg[n * 256 + (i & 127)] = pk2(v[0], v[1]); }
    __syncthreads();
}
__device__ __forceinline__ void s5_recur(CArgs& A, LAS unsigned char* lds, int g, int mt, int tid) {
    unsigned char* ws = A.ws;
    const bf16* EB = (const bf16*)(ws + WS_EBUF) + (size_t)(g * 512 + mt * 256) * 256;
    bf16* UHg = (bf16*)(ws + WS_UH) + (size_t)(g * 512 + mt * 256) * 512;
    LAS float* El = (LAS float*)lds;
    const int nrow = mt == 0 ? 16 : 64;
    for (int d = 0; d < 2; ++d) {
        for (int i = tid; i < 256 * 32; i += 512) { const int r = i >> 5, q = i & 31; const v2u ew = *(const v2u*)(EB + (size_t)r * 256 + d * 128 + 4 * q); *(LAS f32x4*)(El + r * 128 + 4 * q) = (f32x4){bflo(ew.x), bfhi(ew.x), bflo(ew.y), bfhi(ew.y)}; }
        __syncthreads();
        const int nseq = mt == 0 ? 16 : 4;
        for (int idx = tid; idx < nseq * 64; idx += 512) { const int p = idx & 63, b = idx >> 6;
            const float lre = A.in[17][(d * 32 + g) * 64 + p], lim = A.in[18][(d * 32 + g) * 64 + p];
            const float dt = __expf(A.in[19][d * 32 + g]);
            const float sn = __sinf(lim * dt), cs = __cosf(lim * dt); const float ea = __expf(lre * dt);
            float pr = ea * cs, pi = ea * sn;
#pragma unroll
            for (int s_ = 0; s_ < 4; ++s_) { const float n0 = pr * pr - pi * pi, n1 = 2.f * pr * pi; pr = n0; pi = n1; }
            float hr = 0.f, hi_ = 0.f;
            if (mt == 1) { hr = A.in[2][(size_t)((b * 2 + d) * 32 + g) * 64 + p]; hi_ = A.in[3][(size_t)((b * 2 + d) * 32 + g) * 64 + p]; }
            for (int st = 0; st < nrow; ++st) { const int r = b * nrow + (d == 0 ? st : nrow - 1 - st);
                bf16* up = UHg + (size_t)r * 512 + 256 + d * 128 + p; up[0] = (bf16)f2bf(hr); up[64] = (bf16)f2bf(hi_);
                const float er = El[r * 128 + p], ei = El[r * 128 + 64 + p];
                const float n0 = pr * hr - pi * hi_ + er, n1 = pr * hi_ + pi * hr + ei; hr = n0; hi_ = n1; }
            if (mt == 0) {
                const int r = b * 16 + (d == 0 ? 0 : 15), s_ = d == 0 ? 0 : 15;
                const float* BBg = (const float*)(ws + WS_BB) + (size_t)(g * 2 + d) * 2048 + p * 16; const bf16* up = UHg + (size_t)r * 512 + s_ * 16;
                float fr_ = 0.f, fi_ = 0.f;
#pragma unroll
                for (int c = 0; c < 16; ++c) { const float u = bf2f(up[c]); fr_ = fmaf(BBg[c], u, fr_); fi_ = fmaf(BBg[1024 + c], u, fi_); }
                A.out[OUT_S5RE + (size_t)((b * 2 + d) * 32 + g) * 64 + p] = fr_; A.out[OUT_S5IM + (size_t)((b * 2 + d) * 32 + g) * 64 + p] = fi_; }
        }
        __syncthreads();
    }
    VM_WAIT(); __syncthreads();
}
struct GroupOrder { int c, G_;
    __device__ __forceinline__ bool next(int i, pg8::Unit& u) const { const int L = i * G_ + c; if (L >= 64) return false; u.pm = L; u.pn = L >> 1; return true; }
    __device__ __forceinline__ void a_ready(const pg8::Unit&) const {}
    __device__ __forceinline__ void done(const pg8::Unit&) const {} };
struct EpiF32 {
    static constexpr bool PERM = false, AFTER_DRAIN = false; bf16* O;
    __device__ __forceinline__ void operator()(const f32x4 (&acc)[2][2][4][2], const pg8::Unit& u, int wr, int wc, int fr, int fq) const {
        const int row0 = u.pm * 256 + wr * 64 + fr, col0 = wc * 32 + 4 * fq;
#pragma unroll
        for (int ai = 0; ai < 2; ++ai)
#pragma unroll
            for (int m = 0; m < 4; ++m)
#pragma unroll
                for (int bj = 0; bj < 2; ++bj)
#pragma unroll
                    for (int n = 0; n < 2; ++n) { const f32x4 a = acc[ai][bj][m][n]; v2u w; w.x = pk2(a[0], a[1]); w.y = pk2(a[2], a[3]); *(v2u*)(O + (size_t)(row0 + ai * 128 + m * 16) * 256 + col0 + bj * 128 + n * 16) = w; }
    }
};
struct EpiS5Y {
    static constexpr bool PERM = true, AFTER_DRAIN = false; bf16* Gp;
    __device__ __forceinline__ void operator()(const f32x4 (&acc)[2][2][4][2], const pg8::Unit& u, int wr, int wc, int fr, int fq) const {
        const int g = u.pm >> 1, jj0 = (u.pm & 1) * 256 + wr * 64 + fr, col0 = wc * 32 + 8 * fq;
#pragma unroll
        for (int ai = 0; ai < 2; ++ai)
#pragma unroll
            for (int m = 0; m < 4; ++m) { const int jj = jj0 + ai * 128 + m * 16;
#pragma unroll
                for (int bj = 0; bj < 2; ++bj) { const int n = col0 + bj * 128, t = n >> 4, c0 = n & 15; const f32x4 v0 = acc[ai][bj][m][0], v1 = acc[ai][bj][m][1];
                    v4u w; w.x = pk2(gelu_tanh(v0[0]), gelu_tanh(v0[1])); w.y = pk2(gelu_tanh(v0[2]), gelu_tanh(v0[3])); w.z = pk2(gelu_tanh(v1[0]), gelu_tanh(v1[1])); w.w = pk2(gelu_tanh(v1[2]), gelu_tanh(v1[3]));
                    *(v4u*)(Gp + (size_t)(16 * jj + t) * 512 + g * 16 + c0) = w; } }
    }
};
struct EpiZU {
    static constexpr bool PERM = true, AFTER_DRAIN = false; bf16* Zp; bf16* UHp;
    __device__ __forceinline__ void operator()(const f32x4 (&acc)[2][2][4][2], const pg8::Unit& u, int wr, int wc, int fr, int fq) const {
        const int row0 = u.pm * 256 + wr * 64 + fr; const int col0 = u.pn * 256 + wc * 32 + 8 * fq;
#pragma unroll
        for (int ai = 0; ai < 2; ++ai)
#pragma unroll
            for (int m = 0; m < 4; ++m) { const int row = row0 + ai * 128 + m * 16;
#pragma unroll
                for (int bj = 0; bj < 2; ++bj) { const f32x4 v0 = acc[ai][bj][m][0], v1 = acc[ai][bj][m][1]; const int col = col0 + bj * 128;
                    v4u w; w.x = pk2(v0[0], v0[1]); w.y = pk2(v0[2], v0[3]); w.z = pk2(v1[0], v1[1]); w.w = pk2(v1[2], v1[3]);
                    if (u.pn < 2) *(v4u*)(UHp + ((size_t)(col >> 4) * 512 + (row >> 4)) * 512 + (row & 15) * 16 + (col & 15)) = w;
                    else *(v4u*)(Zp + (size_t)row * 2048 + col) = w; } }
    }
};

__device__ __forceinline__ int gla_slot(int bb, int h, int d, int j) { return bb < 16 ? ((bb * 4 + h) * 2 + d) * 4 + j : 512 + (((bb - 16) * 4 + h) * 2 + d) * 16 + j; }
constexpr int GL_V = 0, GL_VROW = 320;
constexpr int GL_KT = 20480, GL_KTROW = 144;
constexpr int GL_TOT = GL_KT + 4 * 9216;
constexpr int GL_PART = GL_TOT + 2048;
constexpr int GL_BYTES = GL_PART + 1024;
template <int MODE>
__device__ __forceinline__ void gla_prep(CArgs& A, LAS unsigned char* lds, int bb, int h, int j, int row0, int tid, int lane, int wave) {
    unsigned char* ws = A.ws;
    const bf16* Z = (const bf16*)(ws + WS_Z); const bf16* GDi = (const bf16*)(ws + WS_GD);
    const int d = wave >> 2, wg = wave & 3;
#pragma unroll
    for (int i = 0; i < 2; ++i) { const int r = (tid >> 4) + 32 * i, c = tid & 15;
        const v4u v = *(const v4u*)(Z + (size_t)(row0 + r) * 2048 + 1024 + h * 128 + 8 * c);
        *(LAS v4u*)(lds + GL_V + r * GL_VROW + c * 16) = v; }
    float gd[16]; float tot = 0.f;
#pragma unroll
    for (int i = 0; i < 16; ++i) { gd[i] = bf2f(GDi[(size_t)(row0 + 16 * wg + i) * 512 + d * 256 + h * 64 + lane]); tot += gd[i]; }
    LAS float* TOT = (LAS float*)(lds + GL_TOT);
    TOT[(d * 4 + wg) * 64 + lane] = tot;
    __syncthreads();
    float off = 0.f, total = 0.f;
#pragma unroll
    for (int w = 0; w < 4; ++w) { const float tw = TOT[(d * 4 + w) * 64 + lane]; total += tw; if (d == 0 ? (w < wg) : (w > wg)) off += tw; }
    float bcum[16];
    if (d == 0) { float s = off;
#pragma unroll
        for (int i = 0; i < 16; ++i) { s += gd[i]; bcum[i] = s; } }
    else { float s = off;
#pragma unroll
        for (int i = 15; i >= 0; --i) { s += gd[i]; bcum[i] = s; } }
    LAS unsigned char* img = lds + GL_KT + d * 2 * 9216;
    if (MODE == 0) {
        unsigned pkk[8];
#pragma unroll
        for (int i = 0; i < 16; i += 2) { const float k0 = bf2f(Z[(size_t)(row0 + 16 * wg + i) * 2048 + 768 + h * 64 + lane]), k1 = bf2f(Z[(size_t)(row0 + 16 * wg + i + 1) * 2048 + 768 + h * 64 + lane]);
            pkk[i >> 1] = pk2(k0 * __expf(total - bcum[i]), k1 * __expf(total - bcum[i + 1])); }
        *(LAS v4u*)(img + lane * GL_KTROW + 32 * wg) = (v4u){pkk[0], pkk[1], pkk[2], pkk[3]};
        *(LAS v4u*)(img + lane * GL_KTROW + 32 * wg + 16) = (v4u){pkk[4], pkk[5], pkk[6], pkk[7]};
        if (wg == 0) ((float*)(ws + WS_DEC))[(size_t)gla_slot(bb, h, d, j) * 64 + lane] = __expf(total);
    } else {
#pragma unroll
        for (int i = 0; i < 16; ++i) { const size_t zr = (size_t)(row0 + 16 * wg + i) * 2048 + h * 64 + lane;
            const float q = bf2f(Z[zr + 512]) * 0.125f, k = bf2f(Z[zr + 768]);
            *(LAS unsigned short*)(img + (16 * wg + i) * GL_KTROW + lane * 2) = (unsigned short)f2bf(q * __expf(bcum[i]));
            *(LAS unsigned short*)(img + 9216 + (16 * wg + i) * GL_KTROW + lane * 2) = (unsigned short)f2bf(k * __expf(-bcum[i])); }
    }
    __syncthreads();
}
__device__ __forceinline__ void gla_task_rows(int task, int& bb, int& h, int& j, int& row0) {
    if (task < 256) { bb = task >> 4; h = (task >> 2) & 3; j = task & 3; row0 = bb * 256 + 64 * j; }
    else { const int t = task - 256; bb = 16 + (t >> 6); h = (t >> 4) & 3; j = t & 15; row0 = NPR + (bb - 16) * 1024 + 64 * j; }
}
__device__ __forceinline__ void gla_a_task(CArgs& A, LAS unsigned char* lds, int task, int tid, int lane, int wave) {
    int bb, h, j, row0; gla_task_rows(task, bb, h, j, row0);
    gla_prep<0>(A, lds, bb, h, j, row0, tid, lane, wave);
    const int d = wave >> 2, wg = wave & 3, r32 = lane & 31, hi = lane >> 5;
    const unsigned lbase = (unsigned)(uintptr_t)(lds);
    const unsigned vaddr = lbase + GL_V + (8 * hi + ((lane & 15) >> 2)) * GL_VROW + (32 * wg + 16 * ((lane >> 4) & 1) + 4 * (lane & 3)) * 2;
    LAS unsigned char* img = lds + GL_KT + d * 2 * 9216;
    f32x16 acc0 = {}, acc1 = {};
#pragma unroll
    for (int ks = 0; ks < 4; ++ks) {
        const s16x4 lo = tr_read4(vaddr + (16 * ks) * GL_VROW), hi4 = tr_read4(vaddr + (16 * ks + 4) * GL_VROW);
        const bf16x8 b0 = *(const LAS bf16x8*)(img + r32 * GL_KTROW + (16 * ks + 8 * hi) * 2);
        const bf16x8 b1 = *(const LAS bf16x8*)(img + (32 + r32) * GL_KTROW + (16 * ks + 8 * hi) * 2);
        asm volatile("s_waitcnt lgkmcnt(0)" ::: "memory"); __builtin_amdgcn_sched_barrier(0);
        const bf16x8 a = (bf16x8){lo[0], lo[1], lo[2], lo[3], hi4[0], hi4[1], hi4[2], hi4[3]};
        acc0 = __builtin_amdgcn_mfma_f32_32x32x16_bf16(a, b0, acc0, 0, 0, 0);
        acc1 = __builtin_amdgcn_mfma_f32_32x32x16_bf16(a, b1, acc1, 0, 0, 0);
    }
    bf16* SL = (bf16*)(A.ws + WS_SLOC) + (size_t)gla_slot(bb, h, d, j) * 8192;
    { bf16* slp = SL + (32 * wg + 4 * hi) * 64 + r32;
#pragma unroll
    for (int r = 0; r < 16; ++r) { slp[((r & 3) + 8 * (r >> 2)) * 64] = (bf16)f2bf(acc0[r]); slp[((r & 3) + 8 * (r >> 2)) * 64 + 32] = (bf16)f2bf(acc1[r]); } }
    __syncthreads();
}
template <int N>
__device__ __forceinline__ void gla_b_chain(CArgs& A, int bb, int h, int d, int v, int kk, bool samp) {
    unsigned char* ws = A.ws;
    const bf16* SL = (const bf16*)(ws + WS_SLOC); const float* DEC = (const float*)(ws + WS_DEC); bf16* SIN = (bf16*)(ws + WS_SIN);
    f32x4 dc[N], sl[N];
#pragma unroll
    for (int i = 0; i < N; ++i) { const int j = d == 0 ? i : N - 1 - i; const size_t slot = (size_t)gla_slot(bb, h, d, j);
        dc[i] = *(const f32x4*)(DEC + slot * 64 + kk); const v2u sw = *(const v2u*)(SL + slot * 8192 + v * 64 + kk); sl[i] = (f32x4){bflo(sw.x), bfhi(sw.x), bflo(sw.y), bfhi(sw.y)}; }
    f32x4 S = {0.f, 0.f, 0.f, 0.f};
    if (samp) { const float* s0 = A.in[4] + (size_t)(((bb - 16) * 2 + d) * 4 + h) * 8192;
#pragma unroll
        for (int q = 0; q < 4; ++q) S[q] = s0[(kk + q) * 128 + v]; }
#pragma unroll
    for (int i = 0; i < N; ++i) { const int j = d == 0 ? i : N - 1 - i; const size_t slot = (size_t)gla_slot(bb, h, d, j);
        v2u w; w.x = pk2(S.x, S.y); w.y = pk2(S.z, S.w); *(v2u*)(SIN + slot * 8192 + v * 64 + kk) = w;
        S = S * dc[i] + sl[i]; }
    if (!samp) { float* o = A.out + OUT_GLA + (size_t)((bb * 2 + d) * 4 + h) * 8192;
#pragma unroll
        for (int q = 0; q < 4; ++q) o[(kk + q) * 128 + v] = S[q]; }
}
__device__ __forceinline__ void gla_b_phase(CArgs& A, int gtid, int nthreads) {
    for (int it = gtid; it < 160 * 2048; it += nthreads) {
        const int s = it >> 11, e = it & 2047;
        const int grp = s / 5, m = s % 5; const int chain = m == 4 ? 128 + grp : grp * 4 + m;
        const bool samp = chain >= 128; const int ci = samp ? chain - 128 : chain;
        const int bb = (samp ? 16 : 0) + (ci >> 3), h = (ci >> 1) & 3, d = ci & 1;
        const int v = e >> 4, kk = (e & 15) * 4;
        if (samp) gla_b_chain<16>(A, bb, h, d, v, kk, true); else gla_b_chain<4>(A, bb, h, d, v, kk, false);
    }
}
__device__ __forceinline__ void gla_c_task(CArgs& A, LAS unsigned char* lds, int task, int tid, int lane, int wave) {
    int bb, h, j, row0; gla_task_rows(task, bb, h, j, row0);
    gla_prep<1>(A, lds, bb, h, j, row0, tid, lane, wave);
    unsigned char* ws = A.ws;
    const bf16* Z = (const bf16*)(ws + WS_Z); const bf16* SIN = (const bf16*)(ws + WS_SIN); bf16* MIX = (bf16*)(ws + WS_MIX);
    const int ti = wave >> 2, vi = wave & 3, r32 = lane & 31, hi = lane >> 5;
    const unsigned lbase = (unsigned)(uintptr_t)(lds);
    const unsigned vaddr = lbase + GL_V + (4 * hi + ((lane & 15) >> 2)) * GL_VROW + (32 * vi + 16 * ((lane >> 4) & 1) + 4 * (lane & 3)) * 2;
    f32x16 o = {};
    const int t = 32 * ti + r32;
#pragma unroll
    for (int d = 0; d < 2; ++d) {
        LAS unsigned char* qimg = lds + GL_KT + d * 2 * 9216; LAS unsigned char* kimg = qimg + 9216;
        bf16x8 qf[4];
#pragma unroll
        for (int ks = 0; ks < 4; ++ks) qf[ks] = *(const LAS bf16x8*)(qimg + t * GL_KTROW + (16 * ks + 8 * hi) * 2);
        const bf16* SI = SIN + (size_t)gla_slot(bb, h, d, j) * 8192 + (size_t)(32 * vi + r32) * 64 + 8 * hi;
#pragma unroll
        for (int ks = 0; ks < 4; ++ks) { const bf16x8 sa = *(const bf16x8*)(SI + 16 * ks); o = __builtin_amdgcn_mfma_f32_32x32x16_bf16(sa, qf[ks], o, 0, 0, 0); }
#pragma unroll
        for (int si = 0; si < 2; ++si) {
            f32x16 x = {};
#pragma unroll
            for (int ks = 0; ks < 4; ++ks) { const bf16x8 ka = *(const LAS bf16x8*)(kimg + (32 * si + r32) * GL_KTROW + (16 * ks + 8 * hi) * 2); x = __builtin_amdgcn_mfma_f32_32x32x16_bf16(ka, qf[ks], x, 0, 0, 0); }
            unsigned pw[8];
#pragma unroll
            for (int r = 0; r < 16; r += 2) { const int s0 = 32 * si + crow(r, hi), s1 = s0 + 1;
                const float x0 = (d == 0 ? (s0 <= t) : (s0 >= t)) ? x[r] : 0.f, x1 = (d == 0 ? (s1 <= t) : (s1 >= t)) ? x[r + 1] : 0.f;
                pw[r >> 1] = pk2(x0, x1); }
#pragma unroll
            for (int sp = 0; sp < 2; ++sp) {
                const s16x4 lo = tr_read4(vaddr + (32 * si + 16 * sp) * GL_VROW), hi4 = tr_read4(vaddr + (32 * si + 16 * sp + 8) * GL_VROW);
                asm volatile("s_waitcnt lgkmcnt(0)" ::: "memory"); __builtin_amdgcn_sched_barrier(0);
                const bf16x8 va = (bf16x8){lo[0], lo[1], lo[2], lo[3], hi4[0], hi4[1], hi4[2], hi4[3]};
                const v4u pq = {pw[4 * sp], pw[4 * sp + 1], pw[4 * sp + 2], pw[4 * sp + 3]};
                o = __builtin_amdgcn_mfma_f32_32x32x16_bf16(va, __builtin_bit_cast(bf16x8, pq), o, 0, 0, 0);
            }
        }
    }
    float ss = 0.f;
#pragma unroll
    for (int r = 0; r < 16; ++r) ss += o[r] * o[r];
    ss += __shfl_xor(ss, 32);
    LAS float* PART = (LAS float*)(lds + GL_PART);
    if (hi == 0) PART[(ti * 4 + vi) * 32 + r32] = ss;
    __syncthreads();
    const float tot = PART[(ti * 4 + 0) * 32 + r32] + PART[(ti * 4 + 1) * 32 + r32] + PART[(ti * 4 + 2) * 32 + r32] + PART[(ti * 4 + 3) * 32 + r32];
    const float rstd = 1.f / sqrtf(tot * (1.f / 128.f) + EPS);
    const size_t row = (size_t)(row0 + t);
#pragma unroll
    for (int rq = 0; rq < 4; ++rq) { const int v = 32 * vi + 8 * rq + 4 * hi;
        const v2u rr = *(const v2u*)(Z + row * 2048 + 1536 + h * 128 + v);
        const f32x4 gn = *(const f32x4*)(A.in[29] + v);
        float rv[4] = {bflo(rr.x), bfhi(rr.x), bflo(rr.y), bfhi(rr.y)}; float ov[4];
#pragma unroll
        for (int e = 0; e < 4; ++e) { const float sl = rv[e] / (1.f + __expf(-rv[e])); ov[e] = o[4 * rq + e] * rstd * gn[e] * sl; }
        v2u w; w.x = pk2(ov[0], ov[1]); w.y = pk2(ov[2], ov[3]);
        *(v2u*)(MIX + row * 1024 + 512 + h * 128 + v) = w; }
    __syncthreads();
}

__device__ __forceinline__ void qk_phase(CArgs& A, int lane, int gw, int ngw) {
    unsigned char* ws = A.ws;
    const bf16* QKV = (const bf16*)(ws + WS_QKV); bf16* QN = (bf16*)(ws + WS_QN);
    const float qw0 = A.in[32][2 * lane], qw1 = A.in[32][2 * lane + 1], kw0 = A.in[33][2 * lane], kw1 = A.in[33][2 * lane + 1];
    const float inv = __powf(10000.f, -(float)(2 * (lane & 31)) / 64.f);
    for (int cr = gw; cr < 2048; cr += ngw) {
        const int b = cr >> 9, pl = cr & 511;
        const f32x4 kx = *(const f32x4*)(A.in[5] + (size_t)(b * 512 + pl) * 256 + 4 * lane), vx = *(const f32x4*)(A.in[6] + (size_t)(b * 512 + pl) * 256 + 4 * lane);
        v2u kwd, vwd; kwd.x = pk2(kx.x, kx.y); kwd.y = pk2(kx.z, kx.w); vwd.x = pk2(vx.x, vx.y); vwd.y = pk2(vx.z, vx.w);
        *(v2u*)((bf16*)(ws + WS_KS) + (size_t)(b * 1536 + 1024 + pl) * 256 + 4 * lane) = kwd;
        *(v2u*)((bf16*)(ws + WS_VS) + (size_t)(b * 1536 + 1024 + pl) * 256 + 4 * lane) = vwd;
    }
    for (int base = gw; base < NTOK; base += 4 * ngw) {
      unsigned wq[4][12];
#pragma unroll
      for (int r = 0; r < 4; ++r) { const int row = base + r * ngw; const unsigned* src = (const unsigned*)(QKV + (size_t)(row < NTOK ? row : base) * QKVW);
#pragma unroll
          for (int hd = 0; hd < 12; ++hd) wq[r][hd] = src[hd * 64 + lane]; }
#pragma unroll
      for (int r = 0; r < 4; ++r) { const int row = base + r * ngw; if (row >= NTOK) continue;
        const bool samp = row >= NPR; const int b = samp ? (row - NPR) >> 10 : row >> 8, t = samp ? (row - NPR) & 1023 : row & 255;
        float cs = 1.f, sn = 0.f;
        if (samp) { const float pos = (float)(lane < 32 ? (t >> 6) : (t & 63)); sn = __sinf(pos * inv); cs = __cosf(pos * inv); }
        bf16* kdst = samp ? (bf16*)(ws + WS_KS) + (size_t)(b * 1536 + t) * 256 : (bf16*)(ws + WS_KP) + (size_t)row * 256;
        bf16* vdst = samp ? (bf16*)(ws + WS_VS) + (size_t)(b * 1536 + t) * 256 : (bf16*)(ws + WS_VP) + (size_t)row * 256;
        float xa[10], xb[10], ssq[10];
#pragma unroll
        for (int hd = 0; hd < 10; ++hd) { const unsigned w = wq[r][hd]; xa[hd] = bflo(w); xb[hd] = bfhi(w); ssq[hd] = xa[hd] * xa[hd] + xb[hd] * xb[hd]; }
#pragma unroll
        for (int of = 1; of < 64; of <<= 1) {
#pragma unroll
            for (int hd = 0; hd < 10; ++hd) ssq[hd] += __shfl_xor(ssq[hd], of); }
#pragma unroll
        for (int hd = 0; hd < 10; ++hd) {
            float x0 = xa[hd], x1 = xb[hd];
            const float rstd = 1.f / sqrtf(ssq[hd] * (1.f / 128.f) + EPS);
            x0 *= rstd * (hd < 8 ? qw0 : kw0); x1 *= rstd * (hd < 8 ? qw1 : kw1);
            if (hd >= 8 && !samp) { float* nk = A.out + OUT_NK + ((size_t)row * 2 + (hd - 8)) * 128 + 2 * lane; nk[0] = x0; nk[1] = x1; }
            const float y0 = x0 * cs - x1 * sn, y1 = x0 * sn + x1 * cs;
            const unsigned ow = pk2(y0, y1);
            if (hd < 8) ((unsigned*)(QN + (size_t)row * 1024))[hd * 64 + lane] = ow;
            else ((unsigned*)kdst)[(hd - 8) * 64 + lane] = ow;
        }
#pragma unroll
        for (int hv = 0; hv < 2; ++hv) { const unsigned w = wq[r][10 + hv]; ((unsigned*)vdst)[hv * 64 + lane] = w;
            if (!samp) { float* nv = A.out + OUT_NV + ((size_t)row * 2 + hv) * 128 + 2 * lane; nv[0] = bflo(w); nv[1] = bfhi(w); } }
      }
    }
}


struct EpiQKV {
    static constexpr bool PERM = true, AFTER_DRAIN = true;
    const float* rsw; const float* cv; const float* qn; const float* kn; unsigned char* wsb; float* outp;
    __device__ __forceinline__ void fused(f32x4 (&acc)[2][2][4][2], const pg8::Unit& u, int wr, int wc, int fr, int fq, LAS unsigned char* lds, int wid, int lane) const {
        const int row0 = u.pm * 256 + wr * 64 + fr, d0 = wc * 32 + 8 * fq;
        const int cond = u.pm < 16 ? 0 : 1 + ((u.pm - 16) >> 2); const bool samp = u.pm >= 16;
        f32x4 cvv[2][2];
#pragma unroll
        for (int bj = 0; bj < 2; ++bj)
#pragma unroll
            for (int n = 0; n < 2; ++n) cvv[bj][n] = *(const f32x4*)(cv + (size_t)cond * 1536 + u.pn * 256 + bj * 128 + d0 + 4 * n);
#pragma unroll
        for (int ai = 0; ai < 2; ++ai)
#pragma unroll
            for (int m = 0; m < 4; ++m) { const int row = row0 + ai * 128 + m * 16;
                const f32x4* rp = (const f32x4*)(rsw + (size_t)row * 16); const f32x4 s4 = (rp[0] + rp[1]) + (rp[2] + rp[3]);
                const float rstd = 1.0f / sqrtf(((s4[0] + s4[1]) + (s4[2] + s4[3])) * (1.f / 1024.f) + EPS);
#pragma unroll
                for (int bj = 0; bj < 2; ++bj)
#pragma unroll
                    for (int n = 0; n < 2; ++n) acc[ai][bj][m][n] = acc[ai][bj][m][n] * rstd + cvv[bj][n]; }
        if (u.pn == 5) {
#pragma unroll
            for (int ai = 0; ai < 2; ++ai)
#pragma unroll
                for (int m = 0; m < 4; ++m) { const int row = row0 + ai * 128 + m * 16;
                    bf16* vdst = samp ? (bf16*)(wsb + WS_VS) + (size_t)(((row - NPR) >> 10) * 1536 + ((row - NPR) & 1023)) * 256 : (bf16*)(wsb + WS_VP) + (size_t)row * 256;
#pragma unroll
                    for (int bj = 0; bj < 2; ++bj) { const f32x4 v0 = acc[ai][bj][m][0], v1 = acc[ai][bj][m][1];
                        v4u w; w.x = pk2(v0[0], v0[1]); w.y = pk2(v0[2], v0[3]); w.z = pk2(v1[0], v1[1]); w.w = pk2(v1[2], v1[3]);
                        *(v4u*)(vdst + bj * 128 + d0) = w;
                        if (!samp) { float* nv = outp + OUT_NV + ((size_t)row * 2 + bj) * 128 + d0; *(f32x4*)nv = (f32x4){bflo(w.x), bfhi(w.x), bflo(w.y), bfhi(w.y)}; *(f32x4*)(nv + 4) = (f32x4){bflo(w.z), bfhi(w.z), bflo(w.w), bfhi(w.w)}; } } }
            return;
        }
        LAS float* part = (LAS float*)lds;
#pragma unroll
        for (int ai = 0; ai < 2; ++ai)
#pragma unroll
            for (int m = 0; m < 4; ++m)
#pragma unroll
                for (int bj = 0; bj < 2; ++bj) { const f32x4 v0 = acc[ai][bj][m][0], v1 = acc[ai][bj][m][1];
                    float ss = ((v0[0] * v0[0] + v0[1] * v0[1]) + (v0[2] * v0[2] + v0[3] * v0[3])) + ((v1[0] * v1[0] + v1[1] * v1[1]) + (v1[2] * v1[2] + v1[3] * v1[3]));
                    ss += __shfl_xor(ss, 16); ss += __shfl_xor(ss, 32);
                    if (fq == 0) part[((ai * 128 + wr * 64 + m * 16 + fr) * 2 + bj) * 4 + wc] = ss; }
        __syncthreads();
        const bool isk = u.pn == 4; const float* nwp = (isk ? kn : qn) + d0;
        const f32x4 w0 = *(const f32x4*)nwp, w1 = *(const f32x4*)(nwp + 4);
        float inv[4];
#pragma unroll
        for (int e = 0; e < 4; ++e) inv[e] = __builtin_amdgcn_exp2f(-(float)(((d0 >> 1) + e) & 31) * (13.287712379549449f / 32.f));
#pragma unroll
        for (int ai = 0; ai < 2; ++ai)
#pragma unroll
            for (int m = 0; m < 4; ++m) { const int rl = ai * 128 + wr * 64 + m * 16 + fr, row = u.pm * 256 + rl;
                const int t = samp ? (row - NPR) & 1023 : 0; const float pos = (float)((d0 >> 1) < 32 ? (t >> 6) : (t & 63));
                float cs[4], sn[4];
#pragma unroll
                for (int e = 0; e < 4; ++e) { if (samp) { sn[e] = __sinf(pos * inv[e]); cs[e] = __cosf(pos * inv[e]); } else { sn[e] = 0.f; cs[e] = 1.f; } }
#pragma unroll
                for (int bj = 0; bj < 2; ++bj) { const f32x4 pt = *(const LAS f32x4*)(part + (rl * 2 + bj) * 4);
                    const float rstd = 1.0f / sqrtf(((pt[0] + pt[1]) + (pt[2] + pt[3])) * (1.f / 128.f) + EPS);
                    const f32x4 x0 = acc[ai][bj][m][0] * rstd * w0, x1 = acc[ai][bj][m][1] * rstd * w1;
                    const int head = u.pn * 2 + bj;
                    if (isk && !samp) { float* nk = outp + OUT_NK + ((size_t)row * 2 + bj) * 128 + d0; *(f32x4*)nk = x0; *(f32x4*)(nk + 4) = x1; }
                    v4u w; w.x = pk2(x0[0] * cs[0] - x0[1] * sn[0], x0[0] * sn[0] + x0[1] * cs[0]); w.y = pk2(x0[2] * cs[1] - x0[3] * sn[1], x0[2] * sn[1] + x0[3] * cs[1]);
                    w.z = pk2(x1[0] * cs[2] - x1[1] * sn[2], x1[0] * sn[2] + x1[1] * cs[2]); w.w = pk2(x1[2] * cs[3] - x1[3] * sn[3], x1[2] * sn[3] + x1[3] * cs[3]);
                    if (!isk) *(v4u*)((bf16*)(wsb + WS_QN) + (size_t)row * 1024 + head * 128 + d0) = w;
                    else { bf16* kdst = samp ? (bf16*)(wsb + WS_KS) + (size_t)(((row - NPR) >> 10) * 1536 + t) * 256 : (bf16*)(wsb + WS_KP) + (size_t)row * 256; *(v4u*)(kdst + bj * 128 + d0) = w; } } }
    }
};
__device__ __forceinline__ void kv_cache_rows(CArgs& A, int lane, int gw, int ngw) {
    unsigned char* ws = A.ws;
    for (int cr = gw; cr < 2048; cr += ngw) { const int b = cr >> 9, pl = cr & 511;
        const f32x4 kx = *(const f32x4*)(A.in[5] + (size_t)(b * 512 + pl) * 256 + 4 * lane), vx = *(const f32x4*)(A.in[6] + (size_t)(b * 512 + pl) * 256 + 4 * lane);
        v2u kwd, vwd; kwd.x = pk2(kx.x, kx.y); kwd.y = pk2(kx.z, kx.w); vwd.x = pk2(vx.x, vx.y); vwd.y = pk2(vx.z, vx.w);
        *(v2u*)((bf16*)(ws + WS_KS) + (size_t)(b * 1536 + 1024 + pl) * 256 + 4 * lane) = kwd;
        *(v2u*)((bf16*)(ws + WS_VS) + (size_t)(b * 1536 + 1024 + pl) * 256 + 4 * lane) = vwd; }
}

__device__ __forceinline__ void cv_phase(CArgs& A, int lane, int gw, int ngw) {
    unsigned char* ws = A.ws; const float* ADAp = (const float*)(ws + WS_ADA); float* CV = (float*)(ws + WS_CV);
    for (int c = gw; c < 4096 + 1536 + 4096; c += ngw) {
        const bf16* wrow; const float* sh; float* o; int ncv;
        if (c < 4096) { wrow = (const bf16*)(ws + WS_W1) + (size_t)c * 1024; sh = ADAp + 3 * 1024; o = CV + c; ncv = 4096; }
        else if (c < 5632) { wrow = (const bf16*)(ws + WS_WQKV) + (size_t)(c - 4096) * 1024; sh = ADAp + 5 * 6144; o = CV + 5 * 4096 + (c - 4096); ncv = 1536; }
        else { wrow = (const bf16*)(ws + WS_W1) + (size_t)4096 * 1024 + (size_t)(c - 5632) * 1024; sh = ADAp + 5 * 6144 + 3 * 1024; o = CV + 5 * 4096 + 5 * 1536 + (c - 5632); ncv = 4096; }
        const v4u w0 = *(const v4u*)(wrow + 16 * lane), w1 = *(const v4u*)(wrow + 16 * lane + 8);
        float wf[16];
#pragma unroll
        for (int e = 0; e < 4; ++e) { wf[2 * e] = bflo(w0[e]); wf[2 * e + 1] = bfhi(w0[e]); wf[8 + 2 * e] = bflo(w1[e]); wf[8 + 2 * e + 1] = bfhi(w1[e]); }
        float ps[5];
#pragma unroll
        for (int cond = 0; cond < 5; ++cond) { const f32x4* sp = (const f32x4*)(sh + cond * 6144 + 16 * lane); float s = 0.f;
#pragma unroll
            for (int q = 0; q < 4; ++q) { const f32x4 s4 = sp[q]; s += (s4[0] * wf[4 * q] + s4[1] * wf[4 * q + 1]) + (s4[2] * wf[4 * q + 2] + s4[3] * wf[4 * q + 3]); }
            ps[cond] = s; }
#pragma unroll
        for (int of = 1; of < 64; of <<= 1) {
#pragma unroll
            for (int cond = 0; cond < 5; ++cond) ps[cond] += __shfl_xor(ps[cond], of); }
        if (lane < 5) { float v = ps[0];
#pragma unroll
            for (int cond = 1; cond < 5; ++cond) v = lane == cond ? ps[cond] : v;
            o[(size_t)lane * ncv] = v; }
    }
}

#ifndef DBL_MASK
#define DBL_MASK 0u
#endif
#ifndef XBAR_N
#define XBAR_N 0
#endif
__global__ void __launch_bounds__(NWAVES * 64, 2) fwd_kernel(Args args_unused) {
    extern __shared__ __attribute__((aligned(16))) unsigned char lds_raw[];
#define lds ((LAS unsigned char*)lds_raw)
#define MISC ((volatile LAS unsigned*)(lds + MISC_OFF))
#define tid (tid_opaque())
#define lane (tid_opaque() & 63)
#define wave (__builtin_amdgcn_readfirstlane(tid_opaque() >> 6))
#define G ((int)gridDim.x)
#define ws (kargs()->ws)
#define ADA ((const float*)(ws + WS_ADA))
#define H ((bf16*)(ws + WS_H))
#define Y ((bf16*)(ws + WS_Y))
#define xs_off (KA.in[1] - (size_t)NPR * 1024)
#define ADA1 (ADA + 5 * 6144)
    for (int u = tid; u < (LDS_BYTES - LDSCTL_OFF) / 4; u += NWAVES * 64) ((LAS unsigned*)(lds + LDSCTL_OFF))[u] = 0u;
    __syncthreads();
    (void)xcd_barrier_post((unsigned*)((gu32*)(ws + WS_CTL) + CW_BAR), MISC + 8);
#define MKBAR() XcdBarrier bar; bar.bar = (unsigned*)((gu32*)(ws + WS_CTL) + CW_BAR); bar.x = xb_xcc_id(); bar.st = MISC + 8;
#define IN(k) (KA.ph_lo <= (k) && (k) < KA.ph_hi)
#define SEAM(k) do { if ((k) + 1 < KA.ph_hi) { MKBAR(); xcd_barrier(bar); } } while (0)
#define REPS(k) (((DBL_MASK >> (k)) & 1u) ? 2 : 1)
#define SEAM2(k) do { if (rep_ + 1 < REPS(k)) { MKBAR(); xcd_barrier(bar); } else SEAM(k); } while (0)

    if (IN(0)) for (int rep_ = 0; rep_ < REPS(0); ++rep_) { p0_prologue(KA, lds, tid, lane, wave); __syncthreads(); s5_small(KA, lds, (int)blockIdx.x >> 3, ((int)blockIdx.x & 7) == 0, tid); s5_k_slice(KA, lds, (int)blockIdx.x >> 3, (int)blockIdx.x & 7, tid); SEAM2(0); }
    for (int xb_ = 0; xb_ < XBAR_N; ++xb_) { MKBAR(); xcd_barrier(bar); }
    if (IN(1)) for (int rep_ = 0; rep_ < REPS(1); ++rep_) { norm_phase<true>(KA, lds, KA.in[0], xs_off, KA.in[9], ADA, 0, 1, tid, lane, wave); __syncthreads(); s5_small(KA, lds, (int)blockIdx.x >> 3, false, tid); s5_expand(KA, lds, (int)blockIdx.x >> 3, (int)blockIdx.x & 7, tid); SEAM2(1); }
    if (IN(2)) for (int rep_ = 0; rep_ < REPS(2); ++rep_) { pg8::Gemm g{H, (const bf16*)(ws + WS_WIN), NTOK, INW, 1024, 1024, 1024}; pg8::StaticOrder S; S.init(NTOK, INW, G, (int)blockIdx.x);
        EpiZU E{(bf16*)(ws + WS_Z), (bf16*)(ws + WS_UH)};
        pg8::gemm_phase<EpiZU, pg8::StaticOrder, true, true>(lds, g, S, E); SEAM2(2); }
    if (IN(3)) for (int rep_ = 0; rep_ < REPS(3); ++rep_) {
        if ((int)blockIdx.x < 64) { pg8::Gemm g{(const bf16*)(ws + WS_UH), (const bf16*)(ws + WS_WE), 16384, 8192, 256, 512, 512}; GroupOrder S{(int)blockIdx.x, 64};
            EpiF32 E{(bf16*)(ws + WS_EBUF)};
            pg8::gemm_phase<EpiF32, GroupOrder, true, true>(lds, g, S, E);
            { int task_ = (int)blockIdx.x; asm volatile("" : "+s"(task_)); gla_a_task(KA, lds, task_, tid, lane, wave); } }
        else { for (int task = (int)blockIdx.x; task < 512; task += 192) gla_a_task(KA, lds, task, tid, lane, wave); }
        SEAM2(3); }
    if (IN(4)) for (int rep_ = 0; rep_ < REPS(4); ++rep_) {
        if ((int)blockIdx.x < 64) { s5_recur(KA, lds, (int)blockIdx.x >> 1, (int)blockIdx.x & 1, tid);
            pg8::Gemm g{(const bf16*)(ws + WS_UH), (const bf16*)(ws + WS_WY), 16384, 8192, 512, 512, 512}; GroupOrder S{(int)blockIdx.x, 64};
            EpiS5Y E{(bf16*)(ws + WS_G)};
            pg8::gemm_phase<EpiS5Y, GroupOrder, true, true>(lds, g, S, E); }
        else gla_b_phase(KA, ((int)blockIdx.x - 64) * 512 + tid, 192 * 512);
        SEAM2(4); }
    if (IN(5)) for (int rep_ = 0; rep_ < REPS(5); ++rep_) {
        if ((int)blockIdx.x < 64) { pg8::Gemm g{(const bf16*)(ws + WS_G), (const bf16*)(ws + WS_WGLU), NTOK, 512, 512, 512, 512}; pg8::StaticOrder S; S.init(NTOK, 512, 64, (int)blockIdx.x);
            pg8::EpiGlu E{(const bf16*)(ws + WS_G), (bf16*)(ws + WS_MIX), KA.in[26]};
            pg8::gemm_phase<pg8::EpiGlu, pg8::StaticOrder, true, true>(lds, g, S, E);
            { int task_ = (int)blockIdx.x; asm volatile("" : "+s"(task_)); gla_c_task(KA, lds, task_, tid, lane, wave); } }
        else { for (int task = (int)blockIdx.x; task < 512; task += 192) gla_c_task(KA, lds, task, tid, lane, wave);
            if ((int)blockIdx.x >= 128) cv_phase(KA, lane, ((int)blockIdx.x - 128) * NWAVES + wave, 128 * NWAVES); }
        SEAM2(5); }
    if (IN(6)) for (int rep_ = 0; rep_ < REPS(6); ++rep_) { const int bx = blockIdx.x, kh = (bx >> 3) & 1, jx = bx >> 4;
        pg8::Gemm g{(const bf16*)(ws + WS_MIX) + kh * 512, (const bf16*)(ws + WS_WOUT) + kh * 512, NTOK, 1024, 512, 1024, 1024}; SplitKOrder S{4 * (bx & 7) + (jx >> 2), jx & 3};
        MKBAR(); EpiResidSplitT<true, false, true> E{KA.in[0], xs_off, Y, ADA + 2 * 1024, (bf16*)(ws + WS_XBUF), bar, kh, H, KA.in[10], ADA + 4 * 1024, (float*)(ws + WS_RSW)};
        pg8::gemm_phase<EpiResidSplitT<true, false, true>, SplitKOrder, false, true>(lds, g, S, E); SEAM2(6); }
    if (IN(8)) for (int rep_ = 0; rep_ < REPS(8); ++rep_) { pg8::Gemm g{H, (const bf16*)(ws + WS_W1), NTOK, FF, 1024, 1024, 1024}; pg8::StaticOrder S; S.init(NTOK, FF, G, (int)blockIdx.x);
        pg8::EpiBf16<2, true> E{(bf16*)(ws + WS_ACT), FF, (const float*)(ws + WS_RSW), (const float*)(ws + WS_CV), 4096};
        pg8::gemm_phase<pg8::EpiBf16<2, true>, pg8::StaticOrder, true, true>(lds, g, S, E); SEAM2(8); }
    if (IN(9)) for (int rep_ = 0; rep_ < REPS(9); ++rep_) { const int bx = blockIdx.x, kh = (bx >> 3) & 1, jx = bx >> 4;
        pg8::Gemm g{(const bf16*)(ws + WS_ACT) + kh * 2048, (const bf16*)(ws + WS_W2) + kh * 2048, NTOK, 1024, 2048, FF, FF}; SplitKOrder S{4 * (bx & 7) + (jx >> 2), jx & 3};
        MKBAR(); EpiResidSplitT<true, true, true> E{Y, Y, Y, ADA + 5 * 1024, (bf16*)(ws + WS_XBUF), bar, kh, H, KA.in[9] + 1024, ADA1 + 1 * 1024, (float*)(ws + WS_RSW)};
        pg8::gemm_phase<EpiResidSplitT<true, true, true>, SplitKOrder, false, true>(lds, g, S, E); SEAM2(9); }
    if (IN(11)) for (int rep_ = 0; rep_ < REPS(11); ++rep_) { pg8::Gemm g{H, (const bf16*)(ws + WS_WQKV), NTOK, QKVW, 1024, 1024, 1024}; pg8::StaticOrder S; S.init(NTOK, QKVW, G, (int)blockIdx.x);
        EpiQKV E{(const float*)(ws + WS_RSW), (const float*)(ws + WS_CV) + 5 * 4096, KA.in[32], KA.in[33], ws, KA.out};
        pg8::gemm_phase<EpiQKV, pg8::StaticOrder, false, true>(lds, g, S, E);
        if ((int)blockIdx.x >= 192) kv_cache_rows(KA, lane, ((int)blockIdx.x - 192) * NWAVES + wave, 64 * NWAVES);
        SEAM2(11); }
    if (IN(13)) for (int rep_ = 0; rep_ < REPS(13); ++rep_) {
        const att::bf16* QN = (const att::bf16*)(ws + WS_QN); att::bf16* OB = (att::bf16*)(ws + WS_OB);
        for (int u = blockIdx.x; u < 256; u += G) {
            if (u < 128) { const int b = u >> 5, hq = (u >> 2) & 7, qb = u & 3; const size_t qrow = (size_t)NPR + b * 1024 + qb * 256;
                att::attn_dense_body<att::bf16>(QN + qrow * 1024 + hq * 128, (const att::bf16*)(ws + WS_KS) + (size_t)b * 1536 * 256 + (hq >> 2) * 128, (const att::bf16*)(ws + WS_VS) + (size_t)b * 1536 * 256 + (hq >> 2) * 128,
                                                OB + qrow * 1024 + hq * 128, 1536, (char*)lds_raw); }
            else { const int v = u - 128, b = v >> 3, hq = v & 7; const size_t qrow = (size_t)b * 256;
                att::attn_dense_body<att::bf16>(QN + qrow * 1024 + hq * 128, (const att::bf16*)(ws + WS_KP) + qrow * 256 + (hq >> 2) * 128, (const att::bf16*)(ws + WS_VP) + qrow * 256 + (hq >> 2) * 128,
                                                OB + qrow * 1024 + hq * 128, 256, (char*)lds_raw); }
            __syncthreads();
        }
        SEAM2(13); }
    if (IN(14)) for (int rep_ = 0; rep_ < REPS(14); ++rep_) { const int bx = blockIdx.x, kh = (bx >> 3) & 1, jx = bx >> 4;
        pg8::Gemm g{(const bf16*)(ws + WS_OB) + kh * 512, (const bf16*)(ws + WS_WO) + kh * 512, NTOK, 1024, 512, 1024, 1024}; SplitKOrder S{4 * (bx & 7) + (jx >> 2), jx & 3};
        MKBAR(); EpiResidSplitT<true, true, true> E{Y, Y, Y, ADA1 + 2 * 1024, (bf16*)(ws + WS_XBUF), bar, kh, H, KA.in[10] + 1024, ADA1 + 4 * 1024, (float*)(ws + WS_RSW)};
        pg8::gemm_phase<EpiResidSplitT<true, true, true>, SplitKOrder, false, true>(lds, g, S, E); SEAM2(14); }
    if (IN(16)) for (int rep_ = 0; rep_ < REPS(16); ++rep_) { pg8::Gemm g{H, (const bf16*)(ws + WS_W1) + (size_t)4096 * 1024, NTOK, FF, 1024, 1024, 1024}; pg8::StaticOrder S; S.init(NTOK, FF, G, (int)blockIdx.x);
        pg8::EpiBf16<2, true> E{(bf16*)(ws + WS_ACT), FF, (const float*)(ws + WS_RSW), (const float*)(ws + WS_CV) + 5 * 4096 + 5 * 1536, 4096};
        pg8::gemm_phase<pg8::EpiBf16<2, true>, pg8::StaticOrder, true, true>(lds, g, S, E); SEAM2(16); }
    if (IN(17)) for (int rep_ = 0; rep_ < REPS(17); ++rep_) { const int bx = blockIdx.x, kh = (bx >> 3) & 1, jx = bx >> 4;
        pg8::Gemm g{(const bf16*)(ws + WS_ACT) + kh * 2048, (const bf16*)(ws + WS_W2) + (size_t)1024 * 4096 + kh * 2048, NTOK, 1024, 2048, FF, FF}; SplitKOrder S{4 * (bx & 7) + (jx >> 2), jx & 3};
        MKBAR(); EpiResidSplitT<false, true, false> E{Y, Y, KA.out + OUT_Y, ADA1 + 5 * 1024, (bf16*)(ws + WS_XBUF), bar, kh, nullptr, nullptr, nullptr, nullptr};
        pg8::gemm_phase<EpiResidSplitT<false, true, false>, SplitKOrder, false, true>(lds, g, S, E); SEAM2(17); }
#undef IN
#undef SEAM
#undef lds
#undef MISC
#undef tid
#undef lane
#undef wave
#undef G
#undef ws
#undef ADA
#undef H
#undef Y
#undef xs_off
#undef ADA1
}
constexpr int N_PHASES = 18;

#ifndef MK_ONE_LAUNCH
#define MK_ONE_LAUNCH 1
#endif
extern "C" void kernel_launch(void* const* d_in, const int* in_sizes, int n_in, void* d_out, int out_size, void* d_ws, size_t ws_size, hipStream_t stream) {
    static int grid = 0;
    if (grid == 0) {
        if (n_in != 34 || out_size != (int)OUT_END || ws_size < WS_END) { fprintf(stderr, "kernel_launch: unexpected shapes: n_in %d out %d ws %zu\n", n_in, out_size, ws_size); grid = -1; return; }
        int dev = 0, cus = 0, per_cu = 0;
        if (hipGetDevice(&dev) != hipSuccess || hipDeviceGetAttribute(&cus, hipDeviceAttributeMultiprocessorCount, dev) != hipSuccess) { grid = -1; return; }
        if (hipFuncSetAttribute((const void*)fwd_kernel, hipFuncAttributeMaxDynamicSharedMemorySize, LDS_BYTES) != hipSuccess) { fprintf(stderr, "kernel_launch: hipFuncSetAttribute failed\n"); grid = -1; return; }
        if (hipOccupancyMaxActiveBlocksPerMultiprocessor(&per_cu, (const void*)fwd_kernel, NWAVES * 64, LDS_BYTES) != hipSuccess || per_cu < 1) { fprintf(stderr, "kernel_launch: occupancy query says %d blocks per CU\n", per_cu); }
        (void)hipGetLastError();
        grid = cus < 256 ? cus : 256;
        if (grid != 256) { fprintf(stderr, "kernel_launch: this kernel needs a 256-CU device (one workgroup per CU); found %d\n", cus); grid = -1; return; }
    }
    if (grid < 0) return;
    (void)hipMemsetAsync((char*)d_ws + WS_CTL, 0, CTL_ZERO_BYTES, stream);
    Args a{};
    for (int i = 0; i < 34; ++i) a.in[i] = (const float*)d_in[i];
    a.out = (float*)d_out; a.ws = (unsigned char*)d_ws;
#if MK_ONE_LAUNCH
    a.ph_lo = 0; a.ph_hi = N_PHASES;
    hipLaunchKernelGGL(fwd_kernel, dim3(grid), dim3(NWAVES * 64), LDS_BYTES, stream, a);
#else
    for (int p = 0; p < N_PHASES; ++p) { a.ph_lo = p; a.ph_hi = p + 1; hipLaunchKernelGGL(fwd_kernel, dim3(grid), dim3(NWAVES * 64), LDS_BYTES, stream, a); }
#endif
    const hipError_t le = hipPeekAtLastError();
    if (le != hipSuccess) fprintf(stderr, "kernel_launch: launch failed: %s\n", hipGetErrorName(le));
}
```

```cpp
#include <hip/hip_runtime.h>
#include <hip/hip_bf16.h>
#include <cstdio>
#include <cstdint>
#include <cmath>
namespace pg8 {
#define PG8_LAS __attribute__((address_space(3)))
typedef unsigned short bf16_t;
typedef short bf16x8 __attribute__((ext_vector_type(8)));
typedef float f32x4 __attribute__((ext_vector_type(4)));
typedef unsigned u32x4 __attribute__((ext_vector_type(4)));
constexpr int BM = 256, BK = 64, HALF = 128, HTB = HALF * BK * 2  , STAGE_BYTES = 8 * HTB, NXCD = 8, WGM = 8;

__host__ __device__ __forceinline__ int lds_byte(int r, int c) { const int st = (r >> 4) * 2 + (c >> 5), rr = r & 15, cc = c & 31, ob = rr * 64 + cc * 2; return st * 1024 + (ob ^ (((ob >> 9) & 1) << 5)); }
__host__ __device__ __forceinline__ void stage_rc(int b, int& R, int& C) { const int st = b / 1024, sb = b % 1024, swz = sb ^ (((sb >> 9) & 1) << 5); R = (st >> 1) * 16 + swz / 64; C = (st & 1) * 32 + (swz % 64) / 2; }
__host__ __device__ __forceinline__ int perm32(int rho) { const int n = rho >> 4, i = rho & 15; return 8 * (i >> 2) + 4 * n + (i & 3); }

struct Unit { int pm, pn; };
struct Gemm { const bf16_t* A; const bf16_t* Bt; int M, N, K, lda, ldb; };

struct StaticOrder {
    int nM, nN, nwg, G, c;
    __host__ __device__ void init(int M, int N, int G_, int c_) { nM = M / BM; nN = N / BM; nwg = nM * nN; G = G_; c = c_; }
    __host__ __device__ bool next(int i, Unit& u) const {
        const long L = (long)i * G + c; if (L >= nwg) return false;
        int wgid = (int)L; { const int q = nwg / NXCD, r = nwg % NXCD, xcd = wgid % NXCD, off = wgid / NXCD; wgid = (xcd < r ? xcd * (q + 1) : r * (q + 1) + (xcd - r) * q) + off; }
        const int nig = WGM * nN, gid = wgid / nig, fm = gid * WGM, gsz = (nM - fm) < WGM ? (nM - fm) : WGM;
        u.pm = fm + ((wgid % nig) % gsz); u.pn = (wgid % nig) / gsz; return true;
    }
    __device__ __forceinline__ void a_ready(const Unit&) const {}
    __device__ __forceinline__ void done(const Unit&) const {}
};

__device__ __forceinline__ unsigned cvt_pk_bf16(float lo, float hi) { unsigned r; asm volatile("v_cvt_pk_bf16_f32 %0, %1, %2" : "=v"(r) : "v"(lo), "v"(hi)); return r; }
typedef float f32x2 __attribute__((ext_vector_type(2)));
template <int ACT  , bool NORM = false> struct EpiBf16 {
    static constexpr bool PERM = true, AFTER_DRAIN = false;
    bf16_t* O; int ldc; const float* rsw; const float* cv; int ncv;
    __device__ __forceinline__ void operator()(const f32x4 (&acc)[2][2][4][2], const Unit& u, int wr, int wc, int fr, int fq) const {
        const int row0 = u.pm * BM + wr * 64 + fr; const int col0 = u.pn * BM + wc * 32 + 8 * fq;
        const __amdgpu_buffer_rsrc_t orsrc = __builtin_amdgcn_make_buffer_rsrc((void*)O, (short)0, 8192 * ldc * 2, 0x00020000);
        f32x4 cvv[2][2];
        if (NORM) { const int cond = u.pm < 16 ? 0 : 1 + ((u.pm - 16) >> 2);
#pragma unroll
            for (int bj = 0; bj < 2; ++bj)
#pragma unroll
                for (int n = 0; n < 2; ++n) cvv[bj][n] = *(const f32x4*)(cv + (size_t)cond * ncv + col0 + bj * HALF + 4 * n); }
        float rstdv[2][4];
        if (NORM) { f32x4 s4v[2][4];
#pragma unroll
            for (int ai = 0; ai < 2; ++ai)
#pragma unroll
                for (int m = 0; m < 4; ++m) s4v[ai][m] = *(const f32x4*)(rsw + (size_t)(row0 + ai * HALF + m * 16) * 4);
#pragma unroll
            for (int ai = 0; ai < 2; ++ai)
#pragma unroll
                for (int m = 0; m < 4; ++m) { const f32x4 s4 = s4v[ai][m]; rstdv[ai][m] = __builtin_amdgcn_rsqf(((s4[0] + s4[1]) + (s4[2] + s4[3])) * (1.f / 1024.f) + 1e-6f); }
            asm volatile("" ::: "memory"); }
#pragma unroll
        for (int ai = 0; ai < 2; ++ai)
#pragma unroll
            for (int m = 0; m < 4; ++m) { const int row = row0 + ai * HALF + m * 16; const unsigned rowoff = (unsigned)(row * ldc + col0) * 2u;
                float rstd = 1.f;
                if (NORM) rstd = rstdv[ai][m];
#pragma unroll
                for (int bj = 0; bj < 2; ++bj) { f32x4 v0 = acc[ai][bj][m][0], v1 = acc[ai][bj][m][1];
                    if (NORM) { v0 = v0 * rstd + cvv[bj][0]; v1 = v1 * rstd + cvv[bj][1]; }
                    if (ACT == 2) {
#pragma unroll
                        for (int e = 0; e < 4; ++e) { float a = v0[e] > 0.f ? v0[e] : 0.f; v0[e] = a * a; float b = v1[e] > 0.f ? v1[e] : 0.f; v1[e] = b * b; } }
                    u32x4 w; w.x = cvt_pk_bf16(v0[0], v0[1]); w.y = cvt_pk_bf16(v0[2], v0[3]); w.z = cvt_pk_bf16(v1[0], v1[1]); w.w = cvt_pk_bf16(v1[2], v1[3]);
                    __builtin_amdgcn_raw_buffer_store_b128(w, orsrc, rowoff + bj * HALF * 2, 0, 16); } }
    }
};
template <bool NEXT> struct EpiResidT {
    static constexpr bool PERM = false, AFTER_DRAIN = false;
    const float* base_p; const float* base_s; float* out; const float* gate;
    bf16_t* Hn; const float* nw; const float* nsc; float* rsw;
    __device__ __forceinline__ void operator()(const f32x4 (&acc)[2][2][4][2], const Unit& u, int wr, int wc, int fr, int fq) const {
        const int row0 = u.pm * BM + wr * 64 + fr; const int col0 = u.pn * BM + wc * 32 + 4 * fq;
        const int cond = u.pm < 16 ? 0 : 1 + ((u.pm - 16) >> 2);
        const float* gp = gate + cond * 6144; const float* bp = u.pm < 16 ? base_p : base_s;
        f32x4 gv[2][2];
#pragma unroll
        for (int bj = 0; bj < 2; ++bj)
#pragma unroll
            for (int n = 0; n < 2; ++n) gv[bj][n] = *(const f32x4*)(gp + col0 + bj * HALF + n * 16);
        f32x4 (&y)[2][2][4][2] = const_cast<f32x4 (&)[2][2][4][2]>(acc);
#pragma unroll
        for (int ai = 0; ai < 2; ++ai)
#pragma unroll
            for (int m = 0; m < 4; ++m) { const size_t off = (size_t)(row0 + ai * HALF + m * 16) * 1024 + col0;
#pragma unroll
                for (int bj = 0; bj < 2; ++bj)
#pragma unroll
                    for (int n = 0; n < 2; ++n) { const f32x4 b = *(const f32x4*)(bp + off + bj * HALF + n * 16); const f32x4 yy = b + gv[bj][n] * acc[ai][bj][m][n];
                        *(f32x4*)(out + off + bj * HALF + n * 16) = yy; if (NEXT) y[ai][bj][m][n] = yy; } }
        if (NEXT) {
            asm volatile("" ::: "memory");
            f32x4 av[2][2];
#pragma unroll
            for (int bj = 0; bj < 2; ++bj)
#pragma unroll
                for (int n = 0; n < 2; ++n) av[bj][n] = *(const f32x4*)(nw + col0 + bj * HALF + n * 16) * (*(const f32x4*)(nsc + cond * 6144 + col0 + bj * HALF + n * 16) + 1.0f);
#pragma unroll
            for (int ai = 0; ai < 2; ++ai)
#pragma unroll
                for (int m = 0; m < 4; ++m) { const int row = row0 + ai * HALF + m * 16; const size_t off = (size_t)row * 1024 + col0; float ss = 0.f;
#pragma unroll
                    for (int bj = 0; bj < 2; ++bj)
#pragma unroll
                        for (int n = 0; n < 2; ++n) { const f32x4 yy = y[ai][bj][m][n]; ss += (yy[0] * yy[0] + yy[1] * yy[1]) + (yy[2] * yy[2] + yy[3] * yy[3]); const f32x4 h = yy * av[bj][n];
                            typedef unsigned u32x2 __attribute__((ext_vector_type(2))); u32x2 w; w.x = cvt_pk_bf16(h[0], h[1]); w.y = cvt_pk_bf16(h[2], h[3]); *(u32x2*)(Hn + off + bj * HALF + n * 16) = w; }
                    ss += __shfl_xor(ss, 16); ss += __shfl_xor(ss, 32); if (fq == 0) rsw[(size_t)row * 16 + u.pn * 4 + wc] = ss; }
        }
    }
};
typedef EpiResidT<false> EpiResid;
struct EpiGlu {
    static constexpr bool PERM = true, AFTER_DRAIN = false;
    const bf16_t* G; bf16_t* O; const float* bias;
    __device__ __forceinline__ void operator()(const f32x4 (&acc)[2][2][4][2], const Unit& u, int wr, int wc, int fr, int fq) const {
        const int row0 = u.pm * BM + wr * 64 + fr; const int col0 = u.pn * BM + wc * 32 + 8 * fq;
        f32x4 bv[2][2];
#pragma unroll
        for (int bj = 0; bj < 2; ++bj)
#pragma unroll
            for (int n = 0; n < 2; ++n) bv[bj][n] = *(const f32x4*)(bias + col0 + bj * HALF + 4 * n);
        u32x4 gwv[2][4][2];
#pragma unroll
        for (int ai = 0; ai < 2; ++ai)
#pragma unroll
            for (int m = 0; m < 4; ++m)
#pragma unroll
                for (int bj = 0; bj < 2; ++bj) gwv[ai][m][bj] = *(const u32x4*)(G + (size_t)(row0 + ai * HALF + m * 16) * 512 + col0 + bj * HALF);
#pragma unroll
        for (int ai = 0; ai < 2; ++ai)
#pragma unroll
            for (int m = 0; m < 4; ++m) { const size_t row = (size_t)(row0 + ai * HALF + m * 16);
#pragma unroll
                for (int bj = 0; bj < 2; ++bj) { f32x4 v0 = acc[ai][bj][m][0] + bv[bj][0], v1 = acc[ai][bj][m][1] + bv[bj][1];
                    const u32x4 gw = gwv[ai][m][bj];
                    float gf[8];
#pragma unroll
                    for (int e = 0; e < 4; ++e) { gf[2 * e] = __uint_as_float(gw[e] << 16); gf[2 * e + 1] = __uint_as_float(gw[e] & 0xffff0000u); }
                    float o[8];
#pragma unroll
                    for (int e = 0; e < 4; ++e) { o[e] = gf[e] * __builtin_amdgcn_rcpf(1.f + __expf(-v0[e])); o[4 + e] = gf[4 + e] * __builtin_amdgcn_rcpf(1.f + __expf(-v1[e])); }
                    u32x4 w; w.x = cvt_pk_bf16(o[0], o[1]); w.y = cvt_pk_bf16(o[2], o[3]); w.z = cvt_pk_bf16(o[4], o[5]); w.w = cvt_pk_bf16(o[6], o[7]);
                    *(u32x4*)(O + row * 1024 + col0 + bj * HALF) = w; } }
    }
};

template <class Epi, class Sched, bool ALIGN_EPI = false, bool SP2 = false>
__device__ __forceinline__ void gemm_phase(PG8_LAS unsigned char* lds, const Gemm g, const Sched& S, const Epi& E) {
    int tid_ = threadIdx.x; asm volatile("" : "+v"(tid_));
    const int tid = tid_, wid = __builtin_amdgcn_readfirstlane(tid >> 6), lane = tid & 63, wr = wid >> 2, wc = wid & 3, fr = lane & 15, fq = lane >> 4;
    const int K = g.K, nt = K / BK, LDA_ = g.lda, LDB_ = g.ldb;
    unsigned voffA[2], voffB[2];
#pragma unroll
    for (int i = 0; i < 2; ++i) { int R, C; stage_rc(tid * 16 + i * 8192, R, C); const int Rb = Epi::PERM ? ((R & ~31) + perm32(R & 31)) : R;
        voffA[i] = (unsigned)(R * LDA_ + C) * 2u; voffB[i] = (unsigned)(Rb * LDB_ + C) * 2u; }
    const size_t kstep = (size_t)(BK * 2);
    const size_t hstepA = (size_t)HALF * LDA_ * 2, hstepB = (size_t)HALF * LDB_ * 2;
    const size_t tstepA = 2 * hstepA, tstepB = 2 * hstepB;
    const unsigned ldsw = (unsigned)wid * 1024u;
    const int aoff = lds_byte(wr * 64 + fr, fq * 8), boff = lds_byte(wc * 32 + fr, fq * 8);
#define PG8_SA(b, h) (((b) * 2 + (h)) * HTB)
#define PG8_SB(b, h) ((4 + (b) * 2 + (h)) * HTB)
#define PG8_STAGE(bufoff, gbase, voff) do { _Pragma("unroll") for (int _i = 0; _i < 2; ++_i) \
        __builtin_amdgcn_global_load_lds((const unsigned*)((const char*)(gbase) + (voff)[_i]), (PG8_LAS unsigned*)(lds + (bufoff) + ldsw + _i * 8192), 16, 0, 0); } while (0)
#define PG8_LDA(dst, b, h) do { _Pragma("unroll") for (int m = 0; m < 4; ++m) _Pragma("unroll") for (int k = 0; k < 2; ++k) dst[m][k] = *(const PG8_LAS bf16x8*)(lds + PG8_SA(b, h) + aoff + m * 2048 + k * 1024); } while (0)
#define PG8_LDB(dst, b, h) do { _Pragma("unroll") for (int n = 0; n < 2; ++n) _Pragma("unroll") for (int k = 0; k < 2; ++k) dst[n][k] = *(const PG8_LAS bf16x8*)(lds + PG8_SB(b, h) + boff + n * 2048 + k * 1024); } while (0)
#define PG8_MMA(ai, bj, At, Bt) do { __builtin_amdgcn_s_setprio(1); _Pragma("unroll") for (int m = 0; m < 4; ++m) _Pragma("unroll") for (int n = 0; n < 2; ++n) _Pragma("unroll") for (int k = 0; k < 2; ++k) \
        acc[ai][bj][m][n] = __builtin_amdgcn_mfma_f32_16x16x32_bf16(Bt[n][k], At[m][k], acc[ai][bj][m][n], 0, 0, 0); __builtin_amdgcn_s_setprio(0); } while (0)
#define PG8_WAIT_V(n) asm volatile("s_waitcnt vmcnt(" #n ")" ::: "memory")
#define PG8_WAIT_L(n) asm volatile("s_waitcnt lgkmcnt(" #n ")" ::: "memory")
#define PG8_BAR __builtin_amdgcn_s_barrier()
#define PG8_SCHED __builtin_amdgcn_sched_barrier(0)
    Unit cur, nxt; int ui = 0;
    if (!S.next(0, cur)) return;
    f32x4 acc[2][2][4][2];
#pragma unroll
    for (int a = 0; a < 2; ++a)
#pragma unroll
        for (int b = 0; b < 2; ++b)
#pragma unroll
            for (int m = 0; m < 4; ++m)
#pragma unroll
                for (int n = 0; n < 2; ++n) acc[a][b][m][n] = (f32x4){0.f, 0.f, 0.f, 0.f};
    bf16x8 At[4][2], B0[2][2], B1[2][2];
    const char* cA = (const char*)g.A + (size_t)cur.pm * tstepA; const char* cB = (const char*)g.Bt + (size_t)cur.pn * tstepB;
    S.a_ready(cur);
    if constexpr (SP2) {
        PG8_STAGE(PG8_SB(0, 0), cB, voffB); PG8_STAGE(PG8_SB(0, 1), cB + hstepB, voffB); PG8_STAGE(PG8_SA(0, 0), cA, voffA); PG8_STAGE(PG8_SA(0, 1), cA + hstepA, voffA);
        if (wr == 1) PG8_BAR;
        PG8_WAIT_V(2); PG8_BAR;
        PG8_STAGE(PG8_SB(1, 0), cB + kstep, voffB); PG8_STAGE(PG8_SA(1, 0), cA + kstep, voffA); PG8_STAGE(PG8_SB(1, 1), cB + hstepB + kstep, voffB);
        PG8_WAIT_V(6); PG8_BAR;
    } else {
        PG8_STAGE(PG8_SB(0, 0), cB, voffB); PG8_STAGE(PG8_SA(0, 0), cA, voffA); PG8_STAGE(PG8_SB(0, 1), cB + hstepB, voffB); PG8_STAGE(PG8_SA(0, 1), cA + hstepA, voffA);
        if (wr == 1) PG8_BAR;
        PG8_WAIT_V(4); PG8_BAR;
        PG8_STAGE(PG8_SB(1, 0), cB + kstep, voffB); PG8_STAGE(PG8_SA(1, 0), cA + kstep, voffA); PG8_STAGE(PG8_SB(1, 1), cB + hstepB + kstep, voffB);
        PG8_WAIT_V(6); PG8_BAR;
    }
    for (;;) {
        const bool has_next = S.next(ui + 1, nxt);
        const char* nA = has_next ? (const char*)g.A + (size_t)nxt.pm * tstepA : cA; const char* nB = has_next ? (const char*)g.Bt + (size_t)nxt.pn * tstepB : cB;
        for (int t = 0; t < nt; t += 2) {
            const bool last = (t == nt - 2);
            const char* a1 = cA + (size_t)(t + 1) * kstep;
            const char* a2 = last ? nA : cA + (size_t)(t + 2) * kstep; const char* b2 = last ? nB : cB + (size_t)(t + 2) * kstep;
            const char* a3 = a2 + kstep; const char* b3 = b2 + kstep;
            if (last && has_next) S.a_ready(nxt);
            if constexpr (SP2) {
            PG8_LDB(B0, 0, 0); PG8_LDB(B1, 0, 1); PG8_SCHED; PG8_LDA(At, 0, 0); PG8_STAGE(PG8_SA(1, 1), a1 + hstepA, voffA);
            PG8_WAIT_V(8); PG8_WAIT_L(0); PG8_BAR; PG8_MMA(0, 0, At, B0); PG8_MMA(0, 1, At, B1); PG8_BAR; PG8_SCHED;
            PG8_LDA(At, 0, 1); PG8_STAGE(PG8_SB(0, 0), b2, voffB); PG8_STAGE(PG8_SB(0, 1), b2 + hstepB, voffB); PG8_STAGE(PG8_SA(0, 0), a2, voffA);
            PG8_WAIT_V(8); PG8_WAIT_L(0); PG8_BAR; PG8_MMA(1, 0, At, B0); PG8_MMA(1, 1, At, B1); PG8_BAR; PG8_SCHED;
            PG8_LDB(B0, 1, 0); PG8_LDB(B1, 1, 1); PG8_SCHED; PG8_LDA(At, 1, 0); PG8_STAGE(PG8_SA(0, 1), a2 + hstepA, voffA);
            PG8_WAIT_V(8); PG8_WAIT_L(0); PG8_BAR; PG8_MMA(0, 0, At, B0); PG8_MMA(0, 1, At, B1); PG8_BAR; PG8_SCHED;
            PG8_LDA(At, 1, 1); PG8_STAGE(PG8_SB(1, 0), b3, voffB); PG8_STAGE(PG8_SB(1, 1), b3 + hstepB, voffB); PG8_STAGE(PG8_SA(1, 0), a3, voffA);
            PG8_WAIT_V(8); PG8_WAIT_L(0); PG8_BAR; PG8_MMA(1, 0, At, B0); PG8_MMA(1, 1, At, B1); PG8_BAR; PG8_SCHED;
            } else {
            PG8_LDB(B0, 0, 0); PG8_SCHED; PG8_LDA(At, 0, 0); PG8_STAGE(PG8_SA(1, 1), a1 + hstepA, voffA);
            PG8_WAIT_L(8); PG8_BAR; PG8_WAIT_L(0); PG8_MMA(0, 0, At, B0); PG8_BAR; PG8_SCHED;
            PG8_LDB(B1, 0, 1); PG8_STAGE(PG8_SB(0, 0), b2, voffB);
            PG8_BAR; PG8_WAIT_L(0); PG8_MMA(0, 1, At, B1); PG8_BAR;
            PG8_LDA(At, 0, 1); PG8_STAGE(PG8_SA(0, 0), a2, voffA);
            PG8_BAR; PG8_WAIT_L(0); PG8_MMA(1, 0, At, B0); PG8_BAR; PG8_SCHED;
            PG8_STAGE(PG8_SB(0, 1), b2 + hstepB, voffB);
            PG8_WAIT_V(6); PG8_BAR; PG8_MMA(1, 1, At, B1); PG8_BAR;
            PG8_LDB(B0, 1, 0); PG8_SCHED; PG8_LDA(At, 1, 0); PG8_STAGE(PG8_SA(0, 1), a2 + hstepA, voffA);
            PG8_WAIT_L(8); PG8_BAR; PG8_WAIT_L(0); PG8_MMA(0, 0, At, B0); PG8_BAR; PG8_SCHED;
            PG8_LDB(B1, 1, 1); PG8_STAGE(PG8_SB(1, 0), b3, voffB);
            PG8_BAR; PG8_WAIT_L(0); PG8_MMA(0, 1, At, B1); PG8_BAR;
            PG8_LDA(At, 1, 1); PG8_STAGE(PG8_SA(1, 0), a3, voffA);
            PG8_BAR; PG8_WAIT_L(0); PG8_MMA(1, 0, At, B0); PG8_BAR; PG8_SCHED;
            PG8_STAGE(PG8_SB(1, 1), b3 + hstepB, voffB);
            PG8_WAIT_V(6); PG8_BAR; PG8_MMA(1, 1, At, B1); PG8_BAR;
            }
        }
        if constexpr (ALIGN_EPI) { if (wr == 0) PG8_BAR; }
        if constexpr (!Epi::AFTER_DRAIN) { E(acc, cur, wr, wc, fr, fq); S.done(cur); }
        if (!has_next) break;
#pragma unroll
        for (int a = 0; a < 2; ++a)
#pragma unroll
            for (int b = 0; b < 2; ++b)
#pragma unroll
                for (int m = 0; m < 4; ++m)
#pragma unroll
                    for (int n = 0; n < 2; ++n) acc[a][b][m][n] = (f32x4){0.f, 0.f, 0.f, 0.f};
        cur = nxt; cA = nA; cB = nB; ++ui;
        if constexpr (ALIGN_EPI) { if (wr == 1) PG8_BAR; }
    }
    PG8_WAIT_V(0);
    if constexpr (!ALIGN_EPI) { if (wr == 0) PG8_BAR; }
    PG8_BAR;
    if constexpr (Epi::AFTER_DRAIN) { E.fused(acc, cur, wr, wc, fr, fq, lds, wid, lane); S.done(cur); }
#undef PG8_SA
#undef PG8_SB
#undef PG8_STAGE
#undef PG8_LDA
#undef PG8_LDB
#undef PG8_MMA
#undef PG8_WAIT_V
#undef PG8_WAIT_L
#undef PG8_BAR
#undef PG8_SCHED
}
}

namespace att {
using bf16 = __hip_bfloat16;
constexpr int D = 128, NW = 8, QBLK = 32, KVBLK = 64; constexpr float SCALE = 0.088388347648318440f; constexpr float THR = 8.f; constexpr int SDEPTH = 2;
constexpr int LDQ = 1024, LDK = 256, LDO = 1024;
constexpr size_t SHM_V = KVBLK * D * 2, SHM_K = KVBLK * D * 2, SHM_ATTN = 2 * SHM_V + 2 * SHM_K + NW * 64 * 4;
using bf16x8 = __attribute__((ext_vector_type(8))) short;
using s16x4  = __attribute__((ext_vector_type(4))) short;
using f32x16 = __attribute__((ext_vector_type(16))) float;
using f32x8  = __attribute__((ext_vector_type(8))) float;
using u32x4  = __attribute__((ext_vector_type(4))) unsigned;
#define KSWZ(row, colB) ((row) * 256 + ((colB) ^ (((row) & 7) << 4)))
#define SBAR() __builtin_amdgcn_sched_barrier(0)
__device__ __forceinline__ int crow(int r, int hi) { return (r & 3) + 8 * (r >> 2) + 4 * hi; }
__device__ __forceinline__ unsigned cvtpk(float lo, float hi) {
  unsigned r; asm volatile("v_cvt_pk_bf16_f32 %0, %1, %2" : "=v"(r) : "v"(lo), "v"(hi)); return r;
}
template <typename TIn> struct Stage;
template <> struct Stage<bf16>  { using T = bf16x8;
  __device__ static __forceinline__ T ld8(const bf16* p) { return *reinterpret_cast<const bf16x8*>(p); }
  __device__ static __forceinline__ bf16x8 tobf(T x) { return x; } };
template <> struct Stage<float> { using T = f32x8;
  __device__ static __forceinline__ T ld8(const float* p) { return *reinterpret_cast<const f32x8*>(p); }
  __device__ static __forceinline__ bf16x8 tobf(T x) {
    u32x4 w = {cvtpk(x[0], x[1]), cvtpk(x[2], x[3]), cvtpk(x[4], x[5]), cvtpk(x[6], x[7])}; return *reinterpret_cast<bf16x8*>(&w); } };

__device__ __forceinline__ void partialSM(f32x16& p0, f32x16& p1, float& m_reg, float& mn, float& alpha) {
  constexpr float C = SCALE * 1.4426950408889634f;
  float pmax = p0[0]; for (int r = 1; r < 16; ++r) pmax = fmaxf(pmax, p0[r]); for (int r = 0; r < 16; ++r) pmax = fmaxf(pmax, p1[r]);
  { auto rr = __builtin_amdgcn_permlane32_swap(__float_as_uint(pmax), __float_as_uint(pmax), false, false);
    pmax = fmaxf(__uint_as_float(rr[0]), __uint_as_float(rr[1])); }
  if (__builtin_expect(__all(pmax - m_reg <= THR / SCALE), 1)) { mn = m_reg; alpha = 1.f; }
  else { mn = fmaxf(m_reg, pmax); alpha = __builtin_amdgcn_exp2f((m_reg - mn) * C); m_reg = mn; }
  float mnC = -mn * C;
  for (int r = 0; r < 16; ++r) p0[r] = fmaf(p0[r], C, mnC); for (int r = 0; r < 16; ++r) p1[r] = fmaf(p1[r], C, mnC);
  for (int r = 0; r < 16; ++r) p0[r] = __builtin_amdgcn_exp2f(p0[r]);
}
__device__ __forceinline__ void finishSM(f32x16& p0, f32x16& p1, float alpha, float& l_reg, bf16x8& pa0, bf16x8& pa1, bf16x8& pa2, bf16x8& pa3) {
  for (int r = 0; r < 16; ++r) p1[r] = __builtin_amdgcn_exp2f(p1[r]);
  float ps = 0; for (int r = 0; r < 16; ++r) ps += p0[r]; for (int r = 0; r < 16; ++r) ps += p1[r];
  { auto rr = __builtin_amdgcn_permlane32_swap(__float_as_uint(ps), __float_as_uint(ps), false, false);
    ps = __uint_as_float(rr[0]) + __uint_as_float(rr[1]); }
  l_reg = l_reg * alpha + ps;
#define PK4(P, BASE, OUT) do { unsigned a0 = cvtpk(P[BASE + 0], P[BASE + 1]), a1 = cvtpk(P[BASE + 2], P[BASE + 3]);   \
    unsigned b0 = cvtpk(P[BASE + 4], P[BASE + 5]), b1 = cvtpk(P[BASE + 6], P[BASE + 7]);                              \
    auto r0 = __builtin_amdgcn_permlane32_swap(a0, b0, false, false); auto r1 = __builtin_amdgcn_permlane32_swap(a1, b1, false, false); \
    u32x4 w = {r0[0], r1[0], r0[1], r1[1]}; OUT = *reinterpret_cast<bf16x8*>(&w); } while (0)
  PK4(p0, 0, pa0); PK4(p0, 8, pa1); PK4(p1, 0, pa2); PK4(p1, 8, pa3);
#undef PK4
}
__device__ __forceinline__ void qkt(f32x16& p0, f32x16& p1, const bf16* Ks, const bf16x8* qr, int r32, int hi) {
  p0 = f32x16{}; p1 = f32x16{};
  for (int d0 = 0; d0 < 8; ++d0) { int cb = (d0 * 16 + hi * 8) * 2;
    bf16x8 b0 = *reinterpret_cast<const bf16x8*>((const char*)Ks + KSWZ(r32, cb));
    bf16x8 b1 = *reinterpret_cast<const bf16x8*>((const char*)Ks + KSWZ(32 + r32, cb));
    p0 = __builtin_amdgcn_mfma_f32_32x32x16_bf16(b0, qr[d0], p0, 0, 0, 0);
    p1 = __builtin_amdgcn_mfma_f32_32x32x16_bf16(b1, qr[d0], p1, 0, 0, 0); }
}
__device__ __forceinline__ int v_st(int k, int c) { const int kk = (k & ~0xC) | ((k & 4) << 1) | ((k & 8) >> 1); return ((kk >> 3) * 4 + (c >> 5)) * 512 + ((kk & 7) * 32 + (c & 31)) * 2; }
__device__ __forceinline__ int v_rd_base(int lane) { return ((lane & 3) << 3) | (((lane >> 2) & 3) << 6) | (((lane >> 4) & 1) << 5) | (((lane >> 5) & 1) << 8); }
constexpr int v_rd_off(int d0, int ks, int half) { return d0 * 512 + ks * 4096 + half * 2048; }
template <int OFF> __device__ __forceinline__ s16x4 tr_read(int vb) {
  s16x4 r; asm volatile("ds_read_b64_tr_b16 %0, %1 offset:%2" : "=&v"(r) : "v"(vb), "i"(OFF) : "memory"); return r;
}
template <int D0> __device__ __forceinline__ void pv_one(f32x16& od, int vb, bf16x8 pa0, bf16x8 pa1, bf16x8 pa2, bf16x8 pa3) {
  const s16x4 l0 = tr_read<v_rd_off(D0, 0, 0)>(vb), h0 = tr_read<v_rd_off(D0, 0, 1)>(vb), l1 = tr_read<v_rd_off(D0, 1, 0)>(vb), h1 = tr_read<v_rd_off(D0, 1, 1)>(vb);
  const s16x4 l2 = tr_read<v_rd_off(D0, 2, 0)>(vb), h2 = tr_read<v_rd_off(D0, 2, 1)>(vb), l3 = tr_read<v_rd_off(D0, 3, 0)>(vb), h3 = tr_read<v_rd_off(D0, 3, 1)>(vb);
  asm volatile("s_waitcnt lgkmcnt(0)" ::: "memory"); SBAR();
#define PK(L, H) (bf16x8){L[0], L[1], L[2], L[3], H[0], H[1], H[2], H[3]}
  od = __builtin_amdgcn_mfma_f32_32x32x16_bf16(pa0, PK(l0, h0), od, 0, 0, 0);
  od = __builtin_amdgcn_mfma_f32_32x32x16_bf16(pa1, PK(l1, h1), od, 0, 0, 0);
  od = __builtin_amdgcn_mfma_f32_32x32x16_bf16(pa2, PK(l2, h2), od, 0, 0, 0);
  od = __builtin_amdgcn_mfma_f32_32x32x16_bf16(pa3, PK(l3, h3), od, 0, 0, 0);
#undef PK
}
__device__ __forceinline__ void pv_d0(f32x16* o, int vb, bf16x8 pa0, bf16x8 pa1, bf16x8 pa2, bf16x8 pa3) {
  pv_one<0>(o[0], vb, pa0, pa1, pa2, pa3); pv_one<1>(o[1], vb, pa0, pa1, pa2, pa3); pv_one<2>(o[2], vb, pa0, pa1, pa2, pa3); pv_one<3>(o[3], vb, pa0, pa1, pa2, pa3);
}

constexpr int OSC_BYTES = 32 * 256;
__device__ __forceinline__ void o_tile_out(char* osc, bf16* Ob, int wid, int lane) {
  asm volatile("s_waitcnt lgkmcnt(0)" ::: "memory");
  const __amdgpu_buffer_rsrc_t orr = __builtin_amdgcn_make_buffer_rsrc((void*)Ob, (short)0, 256 * LDO * 2, 0x00020000);
  typedef unsigned ou32x4 __attribute__((ext_vector_type(4)));
#pragma unroll
  for (int i = 0; i < 8; ++i) { const int q = lane + 64 * i, row = q >> 4, c16 = q & 15;
    const ou32x4 w = *(const ou32x4*)(osc + row * 256 + c16 * 16);
    __builtin_amdgcn_raw_buffer_store_b128(w, orr, (unsigned)(((wid * QBLK + row) * LDO + c16 * 8) * 2), 0, 16); }
}
template <typename TQ, bool PART = false>
__device__ __forceinline__ void attn_dense_body(const TQ* __restrict__ Qb, const bf16* __restrict__ Kh, const bf16* __restrict__ Vh,
                                                bf16* __restrict__ Ob, int seq, char* lds, unsigned long long* xsend = nullptr, const unsigned long long* xrecv = nullptr,
                                                unsigned* fl_mine = nullptr, unsigned* fl_partner = nullptr, unsigned epoch = 0u, int half = 0, unsigned* done_cnt = nullptr) {
  using St = Stage<bf16>; using SQ = Stage<TQ>;
  int tid_ = threadIdx.x; asm volatile("" : "+v"(tid_));
  const int tid = tid_, wid = tid >> 6, lane = tid & 63, r32 = lane & 31, hi = lane >> 5;
  bf16* V_lds = (bf16*)lds; bf16* K_lds = (bf16*)(lds + 2 * SHM_V);
  float* ws = (float*)(lds + 2 * SHM_V + 2 * SHM_K) + wid * 64; float* li_l = ws; float* al_l = ws + 32;
  float m_reg = -1e30f, l_reg = 0; f32x16 o[4] = {}; bf16x8 qr[8];
  const TQ* Qw = Qb + (long)(wid * QBLK + r32) * LDQ + hi * 8;
#pragma unroll
  for (int d0 = 0; d0 < 8; ++d0) qr[d0] = SQ::tobf(SQ::ld8(Qw + d0 * 16));
  const int sr = tid >> 4, sc = (tid & 15) * 8, vst0 = v_st(sr, sc), vst1 = v_st(32 + sr, sc);
  const int vb0 = (int)(uintptr_t)V_lds + v_rd_base(lane);
  struct { typename St::T vs0, vs1, ks0, ks1; } sr_[SDEPTH];
#define SLOAD(i, k0) do { sr_[i].vs0 = St::ld8(&Vh[(long)((k0) + sr) * LDK + sc]); sr_[i].vs1 = St::ld8(&Vh[(long)((k0) + 32 + sr) * LDK + sc]); \
    sr_[i].ks0 = St::ld8(&Kh[(long)((k0) + sr) * LDK + sc]); sr_[i].ks1 = St::ld8(&Kh[(long)((k0) + 32 + sr) * LDK + sc]); } while (0)
#define SWRITE(b, i) do { *(bf16x8*)((char*)V_lds + (b) * SHM_V + vst0) = St::tobf(sr_[i].vs0);          \
    *(bf16x8*)((char*)V_lds + (b) * SHM_V + vst1) = St::tobf(sr_[i].vs1); int kc = sc * 2;               \
    *(bf16x8*)((char*)K_lds + (b) * SHM_K + KSWZ(sr, kc)) = St::tobf(sr_[i].ks0);                       \
    *(bf16x8*)((char*)K_lds + (b) * SHM_K + KSWZ(32 + sr, kc)) = St::tobf(sr_[i].ks1); } while (0)
#define SWAIT() do { if constexpr (SDEPTH == 2) asm volatile("s_waitcnt vmcnt(4)" ::: "memory"); else asm volatile("s_waitcnt vmcnt(0)" ::: "memory"); } while (0)
#define RESC(a) do { if (__any((a) < 1.f)) { if (hi == 0) al_l[r32] = (a); asm volatile("s_waitcnt lgkmcnt(0)" ::: "memory"); \
    for (int d = 0; d < 4; ++d) for (int r = 0; r < 16; ++r) o[d][r] *= al_l[crow(r, hi)]; } } while (0)
  f32x16 pA0, pA1, pB0, pB1; float mnA, mnB, alA, alB; bf16x8 pa0, pa1, pa2, pa3; const int NT = seq / KVBLK;
  constexpr int SE = 0, SO = SDEPTH - 1;
  SLOAD(SE, 0); asm volatile("s_waitcnt vmcnt(0)" ::: "memory"); SWRITE(0, SE); __syncthreads();
  qkt(pA0, pA1, K_lds, qr, r32, hi); partialSM(pA0, pA1, m_reg, mnA, alA);
  SLOAD(SO, KVBLK); if constexpr (SDEPTH == 2) { if (2 < NT) SLOAD(SE, 2 * KVBLK); }
  SWAIT(); SWRITE(1, SO); __syncthreads();
  for (int j = 1; j + 1 < NT; j += 2) {
    SBAR(); qkt(pB0, pB1, (bf16*)((char*)K_lds + SHM_K), qr, r32, hi);
    finishSM(pA0, pA1, alA, l_reg, pa0, pa1, pa2, pa3); SBAR();
    SLOAD(SO, (j + SDEPTH) * KVBLK); SBAR();
    pv_d0(o, vb0, pa0, pa1, pa2, pa3); partialSM(pB0, pB1, m_reg, mnB, alB);
    __syncthreads(); SWAIT(); SWRITE(0, SE);
    RESC(alB); __syncthreads();
    SBAR(); qkt(pA0, pA1, K_lds, qr, r32, hi);
    finishSM(pB0, pB1, alB, l_reg, pa0, pa1, pa2, pa3); SBAR();
    if (SDEPTH == 1 || j + 3 < NT) SLOAD(SE, (j + 1 + SDEPTH) * KVBLK); SBAR();
    pv_d0(o, vb0 + (int)SHM_V, pa0, pa1, pa2, pa3); partialSM(pA0, pA1, m_reg, mnA, alA);
    __syncthreads(); SWAIT(); SWRITE(1, SO);
    RESC(alA); __syncthreads();
  }
  SBAR(); qkt(pB0, pB1, (bf16*)((char*)K_lds + SHM_K), qr, r32, hi);
  finishSM(pA0, pA1, alA, l_reg, pa0, pa1, pa2, pa3); SBAR();
  pv_d0(o, vb0, pa0, pa1, pa2, pa3); partialSM(pB0, pB1, m_reg, mnB, alB);
  __syncthreads(); RESC(alB);
  finishSM(pB0, pB1, alB, l_reg, pa0, pa1, pa2, pa3); SBAR();
  pv_d0(o, vb0 + (int)SHM_V, pa0, pa1, pa2, pa3);
  if constexpr (!PART) {
  if (hi == 0) li_l[r32] = l_reg; asm volatile("s_waitcnt lgkmcnt(0)" ::: "memory");
  float rli[16];
#pragma unroll
  for (int r = 0; r < 16; ++r) rli[r] = __builtin_amdgcn_rcpf(li_l[crow(r, hi)]);
  __syncthreads();
  char* osc = lds + wid * OSC_BYTES;
#pragma unroll
  for (int r = 0; r < 16; ++r) { int orow = crow(r, hi);
    for (int d0 = 0; d0 < 4; ++d0) *(bf16*)(osc + orow * 256 + (d0 * 32 + r32) * 2) = __float2bfloat16(o[d0][r] * rli[r]); }
  o_tile_out(osc, Ob, wid, lane);
  if (done_cnt) { asm volatile("s_waitcnt vmcnt(0)" ::: "memory"); if (lane == 0) __hip_atomic_fetch_add(done_cnt, 1u, __ATOMIC_RELAXED, __HIP_MEMORY_SCOPE_AGENT); }
  } else {
  constexpr float C = SCALE * 1.4426950408889634f;
  const bool fin = (wid >> 2) == half;
  if (!fin) { unsigned long long* xs = xsend + (size_t)((wid & 3) * 17) * 64 + lane;
#pragma unroll
    for (int d0 = 0; d0 < 4; ++d0)
#pragma unroll
      for (int rq = 0; rq < 4; ++rq) { const unsigned long long w = (unsigned long long)cvtpk(o[d0][4 * rq], o[d0][4 * rq + 1]) | ((unsigned long long)cvtpk(o[d0][4 * rq + 2], o[d0][4 * rq + 3]) << 32);
        __hip_atomic_store(xs + (d0 * 4 + rq) * 64, w, __ATOMIC_RELAXED, __HIP_MEMORY_SCOPE_AGENT); }
    __hip_atomic_store(xs + 16 * 64, (unsigned long long)__float_as_uint(m_reg) | ((unsigned long long)__float_as_uint(l_reg) << 32), __ATOMIC_RELAXED, __HIP_MEMORY_SCOPE_AGENT); }
  asm volatile("s_waitcnt vmcnt(0)" ::: "memory");
  __syncthreads();
  if (tid == 0) { __hip_atomic_store(fl_mine, epoch, __ATOMIC_RELAXED, __HIP_MEMORY_SCOPE_AGENT);
    unsigned sp = 0; while (__hip_atomic_load(fl_partner, __ATOMIC_RELAXED, __HIP_MEMORY_SCOPE_AGENT) < epoch) { __builtin_amdgcn_s_sleep(1); if (++sp > (1u << 22)) break; } }
  __syncthreads();
  if (fin) { const unsigned long long* xr = xrecv + (size_t)((wid & 3) * 17) * 64 + lane;
    const unsigned long long ml = __hip_atomic_load(xr + 16 * 64, __ATOMIC_RELAXED, __HIP_MEMORY_SCOPE_AGENT);
    const float mp = __uint_as_float((unsigned)ml), lp = __uint_as_float((unsigned)(ml >> 32));
    const float mx = fmaxf(m_reg, mp), fa = __builtin_amdgcn_exp2f((m_reg - mx) * C), fb = __builtin_amdgcn_exp2f((mp - mx) * C);
    const float rl = __builtin_amdgcn_rcpf(l_reg * fa + lp * fb);
    if (hi == 0) { li_l[r32] = fa * rl; al_l[r32] = fb * rl; } asm volatile("s_waitcnt lgkmcnt(0)" ::: "memory");
    float sa[16], sb[16];
#pragma unroll
    for (int r = 0; r < 16; ++r) { sa[r] = li_l[crow(r, hi)]; sb[r] = al_l[crow(r, hi)]; }
    char* osc = lds + wid * OSC_BYTES;
    unsigned long long pwv[4][4];
#pragma unroll
    for (int d0 = 0; d0 < 4; ++d0)
#pragma unroll
      for (int rq = 0; rq < 4; ++rq) pwv[d0][rq] = __hip_atomic_load(xr + (d0 * 4 + rq) * 64, __ATOMIC_RELAXED, __HIP_MEMORY_SCOPE_AGENT);
#pragma unroll
    for (int d0 = 0; d0 < 4; ++d0)
#pragma unroll
      for (int rq = 0; rq < 4; ++rq) { const unsigned long long w = pwv[d0][rq];
        const unsigned wl = (unsigned)w, wh = (unsigned)(w >> 32);
        const float p0 = __uint_as_float(wl << 16), p1 = __uint_as_float(wl & 0xffff0000u), p2 = __uint_as_float(wh << 16), p3 = __uint_as_float(wh & 0xffff0000u);
        const int r = 4 * rq;
        *(bf16*)(osc + crow(r, hi) * 256 + (d0 * 32 + r32) * 2) = __float2bfloat16(o[d0][r] * sa[r] + p0 * sb[r]);
        *(bf16*)(osc + crow(r + 1, hi) * 256 + (d0 * 32 + r32) * 2) = __float2bfloat16(o[d0][r + 1] * sa[r + 1] + p1 * sb[r + 1]);
        *(bf16*)(osc + crow(r + 2, hi) * 256 + (d0 * 32 + r32) * 2) = __float2bfloat16(o[d0][r + 2] * sa[r + 2] + p2 * sb[r + 2]);
        *(bf16*)(osc + crow(r + 3, hi) * 256 + (d0 * 32 + r32) * 2) = __float2bfloat16(o[d0][r + 3] * sa[r + 3] + p3 * sb[r + 3]); }
      o_tile_out(osc, Ob, wid, lane);
      if (done_cnt) { asm volatile("s_waitcnt vmcnt(0)" ::: "memory"); if (lane == 0) __hip_atomic_fetch_add(done_cnt, 1u, __ATOMIC_RELAXED, __HIP_MEMORY_SCOPE_AGENT); } }
  }
#undef SLOAD
#undef SWRITE
#undef SWAIT
#undef RESC
}
}

constexpr int NWAVES = 8;
constexpr int DM = 1024, NTOK = 8192, NPR = 4096, FF = 4096, INW = 2048, INE = 2080, QKVW = 1536;
constexpr float EPS = 1e-6f;
constexpr size_t OUT_Y = 0, OUT_S5RE = 8388608, OUT_S5IM = OUT_S5RE + 65536, OUT_GLA = OUT_S5IM + 65536, OUT_NK = OUT_GLA + 1048576, OUT_NV = OUT_NK + 1048576, OUT_END = OUT_NV + 1048576;
constexpr size_t MiB = 1u << 20;
constexpr size_t WS_CTL = 0, CTL_ZERO_BYTES = 128 * 1024;
constexpr size_t WS_ADA = 1 * MiB;
constexpr size_t WS_CV = WS_ADA + 512 * 1024;
constexpr size_t WS_WIN = 2 * MiB, WS_WGLR = 6 * MiB, WS_WGLU = 6 * MiB + 512 * 1024, WS_WOUT = 7 * MiB, WS_W1 = 9 * MiB, WS_W2 = 25 * MiB, WS_WQKV = 41 * MiB, WS_WO = 44 * MiB;
constexpr size_t WS_H = 46 * MiB, WS_Y = 62 * MiB, WS_SCR = 94 * MiB;
constexpr size_t WS_Z = WS_SCR, WS_GD = WS_SCR + 32 * MiB, WS_G = WS_SCR + 48 * MiB, WS_UH = WS_SCR + 56 * MiB, WS_SLOC = WS_SCR + 72 * MiB, WS_SIN = WS_SCR + 104 * MiB, WS_DEC = WS_SCR + 120 * MiB,
                 WS_MIX = WS_SCR + 121 * MiB, WS_EBUF = WS_SCR + 88 * MiB  , WS_WY = WS_SCR + 137 * MiB, WS_WE = WS_SCR + 145 * MiB  , WS_BB = WS_SCR + 153 * MiB, WS_KB = WS_SCR + 154 * MiB, WS_RSW = WS_SCR + 155 * MiB  ;
constexpr size_t WS_ACT = WS_SCR, WS_XBUF = WS_SCR + 72 * MiB;
constexpr size_t WS_QKV = WS_SCR, WS_QN = WS_SCR + 121 * MiB, WS_KP = WS_SCR + 137 * MiB, WS_KS = WS_SCR + 139 * MiB, WS_VP = WS_SCR + 142 * MiB, WS_VS = WS_SCR + 144 * MiB,     WS_OB = WS_SCR + 104 * MiB;
constexpr size_t WS_END = WS_SCR + 156 * MiB;
static_assert(WS_END <= 256 * MiB, "d_ws map");
constexpr int CW_TS = 12800;
constexpr int CW_MLPCNT = 13312;
constexpr int CW_FLAG = 16384;
constexpr int CW_ADACNT = 512;
constexpr int CW_BAR = 1024;
constexpr int CW_BARG0 = 5120, CW_BARG1 = 9216;
constexpr int RING_BYTES = 131072, LDSCTL_OFF = RING_BYTES, MISC_OFF = LDSCTL_OFF + 320, LDS_BYTES = 147456;

#define GAS __attribute__((address_space(1)))
#define LAS __attribute__((address_space(3)))
typedef unsigned short bf16;
typedef unsigned v4u __attribute__((ext_vector_type(4)));
typedef unsigned v2u __attribute__((ext_vector_type(2)));
typedef float f32x4 __attribute__((ext_vector_type(4)));
typedef float f32x16 __attribute__((ext_vector_type(16)));
typedef short bf16x8 __attribute__((ext_vector_type(8)));
typedef short s16x4 __attribute__((ext_vector_type(4)));
typedef GAS unsigned gu32;
#define RLX_AGENT __ATOMIC_RELAXED, __HIP_MEMORY_SCOPE_AGENT
#define LDS_WAIT() asm volatile("s_waitcnt lgkmcnt(0)" ::: "memory")
#define VM_WAIT() asm volatile("s_waitcnt vmcnt(0)" ::: "memory")
__device__ __forceinline__ unsigned f2bf(float f) { unsigned u = __builtin_bit_cast(unsigned, f); return (u + 0x7fffu + ((u >> 16) & 1u)) >> 16; }
__device__ __forceinline__ unsigned pk2(float lo, float hi) { return f2bf(lo) | (f2bf(hi) << 16); }
__device__ __forceinline__ float bf2f(unsigned short b) { return __uint_as_float(((unsigned)b) << 16); }
__device__ __forceinline__ float bflo(unsigned w) { return __uint_as_float(w << 16); }
__device__ __forceinline__ float bfhi(unsigned w) { return __uint_as_float(w & 0xffff0000u); }
__device__ __forceinline__ float wave_sum(float v) {
#pragma unroll
    for (int o = 1; o < 64; o <<= 1) v += __shfl_xor(v, o);
    return v;
}
__device__ __forceinline__ int crow(int r, int hi) { return (r & 3) + 8 * (r >> 2) + 4 * hi; }
__device__ __forceinline__ s16x4 tr_read4(unsigned addr) { s16x4 r; asm volatile("ds_read_b64_tr_b16 %0, %1" : "=&v"(r) : "v"(addr) : "memory"); return r; }

#define XB_TMO      128
#define XB_XCNT(j)  (256  + 64 * (j))
#define XB_XSUB(j)  (1280 + 64 * (j))
#define XB_XGEN(j)  (2304 + 64 * (j))
#define XB_TOP      3328
#define XB_TOPGEN   3392
#define XCD_BAR_WORDS 3456
#define XB_SPIN_CAP (1u << 18)

__device__ __forceinline__ unsigned xb_ld(unsigned* p)              { return __hip_atomic_load(p, __ATOMIC_RELAXED, __HIP_MEMORY_SCOPE_AGENT); }
__device__ __forceinline__ unsigned xb_add(unsigned* p, unsigned v) { return __hip_atomic_fetch_add(p, v, __ATOMIC_RELAXED, __HIP_MEMORY_SCOPE_AGENT); }
__device__ __forceinline__ unsigned xb_xcc_id() { return (unsigned)__builtin_amdgcn_s_getreg((3 << 11) | 20) & 0xFu; }
#define XB_SPIN(cond, bar) do { unsigned _sp = 0; while (cond) { __builtin_amdgcn_s_sleep(1); \
    if ((++_sp & 255u) == 0u) { if (xb_ld(&(bar)[XB_TMO])) break; if (_sp > XB_SPIN_CAP) { atomicAdd(&(bar)[XB_TMO], 1u); break; } } } } while (0)

struct XcdBarrier {
    unsigned* bar; unsigned x;
    volatile LAS unsigned* st;
    unsigned gsize;
};

__device__ __forceinline__ XcdBarrier xcd_barrier_post(unsigned* bar, volatile LAS unsigned* st, unsigned gsize) {
    XcdBarrier b; b.bar = bar; b.x = xb_xcc_id(); b.st = st; b.gsize = gsize;
    if (threadIdx.x == 0) (void)xb_add(&bar[XB_XCNT(b.x)], 1u);
    return b;
}
__device__ __forceinline__ void xcd_barrier_complete(unsigned* bar, unsigned x, unsigned& nloc, unsigned& nx, unsigned gsize) {
    const unsigned G = gsize;
    unsigned sum, cnt, mine, sp = 0u;
    for (;;) {
        sum = 0u; cnt = 0u; mine = 0u;
#pragma unroll
        for (unsigned j = 0; j < 16; ++j) { const unsigned c = xb_ld(&bar[XB_XCNT(j)]); sum += c; cnt += (c > 0u) ? 1u : 0u; mine = (j == x) ? c : mine; }
        if (sum == G) break;
        __builtin_amdgcn_s_sleep(1);
        if ((++sp & 255u) == 0u) { if (xb_ld(&bar[XB_TMO])) break; if (sp > XB_SPIN_CAP) { atomicAdd(&bar[XB_TMO], 1u); break; } }
    }
    nloc = mine > 0u ? mine : 1u; nx = cnt > 0u ? cnt : 1u;
}

__device__ __forceinline__ void xcd_barrier(const XcdBarrier& b) {
    asm volatile("s_waitcnt vmcnt(0)" ::: "memory");
    __syncthreads();
    if (threadIdx.x == 0) {
        unsigned* bar = b.bar;
        __builtin_amdgcn_s_waitcnt(0);
        unsigned nloc = b.st[0], nx = b.st[1];
        if (nloc == 0u) { xcd_barrier_complete(bar, b.x, nloc, nx, b.gsize); b.st[0] = nloc; b.st[1] = nx; }
        const unsigned old = xb_add(&bar[XB_XSUB(b.x)], 1u);
        const unsigned gen = old / nloc;
        if (old + 1u == (gen + 1u) * nloc) {
            __builtin_amdgcn_fence(__ATOMIC_RELEASE, "agent");
            asm volatile("s_waitcnt vmcnt(0)" ::: "memory");
            const unsigned og = xb_add(&bar[XB_TOP], 1u);
            const unsigned tg = og / nx;
            if (og + 1u == (tg + 1u) * nx) xb_add(&bar[XB_TOPGEN], 1u);
            else XB_SPIN(xb_ld(&bar[XB_TOPGEN]) == tg, bar);
            __builtin_amdgcn_fence(__ATOMIC_ACQUIRE, "agent");
            xb_add(&bar[XB_XGEN(b.x)], 1u);
            asm volatile("s_waitcnt vmcnt(0)" ::: "memory");
        } else {
            XB_SPIN(xb_ld(&bar[XB_XGEN(b.x)]) == gen, bar);
            __builtin_amdgcn_fence(__ATOMIC_ACQUIRE, "agent");
            asm volatile("s_waitcnt vmcnt(0)" ::: "memory");
        }
    }
    __syncthreads();
}


struct SplitKOrder { int pm, pn;
    __device__ __forceinline__ bool next(int i, pg8::Unit& u) const { if (i > 0) return false; u.pm = pm; u.pn = pn; return true; }
    __device__ __forceinline__ void a_ready(const pg8::Unit&) const {}
    __device__ __forceinline__ void done(const pg8::Unit&) const {} };
struct PanelOrder { int pm, pn0; gu32* cnt;
    __device__ __forceinline__ bool next(int i, pg8::Unit& u) const { if (i > 1) return false; u.pm = pm; u.pn = pn0 + i; return true; }
    __device__ __forceinline__ void a_ready(const pg8::Unit&) const {}
    __device__ __forceinline__ void done(const pg8::Unit& u) const { asm volatile("s_waitcnt vmcnt(0)" ::: "memory");
        if ((threadIdx.x & 63) == 0) __hip_atomic_fetch_add((unsigned*)(cnt + (pm * 2 + (u.pn >> 3)) * 16), 1u, __ATOMIC_RELAXED, __HIP_MEMORY_SCOPE_AGENT); } };
__device__ __forceinline__ void panel_wait(gu32* cnt, int pm, unsigned target, int tid) {
    if (tid == 0) { unsigned sp = 0;
        while (__hip_atomic_load((unsigned*)(cnt + (pm * 2) * 16), __ATOMIC_RELAXED, __HIP_MEMORY_SCOPE_AGENT) < target || __hip_atomic_load((unsigned*)(cnt + (pm * 2 + 1) * 16), __ATOMIC_RELAXED, __HIP_MEMORY_SCOPE_AGENT) < target) { __builtin_amdgcn_s_sleep(1); if (++sp > (1u << 22)) break; }
        __builtin_amdgcn_fence(__ATOMIC_ACQUIRE, "agent"); asm volatile("s_waitcnt vmcnt(0)" ::: "memory"); }
    __syncthreads(); }
__device__ __forceinline__ void panel_chain(gu32* cnt, int pm, unsigned target, int tid) {
    asm volatile("s_waitcnt vmcnt(0)" ::: "memory"); __syncthreads();
    if (tid == 0) { __hip_atomic_fetch_add((unsigned*)(cnt + pm * 16), 1u, __ATOMIC_RELAXED, __HIP_MEMORY_SCOPE_AGENT); unsigned sp = 0;
        while (__hip_atomic_load((unsigned*)(cnt + pm * 16), __ATOMIC_RELAXED, __HIP_MEMORY_SCOPE_AGENT) < target) { __builtin_amdgcn_s_sleep(1); if (++sp > (1u << 22)) break; }
        __builtin_amdgcn_fence(__ATOMIC_ACQUIRE, "agent"); asm volatile("s_waitcnt vmcnt(0)" ::: "memory"); }
    __syncthreads(); }
__device__ __forceinline__ void qkv_wait(gu32* cnt, int G_, int tid) {
    if (tid == 0) { pg8::Unit u0; pg8::StaticOrder S0; S0.init(NTOK, QKVW, G_, (int)blockIdx.x + (tid >> 10));
        if (S0.next(0, u0)) { gu32* c9 = cnt + u0.pm * 16; unsigned sp = 0;
            while (__hip_atomic_load((unsigned*)c9, __ATOMIC_RELAXED, __HIP_MEMORY_SCOPE_AGENT) < 8u) { __builtin_amdgcn_s_sleep(1); if (++sp > (1u << 22)) break; }
            __builtin_amdgcn_fence(__ATOMIC_ACQUIRE, "agent"); asm volatile("s_waitcnt vmcnt(0)" ::: "memory"); } }
    __syncthreads(); }
__device__ __forceinline__ void z_arrive(gu32* ctl, int G_, int tid) {
    asm volatile("s_waitcnt vmcnt(0)" ::: "memory"); __syncthreads();
    if (tid == 0) { pg8::Unit u0; pg8::StaticOrder S0; S0.init(NTOK, INW, G_, (int)blockIdx.x + (tid >> 10));
        if (S0.next(0, u0)) __hip_atomic_fetch_add((unsigned*)(ctl + u0.pm * 16), 1u, __ATOMIC_RELAXED, __HIP_MEMORY_SCOPE_AGENT);
        __hip_atomic_fetch_add((unsigned*)(ctl + 544), 1u, __ATOMIC_RELAXED, __HIP_MEMORY_SCOPE_AGENT); } }
__device__ __forceinline__ void cnt_wait(gu32* c, unsigned target, int tid) {
    if (tid == 0) { unsigned sp = 0;
        while (__hip_atomic_load((unsigned*)c, __ATOMIC_RELAXED, __HIP_MEMORY_SCOPE_AGENT) < target) { __builtin_amdgcn_s_sleep(1); if (++sp > (1u << 22)) break; }
        __builtin_amdgcn_fence(__ATOMIC_ACQUIRE, "agent"); asm volatile("s_waitcnt vmcnt(0)" ::: "memory"); }
    __syncthreads(); }
__device__ __forceinline__ void s5_g_handoff(gu32* cg, int tid) {
    asm volatile("s_waitcnt vmcnt(0)" ::: "memory"); __syncthreads();
    if (tid == 0) { __hip_atomic_fetch_add((unsigned*)(cg + ((int)blockIdx.x & 1) * 16), 1u, __ATOMIC_RELAXED, __HIP_MEMORY_SCOPE_AGENT);
        pg8::Unit u0; pg8::StaticOrder S0; S0.init(NTOK, 512, 64, (int)blockIdx.x + (tid >> 10));
        if (S0.next(0, u0)) { gu32* c = cg + (u0.pm >> 4) * 16; unsigned sp = 0;
            while (__hip_atomic_load((unsigned*)c, __ATOMIC_RELAXED, __HIP_MEMORY_SCOPE_AGENT) < 32u) { __builtin_amdgcn_s_sleep(1); if (++sp > (1u << 22)) break; } }
        __builtin_amdgcn_fence(__ATOMIC_ACQUIRE, "agent"); asm volatile("s_waitcnt vmcnt(0)" ::: "memory"); }
    __syncthreads(); }
template <bool NEXT, bool BASE_BF16, bool OUT_BF16, bool XCH = true> struct EpiResidSplitT {
    static constexpr bool PERM = true, AFTER_DRAIN = true;
    const void* base_p; const void* base_s; void* out; const float* gate; bf16* xbuf; unsigned* flags; int epoch; int kh;
    bf16* Hn; const float* nw; const float* nsc; float* rsw;
    template <int KH> __device__ __forceinline__ void run(f32x4 (&acc)[2][2][4][2], const pg8::Unit& u, int wr, int wc, int fr, int fq, int tid, LAS unsigned char* lds) const {
        const int tile = u.pm * 4 + u.pn;
        const void* base = u.pm < 16 ? base_p : base_s;
        const int row0 = u.pm * 256 + KH * 128 + wr * 64 + fr; const int col0 = u.pn * 256 + wc * 32 + 8 * fq;
        f32x4 bpre[4][2][2];
#pragma unroll
        for (int m = 0; m < 4; ++m)
#pragma unroll
            for (int bj = 0; bj < 2; ++bj)
#pragma unroll
                for (int n = 0; n < 2; ++n) { const size_t eo = (size_t)(row0 + m * 16) * 1024 + col0 + bj * 128 + n * 4;
                    if (BASE_BF16) { const v2u bw = *(const v2u*)((const bf16*)base + eo); bpre[m][bj][n] = (f32x4){__uint_as_float(bw.x), __uint_as_float(bw.y), 0.f, 0.f}; }
                    else bpre[m][bj][n] = *(const f32x4*)((const float*)base + eo); }
        if (XCH) { bf16* xs = xbuf + ((size_t)(tile * 2 + KH) * 16) * 2048 + tid * 4;
#pragma unroll
        for (int bj = 0; bj < 2; ++bj)
#pragma unroll
            for (int m = 0; m < 4; ++m)
#pragma unroll
                for (int n = 0; n < 2; ++n) { const f32x4 a = acc[1 - KH][bj][m][n]; const unsigned long long w = (unsigned long long)pk2(a[0], a[1]) | ((unsigned long long)pk2(a[2], a[3]) << 32);
                    __hip_atomic_store((unsigned long long*)(xs + ((bj * 4 + m) * 2 + n) * 2048), w, __ATOMIC_RELAXED, __HIP_MEMORY_SCOPE_AGENT); }
        asm volatile("s_waitcnt vmcnt(0)" ::: "memory");
        __syncthreads();
        if (tid == 0) { gu32* fl = (gu32*)flags;
            __hip_atomic_store(fl + (tile * 2 + KH) * 64, (unsigned)epoch, __ATOMIC_RELAXED, __HIP_MEMORY_SCOPE_AGENT);
            unsigned sp = 0; while (__hip_atomic_load(fl + (tile * 2 + (1 - KH)) * 64, __ATOMIC_RELAXED, __HIP_MEMORY_SCOPE_AGENT) < (unsigned)epoch) { __builtin_amdgcn_s_sleep(1); if (++sp > (1u << 22)) break; } }
        __syncthreads(); }
        const bf16* xr = xbuf + ((size_t)(tile * 2 + (1 - KH)) * 16) * 2048 + tid * 4;
        const int cond = u.pm < 16 ? 0 : 1 + ((u.pm - 16) >> 2);
        const float* gp = gate + cond * 6144;
        f32x4 gv[2][2];
#pragma unroll
        for (int bj = 0; bj < 2; ++bj)
#pragma unroll
            for (int n = 0; n < 2; ++n) gv[bj][n] = *(const f32x4*)(gp + col0 + bj * 128 + n * 4);
        constexpr int MB = 2;
#pragma unroll
        for (int mp = 0; mp < 4 / MB; ++mp) {
        unsigned long long pwv[4][2][2];
        if (XCH) {
#pragma unroll
            for (int m = MB * mp; m < MB * mp + MB; ++m)
#pragma unroll
                for (int bj = 0; bj < 2; ++bj)
#pragma unroll
                    for (int n = 0; n < 2; ++n) pwv[m][bj][n] = __hip_atomic_load((const unsigned long long*)(xr + ((bj * 4 + m) * 2 + n) * 2048), __ATOMIC_RELAXED, __HIP_MEMORY_SCOPE_AGENT); }
#pragma unroll
        for (int m = MB * mp; m < MB * mp + MB; ++m) { const unsigned off = (unsigned)((row0 + m * 16) * 1024 + col0);
#pragma unroll
            for (int bj = 0; bj < 2; ++bj) { f32x4 yv[2];
#pragma unroll
                for (int n = 0; n < 2; ++n) { f32x4 p = {0.f, 0.f, 0.f, 0.f}; if (XCH) { const unsigned long long pw = pwv[m][bj][n]; const unsigned plo = (unsigned)pw, phi = (unsigned)(pw >> 32); p = (f32x4){bflo(plo), bfhi(plo), bflo(phi), bfhi(phi)}; }
                    f32x4 b; if (BASE_BF16) { const unsigned b0 = __float_as_uint(bpre[m][bj][n][0]), b1 = __float_as_uint(bpre[m][bj][n][1]); b = (f32x4){bflo(b0), bfhi(b0), bflo(b1), bfhi(b1)}; } else b = bpre[m][bj][n];
                    yv[n] = b + gv[bj][n] * (acc[KH][bj][m][n] + p);
                    if (NEXT) acc[KH][bj][m][n] = yv[n]; }
                if (OUT_BF16) { v4u ow; ow.x = pk2(yv[0][0], yv[0][1]); ow.y = pk2(yv[0][2], yv[0][3]); ow.z = pk2(yv[1][0], yv[1][1]); ow.w = pk2(yv[1][2], yv[1][3]);
                    __builtin_amdgcn_raw_buffer_store_b128(__builtin_bit_cast(pg8::u32x4, ow), __builtin_amdgcn_make_buffer_rsrc((void*)out, (short)0, 8192 * 1024 * 2, 0x00020000), (off + bj * 128) * 2u, 0, 16); }
                else { float* op = (float*)out + off + bj * 128; *(f32x4*)op = yv[0]; *(f32x4*)(op + 4) = yv[1]; } }
            } }
        if (NEXT) {
            asm volatile("" ::: "memory");
            int row0b = row0, col0b = col0; asm volatile("" : "+v"(row0b), "+v"(col0b));
            f32x4 av[2][2];
#pragma unroll
            for (int bj = 0; bj < 2; ++bj)
#pragma unroll
                for (int n = 0; n < 2; ++n) av[bj][n] = *(const f32x4*)(nw + col0b + bj * 128 + n * 4) * (*(const f32x4*)(nsc + cond * 6144 + col0b + bj * 128 + n * 4) + 1.0f);
#pragma unroll
            for (int m = 0; m < 4; ++m) { const int row = row0b + m * 16; const unsigned off = (unsigned)(row * 1024 + col0b); float ss = 0.f;
#pragma unroll
                for (int bj = 0; bj < 2; ++bj) { const f32x4 y0 = acc[KH][bj][m][0], y1 = acc[KH][bj][m][1];
                    ss += ((y0[0] * y0[0] + y0[1] * y0[1]) + (y0[2] * y0[2] + y0[3] * y0[3])) + ((y1[0] * y1[0] + y1[1] * y1[1]) + (y1[2] * y1[2] + y1[3] * y1[3]));
                    const f32x4 h0 = y0 * av[bj][0], h1 = y1 * av[bj][1];
                    v4u w; w.x = pk2(h0[0], h0[1]); w.y = pk2(h0[2], h0[3]); w.z = pk2(h1[0], h1[1]); w.w = pk2(h1[2], h1[3]);
                    __builtin_amdgcn_raw_buffer_store_b128(__builtin_bit_cast(pg8::u32x4, w), __builtin_amdgcn_make_buffer_rsrc((void*)Hn, (short)0, 8192 * 1024 * 2, 0x00020000), (off + bj * 128) * 2u, 0, 16); }
                ss += __shfl_xor(ss, 16); ss += __shfl_xor(ss, 32); if (fq == 0) ((LAS float*)lds)[(wr * 64 + m * 16 + fr) * 4 + wc] = ss; }
            __syncthreads();
            if (tid < 128) { const f32x4 p4 = *(const LAS f32x4*)((LAS float*)lds + tid * 4); __hip_atomic_store(rsw + (size_t)(u.pm * 256 + KH * 128 + tid) * 4 + u.pn, (p4[0] + p4[1]) + (p4[2] + p4[3]), __ATOMIC_RELAXED, __HIP_MEMORY_SCOPE_AGENT); }
        }
    }
    __device__ __forceinline__ void fused(f32x4 (&acc)[2][2][4][2], const pg8::Unit& u, int wr, int wc, int fr, int fq, LAS unsigned char* lds, int wid, int lane) const {
        if (kh == 0) run<0>(acc, u, wr, wc, fr, fq, wid * 64 + lane, lds); else run<1>(acc, u, wr, wc, fr, fq, wid * 64 + lane, lds);
    }
};

struct Args { const float* in[34]; float* out; unsigned char* ws; int ph_lo, ph_hi; };
typedef const __attribute__((address_space(4))) Args CArgs;
__device__ __forceinline__ CArgs* kargs() { CArgs* p = (CArgs*)__builtin_amdgcn_kernarg_segment_ptr(); asm volatile("" : "+s"(p)); return p; }
#define KA (*kargs())
#ifndef TS_ON
#define TS_ON 0
#endif
#ifndef TS_A
#define TS_A 0
#endif
#ifndef TS_B
#define TS_B 1
#endif
#ifndef TS_CAL
#define TS_CAL 0
#endif
#if TS_ON
#define STAMP(i) do { if (blockIdx.x == 0 && threadIdx.x == 0) ((unsigned long long*)((gu32*)(ws + WS_CTL) + CW_TS))[i] = __builtin_amdgcn_s_memrealtime(); } while (0)
#define STAMPB(i, blk) do { if (blockIdx.x == (blk) && threadIdx.x == 0) { asm volatile("s_waitcnt vmcnt(0)" ::: "memory"); ((unsigned long long*)((gu32*)(ws + WS_CTL) + CW_TS))[i] = __builtin_amdgcn_s_memrealtime(); } } while (0)
#else
#define STAMP(i) do {} while (0)
#define STAMPB(i, blk) do {} while (0)
#endif
__device__ __forceinline__ int tid_opaque() { int t = threadIdx.x; asm volatile("" : "+v"(t)); return t; }

__device__ __forceinline__ void p0_transpose_item(const float* W, int ld, int K, bf16* WT, int nblk, LAS float* scr, int item, int lane) {
    const int kb = item / nblk, nb = item % nblk, k0 = 64 * kb, n0 = 32 * nb;
#pragma unroll
    for (int i = 0; i < 8; ++i) { const int kk = 8 * i + (lane >> 3), c4 = 4 * (lane & 7); const f32x4 v = *(const f32x4*)(W + (size_t)(k0 + kk) * ld + n0 + c4);
        scr[kk * 33 + c4] = v[0]; scr[kk * 33 + c4 + 1] = v[1]; scr[kk * 33 + c4 + 2] = v[2]; scr[kk * 33 + c4 + 3] = v[3]; }
    LDS_WAIT(); asm volatile("" ::: "memory");
    const int c = lane & 7;
#pragma unroll
    for (int j = 0; j < 4; ++j) { const int n = (lane >> 3) + 8 * j; const LAS float* s = scr + (8 * c) * 33 + n;
        v4u o; o.x = pk2(s[0 * 33], s[1 * 33]); o.y = pk2(s[2 * 33], s[3 * 33]); o.z = pk2(s[4 * 33], s[5 * 33]); o.w = pk2(s[6 * 33], s[7 * 33]);
        *(GAS v4u*)(WT + (size_t)(n0 + n) * K + k0 + 8 * c) = o; }
    LDS_WAIT(); asm volatile("" ::: "memory");
}
__device__ __forceinline__ void ada_block(CArgs& A, LAS unsigned char* lds, int ab, int tid, int lane, int wave) {
    unsigned char* ws = A.ws;
    LAS float* sc = (LAS float*)(lds);
    LAS float* red = (LAS float*)(lds + 20480);
    for (int i = tid; i < 5 * 1024; i += 512) { const int c = i >> 10, k = i & 1023; const float x = c == 0 ? A.in[8][k] : A.in[7][(c - 1) * 1024 + k]; sc[i] = x / (1.f + __expf(-x)); }
    __syncthreads();
    const int layer = ab >> 7, n0 = (ab & 127) * 48;
    const float* W = A.in[11] + (size_t)layer * 1024 * 6144 + n0;
    const int kq = lane / 12, nq = lane % 12;
    f32x4 acc[5];
#pragma unroll
    for (int c = 0; c < 5; ++c) acc[c] = (f32x4){0.f, 0.f, 0.f, 0.f};
    if (kq < 4) {
#pragma unroll 8
        for (int i = 0; i < 32; ++i) { const int k = 128 * wave + 4 * i + kq; const f32x4 w = *(const f32x4*)(W + (size_t)k * 6144 + 4 * nq);
#pragma unroll
            for (int c = 0; c < 5; ++c) acc[c] += w * sc[c * 1024 + k]; }
#pragma unroll
        for (int c = 0; c < 5; ++c) *(LAS f32x4*)(red + ((wave * 4 + kq) * 5 + c) * 48 + 4 * nq) = acc[c];
    }
    __syncthreads();
    if (tid < 240) { const int c = tid / 48, n = tid % 48; float s = 0.f;
#pragma unroll 8
        for (int p = 0; p < 32; ++p) s += red[(p * 5 + c) * 48 + n];
        ((float*)(ws + WS_ADA))[(size_t)(layer * 5 + c) * 6144 + n0 + n] = s + A.in[12][layer * 6144 + n0 + n]; }
    __syncthreads();
}
__device__ __forceinline__ void ada_block32(CArgs& A, LAS unsigned char* lds, int ab, int tid, int lane, int wave) {
    unsigned char* ws = A.ws;
    LAS float* sc = (LAS float*)(lds);
    LAS float* red = (LAS float*)(lds + 20480);
    for (int i = tid; i < 5 * 1024; i += 512) { const int c = i >> 10, k = i & 1023; const float x = c == 0 ? A.in[8][k] : A.in[7][(c - 1) * 1024 + k]; sc[i] = x / (1.f + __expf(-x)); }
    __syncthreads();
    const int n0 = ab * 32, kq = lane >> 3, nq = lane & 7;
    const float* W = A.in[11] + n0 + 4 * nq;
    f32x4 acc[5];
#pragma unroll
    for (int c = 0; c < 5; ++c) acc[c] = (f32x4){0.f, 0.f, 0.f, 0.f};
#pragma unroll 8
    for (int i = 0; i < 16; ++i) { const int k = 128 * wave + 8 * i + kq; const f32x4 w = *(const f32x4*)(W + (size_t)k * 6144);
#pragma unroll
        for (int c = 0; c < 5; ++c) acc[c] += w * sc[c * 1024 + k]; }
#pragma unroll
    for (int c = 0; c < 5; ++c) *(LAS f32x4*)(red + ((wave * 8 + kq) * 5 + c) * 32 + 4 * nq) = acc[c];
    __syncthreads();
    if (tid < 160) { const int c = tid >> 5, n = tid & 31; float s_ = 0.f;
#pragma unroll 8
        for (int p = 0; p < 64; ++p) s_ += red[(p * 5 + c) * 32 + n];
        __hip_atomic_store((float*)(ws + WS_ADA) + (size_t)c * 6144 + n0 + n, s_ + A.in[12][n0 + n], __ATOMIC_RELAXED, __HIP_MEMORY_SCOPE_AGENT); }
    asm volatile("s_waitcnt vmcnt(0)" ::: "memory");
    __syncthreads();
    if (tid == 0) __hip_atomic_fetch_add((unsigned*)((gu32*)(ws + WS_CTL) + CW_ADACNT), 1u, __ATOMIC_RELAXED, __HIP_MEMORY_SCOPE_AGENT);
}
__device__ __forceinline__ void ada_wait(CArgs& A, int tid) {
    if (tid == 0) { gu32* cnt = (gu32*)(A.ws + WS_CTL) + CW_ADACNT; unsigned sp = 0;
        while (__hip_atomic_load(cnt, __ATOMIC_RELAXED, __HIP_MEMORY_SCOPE_AGENT) < 192u || __hip_atomic_load(cnt + 16, __ATOMIC_RELAXED, __HIP_MEMORY_SCOPE_AGENT) < 2u) { __builtin_amdgcn_s_sleep(1); if (++sp > (1u << 22)) break; }
        __builtin_amdgcn_fence(__ATOMIC_ACQUIRE, "agent"); asm volatile("s_waitcnt vmcnt(0)" ::: "memory"); }
    __syncthreads();
}
constexpr int T_IN = 16 * 65, T_OUT = 16 * 32, T_GLU = 8 * 16, T_M1 = 16 * 128, T_M2 = 64 * 32, T_QKV = 16 * 48, T_WO = 16 * 32;
constexpr int T_EARLY = T_IN + T_OUT + T_GLU, T_ALL = T_EARLY + 2 * T_M1 + 2 * T_M2 + T_QKV + T_WO;
__device__ __forceinline__ void transpose_items(CArgs& A, LAS unsigned char* lds, int it0, int it1, int gw, int ngw, int lane, int wave) {
    unsigned char* ws = A.ws;
    LAS float* scr = (LAS float*)(lds + wave * 16384);
    for (int it = it0 + gw; it < it1; it += ngw) {
        int r = it;
        if (r < T_IN) { const int kb = r / 65, nb = r % 65;
            if (nb < 64) p0_transpose_item(A.in[15], INE, 1024, (bf16*)(ws + WS_WIN), 64, scr, kb * 64 + nb, lane);
            else {   }
            continue; } r -= T_IN;
        if (r < T_OUT) { p0_transpose_item(A.in[16], 1024, 1024, (bf16*)(ws + WS_WOUT), 32, scr, r, lane); continue; } r -= T_OUT;
        if (r < T_GLU) { p0_transpose_item(A.in[25], 512, 512, (bf16*)(ws + WS_WGLU), 16, scr, r, lane); continue; } r -= T_GLU;
        if (r < 2 * T_M1) { const int l = r / T_M1; p0_transpose_item(A.in[13] + (size_t)l * 1024 * 4096, 4096, 1024, (bf16*)(ws + WS_W1) + (size_t)l * 4096 * 1024, 128, scr, r % T_M1, lane); continue; } r -= 2 * T_M1;
        if (r < 2 * T_M2) { const int l = r / T_M2; p0_transpose_item(A.in[14] + (size_t)l * 4096 * 1024, 1024, 4096, (bf16*)(ws + WS_W2) + (size_t)l * 1024 * 4096, 32, scr, r % T_M2, lane); continue; } r -= 2 * T_M2;
        if (r < T_QKV) { p0_transpose_item(A.in[30], 1536, 1024, (bf16*)(ws + WS_WQKV), 48, scr, r, lane); continue; } r -= T_QKV;
        p0_transpose_item(A.in[31], 1024, 1024, (bf16*)(ws + WS_WO), 32, scr, r, lane);
    }
}

template <bool GLR>
__device__ __forceinline__ void norm_phase(CArgs& A, LAS unsigned char* lds, const float* src_p, const float* src_s, const float* g, const float* ada, int ch_shift, int ch_scale,
                                           int tid, int lane, int wave) {
    unsigned char* ws = A.ws;
    bf16* H = (bf16*)(ws + WS_H);
    for (int blk = blockIdx.x; blk < NTOK / 32; blk += gridDim.x) {
        const int r0 = blk * 32; const int cond = r0 < NPR ? 0 : 1 + ((r0 - NPR) >> 10);
        const float* src = r0 < NPR ? src_p : src_s;
        const float* adc = ada + cond * 6144;
        f32x4 ga[4], gb[4];
#pragma unroll
        for (int j = 0; j < 4; ++j) { const int col = 8 * lane + 512 * (j >> 1) + 4 * (j & 1); const f32x4 gg = *(const f32x4*)(g + col), s1 = *(const f32x4*)(adc + ch_scale * 1024 + col); ga[j] = gg * (s1 + 1.0f); gb[j] = *(const f32x4*)(adc + ch_shift * 1024 + col); }
        const __amdgpu_buffer_rsrc_t hrs = __builtin_amdgcn_make_buffer_rsrc((void*)H, (short)0, 8192 * 1024 * 2, 0x00020000);
        f32x4 vv[4][4];
#pragma unroll
        for (int i = 0; i < 4; ++i) { const GAS f32x4* xr = (const GAS f32x4*)(src + (size_t)(r0 + wave * 4 + i) * 1024) + 2 * lane;
#pragma unroll
            for (int j = 0; j < 4; ++j) vv[i][j] = xr[128 * (j >> 1) + (j & 1)]; }
        asm volatile("" ::: "memory");
#pragma unroll
        for (int i = 0; i < 4; ++i) { const int row = r0 + wave * 4 + i;
            f32x4 v[4]; float s = 0.f;
#pragma unroll
            for (int j = 0; j < 4; ++j) { v[j] = vv[i][j]; s += (v[j].x * v[j].x + v[j].y * v[j].y) + (v[j].z * v[j].z + v[j].w * v[j].w); }
            const float rstd = 1.f / sqrtf(wave_sum(s) * (1.f / 1024.f) + EPS);
#pragma unroll
            for (int c = 0; c < 2; ++c) { const f32x4 h0 = v[2 * c] * rstd * ga[2 * c] + gb[2 * c], h1 = v[2 * c + 1] * rstd * ga[2 * c + 1] + gb[2 * c + 1];
                v4u w; w.x = pk2(h0.x, h0.y); w.y = pk2(h0.z, h0.w); w.z = pk2(h1.x, h1.y); w.w = pk2(h1.z, h1.w);
                __builtin_amdgcn_raw_buffer_store_b128(__builtin_bit_cast(pg8::u32x4, w), hrs, (unsigned)((row * 1024 + 8 * lane + 512 * c) * 2), 0, 16);
                if (GLR) *(LAS v4u*)(lds + (wave * 4 + i) * 2064 + (8 * lane + 512 * c) * 2) = w; }
        }
        if (GLR) {
            __syncthreads();
            const bf16* WG = (const bf16*)(ws + WS_WGLR);
            const int r32 = lane & 31, hi = lane >> 5;
            f32x16 acc = {};
#pragma unroll
            for (int ks = 0; ks < 8; ++ks) { const int k = wave * 128 + ks * 16 + hi * 8;
                const bf16x8 a = *(const LAS bf16x8*)(lds + r32 * 2064 + k * 2);
                const bf16x8 b = *(const bf16x8*)(WG + (size_t)r32 * 1024 + k);
                acc = __builtin_amdgcn_mfma_f32_32x32x16_bf16(a, b, acc, 0, 0, 0); }
            LAS float* red = (LAS float*)(lds + 69632);
#pragma unroll
            for (int r = 0; r < 16; ++r) red[(wave * 32 + crow(r, hi)) * 32 + r32] = acc[r];
            __syncthreads();
            LAS float* glrs = (LAS float*)(lds + 69632 + 32768);
#pragma unroll
            for (int e = 0; e < 2; ++e) { const int idx = tid + 512 * e; float s = 0.f;
#pragma unroll
                for (int w = 0; w < 8; ++w) s += red[w * 1024 + idx];
                glrs[idx] = s; }
            __syncthreads();
            { const int dcol = tid >> 8, hk = tid & 255; float wg2[16];
#pragma unroll
                for (int r = 0; r < 16; ++r) wg2[r] = A.in[27][(size_t)(dcol * 16 + r) * 256 + hk];
                const float bg = A.in[28][dcol * 256 + hk];
                bf16* GDo = (bf16*)(ws + WS_GD);
                for (int row = 0; row < 32; ++row) { float x = bg;
#pragma unroll
                    for (int r = 0; r < 16; ++r) x = fmaf(glrs[row * 32 + 16 * dcol + r], wg2[r], x);
                    const float ls = fminf(x, 0.f) - __logf(1.f + __expf(-fabsf(x)));
                    GDo[(size_t)(r0 + row) * 512 + tid] = (bf16)f2bf(ls * (1.f / 16.f)); } }
            __syncthreads();
        }
    }
}

__device__ __forceinline__ float gelu_tanh(float y) { const float z = 0.7978845608028654f * (y + 0.044715f * y * y * y); const float e = __expf(2.f * z); const float t = 1.f - 2.f * __builtin_amdgcn_rcpf(e + 1.f); return 0.5f * y * (1.f + t); }
#define S5_PW(lds) ((LAS float*)(lds))
#define S5_BB(lds) (S5_PW(lds) + 2 * 17 * 64 * 2)
#define BBI(d, p, c) ((((d) * 64 + (p)) * 17 + (c)) * 2)
#define S5_CL(lds) (S5_BB(lds) + 2 * 64 * 17 * 2)
#define CLI(c, p) (((p) * 17 + (c)) * 2)
#define S5_KL(lds) (S5_CL(lds) + 64 * 17 * 2)
#define S5_DL(lds) (S5_KL(lds) + 2 * 16 * 16 * 16)
__device__ __forceinline__ void s5_small(CArgs& A, LAS unsigned char* lds, int g, bool write_bb, int tid) {
    unsigned char* ws = A.ws;
    LAS float* Pw = S5_PW(lds); LAS float* BBl = S5_BB(lds); LAS float* Cl = S5_CL(lds);
    if (tid < 128) { const int d = tid >> 6, p = tid & 63;
        const float lre = A.in[17][(d * 32 + g) * 64 + p], lim = A.in[18][(d * 32 + g) * 64 + p];
        const float dt = __expf(A.in[19][d * 32 + g]);
        const float a_ = lre * dt, th = lim * dt;
        const float sn = __sinf(th), cs = __cosf(th);
        const float ea = __expf(a_);
        const float lb_re = ea * cs, lb_im = ea * sn;
        const float sh = __sinf(0.5f * th);
        const float em1 = a_ * (1.f + a_ * (0.5f + a_ * (0.16666667f + a_ * (0.041666668f + a_ * 0.0083333338f))));
        const float nr = em1 * cs - 2.f * sh * sh, ni = ea * sn;
        const float den = 1.f / (lre * lre + lim * lim);
        const float cf_re = (nr * lre + ni * lim) * den, cf_im = (ni * lre - nr * lim) * den;
        float pr = 1.f, pi = 0.f;
        for (int t = 0; t <= 16; ++t) { Pw[((d * 17 + t) * 64 + p) * 2] = pr; Pw[((d * 17 + t) * 64 + p) * 2 + 1] = pi; const float n0 = pr * lb_re - pi * lb_im, n1 = pr * lb_im + pi * lb_re; pr = n0; pi = n1; }
        float* BBg = (float*)(ws + WS_BB) + (size_t)(g * 2 + d) * 2048;
        f32x4 br4[4], bi4[4];
#pragma unroll
        for (int k = 0; k < 4; ++k) { br4[k] = *(const f32x4*)(A.in[20] + (size_t)(g * 64 + p) * 16 + 4 * k); bi4[k] = *(const f32x4*)(A.in[21] + (size_t)(g * 64 + p) * 16 + 4 * k); }
#pragma unroll
        for (int c = 0; c < 16; ++c) { const float br = br4[c >> 2][c & 3], bi = bi4[c >> 2][c & 3];
            const float vr = cf_re * br - cf_im * bi, vi = cf_re * bi + cf_im * br;
            BBl[BBI(d, p, c)] = vr; BBl[BBI(d, p, c) + 1] = vi; if (write_bb) { BBg[p * 16 + c] = vr; BBg[1024 + p * 16 + c] = vi; } }
    } else { if (tid < 144) S5_DL(lds)[tid - 128] = A.in[24][g * 16 + tid - 128];
        for (int i = tid - 128; i < 1024; i += 384) { Cl[CLI(i >> 6, i & 63)] = A.in[22][(size_t)g * 1024 + i]; Cl[CLI(i >> 6, i & 63) + 1] = A.in[23][(size_t)g * 1024 + i]; } }
    __syncthreads();
}
__device__ __forceinline__ void s5_k_mfma(LAS unsigned char* lds, int lane, int wave) {
    LAS float* Pw = S5_PW(lds); LAS float* BBl = S5_BB(lds); LAS float* Cl = S5_CL(lds); LAS float* Kl = S5_KL(lds);
    const int rc = lane & 15, q = lane >> 4, d = wave >> 2;
    bf16x8 bfr[4];
#pragma unroll
    for (int ks = 0; ks < 4; ++ks) { unsigned w[4];
#pragma unroll
        for (int j = 0; j < 8; j += 2) { const int k0 = 32 * ks + 8 * q + j, p0 = k0 & 63, im = k0 >> 6;
            w[j >> 1] = pk2(BBl[BBI(d, p0, rc) + im], BBl[BBI(d, p0 + 1, rc) + im]); }
        bfr[ks] = __builtin_bit_cast(bf16x8, (v4u){w[0], w[1], w[2], w[3]}); }
#pragma unroll
    for (int t4 = 0; t4 < 4; ++t4) { const int tau = (wave & 3) * 4 + t4; f32x4 acc = {0.f, 0.f, 0.f, 0.f};
#pragma unroll
        for (int ks = 0; ks < 4; ++ks) { unsigned w[4];
#pragma unroll
            for (int j = 0; j < 8; j += 2) { float v[2];
#pragma unroll
                for (int e = 0; e < 2; ++e) { const int k = 32 * ks + 8 * q + j + e, p = k & 63; const float cr = Cl[CLI(rc, p)], ci = Cl[CLI(rc, p) + 1], pr = Pw[((d * 17 + tau) * 64 + p) * 2], pi = Pw[((d * 17 + tau) * 64 + p) * 2 + 1];
                    v[e] = k < 64 ? (cr * pr - ci * pi) : -(cr * pi + ci * pr); }
                w[j >> 1] = pk2(v[0], v[1]); }
            acc = __builtin_amdgcn_mfma_f32_16x16x32_bf16(__builtin_bit_cast(bf16x8, (v4u){w[0], w[1], w[2], w[3]}), bfr[ks], acc, 0, 0, 0); }
#pragma unroll
        for (int r = 0; r < 4; ++r) Kl[((d * 16 + tau) * 16 + 4 * q + r) * 16 + rc] = acc[r]; }
    __syncthreads();
}
__device__ __forceinline__ void s5_expand(CArgs& A, LAS unsigned char* lds, int g, int q, int tid) {
    unsigned char* ws = A.ws;
    LAS float* Pw = S5_PW(lds); LAS float* BBl = S5_BB(lds); LAS float* Cl = S5_CL(lds); LAS float* Kl = S5_KL(lds);
    unsigned* WYg = (unsigned*)((bf16*)(ws + WS_WY) + (size_t)g * 256 * 512);
    typedef float lf2 __attribute__((ext_vector_type(2)));
    for (int i = q * 32 * 256 + tid; i < (q + 1) * 32 * 256; i += 512) { const int n = i >> 8, k0 = (i & 255) * 2; const int t = n >> 4, c = n & 15; lf2 v;
        if (k0 < 256) { const int s_ = k0 >> 4, c2 = k0 & 15;
            if (s_ < t) v = *(const LAS lf2*)(Kl + ((0 * 16 + (t - s_)) * 16 + c) * 16 + c2);
            else if (s_ > t) v = *(const LAS lf2*)(Kl + ((1 * 16 + (s_ - t)) * 16 + c) * 16 + c2);
            else { v = *(const LAS lf2*)(Kl + ((0 * 16 + 0) * 16 + c) * 16 + c2) + *(const LAS lf2*)(Kl + ((1 * 16 + 0) * 16 + c) * 16 + c2); const float dd = S5_DL(lds)[c]; if (c == c2) v[0] += dd; if (c == c2 + 1) v[1] += dd; }
        } else { const int kk = k0 - 256, d = kk >> 7, im = (kk >> 6) & 1, p = kk & 63; const int tau = d == 0 ? t + 1 : 16 - t;
            const lf2 c0 = *(const LAS lf2*)(Cl + CLI(c, p)), c1 = *(const LAS lf2*)(Cl + CLI(c, p + 1));
            const lf2 p0 = *(const LAS lf2*)(Pw + ((d * 17 + tau) * 64 + p) * 2), p1 = *(const LAS lf2*)(Pw + ((d * 17 + tau) * 64 + p + 1) * 2);
            v[0] = im ? -(c0[0] * p0[1] + c0[1] * p0[0]) : (c0[0] * p0[0] - c0[1] * p0[1]);
            v[1] = im ? -(c1[0] * p1[1] + c1[1] * p1[0]) : (c1[0] * p1[0] - c1[1] * p1[1]); }
        WYg[i] = pk2(v[0], v[1]); }
    unsigned* WEg = (unsigned*)((bf16*)(ws + WS_WE) + (size_t)g * 256 * 512);
    for (int i = q * 32 * 128 + tid; i < (q + 1) * 32 * 128; i += 512) { const int n = i >> 7, k0 = (i & 127) * 2; const int d = n >> 7, im = (n >> 6) & 1, p = n & 63;
        const int s_ = k0 >> 4, c2 = k0 & 15; const int tau = d == 0 ? 15 - s_ : s_;
        const lf2 pw = *(const LAS lf2*)(Pw + ((d * 17 + tau) * 64 + p) * 2), b0 = *(const LAS lf2*)(BBl + BBI(d, p, c2)), b1 = *(const LAS lf2*)(BBl + BBI(d, p, c2 + 1));
        const float v0 = im ? (pw[0] * b0[1] + pw[1] * b0[0]) : (pw[0] * b0[0] - pw[1] * b0[1]), v1 = im ? (pw[0] * b1[1] + pw[1] * b1[0]) : (pw[0] * b1[0] - pw[1] * b1[1]);
        WEg[n * 256 + (i & 127)] = pk2(v0, v1); }
    __syncthreads();
}
__device__ __forceinline__ void s5_recur(CArgs& A, LAS unsigned char* lds, int g, int mt, int tid) {
    unsigned char* ws = A.ws;
    const bf16* EB = (const bf16*)(ws + WS_EBUF) + (size_t)(g * 512 + mt * 256) * 256;
    bf16* UHg = (bf16*)(ws + WS_UH) + (size_t)(g * 512 + mt * 256) * 512;
    LAS unsigned short* El = (LAS unsigned short*)lds;
    { v2u ew[32];
#pragma unroll
      for (int it = 0; it < 32; ++it) ew[it] = *(const v2u*)(EB + (size_t)(tid + 512 * it) * 4);
#pragma unroll
      for (int it = 0; it < 32; ++it) *(LAS v2u*)(El + (size_t)(tid + 512 * it) * 4) = ew[it]; }
    __syncthreads();
    { const int p = tid & 63, w = tid >> 6;
        float prd[2], pid[2];
#pragma unroll
        for (int d = 0; d < 2; ++d) { const float lre = A.in[17][(d * 32 + g) * 64 + p], lim = A.in[18][(d * 32 + g) * 64 + p]; const float dt = __expf(A.in[19][d * 32 + g]);
            const float sn = __sinf(lim * dt), cs = __cosf(lim * dt), ea = __expf(lre * dt); float pr = ea * cs, pi = ea * sn;
#pragma unroll
            for (int s_ = 0; s_ < 4; ++s_) { const float n0 = pr * pr - pi * pi, n1 = 2.f * pr * pi; pr = n0; pi = n1; }
            prd[d] = pr; pid[d] = pi; }
        if (mt == 1) { const int d = w >> 2, b = w & 3; const float pr = d ? prd[1] : prd[0], pi = d ? pid[1] : pid[0];
            float hr = A.in[2][(size_t)((b * 2 + d) * 32 + g) * 64 + p], hi_ = A.in[3][(size_t)((b * 2 + d) * 32 + g) * 64 + p];
#pragma unroll 8
            for (int st = 0; st < 64; ++st) { const int r = b * 64 + (d == 0 ? st : 63 - st);
                bf16* up = UHg + (size_t)r * 512 + 256 + d * 128 + p; up[0] = (bf16)f2bf(hr); up[64] = (bf16)f2bf(hi_);
                const float er = bf2f(El[r * 256 + d * 128 + p]), ei = bf2f(El[r * 256 + d * 128 + 64 + p]);
                const float n0 = pr * hr - pi * hi_ + er, n1 = pr * hi_ + pi * hr + ei; hr = n0; hi_ = n1; }
        } else {
#pragma unroll
            for (int d = 0; d < 2; ++d) { const float* BBg = (const float*)(ws + WS_BB) + (size_t)(g * 2 + d) * 2048 + p * 16; f32x4 br[4], bi[4];
#pragma unroll
                for (int q = 0; q < 4; ++q) { br[q] = *(const f32x4*)(BBg + 4 * q); bi[q] = *(const f32x4*)(BBg + 1024 + 4 * q); }
#pragma unroll
                for (int bs = 0; bs < 2; ++bs) { const int b = w + 8 * bs; const int r = b * 16 + (d == 0 ? 0 : 15), s_ = d == 0 ? 0 : 15;
                    const v4u u0 = *(const v4u*)(UHg + (size_t)r * 512 + s_ * 16), u1 = *(const v4u*)(UHg + (size_t)r * 512 + s_ * 16 + 8);
                    float fr_ = 0.f, fi_ = 0.f;
#pragma unroll
                    for (int e = 0; e < 4; ++e) { const float ua = bflo(u0[e]), ub = bfhi(u0[e]), uc = bflo(u1[e]), ud = bfhi(u1[e]);
                        fr_ += br[e >> 1][(2 * e) & 3] * ua + br[e >> 1][(2 * e + 1) & 3] * ub + br[2 + (e >> 1)][(2 * e) & 3] * uc + br[2 + (e >> 1)][(2 * e + 1) & 3] * ud;
                        fi_ += bi[e >> 1][(2 * e) & 3] * ua + bi[e >> 1][(2 * e + 1) & 3] * ub + bi[2 + (e >> 1)][(2 * e) & 3] * uc + bi[2 + (e >> 1)][(2 * e + 1) & 3] * ud; }
                    A.out[OUT_S5RE + (size_t)((b * 2 + d) * 32 + g) * 64 + p] = fr_; A.out[OUT_S5IM + (size_t)((b * 2 + d) * 32 + g) * 64 + p] = fi_; } }
            float hr[4] = {0.f, 0.f, 0.f, 0.f}, hi_[4] = {0.f, 0.f, 0.f, 0.f};
#pragma unroll 4
            for (int st = 0; st < 16; ++st) {
#pragma unroll
                for (int c4 = 0; c4 < 4; ++c4) { const int d = c4 >> 1, b = w + 8 * (c4 & 1); const int r = b * 16 + (d == 0 ? st : 15 - st);
                    bf16* up = UHg + (size_t)r * 512 + 256 + d * 128 + p; up[0] = (bf16)f2bf(hr[c4]); up[64] = (bf16)f2bf(hi_[c4]);
                    const float er = bf2f(El[r * 256 + d * 128 + p]), ei = bf2f(El[r * 256 + d * 128 + 64 + p]);
                    const float n0 = prd[d] * hr[c4] - pid[d] * hi_[c4] + er, n1 = prd[d] * hi_[c4] + pid[d] * hr[c4] + ei; hr[c4] = n0; hi_[c4] = n1; } }
        }
    }
    VM_WAIT(); __syncthreads();
}
struct GroupOrder { int c, G_;
    __device__ __forceinline__ bool next(int i, pg8::Unit& u) const { const int L = i * G_ + c; if (L >= 64) return false; u.pm = L; u.pn = L >> 1; return true; }
    __device__ __forceinline__ void a_ready(const pg8::Unit&) const {}
    __device__ __forceinline__ void done(const pg8::Unit&) const {} };
struct EpiF32 {
    static constexpr bool PERM = false, AFTER_DRAIN = false; bf16* O;
    __device__ __forceinline__ void operator()(const f32x4 (&acc)[2][2][4][2], const pg8::Unit& u, int wr, int wc, int fr, int fq) const {
        const int row0 = u.pm * 256 + wr * 64 + fr, col0 = wc * 32 + 4 * fq;
#pragma unroll
        for (int ai = 0; ai < 2; ++ai)
#pragma unroll
            for (int m = 0; m < 4; ++m)
#pragma unroll
                for (int bj = 0; bj < 2; ++bj)
#pragma unroll
                    for (int n = 0; n < 2; ++n) { const f32x4 a = acc[ai][bj][m][n]; v2u w; w.x = pk2(a[0], a[1]); w.y = pk2(a[2], a[3]); *(v2u*)(O + (size_t)(row0 + ai * 128 + m * 16) * 256 + col0 + bj * 128 + n * 16) = w; }
    }
};
struct EpiS5Y {
    static constexpr bool PERM = true, AFTER_DRAIN = false; bf16* Gp;
    __device__ __forceinline__ void operator()(const f32x4 (&acc)[2][2][4][2], const pg8::Unit& u, int wr, int wc, int fr, int fq) const {
        const int g = u.pm >> 1, jj0 = (u.pm & 1) * 256 + wr * 64 + fr, col0 = wc * 32 + 8 * fq;
#pragma unroll
        for (int ai = 0; ai < 2; ++ai)
#pragma unroll
            for (int m = 0; m < 4; ++m) { const int jj = jj0 + ai * 128 + m * 16;
#pragma unroll
                for (int bj = 0; bj < 2; ++bj) { const int n = col0 + bj * 128, t = n >> 4, c0 = n & 15; const f32x4 v0 = acc[ai][bj][m][0], v1 = acc[ai][bj][m][1];
                    v4u w; w.x = pk2(gelu_tanh(v0[0]), gelu_tanh(v0[1])); w.y = pk2(gelu_tanh(v0[2]), gelu_tanh(v0[3])); w.z = pk2(gelu_tanh(v1[0]), gelu_tanh(v1[1])); w.w = pk2(gelu_tanh(v1[2]), gelu_tanh(v1[3]));
                    __builtin_amdgcn_raw_buffer_store_b128(__builtin_bit_cast(pg8::u32x4, w), __builtin_amdgcn_make_buffer_rsrc((void*)Gp, (short)0, 8192 * 512 * 2, 0x00020000), (unsigned)(((16 * jj + t) * 512 + g * 16 + c0) * 2), 0, 16); } }
    }
};
struct EpiZU {
    static constexpr bool PERM = true, AFTER_DRAIN = false; bf16* Zp; bf16* UHp;
    __device__ __forceinline__ void operator()(const f32x4 (&acc)[2][2][4][2], const pg8::Unit& u, int wr, int wc, int fr, int fq) const {
        const int row0 = u.pm * 256 + wr * 64 + fr; const int col0 = u.pn * 256 + wc * 32 + 8 * fq;
        const __amdgpu_buffer_rsrc_t zr = __builtin_amdgcn_make_buffer_rsrc((void*)Zp, (short)0, 8192 * 2048 * 2, 0x00020000), ur = __builtin_amdgcn_make_buffer_rsrc((void*)UHp, (short)0, 8192 * 512 * 2 * 2, 0x00020000);
#pragma unroll
        for (int ai = 0; ai < 2; ++ai)
#pragma unroll
            for (int m = 0; m < 4; ++m) { const int row = row0 + ai * 128 + m * 16;
#pragma unroll
                for (int bj = 0; bj < 2; ++bj) { const f32x4 v0 = acc[ai][bj][m][0], v1 = acc[ai][bj][m][1]; const int col = col0 + bj * 128;
                    v4u w; w.x = pk2(v0[0], v0[1]); w.y = pk2(v0[2], v0[3]); w.z = pk2(v1[0], v1[1]); w.w = pk2(v1[2], v1[3]);
                    if (u.pn < 2) __builtin_amdgcn_raw_buffer_store_b128(__builtin_bit_cast(pg8::u32x4, w), ur, (unsigned)((((col >> 4) * 512 + (row >> 4)) * 512 + (row & 15) * 16 + (col & 15)) * 2), 0, 16);
                    else __builtin_amdgcn_raw_buffer_store_b128(__builtin_bit_cast(pg8::u32x4, w), zr, (unsigned)((row * 2048 + col) * 2), 0, 16); } }
    }
};

__device__ __forceinline__ int gla_slot(int bb, int h, int d, int j) { return bb < 16 ? ((bb * 4 + h) * 2 + d) * 4 + j : 512 + (((bb - 16) * 4 + h) * 2 + d) * 16 + j; }
constexpr int GL_V = 0, GL_VROW = 320;
constexpr int GL_KT = 20480, GL_KTROW = 144;
constexpr int GL_TOT = GL_KT + 4 * 9216;
constexpr int GL_PART = GL_TOT + 2048;
constexpr int GL_BYTES = GL_PART + 1024;
template <int MODE>
__device__ __forceinline__ void gla_prep(CArgs& A, LAS unsigned char* lds, int bb, int h, int j, int row0, int tid, int lane, int wave) {
    unsigned char* ws = A.ws;
    const bf16* Z = (const bf16*)(ws + WS_Z); const bf16* GDi = (const bf16*)(ws + WS_GD);
    const int d = wave >> 2, wg = wave & 3;
#pragma unroll
    for (int i = 0; i < 2; ++i) { const int r = (tid >> 4) + 32 * i, c = tid & 15;
        const v4u v = *(const v4u*)(Z + (size_t)(row0 + r) * 2048 + 1024 + h * 128 + 8 * c);
        *(LAS v4u*)(lds + GL_V + r * GL_VROW + c * 16) = v; }
    float gd[16]; float tot = 0.f;
#pragma unroll
    for (int i = 0; i < 16; ++i) { gd[i] = bf2f(GDi[(size_t)(row0 + 16 * wg + i) * 512 + d * 256 + h * 64 + lane]); tot += gd[i]; }
    unsigned short kx[16], qx[16];
#pragma unroll
    for (int i = 0; i < 16; ++i) { const size_t zr = (size_t)(row0 + 16 * wg + i) * 2048 + h * 64 + lane; kx[i] = Z[zr + 768]; qx[i] = MODE == 1 ? Z[zr + 512] : (unsigned short)0; }
    LAS float* TOT = (LAS float*)(lds + GL_TOT);
    TOT[(d * 4 + wg) * 64 + lane] = tot;
    __syncthreads();
    float off = 0.f, total = 0.f;
#pragma unroll
    for (int w = 0; w < 4; ++w) { const float tw = TOT[(d * 4 + w) * 64 + lane]; total += tw; if (d == 0 ? (w < wg) : (w > wg)) off += tw; }
    float bcum[16];
    if (d == 0) { float s = off;
#pragma unroll
        for (int i = 0; i < 16; ++i) { s += gd[i]; bcum[i] = s; } }
    else { float s = off;
#pragma unroll
        for (int i = 15; i >= 0; --i) { s += gd[i]; bcum[i] = s; } }
    LAS unsigned char* img = lds + GL_KT + d * 2 * 9216;
    if (MODE == 0) {
        unsigned pkk[8];
#pragma unroll
        for (int i = 0; i < 16; i += 2) { const float k0 = bf2f(kx[i]), k1 = bf2f(kx[i + 1]);
            pkk[i >> 1] = pk2(k0 * __expf(total - bcum[i]), k1 * __expf(total - bcum[i + 1])); }
        *(LAS v4u*)(img + lane * GL_KTROW + 32 * wg) = (v4u){pkk[0], pkk[1], pkk[2], pkk[3]};
        *(LAS v4u*)(img + lane * GL_KTROW + 32 * wg + 16) = (v4u){pkk[4], pkk[5], pkk[6], pkk[7]};
        if (wg == 0) ((float*)(ws + WS_DEC))[(size_t)gla_slot(bb, h, d, j) * 64 + lane] = __expf(total);
    } else {
#pragma unroll
        for (int i = 0; i < 16; ++i) {
            const float q = bf2f(qx[i]) * 0.125f, k = bf2f(kx[i]);
            *(LAS unsigned short*)(img + (16 * wg + i) * GL_KTROW + lane * 2) = (unsigned short)f2bf(q * __expf(bcum[i]));
            *(LAS unsigned short*)(img + 9216 + (16 * wg + i) * GL_KTROW + lane * 2) = (unsigned short)f2bf(k * __expf(-bcum[i])); }
    }
    __syncthreads();
}
__device__ __forceinline__ void gla_task_rows(int task, int& bb, int& h, int& j, int& row0) {
    if (task < 256) { bb = task >> 4; h = (task >> 2) & 3; j = task & 3; row0 = bb * 256 + 64 * j; }
    else { const int t = task - 256; bb = 16 + (t >> 6); h = (t >> 4) & 3; j = t & 15; row0 = NPR + (bb - 16) * 1024 + 64 * j; }
}
__device__ __forceinline__ void gla_a_task(CArgs& A, LAS unsigned char* lds, int task, int tid, int lane, int wave) {
    int bb, h, j, row0; gla_task_rows(task, bb, h, j, row0);
    gla_prep<0>(A, lds, bb, h, j, row0, tid, lane, wave);
    const int d = wave >> 2, wg = wave & 3, r32 = lane & 31, hi = lane >> 5;
    const unsigned lbase = (unsigned)(uintptr_t)(lds);
    const unsigned vaddr = lbase + GL_V + (8 * hi + ((lane & 15) >> 2)) * GL_VROW + (32 * wg + 16 * ((lane >> 4) & 1) + 4 * (lane & 3)) * 2;
    LAS unsigned char* img = lds + GL_KT + d * 2 * 9216;
    f32x16 acc0 = {}, acc1 = {};
#pragma unroll
    for (int ks = 0; ks < 4; ++ks) {
        const s16x4 lo = tr_read4(vaddr + (16 * ks) * GL_VROW), hi4 = tr_read4(vaddr + (16 * ks + 4) * GL_VROW);
        const bf16x8 b0 = *(const LAS bf16x8*)(img + r32 * GL_KTROW + (16 * ks + 8 * hi) * 2);
        const bf16x8 b1 = *(const LAS bf16x8*)(img + (32 + r32) * GL_KTROW + (16 * ks + 8 * hi) * 2);
        asm volatile("s_waitcnt lgkmcnt(0)" ::: "memory"); __builtin_amdgcn_sched_barrier(0);
        const bf16x8 a = (bf16x8){lo[0], lo[1], lo[2], lo[3], hi4[0], hi4[1], hi4[2], hi4[3]};
        acc0 = __builtin_amdgcn_mfma_f32_32x32x16_bf16(a, b0, acc0, 0, 0, 0);
        acc1 = __builtin_amdgcn_mfma_f32_32x32x16_bf16(a, b1, acc1, 0, 0, 0);
    }
    bf16* SL = (bf16*)(A.ws + WS_SLOC) + (size_t)gla_slot(bb, h, d, j) * 8192;
    { bf16* slp = SL + (32 * wg + 4 * hi) * 64 + r32;
#pragma unroll
    for (int r = 0; r < 16; ++r) { slp[((r & 3) + 8 * (r >> 2)) * 64] = (bf16)f2bf(acc0[r]); slp[((r & 3) + 8 * (r >> 2)) * 64 + 32] = (bf16)f2bf(acc1[r]); } }
    __syncthreads();
}
template <int N>
__device__ __forceinline__ void gla_b_chain(CArgs& A, int bb, int h, int d, int v, int kk, bool samp) {
    unsigned char* ws = A.ws;
    const bf16* SL = (const bf16*)(ws + WS_SLOC); const float* DEC = (const float*)(ws + WS_DEC); bf16* SIN = (bf16*)(ws + WS_SIN);
    f32x4 dc[N], sl[N];
#pragma unroll
    for (int i = 0; i < N; ++i) { const int j = d == 0 ? i : N - 1 - i; const size_t slot = (size_t)gla_slot(bb, h, d, j);
        dc[i] = *(const f32x4*)(DEC + slot * 64 + kk); const v2u sw = *(const v2u*)(SL + slot * 8192 + v * 64 + kk); sl[i] = (f32x4){bflo(sw.x), bfhi(sw.x), bflo(sw.y), bfhi(sw.y)}; }
    f32x4 S = {0.f, 0.f, 0.f, 0.f};
    if (samp) { const float* s0 = A.in[4] + (size_t)(((bb - 16) * 2 + d) * 4 + h) * 8192;
#pragma unroll
        for (int q = 0; q < 4; ++q) S[q] = s0[(kk + q) * 128 + v]; }
#pragma unroll
    for (int i = 0; i < N; ++i) { const int j = d == 0 ? i : N - 1 - i; const size_t slot = (size_t)gla_slot(bb, h, d, j);
        v2u w; w.x = pk2(S.x, S.y); w.y = pk2(S.z, S.w); *(v2u*)(SIN + slot * 8192 + v * 64 + kk) = w;
        S = S * dc[i] + sl[i]; }
    if (!samp) { float* o = A.out + OUT_GLA + (size_t)((bb * 2 + d) * 4 + h) * 8192;
#pragma unroll
        for (int q = 0; q < 4; ++q) o[(kk + q) * 128 + v] = S[q]; }
}
__device__ __forceinline__ void gla_b_phase(CArgs& A, int gtid, int nthreads) {
    for (int it = gtid; it < 160 * 2048; it += nthreads) {
        const int s = it >> 11, e = it & 2047;
        const int grp = s / 5, m = s % 5; const int chain = m == 4 ? 128 + grp : grp * 4 + m;
        const bool samp = chain >= 128; const int ci = samp ? chain - 128 : chain;
        const int bb = (samp ? 16 : 0) + (ci >> 3), h = (ci >> 1) & 3, d = ci & 1;
        const int v = e >> 4, kk = (e & 15) * 4;
        if (samp) gla_b_chain<16>(A, bb, h, d, v, kk, true); else gla_b_chain<4>(A, bb, h, d, v, kk, false);
    }
}
__device__ __forceinline__ void gla_c_task(CArgs& A, LAS unsigned char* lds, int task, int tid, int lane, int wave) {
    int bb, h, j, row0; gla_task_rows(task, bb, h, j, row0);
    unsigned char* ws = A.ws;
    const bf16* Z = (const bf16*)(ws + WS_Z); const bf16* SIN = (const bf16*)(ws + WS_SIN); bf16* MIX = (bf16*)(ws + WS_MIX);
    const int ti = wave >> 2, vi = wave & 3, r32 = lane & 31, hi = lane >> 5;
    bf16x8 sin_f[2][4]; v2u rr_f[4];
#pragma unroll
    for (int d = 0; d < 2; ++d) { const bf16* SI = SIN + (size_t)gla_slot(bb, h, d, j) * 8192 + (size_t)(32 * vi + r32) * 64 + 8 * hi;
#pragma unroll
        for (int ks = 0; ks < 4; ++ks) sin_f[d][ks] = *(const bf16x8*)(SI + 16 * ks); }
#pragma unroll
    for (int rq = 0; rq < 4; ++rq) rr_f[rq] = *(const v2u*)(Z + (size_t)(row0 + 32 * ti + r32) * 2048 + 1536 + h * 128 + 32 * vi + 8 * rq + 4 * hi);
    f32x4 gn_f[4];
#pragma unroll
    for (int rq = 0; rq < 4; ++rq) gn_f[rq] = *(const f32x4*)(A.in[29] + 32 * vi + 8 * rq + 4 * hi);
    gla_prep<1>(A, lds, bb, h, j, row0, tid, lane, wave);
    const unsigned lbase = (unsigned)(uintptr_t)(lds);
    const unsigned vaddr = lbase + GL_V + (4 * hi + ((lane & 15) >> 2)) * GL_VROW + (32 * vi + 16 * ((lane >> 4) & 1) + 4 * (lane & 3)) * 2;
    f32x16 o = {};
    const int t = 32 * ti + r32;
#pragma unroll
    for (int d = 0; d < 2; ++d) {
        LAS unsigned char* qimg = lds + GL_KT + d * 2 * 9216; LAS unsigned char* kimg = qimg + 9216;
        bf16x8 qf[4];
#pragma unroll
        for (int ks = 0; ks < 4; ++ks) qf[ks] = *(const LAS bf16x8*)(qimg + t * GL_KTROW + (16 * ks + 8 * hi) * 2);
#pragma unroll
        for (int ks = 0; ks < 4; ++ks) o = __builtin_amdgcn_mfma_f32_32x32x16_bf16(sin_f[d][ks], qf[ks], o, 0, 0, 0);
#pragma unroll
        for (int si = 0; si < 2; ++si) {
            f32x16 x = {};
#pragma unroll
            for (int ks = 0; ks < 4; ++ks) { const bf16x8 ka = *(const LAS bf16x8*)(kimg + (32 * si + r32) * GL_KTROW + (16 * ks + 8 * hi) * 2); x = __builtin_amdgcn_mfma_f32_32x32x16_bf16(ka, qf[ks], x, 0, 0, 0); }
            unsigned pw[8];
#pragma unroll
            for (int r = 0; r < 16; r += 2) { const int s0 = 32 * si + crow(r, hi), s1 = s0 + 1;
                const float x0 = (d == 0 ? (s0 <= t) : (s0 >= t)) ? x[r] : 0.f, x1 = (d == 0 ? (s1 <= t) : (s1 >= t)) ? x[r + 1] : 0.f;
                pw[r >> 1] = pk2(x0, x1); }
#pragma unroll
            for (int sp = 0; sp < 2; ++sp) {
                const s16x4 lo = tr_read4(vaddr + (32 * si + 16 * sp) * GL_VROW), hi4 = tr_read4(vaddr + (32 * si + 16 * sp + 8) * GL_VROW);
                asm volatile("s_waitcnt lgkmcnt(0)" ::: "memory"); __builtin_amdgcn_sched_barrier(0);
                const bf16x8 va = (bf16x8){lo[0], lo[1], lo[2], lo[3], hi4[0], hi4[1], hi4[2], hi4[3]};
                const v4u pq = {pw[4 * sp], pw[4 * sp + 1], pw[4 * sp + 2], pw[4 * sp + 3]};
                o = __builtin_amdgcn_mfma_f32_32x32x16_bf16(va, __builtin_bit_cast(bf16x8, pq), o, 0, 0, 0);
            }
        }
    }
    float ss = 0.f;
#pragma unroll
    for (int r = 0; r < 16; ++r) ss += o[r] * o[r];
    ss += __shfl_xor(ss, 32);
    LAS float* PART = (LAS float*)(lds + GL_PART);
    if (hi == 0) PART[(ti * 4 + vi) * 32 + r32] = ss;
    __syncthreads();
    const float tot = PART[(ti * 4 + 0) * 32 + r32] + PART[(ti * 4 + 1) * 32 + r32] + PART[(ti * 4 + 2) * 32 + r32] + PART[(ti * 4 + 3) * 32 + r32];
    const float rstd = 1.f / sqrtf(tot * (1.f / 128.f) + EPS);
    const size_t row = (size_t)(row0 + t);
#pragma unroll
    for (int rq = 0; rq < 4; ++rq) { const int v = 32 * vi + 8 * rq + 4 * hi;
        const v2u rr = rr_f[rq];
        const f32x4 gn = gn_f[rq];
        float rv[4] = {bflo(rr.x), bfhi(rr.x), bflo(rr.y), bfhi(rr.y)}; float ov[4];
#pragma unroll
        for (int e = 0; e < 4; ++e) { const float sl = rv[e] * __builtin_amdgcn_rcpf(1.f + __expf(-rv[e])); ov[e] = o[4 * rq + e] * rstd * gn[e] * sl; }
        v2u w; w.x = pk2(ov[0], ov[1]); w.y = pk2(ov[2], ov[3]);
        *(v2u*)(MIX + row * 1024 + 512 + h * 128 + v) = w; }
    __syncthreads();
}


struct EpiQKV {
    static constexpr bool PERM = true, AFTER_DRAIN = true;
    const float* rsw; const float* cv; const float* qn; const float* kn; unsigned char* wsb; float* outp;
    __device__ __forceinline__ void fused(f32x4 (&acc)[2][2][4][2], const pg8::Unit& u, int wr, int wc, int fr, int fq, LAS unsigned char* lds, int wid, int lane) const {
        const int row0 = u.pm * 256 + wr * 64 + fr, d0 = wc * 32 + 8 * fq;
        const int cond = u.pm < 16 ? 0 : 1 + ((u.pm - 16) >> 2); const bool samp = u.pm >= 16;
        const __amdgpu_buffer_rsrc_t wsr = __builtin_amdgcn_make_buffer_rsrc((void*)wsb, (short)0, 0x10000000, 0x00020000);
        f32x4 cvv[2][2];
#pragma unroll
        for (int bj = 0; bj < 2; ++bj)
#pragma unroll
            for (int n = 0; n < 2; ++n) cvv[bj][n] = *(const f32x4*)(cv + (size_t)cond * 1536 + u.pn * 256 + bj * 128 + d0 + 4 * n);
#pragma unroll
        for (int ai = 0; ai < 2; ++ai)
#pragma unroll
            for (int m = 0; m < 4; ++m) { const int row = row0 + ai * 128 + m * 16;
                const f32x4 s4 = *(const f32x4*)(rsw + (size_t)row * 4);
                const float rstd = 1.0f / sqrtf(((s4[0] + s4[1]) + (s4[2] + s4[3])) * (1.f / 1024.f) + EPS);
#pragma unroll
                for (int bj = 0; bj < 2; ++bj)
#pragma unroll
                    for (int n = 0; n < 2; ++n) acc[ai][bj][m][n] = acc[ai][bj][m][n] * rstd + cvv[bj][n]; }
        if (u.pn == 5) {
#pragma unroll
            for (int ai = 0; ai < 2; ++ai)
#pragma unroll
                for (int m = 0; m < 4; ++m) { const int row = row0 + ai * 128 + m * 16;
                    const unsigned voff = samp ? (unsigned)WS_VS + (unsigned)((((row - NPR) >> 10) * 1536 + ((row - NPR) & 1023)) * 512) : (unsigned)WS_VP + (unsigned)(row * 512);
#pragma unroll
                    for (int bj = 0; bj < 2; ++bj) { const f32x4 v0 = acc[ai][bj][m][0], v1 = acc[ai][bj][m][1];
                        v4u w; w.x = pk2(v0[0], v0[1]); w.y = pk2(v0[2], v0[3]); w.z = pk2(v1[0], v1[1]); w.w = pk2(v1[2], v1[3]);
                        __builtin_amdgcn_raw_buffer_store_b128(__builtin_bit_cast(pg8::u32x4, w), wsr, voff + (unsigned)((bj * 128 + d0) * 2), 0, 16);
                        if (!samp) { float* nv = outp + OUT_NV + ((size_t)row * 2 + bj) * 128 + d0; *(f32x4*)nv = (f32x4){bflo(w.x), bfhi(w.x), bflo(w.y), bfhi(w.y)}; *(f32x4*)(nv + 4) = (f32x4){bflo(w.z), bfhi(w.z), bflo(w.w), bfhi(w.w)}; } } }
            return;
        }
        LAS float* part = (LAS float*)lds;
#pragma unroll
        for (int ai = 0; ai < 2; ++ai)
#pragma unroll
            for (int m = 0; m < 4; ++m)
#pragma unroll
                for (int bj = 0; bj < 2; ++bj) { const f32x4 v0 = acc[ai][bj][m][0], v1 = acc[ai][bj][m][1];
                    float ss = ((v0[0] * v0[0] + v0[1] * v0[1]) + (v0[2] * v0[2] + v0[3] * v0[3])) + ((v1[0] * v1[0] + v1[1] * v1[1]) + (v1[2] * v1[2] + v1[3] * v1[3]));
                    ss += __shfl_xor(ss, 16); ss += __shfl_xor(ss, 32);
                    if (fq == 0) part[((ai * 128 + wr * 64 + m * 16 + fr) * 2 + bj) * 4 + wc] = ss; }
        __syncthreads();
        const bool isk = u.pn == 4; const float* nwp = (isk ? kn : qn) + d0;
        const f32x4 w0 = *(const f32x4*)nwp, w1 = *(const f32x4*)(nwp + 4);
        float inv[4];
#pragma unroll
        for (int e = 0; e < 4; ++e) inv[e] = __builtin_amdgcn_exp2f(-(float)(((d0 >> 1) + e) & 31) * (13.287712379549449f / 32.f));
#pragma unroll
        for (int ai = 0; ai < 2; ++ai)
#pragma unroll
            for (int m = 0; m < 4; ++m) { const int rl = ai * 128 + wr * 64 + m * 16 + fr, row = u.pm * 256 + rl;
                const int t = samp ? (row - NPR) & 1023 : 0; const float pos = (float)((d0 >> 1) < 32 ? (t >> 6) : (t & 63));
                float cs[4], sn[4];
#pragma unroll
                for (int e = 0; e < 4; ++e) { if (samp) { sn[e] = __sinf(pos * inv[e]); cs[e] = __cosf(pos * inv[e]); } else { sn[e] = 0.f; cs[e] = 1.f; } }
#pragma unroll
                for (int bj = 0; bj < 2; ++bj) { const f32x4 pt = *(const LAS f32x4*)(part + (rl * 2 + bj) * 4);
                    const float rstd = 1.0f / sqrtf(((pt[0] + pt[1]) + (pt[2] + pt[3])) * (1.f / 128.f) + EPS);
                    const f32x4 x0 = acc[ai][bj][m][0] * rstd * w0, x1 = acc[ai][bj][m][1] * rstd * w1;
                    const int head = u.pn * 2 + bj;
                    if (isk && !samp) { float* nk = outp + OUT_NK + ((size_t)row * 2 + bj) * 128 + d0; *(f32x4*)nk = x0; *(f32x4*)(nk + 4) = x1; }
                    v4u w; w.x = pk2(x0[0] * cs[0] - x0[1] * sn[0], x0[0] * sn[0] + x0[1] * cs[0]); w.y = pk2(x0[2] * cs[1] - x0[3] * sn[1], x0[2] * sn[1] + x0[3] * cs[1]);
                    w.z = pk2(x1[0] * cs[2] - x1[1] * sn[2], x1[0] * sn[2] + x1[1] * cs[2]); w.w = pk2(x1[2] * cs[3] - x1[3] * sn[3], x1[2] * sn[3] + x1[3] * cs[3]);
                    if (!isk) __builtin_amdgcn_raw_buffer_store_b128(__builtin_bit_cast(pg8::u32x4, w), wsr, (unsigned)WS_QN + (unsigned)((row * 1024 + head * 128 + d0) * 2), 0, 16);
                    else { const unsigned koff = samp ? (unsigned)WS_KS + (unsigned)((((row - NPR) >> 10) * 1536 + t) * 512) : (unsigned)WS_KP + (unsigned)(row * 512); __builtin_amdgcn_raw_buffer_store_b128(__builtin_bit_cast(pg8::u32x4, w), wsr, koff + (unsigned)((bj * 128 + d0) * 2), 0, 16); } } }
    }
};
__device__ __forceinline__ void kv_cache_rows(CArgs& A, int lane, int gw, int ngw) {
    unsigned char* ws = A.ws;
    for (int cr = gw; cr < 2048; cr += ngw) { const int b = cr >> 9, pl = cr & 511;
        const f32x4 kx = *(const f32x4*)(A.in[5] + (size_t)(b * 512 + pl) * 256 + 4 * lane), vx = *(const f32x4*)(A.in[6] + (size_t)(b * 512 + pl) * 256 + 4 * lane);
        v2u kwd, vwd; kwd.x = pk2(kx.x, kx.y); kwd.y = pk2(kx.z, kx.w); vwd.x = pk2(vx.x, vx.y); vwd.y = pk2(vx.z, vx.w);
        *(v2u*)((bf16*)(ws + WS_KS) + (size_t)(b * 1536 + 1024 + pl) * 256 + 4 * lane) = kwd;
        *(v2u*)((bf16*)(ws + WS_VS) + (size_t)(b * 1536 + 1024 + pl) * 256 + 4 * lane) = vwd; }
}


__device__ __forceinline__ void cv_phase(CArgs& A, int lane, int gw, int ngw, int g0, int g1) {
    unsigned char* ws = A.ws; const float* ADAp = (const float*)(ws + WS_ADA); float* CV = (float*)(ws + WS_CV);
    for (int gidx = g0 + gw; gidx < g1; gidx += ngw) { const int c = 4 * gidx;
        const bf16* wrow; const float* sh; float* o; int ncv;
        if (c < 4096) { wrow = (const bf16*)(ws + WS_W1) + (size_t)c * 1024; sh = ADAp + 3 * 1024; o = CV + c; ncv = 4096; }
        else if (c < 5632) { wrow = (const bf16*)(ws + WS_WQKV) + (size_t)(c - 4096) * 1024; sh = ADAp + 5 * 6144; o = CV + 5 * 4096 + (c - 4096); ncv = 1536; }
        else { wrow = (const bf16*)(ws + WS_W1) + (size_t)4096 * 1024 + (size_t)(c - 5632) * 1024; sh = ADAp + 5 * 6144 + 3 * 1024; o = CV + 5 * 4096 + 5 * 1536 + (c - 5632); ncv = 4096; }
        v4u w0[4], w1[4];
#pragma unroll
        for (int j = 0; j < 4; ++j) { w0[j] = *(const v4u*)(wrow + (size_t)j * 1024 + 16 * lane); w1[j] = *(const v4u*)(wrow + (size_t)j * 1024 + 16 * lane + 8); }
        float ps[4][5];
#pragma unroll
        for (int cond = 0; cond < 5; ++cond) { const f32x4* sp = (const f32x4*)(sh + cond * 6144 + 16 * lane); const f32x4 s0 = sp[0], s1 = sp[1], s2 = sp[2], s3 = sp[3];
#pragma unroll
            for (int j = 0; j < 4; ++j) {
                float s = (s0[0] * bflo(w0[j][0]) + s0[1] * bfhi(w0[j][0])) + (s0[2] * bflo(w0[j][1]) + s0[3] * bfhi(w0[j][1]));
                s += (s1[0] * bflo(w0[j][2]) + s1[1] * bfhi(w0[j][2])) + (s1[2] * bflo(w0[j][3]) + s1[3] * bfhi(w0[j][3]));
                s += (s2[0] * bflo(w1[j][0]) + s2[1] * bfhi(w1[j][0])) + (s2[2] * bflo(w1[j][1]) + s2[3] * bfhi(w1[j][1]));
                s += (s3[0] * bflo(w1[j][2]) + s3[1] * bfhi(w1[j][2])) + (s3[2] * bflo(w1[j][3]) + s3[3] * bfhi(w1[j][3]));
                ps[j][cond] = s; } }
#pragma unroll
        for (int of = 1; of < 64; of <<= 1) {
#pragma unroll
            for (int j = 0; j < 4; ++j)
#pragma unroll
                for (int cond = 0; cond < 5; ++cond) ps[j][cond] += __shfl_xor(ps[j][cond], of); }
        if (lane < 20) { const int j = lane / 5, cond = lane % 5; float v = 0.f;
#pragma unroll
            for (int jj = 0; jj < 4; ++jj)
#pragma unroll
                for (int cc = 0; cc < 5; ++cc) v = (j == jj && cond == cc) ? ps[jj][cc] : v;
            o[(size_t)cond * ncv + j] = v; }
    }
}

#ifndef DBL_MASK
#define DBL_MASK 0u
#endif
#ifndef XBAR_N
#define XBAR_N 0
#endif
__global__ void __launch_bounds__(NWAVES * 64, 2) fwd_kernel(Args args_unused) {
    extern __shared__ __attribute__((aligned(16))) unsigned char lds_raw[];
#define lds ((LAS unsigned char*)lds_raw)
#define MISC ((volatile LAS unsigned*)(lds + MISC_OFF))
#define tid (tid_opaque())
#define lane (tid_opaque() & 63)
#define wave (__builtin_amdgcn_readfirstlane(tid_opaque() >> 6))
#define G ((int)gridDim.x)
#define ws (kargs()->ws)
#define ADA ((const float*)(ws + WS_ADA))
#define H ((bf16*)(ws + WS_H))
#define Y ((bf16*)(ws + WS_Y))
#define xs_off (KA.in[1] - (size_t)NPR * 1024)
#define ADA1 (ADA + 5 * 6144)
    for (int u = tid; u < (LDS_BYTES - LDSCTL_OFF) / 4; u += NWAVES * 64) ((LAS unsigned*)(lds + LDSCTL_OFF))[u] = 0u;
    __syncthreads();
    (void)xcd_barrier_post((unsigned*)((gu32*)(ws + WS_CTL) + CW_BAR), MISC + 8, gridDim.x);
    (void)xcd_barrier_post((unsigned*)((gu32*)(ws + WS_CTL) + (blockIdx.x < 64 ? CW_BARG0 : CW_BARG1)), MISC + 10, blockIdx.x < 64 ? 64u : 192u);
#if TS_ON
    if (blockIdx.x == 0 && threadIdx.x == 0) ((unsigned long long*)((gu32*)(ws + WS_CTL) + CW_TS))[0] = __builtin_amdgcn_s_memrealtime();
#endif
#define MKBAR() XcdBarrier bar; bar.bar = (unsigned*)((gu32*)(ws + WS_CTL) + CW_BAR); bar.x = xb_xcc_id(); bar.st = MISC + 8; bar.gsize = gridDim.x;
#define GROUP_BAR() do { XcdBarrier bg; bg.bar = (unsigned*)((gu32*)(ws + WS_CTL) + (blockIdx.x < 64 ? CW_BARG0 : CW_BARG1)); bg.x = xb_xcc_id(); bg.st = MISC + 10; bg.gsize = blockIdx.x < 64 ? 64u : 192u; xcd_barrier(bg); } while (0)
#define IN(k) (KA.ph_lo <= (k) && (k) < KA.ph_hi)
#define SEAM(k) do { if ((k) + 1 < KA.ph_hi) { MKBAR(); xcd_barrier(bar); } } while (0)
#define REPS(k) (((DBL_MASK >> (k)) & 1u) ? 2 : 1)
#define SEAM2(k) do { if (rep_ + 1 < REPS(k)) { MKBAR(); xcd_barrier(bar); } else SEAM(k); STAMP((k) + 1); } while (0)


    if (IN(0)) for (int rep_ = 0; rep_ < REPS(0); ++rep_) { if ((int)blockIdx.x < 192) ada_block32(KA, lds, (int)blockIdx.x, tid, lane, wave); else { const int gw_ = ((int)blockIdx.x - 192) * NWAVES + wave;
            if (gw_ >= 496) { p0_transpose_item(KA.in[15] + 2048, INE, 1024, (bf16*)(ws + WS_WGLR), 1, (LAS float*)(lds + wave * 16384), gw_ - 496, lane); asm volatile("s_waitcnt vmcnt(0)" ::: "memory"); }
            if ((int)blockIdx.x >= 254) { __syncthreads();
                if (tid == 0) { __builtin_amdgcn_fence(__ATOMIC_RELEASE, "agent"); asm volatile("s_waitcnt vmcnt(0)" ::: "memory");
                    __hip_atomic_fetch_add((unsigned*)((gu32*)(ws + WS_CTL) + CW_ADACNT + 16), 1u, __ATOMIC_RELAXED, __HIP_MEMORY_SCOPE_AGENT); } }
            transpose_items(KA, lds, 0, T_EARLY, gw_, 64 * NWAVES, lane, wave); }
        __syncthreads(); STAMP(21); s5_small(KA, lds, (int)blockIdx.x >> 3, ((int)blockIdx.x & 7) == 0, tid); s5_k_mfma(lds, lane, wave); s5_expand(KA, lds, (int)blockIdx.x >> 3, (int)blockIdx.x & 7, tid); STAMP(22);
        ada_wait(KA, tid);
        norm_phase<true>(KA, lds, KA.in[0], xs_off, KA.in[9], ADA, 0, 1, tid, lane, wave); SEAM2(1); }
    for (int xb_ = 0; xb_ < XBAR_N; ++xb_) { MKBAR(); xcd_barrier(bar); }
    if (IN(2)) for (int rep_ = 0; rep_ < REPS(2); ++rep_) { pg8::Gemm g{H, (const bf16*)(ws + WS_WIN), NTOK, INW, 1024, 1024, 1024}; pg8::StaticOrder S; S.init(NTOK, INW, G, (int)blockIdx.x);
        EpiZU E{(bf16*)(ws + WS_Z), (bf16*)(ws + WS_UH)};
        pg8::gemm_phase<EpiZU, pg8::StaticOrder, true, true>(lds, g, S, E); STAMP(3); z_arrive((gu32*)(ws + WS_CTL), G, tid_opaque()); }
    if (IN(3)) {
        if ((int)blockIdx.x < 64) {
            cnt_wait((gu32*)(ws + WS_CTL) + 544, 256u, tid_opaque());
            { pg8::Gemm g{(const bf16*)(ws + WS_UH), (const bf16*)(ws + WS_WE), 16384, 8192, 256, 512, 512}; GroupOrder S{(int)blockIdx.x, 64};
              EpiF32 E{(bf16*)(ws + WS_EBUF)};
              pg8::gemm_phase<EpiF32, GroupOrder, true, true>(lds, g, S, E); }
            VM_WAIT(); __syncthreads();
            { int bx_ = (int)blockIdx.x; asm volatile("" : "+s"(bx_)); s5_recur(KA, lds, bx_ >> 1, bx_ & 1, tid); }
            { int bx_ = (int)blockIdx.x; asm volatile("" : "+s"(bx_));
              pg8::Gemm g{(const bf16*)(ws + WS_UH), (const bf16*)(ws + WS_WY), 16384, 8192, 512, 512, 512}; GroupOrder S{bx_, 64};
              EpiS5Y E{(bf16*)(ws + WS_G)};
              pg8::gemm_phase<EpiS5Y, GroupOrder, true, true>(lds, g, S, E); }
            STAMPB(23, 0);
            s5_g_handoff((gu32*)(ws + WS_CTL) + CW_ADACNT + 48, tid_opaque());
            STAMPB(24, 0);
            { int bx_ = (int)blockIdx.x; asm volatile("" : "+s"(bx_));
              pg8::Gemm g{(const bf16*)(ws + WS_G), (const bf16*)(ws + WS_WGLU), NTOK, 512, 512, 512, 512}; pg8::StaticOrder S; S.init(NTOK, 512, 64, bx_);
              pg8::EpiGlu E{(const bf16*)(ws + WS_G), (bf16*)(ws + WS_MIX), KA.in[26]};
              pg8::gemm_phase<pg8::EpiGlu, pg8::StaticOrder, true, true>(lds, g, S, E); }
            { int bxs_ = (int)blockIdx.x; asm volatile("" : "+s"(bxs_)); transpose_items(KA, lds, T_EARLY + 2 * T_M1, T_EARLY + 2 * T_M1 + T_M2, bxs_ * NWAVES + wave, 64 * NWAVES, lane, wave);
              transpose_items(KA, lds, T_EARLY + T_M1 + 1536, T_EARLY + 2 * T_M1, bxs_ * NWAVES + wave, 64 * NWAVES, lane, wave); }
            STAMPB(25, 0);
        } else {
            for (int task = (int)blockIdx.x - 64; task < 512; task += 192) { const int pz = task < 256 ? (task >> 4) : 16 + ((task - 256) >> 6) * 4 + (((task - 256) & 15) >> 2);
                cnt_wait((gu32*)(ws + WS_CTL) + pz * 16, 8u, tid_opaque());
                gla_a_task(KA, lds, task, tid, lane, wave); }
            STAMPB(26, 64); GROUP_BAR(); STAMPB(27, 64);
            gla_b_phase(KA, ((int)blockIdx.x - 64) * 512 + tid, 192 * 512);
            STAMPB(28, 64); GROUP_BAR(); STAMPB(29, 64);
            for (int task = (int)blockIdx.x - 64; task < 512; task += 192) gla_c_task(KA, lds, task, tid, lane, wave);
            { int bx3_ = (int)blockIdx.x; asm volatile("" : "+s"(bx3_)); if (bx3_ < 192) ada_block(KA, lds, 128 + bx3_ - 64, tid, lane, wave);
              else { transpose_items(KA, lds, T_EARLY, T_EARLY + T_M1, (bx3_ - 192) * NWAVES + wave, 64 * NWAVES, lane, wave);
                     transpose_items(KA, lds, T_EARLY + 2 * T_M1 + 2 * T_M2, T_EARLY + 2 * T_M1 + 2 * T_M2 + T_QKV, (bx3_ - 192) * NWAVES + wave, 64 * NWAVES, lane, wave); } }
            transpose_items(KA, lds, T_EARLY + T_M1, T_EARLY + T_M1 + 1536, ((int)blockIdx.x - 64) * NWAVES + wave, 192 * NWAVES, lane, wave);
            GROUP_BAR();
            cv_phase(KA, lane, ((int)blockIdx.x - 64) * NWAVES + wave, 192 * NWAVES, 0, 1408);
        }
        STAMPB(30, 64);
        { MKBAR(); xcd_barrier(bar); } STAMP(6); }
    if (IN(6)) for (int rep_ = 0; rep_ < REPS(6); ++rep_) { const int bx = blockIdx.x, kh = (bx >> 3) & 1, jx = bx >> 4;
        pg8::Gemm g{(const bf16*)(ws + WS_MIX) + kh * 512, (const bf16*)(ws + WS_WOUT) + kh * 512, NTOK, 1024, 512, 1024, 1024}; SplitKOrder S{4 * (bx & 7) + (jx >> 2), jx & 3};
        EpiResidSplitT<true, false, true> E{KA.in[0], xs_off, Y, ADA + 2 * 1024, (bf16*)(ws + WS_XBUF), (unsigned*)((gu32*)(ws + WS_CTL) + CW_FLAG), 6, kh, H, KA.in[10], ADA + 4 * 1024, (float*)(ws + WS_RSW)};
        pg8::gemm_phase<EpiResidSplitT<true, false, true>, SplitKOrder, false, true>(lds, g, S, E); STAMP(7); panel_chain((gu32*)(ws + WS_CTL) + CW_MLPCNT + 1024, S.pm, 8u, tid_opaque()); }
    if (IN(8)) for (int rep_ = 0; rep_ < REPS(8); ++rep_) { pg8::Gemm g{H, (const bf16*)(ws + WS_W1), NTOK, FF, 1024, 1024, 1024}; const int bx = blockIdx.x, jx = bx >> 4; PanelOrder S{4 * (bx & 7) + (jx >> 2), 8 * ((bx >> 3) & 1) + 2 * (jx & 3), (gu32*)(ws + WS_CTL) + CW_MLPCNT};
        pg8::EpiBf16<2, true> E{(bf16*)(ws + WS_ACT), FF, (const float*)(ws + WS_RSW), (const float*)(ws + WS_CV), 4096};
        pg8::gemm_phase<pg8::EpiBf16<2, true>, PanelOrder, true, true>(lds, g, S, E); STAMP(9); panel_wait((gu32*)(ws + WS_CTL) + CW_MLPCNT, S.pm, 64u, tid_opaque()); }
    if (IN(9)) for (int rep_ = 0; rep_ < REPS(9); ++rep_) { const int bx = blockIdx.x, kh = (bx >> 3) & 1, jx = bx >> 4;
        pg8::Gemm g{(const bf16*)(ws + WS_ACT) + kh * 2048, (const bf16*)(ws + WS_W2) + kh * 2048, NTOK, 1024, 2048, FF, FF}; SplitKOrder S{4 * (bx & 7) + (jx >> 2), jx & 3};
        EpiResidSplitT<true, true, true> E{Y, Y, Y, ADA + 5 * 1024, (bf16*)(ws + WS_XBUF), (unsigned*)((gu32*)(ws + WS_CTL) + CW_FLAG), 9, kh, H, KA.in[9] + 1024, ADA1 + 1 * 1024, (float*)(ws + WS_RSW)};
        pg8::gemm_phase<EpiResidSplitT<true, true, true>, SplitKOrder, false, true>(lds, g, S, E); STAMP(10);
        asm volatile("s_waitcnt vmcnt(0)" ::: "memory"); __syncthreads();
        { int bxo = blockIdx.x; asm volatile("" : "+s"(bxo)); const int pm9 = 4 * (bxo & 7) + (bxo >> 6);
          if (tid_opaque() == 0) __hip_atomic_fetch_add((unsigned*)((gu32*)(ws + WS_CTL) + CW_MLPCNT + 1536 + pm9 * 16), 1u, __ATOMIC_RELAXED, __HIP_MEMORY_SCOPE_AGENT); }
        qkv_wait((gu32*)(ws + WS_CTL) + CW_MLPCNT + 1536, G, tid_opaque()); }
    if (IN(11)) for (int rep_ = 0; rep_ < REPS(11); ++rep_) {
        pg8::Gemm g{H, (const bf16*)(ws + WS_WQKV), NTOK, QKVW, 1024, 1024, 1024}; pg8::StaticOrder S; S.init(NTOK, QKVW, G, (int)blockIdx.x);
        EpiQKV E{(const float*)(ws + WS_RSW), (const float*)(ws + WS_CV) + 5 * 4096, KA.in[32], KA.in[33], ws, KA.out};
        pg8::gemm_phase<EpiQKV, pg8::StaticOrder, false, true>(lds, g, S, E);
        if ((int)blockIdx.x >= 192) { const int gw_ = ((int)blockIdx.x - 192) * NWAVES + wave; kv_cache_rows(KA, lane, gw_, 64 * NWAVES);
            cv_phase(KA, lane, gw_, 64 * NWAVES, 1408, 2432);
            transpose_items(KA, lds, T_EARLY + 2 * T_M1 + T_M2, T_EARLY + 2 * T_M1 + 2 * T_M2, gw_, 64 * NWAVES, lane, wave);
            transpose_items(KA, lds, T_EARLY + 2 * T_M1 + 2 * T_M2 + T_QKV, T_ALL, gw_, 64 * NWAVES, lane, wave); }
        SEAM2(11); }
    if (IN(13)) for (int rep_ = 0; rep_ < REPS(13); ++rep_) {
        const att::bf16* QN = (const att::bf16*)(ws + WS_QN); att::bf16* OB = (att::bf16*)(ws + WS_OB);
        gu32* ocnt = (gu32*)(ws + WS_CTL) + CW_MLPCNT + 2048;
        { const int bx = blockIdx.x, half = (bx >> 3) & 1, su = (bx & 7) + 8 * (bx >> 4); const int b = su >> 5, hq = (su >> 2) & 7, qb = su & 3; const size_t qrow = (size_t)NPR + b * 1024 + qb * 256;
            if (half == 0) { const int bp = su >> 3, hp = su & 7; const size_t prow = (size_t)bp * 256;
                att::attn_dense_body<att::bf16>(QN + prow * 1024 + hp * 128, (const att::bf16*)(ws + WS_KP) + prow * 256 + (hp >> 2) * 128, (const att::bf16*)(ws + WS_VP) + prow * 256 + (hp >> 2) * 128,
                                                OB + prow * 1024 + hp * 128, 256, (char*)lds_raw, nullptr, nullptr, nullptr, nullptr, 0u, 0, (unsigned*)(ocnt + (bp * 2 + (hp >> 2)) * 16));
                __syncthreads(); }
            const size_t kofs = (size_t)b * 1536 * 256 + (size_t)half * 512 * 256 + (hq >> 2) * 128;
            unsigned long long* xa = (unsigned long long*)(ws + WS_SCR + 88 * MiB); gu32* fl = (gu32*)(ws + WS_CTL) + CW_FLAG + 32;
            att::attn_dense_body<att::bf16, true>(QN + qrow * 1024 + hq * 128, (const att::bf16*)(ws + WS_KS) + kofs, (const att::bf16*)(ws + WS_VS) + kofs, OB + qrow * 1024 + hq * 128, half ? 1024 : 512, (char*)lds_raw,
                                                  xa + (size_t)(su * 2 + half) * 4352, xa + (size_t)(su * 2 + (1 - half)) * 4352, (unsigned*)(fl + (su * 2 + half) * 64), (unsigned*)(fl + (su * 2 + (1 - half)) * 64), 13u, half, (unsigned*)(ocnt + ((16 + b * 4 + qb) * 2 + (hq >> 2)) * 16));
            __syncthreads(); }
        STAMP(14);
        { int bxo = blockIdx.x; asm volatile("" : "+s"(bxo)); const int pm14 = 4 * (bxo & 7) + (bxo >> 6), kh14 = (bxo >> 3) & 1;
          if (tid_opaque() == 0) { gu32* c = (gu32*)(ws + WS_CTL) + CW_MLPCNT + 2048 + (pm14 * 2 + kh14) * 16; unsigned sp = 0;
              while (__hip_atomic_load((unsigned*)c, __ATOMIC_RELAXED, __HIP_MEMORY_SCOPE_AGENT) < 32u) { __builtin_amdgcn_s_sleep(1); if (++sp > (1u << 22)) break; }
              __builtin_amdgcn_fence(__ATOMIC_ACQUIRE, "agent"); asm volatile("s_waitcnt vmcnt(0)" ::: "memory"); }
          __syncthreads(); } }
    if (IN(14)) for (int rep_ = 0; rep_ < REPS(14); ++rep_) { const int bx = blockIdx.x, kh = (bx >> 3) & 1, jx = bx >> 4;
        pg8::Gemm g{(const bf16*)(ws + WS_OB) + kh * 512, (const bf16*)(ws + WS_WO) + kh * 512, NTOK, 1024, 512, 1024, 1024}; SplitKOrder S{4 * (bx & 7) + (jx >> 2), jx & 3};
        EpiResidSplitT<true, true, true> E{Y, Y, Y, ADA1 + 2 * 1024, (bf16*)(ws + WS_XBUF), (unsigned*)((gu32*)(ws + WS_CTL) + CW_FLAG), 14, kh, H, KA.in[10] + 1024, ADA1 + 4 * 1024, (float*)(ws + WS_RSW)};
        pg8::gemm_phase<EpiResidSplitT<true, true, true>, SplitKOrder, false, true>(lds, g, S, E); STAMP(15); panel_chain((gu32*)(ws + WS_CTL) + CW_MLPCNT + 1024, S.pm, 16u, tid_opaque()); }
    if (IN(16)) for (int rep_ = 0; rep_ < REPS(16); ++rep_) { pg8::Gemm g{H, (const bf16*)(ws + WS_W1) + (size_t)4096 * 1024, NTOK, FF, 1024, 1024, 1024}; const int bx = blockIdx.x, jx = bx >> 4; PanelOrder S{4 * (bx & 7) + (jx >> 2), 8 * ((bx >> 3) & 1) + 2 * (jx & 3), (gu32*)(ws + WS_CTL) + CW_MLPCNT};
        pg8::EpiBf16<2, true> E{(bf16*)(ws + WS_ACT), FF, (const float*)(ws + WS_RSW), (const float*)(ws + WS_CV) + 5 * 4096 + 5 * 1536, 4096};
        pg8::gemm_phase<pg8::EpiBf16<2, true>, PanelOrder, true, true>(lds, g, S, E); STAMP(17); panel_wait((gu32*)(ws + WS_CTL) + CW_MLPCNT, S.pm, 128u, tid_opaque()); }
    if (IN(17)) for (int rep_ = 0; rep_ < REPS(17); ++rep_) { const int bx = blockIdx.x, kh = (bx >> 3) & 1, jx = bx >> 4;
        pg8::Gemm g{(const bf16*)(ws + WS_ACT) + kh * 2048, (const bf16*)(ws + WS_W2) + (size_t)1024 * 4096 + kh * 2048, NTOK, 1024, 2048, FF, FF}; SplitKOrder S{4 * (bx & 7) + (jx >> 2), jx & 3};
        EpiResidSplitT<false, true, false> E{Y, Y, KA.out + OUT_Y, ADA1 + 5 * 1024, (bf16*)(ws + WS_XBUF), (unsigned*)((gu32*)(ws + WS_CTL) + CW_FLAG), 17, kh, nullptr, nullptr, nullptr, nullptr};
        pg8::gemm_phase<EpiResidSplitT<false, true, false>, SplitKOrder, false, true>(lds, g, S, E); SEAM2(17); }
#if TS_ON
    if (blockIdx.x == 0 && threadIdx.x == 0) { asm volatile("s_waitcnt vmcnt(0)" ::: "memory"); const unsigned long long* tsp = (const unsigned long long*)((gu32*)(ws + WS_CTL) + CW_TS);
        const float ticks = (float)(tsp[TS_B] - tsp[TS_A]); const float d2 = TS_CAL ? 33.0f : ticks * 0.0033f;
        float* po = KA.out + OUT_S5RE; po[0] = po[0] + sqrtf(d2); }
#endif
#undef IN
#undef SEAM
#undef lds
#undef MISC
#undef tid
#undef lane
#undef wave
#undef G
#undef ws
#undef ADA
#undef H
#undef Y
#undef xs_off
#undef ADA1
}
constexpr int N_PHASES = 18;

#ifndef MK_ONE_LAUNCH
#define MK_ONE_LAUNCH 1
#endif
extern "C" void kernel_launch(void* const* d_in, const int* in_sizes, int n_in, void* d_out, int out_size, void* d_ws, size_t ws_size, hipStream_t stream) {
    static int grid = 0;
    if (grid == 0) {
        if (n_in != 34 || out_size != (int)OUT_END || ws_size < WS_END) { fprintf(stderr, "kernel_launch: unexpected shapes: n_in %d out %d ws %zu\n", n_in, out_size, ws_size); grid = -1; return; }
        int dev = 0, cus = 0, per_cu = 0;
        if (hipGetDevice(&dev) != hipSuccess || hipDeviceGetAttribute(&cus, hipDeviceAttributeMultiprocessorCount, dev) != hipSuccess) { grid = -1; return; }
        if (hipFuncSetAttribute((const void*)fwd_kernel, hipFuncAttributeMaxDynamicSharedMemorySize, LDS_BYTES) != hipSuccess) { fprintf(stderr, "kernel_launch: hipFuncSetAttribute failed\n"); grid = -1; return; }
        if (hipOccupancyMaxActiveBlocksPerMultiprocessor(&per_cu, (const void*)fwd_kernel, NWAVES * 64, LDS_BYTES) != hipSuccess || per_cu < 1) { fprintf(stderr, "kernel_launch: occupancy query says %d blocks per CU\n", per_cu); }
        (void)hipGetLastError();
        grid = cus < 256 ? cus : 256;
        if (grid != 256) { fprintf(stderr, "kernel_launch: this kernel needs a 256-CU device (one workgroup per CU); found %d\n", cus); grid = -1; return; }
    }
    if (grid < 0) return;
    (void)hipMemsetAsync((char*)d_ws + WS_CTL, 0, CTL_ZERO_BYTES, stream);
    Args a{};
    for (int i = 0; i < 34; ++i) a.in[i] = (const float*)d_in[i];
    a.out = (float*)d_out; a.ws = (unsigned char*)d_ws;
#if MK_ONE_LAUNCH
    a.ph_lo = 0; a.ph_hi = N_PHASES;
    hipLaunchKernelGGL(fwd_kernel, dim3(grid), dim3(NWAVES * 64), LDS_BYTES, stream, a);
#else
    for (int p = 0; p < N_PHASES; ++p) { a.ph_lo = p; a.ph_hi = p + 1; hipLaunchKernelGGL(fwd_kernel, dim3(grid), dim3(NWAVES * 64), LDS_BYTES, stream, a); }
#endif
    const hipError_t le = hipPeekAtLastError();
    if (le != hipSuccess) fprintf(stderr, "kernel_launch: launch failed: %s\n", hipGetErrorName(le));
}
```

```cpp
#include <hip/hip_runtime.h>
#include <hip/hip_bf16.h>
#include <cstdio>
#include <cstdint>
#include <cmath>
namespace pg8 {
#define PG8_LAS __attribute__((address_space(3)))
typedef unsigned short bf16_t;
typedef short bf16x8 __attribute__((ext_vector_type(8)));
typedef float f32x4 __attribute__((ext_vector_type(4)));
typedef unsigned u32x4 __attribute__((ext_vector_type(4)));
constexpr int BM = 256, BK = 64, HALF = 128, HTB = HALF * BK * 2  , STAGE_BYTES = 8 * HTB, NXCD = 8, WGM = 8;

__host__ __device__ __forceinline__ int lds_byte(int r, int c) { const int st = (r >> 4) * 2 + (c >> 5), rr = r & 15, cc = c & 31, ob = rr * 64 + cc * 2; return st * 1024 + (ob ^ (((ob >> 9) & 1) << 5)); }
__host__ __device__ __forceinline__ void stage_rc(int b, int& R, int& C) { const int st = b / 1024, sb = b % 1024, swz = sb ^ (((sb >> 9) & 1) << 5); R = (st >> 1) * 16 + swz / 64; C = (st & 1) * 32 + (swz % 64) / 2; }
__host__ __device__ __forceinline__ int perm32(int rho) { const int n = rho >> 4, i = rho & 15; return 8 * (i >> 2) + 4 * n + (i & 3); }

struct Unit { int pm, pn; };
struct Gemm { const bf16_t* A; const bf16_t* Bt; int M, N, K, lda, ldb; };

struct StaticOrder {
    int nM, nN, nwg, G, c;
    __host__ __device__ void init(int M, int N, int G_, int c_) { nM = M / BM; nN = N / BM; nwg = nM * nN; G = G_; c = c_; }
    __host__ __device__ bool next(int i, Unit& u) const {
        const long L = (long)i * G + c; if (L >= nwg) return false;
        int wgid = (int)L; { const int q = nwg / NXCD, r = nwg % NXCD, xcd = wgid % NXCD, off = wgid / NXCD; wgid = (xcd < r ? xcd * (q + 1) : r * (q + 1) + (xcd - r) * q) + off; }
        const int nig = WGM * nN, gid = wgid / nig, fm = gid * WGM, gsz = (nM - fm) < WGM ? (nM - fm) : WGM;
        u.pm = fm + ((wgid % nig) % gsz); u.pn = (wgid % nig) / gsz; return true;
    }
    __device__ __forceinline__ void a_ready(const Unit&) const {}
    __device__ __forceinline__ void done(const Unit&) const {}
};

__device__ __forceinline__ unsigned cvt_pk_bf16(float lo, float hi) { unsigned r; asm volatile("v_cvt_pk_bf16_f32 %0, %1, %2" : "=v"(r) : "v"(lo), "v"(hi)); return r; }
typedef float f32x2 __attribute__((ext_vector_type(2)));
template <int ACT  , bool NORM = false> struct EpiBf16 {
    static constexpr bool PERM = true, AFTER_DRAIN = false;
    bf16_t* O; int ldc; const float* rsw; const float* cv; int ncv;
    __device__ __forceinline__ void operator()(const f32x4 (&acc)[2][2][4][2], const Unit& u, int wr, int wc, int fr, int fq) const {
        const int row0 = u.pm * BM + wr * 64 + fr; const int col0 = u.pn * BM + wc * 32 + 8 * fq;
        const __amdgpu_buffer_rsrc_t orsrc = __builtin_amdgcn_make_buffer_rsrc((void*)O, (short)0, 8192 * ldc * 2, 0x00020000);
        f32x4 cvv[2][2];
        if (NORM) { const int cond = u.pm < 16 ? 0 : 1 + ((u.pm - 16) >> 2);
#pragma unroll
            for (int bj = 0; bj < 2; ++bj)
#pragma unroll
                for (int n = 0; n < 2; ++n) cvv[bj][n] = *(const f32x4*)(cv + (size_t)cond * ncv + col0 + bj * HALF + 4 * n); }
        float rstdv[2][4];
        if (NORM) { f32x4 s4v[2][4];
#pragma unroll
            for (int ai = 0; ai < 2; ++ai)
#pragma unroll
                for (int m = 0; m < 4; ++m) s4v[ai][m] = *(const f32x4*)(rsw + (size_t)(row0 + ai * HALF + m * 16) * 4);
#pragma unroll
            for (int ai = 0; ai < 2; ++ai)
#pragma unroll
                for (int m = 0; m < 4; ++m) { const f32x4 s4 = s4v[ai][m]; rstdv[ai][m] = __builtin_amdgcn_rsqf(((s4[0] + s4[1]) + (s4[2] + s4[3])) * (1.f / 1024.f) + 1e-6f); }
            asm volatile("" ::: "memory"); }
#pragma unroll
        for (int ai = 0; ai < 2; ++ai)
#pragma unroll
            for (int m = 0; m < 4; ++m) { const int row = row0 + ai * HALF + m * 16; const unsigned rowoff = (unsigned)(row * ldc + col0) * 2u;
                float rstd = 1.f;
                if (NORM) rstd = rstdv[ai][m];
#pragma unroll
                for (int bj = 0; bj < 2; ++bj) { f32x4 v0 = acc[ai][bj][m][0], v1 = acc[ai][bj][m][1];
                    if (NORM) { v0 = v0 * rstd + cvv[bj][0]; v1 = v1 * rstd + cvv[bj][1]; }
                    if (ACT == 2) {
#pragma unroll
                        for (int e = 0; e < 4; ++e) { float a = v0[e] > 0.f ? v0[e] : 0.f; v0[e] = a * a; float b = v1[e] > 0.f ? v1[e] : 0.f; v1[e] = b * b; } }
                    u32x4 w; w.x = cvt_pk_bf16(v0[0], v0[1]); w.y = cvt_pk_bf16(v0[2], v0[3]); w.z = cvt_pk_bf16(v1[0], v1[1]); w.w = cvt_pk_bf16(v1[2], v1[3]);
                    __builtin_amdgcn_raw_buffer_store_b128(w, orsrc, rowoff + bj * HALF * 2, 0, 16); } }
    }
};
template <bool NEXT> struct EpiResidT {
    static constexpr bool PERM = false, AFTER_DRAIN = false;
    const float* base_p; const float* base_s; float* out; const float* gate;
    bf16_t* Hn; const float* nw; const float* nsc; float* rsw;
    __device__ __forceinline__ void operator()(const f32x4 (&acc)[2][2][4][2], const Unit& u, int wr, int wc, int fr, int fq) const {
        const int row0 = u.pm * BM + wr * 64 + fr; const int col0 = u.pn * BM + wc * 32 + 4 * fq;
        const int cond = u.pm < 16 ? 0 : 1 + ((u.pm - 16) >> 2);
        const float* gp = gate + cond * 6144; const float* bp = u.pm < 16 ? base_p : base_s;
        f32x4 gv[2][2];
#pragma unroll
        for (int bj = 0; bj < 2; ++bj)
#pragma unroll
            for (int n = 0; n < 2; ++n) gv[bj][n] = *(const f32x4*)(gp + col0 + bj * HALF + n * 16);
        f32x4 (&y)[2][2][4][2] = const_cast<f32x4 (&)[2][2][4][2]>(acc);
#pragma unroll
        for (int ai = 0; ai < 2; ++ai)
#pragma unroll
            for (int m = 0; m < 4; ++m) { const size_t off = (size_t)(row0 + ai * HALF + m * 16) * 1024 + col0;
#pragma unroll
                for (int bj = 0; bj < 2; ++bj)
#pragma unroll
                    for (int n = 0; n < 2; ++n) { const f32x4 b = *(const f32x4*)(bp + off + bj * HALF + n * 16); const f32x4 yy = b + gv[bj][n] * acc[ai][bj][m][n];
                        *(f32x4*)(out + off + bj * HALF + n * 16) = yy; if (NEXT) y[ai][bj][m][n] = yy; } }
        if (NEXT) {
            asm volatile("" ::: "memory");
            f32x4 av[2][2];
#pragma unroll
            for (int bj = 0; bj < 2; ++bj)
#pragma unroll
                for (int n = 0; n < 2; ++n) av[bj][n] = *(const f32x4*)(nw + col0 + bj * HALF + n * 16) * (*(const f32x4*)(nsc + cond * 6144 + col0 + bj * HALF + n * 16) + 1.0f);
#pragma unroll
            for (int ai = 0; ai < 2; ++ai)
#pragma unroll
                for (int m = 0; m < 4; ++m) { const int row = row0 + ai * HALF + m * 16; const size_t off = (size_t)row * 1024 + col0; float ss = 0.f;
#pragma unroll
                    for (int bj = 0; bj < 2; ++bj)
#pragma unroll
                        for (int n = 0; n < 2; ++n) { const f32x4 yy = y[ai][bj][m][n]; ss += (yy[0] * yy[0] + yy[1] * yy[1]) + (yy[2] * yy[2] + yy[3] * yy[3]); const f32x4 h = yy * av[bj][n];
                            typedef unsigned u32x2 __attribute__((ext_vector_type(2))); u32x2 w; w.x = cvt_pk_bf16(h[0], h[1]); w.y = cvt_pk_bf16(h[2], h[3]); *(u32x2*)(Hn + off + bj * HALF + n * 16) = w; }
                    ss += __shfl_xor(ss, 16); ss += __shfl_xor(ss, 32); if (fq == 0) rsw[(size_t)row * 16 + u.pn * 4 + wc] = ss; }
        }
    }
};
typedef EpiResidT<false> EpiResid;
struct EpiGlu {
    static constexpr bool PERM = true, AFTER_DRAIN = false;
    const bf16_t* G; bf16_t* O; const float* bias;
    __device__ __forceinline__ void operator()(const f32x4 (&acc)[2][2][4][2], const Unit& u, int wr, int wc, int fr, int fq) const {
        const int row0 = u.pm * BM + wr * 64 + fr; const int col0 = u.pn * BM + wc * 32 + 8 * fq;
        f32x4 bv[2][2];
#pragma unroll
        for (int bj = 0; bj < 2; ++bj)
#pragma unroll
            for (int n = 0; n < 2; ++n) bv[bj][n] = *(const f32x4*)(bias + col0 + bj * HALF + 4 * n);
        u32x4 gwv[2][4][2];
#pragma unroll
        for (int ai = 0; ai < 2; ++ai)
#pragma unroll
            for (int m = 0; m < 4; ++m)
#pragma unroll
                for (int bj = 0; bj < 2; ++bj) gwv[ai][m][bj] = *(const u32x4*)(G + (size_t)(row0 + ai * HALF + m * 16) * 512 + col0 + bj * HALF);
#pragma unroll
        for (int ai = 0; ai < 2; ++ai)
#pragma unroll
            for (int m = 0; m < 4; ++m) { const size_t row = (size_t)(row0 + ai * HALF + m * 16);
#pragma unroll
                for (int bj = 0; bj < 2; ++bj) { f32x4 v0 = acc[ai][bj][m][0] + bv[bj][0], v1 = acc[ai][bj][m][1] + bv[bj][1];
                    const u32x4 gw = gwv[ai][m][bj];
                    float gf[8];
#pragma unroll
                    for (int e = 0; e < 4; ++e) { gf[2 * e] = __uint_as_float(gw[e] << 16); gf[2 * e + 1] = __uint_as_float(gw[e] & 0xffff0000u); }
                    float o[8];
#pragma unroll
                    for (int e = 0; e < 4; ++e) { o[e] = gf[e] * __builtin_amdgcn_rcpf(1.f + __expf(-v0[e])); o[4 + e] = gf[4 + e] * __builtin_amdgcn_rcpf(1.f + __expf(-v1[e])); }
                    u32x4 w; w.x = cvt_pk_bf16(o[0], o[1]); w.y = cvt_pk_bf16(o[2], o[3]); w.z = cvt_pk_bf16(o[4], o[5]); w.w = cvt_pk_bf16(o[6], o[7]);
                    *(u32x4*)(O + row * 1024 + col0 + bj * HALF) = w; } }
    }
};

template <class Epi, class Sched, bool ALIGN_EPI = false, bool SP2 = false>
__device__ __forceinline__ void gemm_phase(PG8_LAS unsigned char* lds, const Gemm g, const Sched& S, const Epi& E) {
    int tid_ = threadIdx.x; asm volatile("" : "+v"(tid_));
    const int tid = tid_, wid = __builtin_amdgcn_readfirstlane(tid >> 6), lane = tid & 63, wr = wid >> 2, wc = wid & 3, fr = lane & 15, fq = lane >> 4;
    const int K = g.K, nt = K / BK, LDA_ = g.lda, LDB_ = g.ldb;
    unsigned voffA[2], voffB[2];
#pragma unroll
    for (int i = 0; i < 2; ++i) { int R, C; stage_rc(tid * 16 + i * 8192, R, C); const int Rb = Epi::PERM ? ((R & ~31) + perm32(R & 31)) : R;
        voffA[i] = (unsigned)(R * LDA_ + C) * 2u; voffB[i] = (unsigned)(Rb * LDB_ + C) * 2u; }
    const size_t kstep = (size_t)(BK * 2);
    const size_t hstepA = (size_t)HALF * LDA_ * 2, hstepB = (size_t)HALF * LDB_ * 2;
    const size_t tstepA = 2 * hstepA, tstepB = 2 * hstepB;
    const unsigned ldsw = (unsigned)wid * 1024u;
    const int aoff = lds_byte(wr * 64 + fr, fq * 8), boff = lds_byte(wc * 32 + fr, fq * 8);
#define PG8_SA(b, h) (((b) * 2 + (h)) * HTB)
#define PG8_SB(b, h) ((4 + (b) * 2 + (h)) * HTB)
#define PG8_STAGE(bufoff, gbase, voff) do { _Pragma("unroll") for (int _i = 0; _i < 2; ++_i) \
        __builtin_amdgcn_global_load_lds((const unsigned*)((const char*)(gbase) + (voff)[_i]), (PG8_LAS unsigned*)(lds + (bufoff) + ldsw + _i * 8192), 16, 0, 0); } while (0)
#define PG8_LDA(dst, b, h) do { _Pragma("unroll") for (int m = 0; m < 4; ++m) _Pragma("unroll") for (int k = 0; k < 2; ++k) dst[m][k] = *(const PG8_LAS bf16x8*)(lds + PG8_SA(b, h) + aoff + m * 2048 + k * 1024); } while (0)
#define PG8_LDB(dst, b, h) do { _Pragma("unroll") for (int n = 0; n < 2; ++n) _Pragma("unroll") for (int k = 0; k < 2; ++k) dst[n][k] = *(const PG8_LAS bf16x8*)(lds + PG8_SB(b, h) + boff + n * 2048 + k * 1024); } while (0)
#define PG8_MMA(ai, bj, At, Bt) do { __builtin_amdgcn_s_setprio(1); _Pragma("unroll") for (int m = 0; m < 4; ++m) _Pragma("unroll") for (int n = 0; n < 2; ++n) _Pragma("unroll") for (int k = 0; k < 2; ++k) \
        acc[ai][bj][m][n] = __builtin_amdgcn_mfma_f32_16x16x32_bf16(Bt[n][k], At[m][k], acc[ai][bj][m][n], 0, 0, 0); __builtin_amdgcn_s_setprio(0); } while (0)
#define PG8_WAIT_V(n) asm volatile("s_waitcnt vmcnt(" #n ")" ::: "memory")
#define PG8_WAIT_L(n) asm volatile("s_waitcnt lgkmcnt(" #n ")" ::: "memory")
#define PG8_BAR __builtin_amdgcn_s_barrier()
#define PG8_SCHED __builtin_amdgcn_sched_barrier(0)
    Unit cur, nxt; int ui = 0;
    if (!S.next(0, cur)) return;
    f32x4 acc[2][2][4][2];
#pragma unroll
    for (int a = 0; a < 2; ++a)
#pragma unroll
        for (int b = 0; b < 2; ++b)
#pragma unroll
            for (int m = 0; m < 4; ++m)
#pragma unroll
                for (int n = 0; n < 2; ++n) acc[a][b][m][n] = (f32x4){0.f, 0.f, 0.f, 0.f};
    bf16x8 At[4][2], B0[2][2], B1[2][2];
    const char* cA = (const char*)g.A + (size_t)cur.pm * tstepA; const char* cB = (const char*)g.Bt + (size_t)cur.pn * tstepB;
    S.a_ready(cur);
    if constexpr (SP2) {
        PG8_STAGE(PG8_SB(0, 0), cB, voffB); PG8_STAGE(PG8_SB(0, 1), cB + hstepB, voffB); PG8_STAGE(PG8_SA(0, 0), cA, voffA); PG8_STAGE(PG8_SA(0, 1), cA + hstepA, voffA);
        if (wr == 1) PG8_BAR;
        PG8_WAIT_V(2); PG8_BAR;
        PG8_STAGE(PG8_SB(1, 0), cB + kstep, voffB); PG8_STAGE(PG8_SA(1, 0), cA + kstep, voffA); PG8_STAGE(PG8_SB(1, 1), cB + hstepB + kstep, voffB);
        PG8_WAIT_V(6); PG8_BAR;
    } else {
        PG8_STAGE(PG8_SB(0, 0), cB, voffB); PG8_STAGE(PG8_SA(0, 0), cA, voffA); PG8_STAGE(PG8_SB(0, 1), cB + hstepB, voffB); PG8_STAGE(PG8_SA(0, 1), cA + hstepA, voffA);
        if (wr == 1) PG8_BAR;
        PG8_WAIT_V(4); PG8_BAR;
        PG8_STAGE(PG8_SB(1, 0), cB + kstep, voffB); PG8_STAGE(PG8_SA(1, 0), cA + kstep, voffA); PG8_STAGE(PG8_SB(1, 1), cB + hstepB + kstep, voffB);
        PG8_WAIT_V(6); PG8_BAR;
    }
    for (;;) {
        const bool has_next = S.next(ui + 1, nxt);
        const char* nA = has_next ? (const char*)g.A + (size_t)nxt.pm * tstepA : cA; const char* nB = has_next ? (const char*)g.Bt + (size_t)nxt.pn * tstepB : cB;
        for (int t = 0; t < nt; t += 2) {
            const bool last = (t == nt - 2);
            const char* a1 = cA + (size_t)(t + 1) * kstep;
            const char* a2 = last ? nA : cA + (size_t)(t + 2) * kstep; const char* b2 = last ? nB : cB + (size_t)(t + 2) * kstep;
            const char* a3 = a2 + kstep; const char* b3 = b2 + kstep;
            if (last && has_next) S.a_ready(nxt);
            if constexpr (SP2) {
            PG8_LDB(B0, 0, 0); PG8_LDB(B1, 0, 1); PG8_SCHED; PG8_LDA(At, 0, 0); PG8_STAGE(PG8_SA(1, 1), a1 + hstepA, voffA);
            PG8_WAIT_V(8); PG8_WAIT_L(0); PG8_BAR; PG8_MMA(0, 0, At, B0); PG8_MMA(0, 1, At, B1); PG8_BAR; PG8_SCHED;
            PG8_LDA(At, 0, 1); PG8_STAGE(PG8_SB(0, 0), b2, voffB); PG8_STAGE(PG8_SB(0, 1), b2 + hstepB, voffB); PG8_STAGE(PG8_SA(0, 0), a2, voffA);
            PG8_WAIT_V(8); PG8_WAIT_L(0); PG8_BAR; PG8_MMA(1, 0, At, B0); PG8_MMA(1, 1, At, B1); PG8_BAR; PG8_SCHED;
            PG8_LDB(B0, 1, 0); PG8_LDB(B1, 1, 1); PG8_SCHED; PG8_LDA(At, 1, 0); PG8_STAGE(PG8_SA(0, 1), a2 + hstepA, voffA);
            PG8_WAIT_V(8); PG8_WAIT_L(0); PG8_BAR; PG8_MMA(0, 0, At, B0); PG8_MMA(0, 1, At, B1); PG8_BAR; PG8_SCHED;
            PG8_LDA(At, 1, 1); PG8_STAGE(PG8_SB(1, 0), b3, voffB); PG8_STAGE(PG8_SB(1, 1), b3 + hstepB, voffB); PG8_STAGE(PG8_SA(1, 0), a3, voffA);
            PG8_WAIT_V(8); PG8_WAIT_L(0); PG8_BAR; PG8_MMA(1, 0, At, B0); PG8_MMA(1, 1, At, B1); PG8_BAR; PG8_SCHED;
            } else {
            PG8_LDB(B0, 0, 0); PG8_SCHED; PG8_LDA(At, 0, 0); PG8_STAGE(PG8_SA(1, 1), a1 + hstepA, voffA);
            PG8_WAIT_L(8); PG8_BAR; PG8_WAIT_L(0); PG8_MMA(0, 0, At, B0); PG8_BAR; PG8_SCHED;
            PG8_LDB(B1, 0, 1); PG8_STAGE(PG8_SB(0, 0), b2, voffB);
            PG8_BAR; PG8_WAIT_L(0); PG8_MMA(0, 1, At, B1); PG8_BAR;
            PG8_LDA(At, 0, 1); PG8_STAGE(PG8_SA(0, 0), a2, voffA);
            PG8_BAR; PG8_WAIT_L(0); PG8_MMA(1, 0, At, B0); PG8_BAR; PG8_SCHED;
            PG8_STAGE(PG8_SB(0, 1), b2 + hstepB, voffB);
            PG8_WAIT_V(6); PG8_BAR; PG8_MMA(1, 1, At, B1); PG8_BAR;
            PG8_LDB(B0, 1, 0); PG8_SCHED; PG8_LDA(At, 1, 0); PG8_STAGE(PG8_SA(0, 1), a2 + hstepA, voffA);
            PG8_WAIT_L(8); PG8_BAR; PG8_WAIT_L(0); PG8_MMA(0, 0, At, B0); PG8_BAR; PG8_SCHED;
            PG8_LDB(B1, 1, 1); PG8_STAGE(PG8_SB(1, 0), b3, voffB);
            PG8_BAR; PG8_WAIT_L(0); PG8_MMA(0, 1, At, B1); PG8_BAR;
            PG8_LDA(At, 1, 1); PG8_STAGE(PG8_SA(1, 0), a3, voffA);
            PG8_BAR; PG8_WAIT_L(0); PG8_MMA(1, 0, At, B0); PG8_BAR; PG8_SCHED;
            PG8_STAGE(PG8_SB(1, 1), b3 + hstepB, voffB);
            PG8_WAIT_V(6); PG8_BAR; PG8_MMA(1, 1, At, B1); PG8_BAR;
            }
        }
        if constexpr (ALIGN_EPI) { if (wr == 0) PG8_BAR; }
        if constexpr (!Epi::AFTER_DRAIN) { E(acc, cur, wr, wc, fr, fq); S.done(cur); }
        if (!has_next) break;
#pragma unroll
        for (int a = 0; a < 2; ++a)
#pragma unroll
            for (int b = 0; b < 2; ++b)
#pragma unroll
                for (int m = 0; m < 4; ++m)
#pragma unroll
                    for (int n = 0; n < 2; ++n) acc[a][b][m][n] = (f32x4){0.f, 0.f, 0.f, 0.f};
        cur = nxt; cA = nA; cB = nB; ++ui;
        if constexpr (ALIGN_EPI) { if (wr == 1) PG8_BAR; }
    }
    PG8_WAIT_V(0);
    if constexpr (!ALIGN_EPI) { if (wr == 0) PG8_BAR; }
    PG8_BAR;
    if constexpr (Epi::AFTER_DRAIN) { E.fused(acc, cur, wr, wc, fr, fq, lds, wid, lane); S.done(cur); }
#undef PG8_SA
#undef PG8_SB
#undef PG8_STAGE
#undef PG8_LDA
#undef PG8_LDB
#undef PG8_MMA
#undef PG8_WAIT_V
#undef PG8_WAIT_L
#undef PG8_BAR
#undef PG8_SCHED
}
}

namespace att {
using bf16 = __hip_bfloat16;
constexpr int D = 128, NW = 8, QBLK = 32, KVBLK = 64; constexpr float SCALE = 0.088388347648318440f; constexpr float THR = 8.f; constexpr int SDEPTH = 2;
constexpr int LDQ = 1024, LDK = 256, LDO = 1024;
constexpr size_t SHM_V = KVBLK * D * 2, SHM_K = KVBLK * D * 2, SHM_ATTN = 2 * SHM_V + 2 * SHM_K + NW * 64 * 4;
using bf16x8 = __attribute__((ext_vector_type(8))) short;
using s16x4  = __attribute__((ext_vector_type(4))) short;
using f32x16 = __attribute__((ext_vector_type(16))) float;
using f32x8  = __attribute__((ext_vector_type(8))) float;
using u32x4  = __attribute__((ext_vector_type(4))) unsigned;
#define KSWZ(row, colB) ((row) * 256 + ((colB) ^ (((row) & 7) << 4)))
#define SBAR() __builtin_amdgcn_sched_barrier(0)
__device__ __forceinline__ int crow(int r, int hi) { return (r & 3) + 8 * (r >> 2) + 4 * hi; }
__device__ __forceinline__ unsigned cvtpk(float lo, float hi) {
  unsigned r; asm volatile("v_cvt_pk_bf16_f32 %0, %1, %2" : "=v"(r) : "v"(lo), "v"(hi)); return r;
}
template <typename TIn> struct Stage;
template <> struct Stage<bf16>  { using T = bf16x8;
  __device__ static __forceinline__ T ld8(const bf16* p) { return *reinterpret_cast<const bf16x8*>(p); }
  __device__ static __forceinline__ bf16x8 tobf(T x) { return x; } };
template <> struct Stage<float> { using T = f32x8;
  __device__ static __forceinline__ T ld8(const float* p) { return *reinterpret_cast<const f32x8*>(p); }
  __device__ static __forceinline__ bf16x8 tobf(T x) {
    u32x4 w = {cvtpk(x[0], x[1]), cvtpk(x[2], x[3]), cvtpk(x[4], x[5]), cvtpk(x[6], x[7])}; return *reinterpret_cast<bf16x8*>(&w); } };

__device__ __forceinline__ void partialSM(f32x16& p0, f32x16& p1, float& m_reg, float& mn, float& alpha) {
  constexpr float C = SCALE * 1.4426950408889634f;
  float pmax = p0[0]; for (int r = 1; r < 16; ++r) pmax = fmaxf(pmax, p0[r]); for (int r = 0; r < 16; ++r) pmax = fmaxf(pmax, p1[r]);
  { auto rr = __builtin_amdgcn_permlane32_swap(__float_as_uint(pmax), __float_as_uint(pmax), false, false);
    pmax = fmaxf(__uint_as_float(rr[0]), __uint_as_float(rr[1])); }
  if (__builtin_expect(__all(pmax - m_reg <= THR / SCALE), 1)) { mn = m_reg; alpha = 1.f; }
  else { mn = fmaxf(m_reg, pmax); alpha = __builtin_amdgcn_exp2f((m_reg - mn) * C); m_reg = mn; }
  float mnC = -mn * C;
  for (int r = 0; r < 16; ++r) p0[r] = fmaf(p0[r], C, mnC); for (int r = 0; r < 16; ++r) p1[r] = fmaf(p1[r], C, mnC);
  for (int r = 0; r < 16; ++r) p0[r] = __builtin_amdgcn_exp2f(p0[r]);
}
__device__ __forceinline__ void finishSM(f32x16& p0, f32x16& p1, float alpha, float& l_reg, bf16x8& pa0, bf16x8& pa1, bf16x8& pa2, bf16x8& pa3) {
  for (int r = 0; r < 16; ++r) p1[r] = __builtin_amdgcn_exp2f(p1[r]);
  float ps = 0; for (int r = 0; r < 16; ++r) ps += p0[r]; for (int r = 0; r < 16; ++r) ps += p1[r];
  { auto rr = __builtin_amdgcn_permlane32_swap(__float_as_uint(ps), __float_as_uint(ps), false, false);
    ps = __uint_as_float(rr[0]) + __uint_as_float(rr[1]); }
  l_reg = l_reg * alpha + ps;
#define PK4(P, BASE, OUT) do { unsigned a0 = cvtpk(P[BASE + 0], P[BASE + 1]), a1 = cvtpk(P[BASE + 2], P[BASE + 3]);   \
    unsigned b0 = cvtpk(P[BASE + 4], P[BASE + 5]), b1 = cvtpk(P[BASE + 6], P[BASE + 7]);                              \
    auto r0 = __builtin_amdgcn_permlane32_swap(a0, b0, false, false); auto r1 = __builtin_amdgcn_permlane32_swap(a1, b1, false, false); \
    u32x4 w = {r0[0], r1[0], r0[1], r1[1]}; OUT = *reinterpret_cast<bf16x8*>(&w); } while (0)
  PK4(p0, 0, pa0); PK4(p0, 8, pa1); PK4(p1, 0, pa2); PK4(p1, 8, pa3);
#undef PK4
}
__device__ __forceinline__ void qkt(f32x16& p0, f32x16& p1, const bf16* Ks, const bf16x8* qr, int r32, int hi) {
  p0 = f32x16{}; p1 = f32x16{};
  for (int d0 = 0; d0 < 8; ++d0) { int cb = (d0 * 16 + hi * 8) * 2;
    bf16x8 b0 = *reinterpret_cast<const bf16x8*>((const char*)Ks + KSWZ(r32, cb));
    bf16x8 b1 = *reinterpret_cast<const bf16x8*>((const char*)Ks + KSWZ(32 + r32, cb));
    p0 = __builtin_amdgcn_mfma_f32_32x32x16_bf16(b0, qr[d0], p0, 0, 0, 0);
    p1 = __builtin_amdgcn_mfma_f32_32x32x16_bf16(b1, qr[d0], p1, 0, 0, 0); }
}
__device__ __forceinline__ int v_st(int k, int c) { const int kk = (k & ~0xC) | ((k & 4) << 1) | ((k & 8) >> 1); return ((kk >> 3) * 4 + (c >> 5)) * 512 + ((kk & 7) * 32 + (c & 31)) * 2; }
__device__ __forceinline__ int v_rd_base(int lane) { return ((lane & 3) << 3) | (((lane >> 2) & 3) << 6) | (((lane >> 4) & 1) << 5) | (((lane >> 5) & 1) << 8); }
constexpr int v_rd_off(int d0, int ks, int half) { return d0 * 512 + ks * 4096 + half * 2048; }
template <int OFF> __device__ __forceinline__ s16x4 tr_read(int vb) {
  s16x4 r; asm volatile("ds_read_b64_tr_b16 %0, %1 offset:%2" : "=&v"(r) : "v"(vb), "i"(OFF) : "memory"); return r;
}
template <int D0> __device__ __forceinline__ void pv_one(f32x16& od, int vb, bf16x8 pa0, bf16x8 pa1, bf16x8 pa2, bf16x8 pa3) {
  const s16x4 l0 = tr_read<v_rd_off(D0, 0, 0)>(vb), h0 = tr_read<v_rd_off(D0, 0, 1)>(vb), l1 = tr_read<v_rd_off(D0, 1, 0)>(vb), h1 = tr_read<v_rd_off(D0, 1, 1)>(vb);
  const s16x4 l2 = tr_read<v_rd_off(D0, 2, 0)>(vb), h2 = tr_read<v_rd_off(D0, 2, 1)>(vb), l3 = tr_read<v_rd_off(D0, 3, 0)>(vb), h3 = tr_read<v_rd_off(D0, 3, 1)>(vb);
  asm volatile("s_waitcnt lgkmcnt(0)" ::: "memory"); SBAR();
#define PK(L, H) (bf16x8){L[0], L[1], L[2], L[3], H[0], H[1], H[2], H[3]}
  od = __builtin_amdgcn_mfma_f32_32x32x16_bf16(pa0, PK(l0, h0), od, 0, 0, 0);
  od = __builtin_amdgcn_mfma_f32_32x32x16_bf16(pa1, PK(l1, h1), od, 0, 0, 0);
  od = __builtin_amdgcn_mfma_f32_32x32x16_bf16(pa2, PK(l2, h2), od, 0, 0, 0);
  od = __builtin_amdgcn_mfma_f32_32x32x16_bf16(pa3, PK(l3, h3), od, 0, 0, 0);
#undef PK
}
__device__ __forceinline__ void pv_d0(f32x16* o, int vb, bf16x8 pa0, bf16x8 pa1, bf16x8 pa2, bf16x8 pa3) {
  pv_one<0>(o[0], vb, pa0, pa1, pa2, pa3); pv_one<1>(o[1], vb, pa0, pa1, pa2, pa3); pv_one<2>(o[2], vb, pa0, pa1, pa2, pa3); pv_one<3>(o[3], vb, pa0, pa1, pa2, pa3);
}

constexpr int OSC_BYTES = 32 * 256;
__device__ __forceinline__ void o_tile_out(char* osc, bf16* Ob, int wid, int lane) {
  asm volatile("s_waitcnt lgkmcnt(0)" ::: "memory");
  const __amdgpu_buffer_rsrc_t orr = __builtin_amdgcn_make_buffer_rsrc((void*)Ob, (short)0, 256 * LDO * 2, 0x00020000);
  typedef unsigned ou32x4 __attribute__((ext_vector_type(4)));
#pragma unroll
  for (int i = 0; i < 8; ++i) { const int q = lane + 64 * i, row = q >> 4, c16 = q & 15;
    const ou32x4 w = *(const ou32x4*)(osc + row * 256 + c16 * 16);
    __builtin_amdgcn_raw_buffer_store_b128(w, orr, (unsigned)(((wid * QBLK + row) * LDO + c16 * 8) * 2), 0, 16); }
}
template <typename TQ, bool PART = false>
__device__ __forceinline__ void attn_dense_body(const TQ* __restrict__ Qb, const bf16* __restrict__ Kh, const bf16* __restrict__ Vh,
                                                bf16* __restrict__ Ob, int seq, char* lds, unsigned long long* xsend = nullptr, const unsigned long long* xrecv = nullptr,
                                                unsigned* fl_mine = nullptr, unsigned* fl_partner = nullptr, unsigned epoch = 0u, int half = 0, unsigned* done_cnt = nullptr) {
  using St = Stage<bf16>; using SQ = Stage<TQ>;
  int tid_ = threadIdx.x; asm volatile("" : "+v"(tid_));
  const int tid = tid_, wid = tid >> 6, lane = tid & 63, r32 = lane & 31, hi = lane >> 5;
  bf16* V_lds = (bf16*)lds; bf16* K_lds = (bf16*)(lds + 2 * SHM_V);
  float* ws = (float*)(lds + 2 * SHM_V + 2 * SHM_K) + wid * 64; float* li_l = ws; float* al_l = ws + 32;
  float m_reg = -1e30f, l_reg = 0; f32x16 o[4] = {}; bf16x8 qr[8];
  const TQ* Qw = Qb + (long)(wid * QBLK + r32) * LDQ + hi * 8;
#pragma unroll
  for (int d0 = 0; d0 < 8; ++d0) qr[d0] = SQ::tobf(SQ::ld8(Qw + d0 * 16));
  const int sr = tid >> 4, sc = (tid & 15) * 8, vst0 = v_st(sr, sc), vst1 = v_st(32 + sr, sc);
  const int vb0 = (int)(uintptr_t)V_lds + v_rd_base(lane);
  struct { typename St::T vs0, vs1, ks0, ks1; } sr_[SDEPTH];
#define SLOAD(i, k0) do { sr_[i].vs0 = St::ld8(&Vh[(long)((k0) + sr) * LDK + sc]); sr_[i].vs1 = St::ld8(&Vh[(long)((k0) + 32 + sr) * LDK + sc]); \
    sr_[i].ks0 = St::ld8(&Kh[(long)((k0) + sr) * LDK + sc]); sr_[i].ks1 = St::ld8(&Kh[(long)((k0) + 32 + sr) * LDK + sc]); } while (0)
#define SWRITE(b, i) do { *(bf16x8*)((char*)V_lds + (b) * SHM_V + vst0) = St::tobf(sr_[i].vs0);          \
    *(bf16x8*)((char*)V_lds + (b) * SHM_V + vst1) = St::tobf(sr_[i].vs1); int kc = sc * 2;               \
    *(bf16x8*)((char*)K_lds + (b) * SHM_K + KSWZ(sr, kc)) = St::tobf(sr_[i].ks0);                       \
    *(bf16x8*)((char*)K_lds + (b) * SHM_K + KSWZ(32 + sr, kc)) = St::tobf(sr_[i].ks1); } while (0)
#define SWAIT() do { if constexpr (SDEPTH == 2) asm volatile("s_waitcnt vmcnt(4)" ::: "memory"); else asm volatile("s_waitcnt vmcnt(0)" ::: "memory"); } while (0)
#define RESC(a) do { if (__any((a) < 1.f)) { if (hi == 0) al_l[r32] = (a); asm volatile("s_waitcnt lgkmcnt(0)" ::: "memory"); \
    for (int d = 0; d < 4; ++d) for (int r = 0; r < 16; ++r) o[d][r] *= al_l[crow(r, hi)]; } } while (0)
  f32x16 pA0, pA1, pB0, pB1; float mnA, mnB, alA, alB; bf16x8 pa0, pa1, pa2, pa3; const int NT = seq / KVBLK;
  constexpr int SE = 0, SO = SDEPTH - 1;
  SLOAD(SE, 0); asm volatile("s_waitcnt vmcnt(0)" ::: "memory"); SWRITE(0, SE); __syncthreads();
  qkt(pA0, pA1, K_lds, qr, r32, hi); partialSM(pA0, pA1, m_reg, mnA, alA);
  SLOAD(SO, KVBLK); if constexpr (SDEPTH == 2) { if (2 < NT) SLOAD(SE, 2 * KVBLK); }
  SWAIT(); SWRITE(1, SO); __syncthreads();
  for (int j = 1; j + 1 < NT; j += 2) {
    SBAR(); qkt(pB0, pB1, (bf16*)((char*)K_lds + SHM_K), qr, r32, hi);
    finishSM(pA0, pA1, alA, l_reg, pa0, pa1, pa2, pa3); SBAR();
    SLOAD(SO, (j + SDEPTH) * KVBLK); SBAR();
    pv_d0(o, vb0, pa0, pa1, pa2, pa3); partialSM(pB0, pB1, m_reg, mnB, alB);
    __syncthreads(); SWAIT(); SWRITE(0, SE);
    RESC(alB); __syncthreads();
    SBAR(); qkt(pA0, pA1, K_lds, qr, r32, hi);
    finishSM(pB0, pB1, alB, l_reg, pa0, pa1, pa2, pa3); SBAR();
    if (SDEPTH == 1 || j + 3 < NT) SLOAD(SE, (j + 1 + SDEPTH) * KVBLK); SBAR();
    pv_d0(o, vb0 + (int)SHM_V, pa0, pa1, pa2, pa3); partialSM(pA0, pA1, m_reg, mnA, alA);
    __syncthreads(); SWAIT(); SWRITE(1, SO);
    RESC(alA); __syncthreads();
  }
  SBAR(); qkt(pB0, pB1, (bf16*)((char*)K_lds + SHM_K), qr, r32, hi);
  finishSM(pA0, pA1, alA, l_reg, pa0, pa1, pa2, pa3); SBAR();
  pv_d0(o, vb0, pa0, pa1, pa2, pa3); partialSM(pB0, pB1, m_reg, mnB, alB);
  __syncthreads(); RESC(alB);
  finishSM(pB0, pB1, alB, l_reg, pa0, pa1, pa2, pa3); SBAR();
  pv_d0(o, vb0 + (int)SHM_V, pa0, pa1, pa2, pa3);
  if constexpr (!PART) {
  if (hi == 0) li_l[r32] = l_reg; asm volatile("s_waitcnt lgkmcnt(0)" ::: "memory");
  float rli[16];
#pragma unroll
  for (int r = 0; r < 16; ++r) rli[r] = __builtin_amdgcn_rcpf(li_l[crow(r, hi)]);
  __syncthreads();
  char* osc = lds + wid * OSC_BYTES;
#pragma unroll
  for (int r = 0; r < 16; ++r) { int orow = crow(r, hi);
    for (int d0 = 0; d0 < 4; ++d0) *(bf16*)(osc + orow * 256 + (d0 * 32 + r32) * 2) = __float2bfloat16(o[d0][r] * rli[r]); }
  o_tile_out(osc, Ob, wid, lane);
  if (done_cnt) { asm volatile("s_waitcnt vmcnt(0)" ::: "memory"); if (lane == 0) __hip_atomic_fetch_add(done_cnt, 1u, __ATOMIC_RELAXED, __HIP_MEMORY_SCOPE_AGENT); }
  } else {
  constexpr float C = SCALE * 1.4426950408889634f;
  const bool fin = (wid >> 2) == half;
  if (!fin) { unsigned long long* xs = xsend + (size_t)((wid & 3) * 17) * 64 + lane;
#pragma unroll
    for (int d0 = 0; d0 < 4; ++d0)
#pragma unroll
      for (int rq = 0; rq < 4; ++rq) { const unsigned long long w = (unsigned long long)cvtpk(o[d0][4 * rq], o[d0][4 * rq + 1]) | ((unsigned long long)cvtpk(o[d0][4 * rq + 2], o[d0][4 * rq + 3]) << 32);
        __hip_atomic_store(xs + (d0 * 4 + rq) * 64, w, __ATOMIC_RELAXED, __HIP_MEMORY_SCOPE_AGENT); }
    __hip_atomic_store(xs + 16 * 64, (unsigned long long)__float_as_uint(m_reg) | ((unsigned long long)__float_as_uint(l_reg) << 32), __ATOMIC_RELAXED, __HIP_MEMORY_SCOPE_AGENT); }
  asm volatile("s_waitcnt vmcnt(0)" ::: "memory");
  __syncthreads();
  if (tid == 0) { __hip_atomic_store(fl_mine, epoch, __ATOMIC_RELAXED, __HIP_MEMORY_SCOPE_AGENT);
    unsigned sp = 0; while (__hip_atomic_load(fl_partner, __ATOMIC_RELAXED, __HIP_MEMORY_SCOPE_AGENT) < epoch) { __builtin_amdgcn_s_sleep(1); if (++sp > (1u << 22)) break; } }
  __syncthreads();
  if (fin) { const unsigned long long* xr = xrecv + (size_t)((wid & 3) * 17) * 64 + lane;
    const unsigned long long ml = __hip_atomic_load(xr + 16 * 64, __ATOMIC_RELAXED, __HIP_MEMORY_SCOPE_AGENT);
    const float mp = __uint_as_float((unsigned)ml), lp = __uint_as_float((unsigned)(ml >> 32));
    const float mx = fmaxf(m_reg, mp), fa = __builtin_amdgcn_exp2f((m_reg - mx) * C), fb = __builtin_amdgcn_exp2f((mp - mx) * C);
    const float rl = __builtin_amdgcn_rcpf(l_reg * fa + lp * fb);
    if (hi == 0) { li_l[r32] = fa * rl; al_l[r32] = fb * rl; } asm volatile("s_waitcnt lgkmcnt(0)" ::: "memory");
    float sa[16], sb[16];
#pragma unroll
    for (int r = 0; r < 16; ++r) { sa[r] = li_l[crow(r, hi)]; sb[r] = al_l[crow(r, hi)]; }
    char* osc = lds + wid * OSC_BYTES;
    unsigned long long pwv[4][4];
#pragma unroll
    for (int d0 = 0; d0 < 4; ++d0)
#pragma unroll
      for (int rq = 0; rq < 4; ++rq) pwv[d0][rq] = __hip_atomic_load(xr + (d0 * 4 + rq) * 64, __ATOMIC_RELAXED, __HIP_MEMORY_SCOPE_AGENT);
#pragma unroll
    for (int d0 = 0; d0 < 4; ++d0)
#pragma unroll
      for (int rq = 0; rq < 4; ++rq) { const unsigned long long w = pwv[d0][rq];
        const unsigned wl = (unsigned)w, wh = (unsigned)(w >> 32);
        const float p0 = __uint_as_float(wl << 16), p1 = __uint_as_float(wl & 0xffff0000u), p2 = __uint_as_float(wh << 16), p3 = __uint_as_float(wh & 0xffff0000u);
        const int r = 4 * rq;
        *(bf16*)(osc + crow(r, hi) * 256 + (d0 * 32 + r32) * 2) = __float2bfloat16(o[d0][r] * sa[r] + p0 * sb[r]);
        *(bf16*)(osc + crow(r + 1, hi) * 256 + (d0 * 32 + r32) * 2) = __float2bfloat16(o[d0][r + 1] * sa[r + 1] + p1 * sb[r + 1]);
        *(bf16*)(osc + crow(r + 2, hi) * 256 + (d0 * 32 + r32) * 2) = __float2bfloat16(o[d0][r + 2] * sa[r + 2] + p2 * sb[r + 2]);
        *(bf16*)(osc + crow(r + 3, hi) * 256 + (d0 * 32 + r32) * 2) = __float2bfloat16(o[d0][r + 3] * sa[r + 3] + p3 * sb[r + 3]); }
      o_tile_out(osc, Ob, wid, lane);
      if (done_cnt) { asm volatile("s_waitcnt vmcnt(0)" ::: "memory"); if (lane == 0) __hip_atomic_fetch_add(done_cnt, 1u, __ATOMIC_RELAXED, __HIP_MEMORY_SCOPE_AGENT); } }
  }
#undef SLOAD
#undef SWRITE
#undef SWAIT
#undef RESC
}
}

constexpr int NWAVES = 8;
constexpr int DM = 1024, NTOK = 8192, NPR = 4096, FF = 4096, INW = 2048, INE = 2080, QKVW = 1536;
constexpr float EPS = 1e-6f;
constexpr size_t OUT_Y = 0, OUT_S5RE = 8388608, OUT_S5IM = OUT_S5RE + 65536, OUT_GLA = OUT_S5IM + 65536, OUT_NK = OUT_GLA + 1048576, OUT_NV = OUT_NK + 1048576, OUT_END = OUT_NV + 1048576;
constexpr size_t MiB = 1u << 20;
constexpr size_t WS_CTL = 0, CTL_ZERO_BYTES = 128 * 1024;
constexpr size_t WS_ADA = 1 * MiB;
constexpr size_t WS_CV = WS_ADA + 512 * 1024;
constexpr size_t WS_WIN = 2 * MiB, WS_WGLR = 6 * MiB, WS_WGLU = 6 * MiB + 512 * 1024, WS_WOUT = 7 * MiB, WS_W1 = 9 * MiB, WS_W2 = 25 * MiB, WS_WQKV = 41 * MiB, WS_WO = 44 * MiB;
constexpr size_t WS_H = 46 * MiB, WS_Y = 62 * MiB, WS_SCR = 94 * MiB;
constexpr size_t WS_Z = WS_SCR, WS_GD = WS_SCR + 32 * MiB, WS_G = WS_SCR + 48 * MiB, WS_UH = WS_SCR + 56 * MiB, WS_SLOC = WS_SCR + 72 * MiB, WS_SIN = WS_SCR + 104 * MiB, WS_DEC = WS_SCR + 120 * MiB,
                 WS_MIX = WS_SCR + 121 * MiB, WS_EBUF = WS_SCR + 88 * MiB  , WS_WY = WS_SCR + 137 * MiB, WS_WE = WS_SCR + 145 * MiB  , WS_BB = WS_SCR + 153 * MiB, WS_KB = WS_SCR + 154 * MiB, WS_RSW = WS_SCR + 155 * MiB  ;
constexpr size_t WS_ACT = WS_SCR, WS_XBUF = WS_SCR + 72 * MiB;
constexpr size_t WS_QKV = WS_SCR, WS_QN = WS_SCR + 121 * MiB, WS_KP = WS_SCR + 137 * MiB, WS_KS = WS_SCR + 139 * MiB, WS_VP = WS_SCR + 142 * MiB, WS_VS = WS_SCR + 144 * MiB,     WS_OB = WS_SCR + 104 * MiB;
constexpr size_t WS_END = WS_SCR + 156 * MiB;
static_assert(WS_END <= 256 * MiB, "d_ws map");
constexpr int CW_TS = 12800;
constexpr int CW_MLPCNT = 13312;
constexpr int CW_FLAG = 16384;
constexpr int CW_ADACNT = 512;
constexpr int CW_BAR = 1024;
constexpr int CW_BARG0 = 5120, CW_BARG1 = 9216;
constexpr int RING_BYTES = 131072, LDSCTL_OFF = RING_BYTES, MISC_OFF = LDSCTL_OFF + 320, LDS_BYTES = 147456;

#define GAS __attribute__((address_space(1)))
#define LAS __attribute__((address_space(3)))
typedef unsigned short bf16;
typedef unsigned v4u __attribute__((ext_vector_type(4)));
typedef unsigned v2u __attribute__((ext_vector_type(2)));
typedef float f32x4 __attribute__((ext_vector_type(4)));
typedef float f32x16 __attribute__((ext_vector_type(16)));
typedef short bf16x8 __attribute__((ext_vector_type(8)));
typedef short s16x4 __attribute__((ext_vector_type(4)));
typedef GAS unsigned gu32;
#define RLX_AGENT __ATOMIC_RELAXED, __HIP_MEMORY_SCOPE_AGENT
#define LDS_WAIT() asm volatile("s_waitcnt lgkmcnt(0)" ::: "memory")
#define VM_WAIT() asm volatile("s_waitcnt vmcnt(0)" ::: "memory")
__device__ __forceinline__ unsigned f2bf(float f) { unsigned u = __builtin_bit_cast(unsigned, f); return (u + 0x7fffu + ((u >> 16) & 1u)) >> 16; }
__device__ __forceinline__ unsigned pk2(float lo, float hi) { return f2bf(lo) | (f2bf(hi) << 16); }
__device__ __forceinline__ float bf2f(unsigned short b) { return __uint_as_float(((unsigned)b) << 16); }
__device__ __forceinline__ float bflo(unsigned w) { return __uint_as_float(w << 16); }
__device__ __forceinline__ float bfhi(unsigned w) { return __uint_as_float(w & 0xffff0000u); }
__device__ __forceinline__ float wave_sum(float v) {
#pragma unroll
    for (int o = 1; o < 64; o <<= 1) v += __shfl_xor(v, o);
    return v;
}
__device__ __forceinline__ int crow(int r, int hi) { return (r & 3) + 8 * (r >> 2) + 4 * hi; }
__device__ __forceinline__ s16x4 tr_read4(unsigned addr) { s16x4 r; asm volatile("ds_read_b64_tr_b16 %0, %1" : "=&v"(r) : "v"(addr) : "memory"); return r; }

#define XB_TMO      128
#define XB_XCNT(j)  (256  + 64 * (j))
#define XB_XSUB(j)  (1280 + 64 * (j))
#define XB_XGEN(j)  (2304 + 64 * (j))
#define XB_TOP      3328
#define XB_TOPGEN   3392
#define XCD_BAR_WORDS 3456
#define XB_SPIN_CAP (1u << 18)

__device__ __forceinline__ unsigned xb_ld(unsigned* p)              { return __hip_atomic_load(p, __ATOMIC_RELAXED, __HIP_MEMORY_SCOPE_AGENT); }
__device__ __forceinline__ unsigned xb_add(unsigned* p, unsigned v) { return __hip_atomic_fetch_add(p, v, __ATOMIC_RELAXED, __HIP_MEMORY_SCOPE_AGENT); }
__device__ __forceinline__ unsigned xb_xcc_id() { return (unsigned)__builtin_amdgcn_s_getreg((3 << 11) | 20) & 0xFu; }
#define XB_SPIN(cond, bar) do { unsigned _sp = 0; while (cond) { __builtin_amdgcn_s_sleep(1); \
    if ((++_sp & 255u) == 0u) { if (xb_ld(&(bar)[XB_TMO])) break; if (_sp > XB_SPIN_CAP) { atomicAdd(&(bar)[XB_TMO], 1u); break; } } } } while (0)

struct XcdBarrier {
    unsigned* bar; unsigned x;
    volatile LAS unsigned* st;
    unsigned gsize;
};

__device__ __forceinline__ XcdBarrier xcd_barrier_post(unsigned* bar, volatile LAS unsigned* st, unsigned gsize) {
    XcdBarrier b; b.bar = bar; b.x = xb_xcc_id(); b.st = st; b.gsize = gsize;
    if (threadIdx.x == 0) (void)xb_add(&bar[XB_XCNT(b.x)], 1u);
    return b;
}
__device__ __forceinline__ void xcd_barrier_complete(unsigned* bar, unsigned x, unsigned& nloc, unsigned& nx, unsigned gsize) {
    const unsigned G = gsize;
    unsigned sum, cnt, mine, sp = 0u;
    for (;;) {
        sum = 0u; cnt = 0u; mine = 0u;
#pragma unroll
        for (unsigned j = 0; j < 16; ++j) { const unsigned c = xb_ld(&bar[XB_XCNT(j)]); sum += c; cnt += (c > 0u) ? 1u : 0u; mine = (j == x) ? c : mine; }
        if (sum == G) break;
        __builtin_amdgcn_s_sleep(1);
        if ((++sp & 255u) == 0u) { if (xb_ld(&bar[XB_TMO])) break; if (sp > XB_SPIN_CAP) { atomicAdd(&bar[XB_TMO], 1u); break; } }
    }
    nloc = mine > 0u ? mine : 1u; nx = cnt > 0u ? cnt : 1u;
}

__device__ __forceinline__ void xcd_barrier(const XcdBarrier& b) {
    asm volatile("s_waitcnt vmcnt(0)" ::: "memory");
    __syncthreads();
    if (threadIdx.x == 0) {
        unsigned* bar = b.bar;
        __builtin_amdgcn_s_waitcnt(0);
        unsigned nloc = b.st[0], nx = b.st[1];
        if (nloc == 0u) { xcd_barrier_complete(bar, b.x, nloc, nx, b.gsize); b.st[0] = nloc; b.st[1] = nx; }
        const unsigned old = xb_add(&bar[XB_XSUB(b.x)], 1u);
        const unsigned gen = old / nloc;
        if (old + 1u == (gen + 1u) * nloc) {
            __builtin_amdgcn_fence(__ATOMIC_RELEASE, "agent");
            asm volatile("s_waitcnt vmcnt(0)" ::: "memory");
            const unsigned og = xb_add(&bar[XB_TOP], 1u);
            const unsigned tg = og / nx;
            if (og + 1u == (tg + 1u) * nx) xb_add(&bar[XB_TOPGEN], 1u);
            else XB_SPIN(xb_ld(&bar[XB_TOPGEN]) == tg, bar);
            __builtin_amdgcn_fence(__ATOMIC_ACQUIRE, "agent");
            xb_add(&bar[XB_XGEN(b.x)], 1u);
            asm volatile("s_waitcnt vmcnt(0)" ::: "memory");
        } else {
            XB_SPIN(xb_ld(&bar[XB_XGEN(b.x)]) == gen, bar);
            __builtin_amdgcn_fence(__ATOMIC_ACQUIRE, "agent");
            asm volatile("s_waitcnt vmcnt(0)" ::: "memory");
        }
    }
    __syncthreads();
}


struct SplitKOrder { int pm, pn;
    __device__ __forceinline__ bool next(int i, pg8::Unit& u) const { if (i > 0) return false; u.pm = pm; u.pn = pn; return true; }
    __device__ __forceinline__ void a_ready(const pg8::Unit&) const {}
    __device__ __forceinline__ void done(const pg8::Unit&) const {} };
struct PanelOrder { int pm, pn0; gu32* cnt;
    __device__ __forceinline__ bool next(int i, pg8::Unit& u) const { if (i > 1) return false; u.pm = pm; u.pn = pn0 + i; return true; }
    __device__ __forceinline__ void a_ready(const pg8::Unit&) const {}
    __device__ __forceinline__ void done(const pg8::Unit& u) const { asm volatile("s_waitcnt vmcnt(0)" ::: "memory");
        if ((threadIdx.x & 63) == 0) __hip_atomic_fetch_add((unsigned*)(cnt + (pm * 2 + (u.pn >> 3)) * 16), 1u, __ATOMIC_RELAXED, __HIP_MEMORY_SCOPE_AGENT); } };
__device__ __forceinline__ void panel_wait(gu32* cnt, int pm, unsigned target, int tid) {
    if (tid == 0) { unsigned sp = 0;
        while (__hip_atomic_load((unsigned*)(cnt + (pm * 2) * 16), __ATOMIC_RELAXED, __HIP_MEMORY_SCOPE_AGENT) < target || __hip_atomic_load((unsigned*)(cnt + (pm * 2 + 1) * 16), __ATOMIC_RELAXED, __HIP_MEMORY_SCOPE_AGENT) < target) { __builtin_amdgcn_s_sleep(1); if (++sp > (1u << 22)) break; }
        __builtin_amdgcn_fence(__ATOMIC_ACQUIRE, "agent"); asm volatile("s_waitcnt vmcnt(0)" ::: "memory"); }
    __syncthreads(); }
__device__ __forceinline__ void panel_chain(gu32* cnt, int pm, unsigned target, int tid) {
    asm volatile("s_waitcnt vmcnt(0)" ::: "memory"); __syncthreads();
    if (tid == 0) { __hip_atomic_fetch_add((unsigned*)(cnt + pm * 16), 1u, __ATOMIC_RELAXED, __HIP_MEMORY_SCOPE_AGENT); unsigned sp = 0;
        while (__hip_atomic_load((unsigned*)(cnt + pm * 16), __ATOMIC_RELAXED, __HIP_MEMORY_SCOPE_AGENT) < target) { __builtin_amdgcn_s_sleep(1); if (++sp > (1u << 22)) break; }
        __builtin_amdgcn_fence(__ATOMIC_ACQUIRE, "agent"); asm volatile("s_waitcnt vmcnt(0)" ::: "memory"); }
    __syncthreads(); }
__device__ __forceinline__ void qkv_wait(gu32* cnt, int G_, int tid) {
    if (tid == 0) { pg8::Unit u0; pg8::StaticOrder S0; S0.init(NTOK, QKVW, G_, (int)blockIdx.x + (tid >> 10));
        if (S0.next(0, u0)) { gu32* c9 = cnt + u0.pm * 16; unsigned sp = 0;
            while (__hip_atomic_load((unsigned*)c9, __ATOMIC_RELAXED, __HIP_MEMORY_SCOPE_AGENT) < 8u) { __builtin_amdgcn_s_sleep(1); if (++sp > (1u << 22)) break; }
            __builtin_amdgcn_fence(__ATOMIC_ACQUIRE, "agent"); asm volatile("s_waitcnt vmcnt(0)" ::: "memory"); } }
    __syncthreads(); }
__device__ __forceinline__ void z_arrive(gu32* ctl, int G_, int tid) {
    asm volatile("s_waitcnt vmcnt(0)" ::: "memory"); __syncthreads();
    if (tid == 0) { pg8::Unit u0; pg8::StaticOrder S0; S0.init(NTOK, INW, G_, (int)blockIdx.x + (tid >> 10));
        if (S0.next(0, u0)) __hip_atomic_fetch_add((unsigned*)(ctl + u0.pm * 16), 1u, __ATOMIC_RELAXED, __HIP_MEMORY_SCOPE_AGENT);
        __hip_atomic_fetch_add((unsigned*)(ctl + 544), 1u, __ATOMIC_RELAXED, __HIP_MEMORY_SCOPE_AGENT); } }
__device__ __forceinline__ void cnt_wait(gu32* c, unsigned target, int tid) {
    if (tid == 0) { unsigned sp = 0;
        while (__hip_atomic_load((unsigned*)c, __ATOMIC_RELAXED, __HIP_MEMORY_SCOPE_AGENT) < target) { __builtin_amdgcn_s_sleep(1); if (++sp > (1u << 22)) break; }
        __builtin_amdgcn_fence(__ATOMIC_ACQUIRE, "agent"); asm volatile("s_waitcnt vmcnt(0)" ::: "memory"); }
    __syncthreads(); }
__device__ __forceinline__ void s5_g_handoff(gu32* cg, int tid) {
    asm volatile("s_waitcnt vmcnt(0)" ::: "memory"); __syncthreads();
    if (tid == 0) { __hip_atomic_fetch_add((unsigned*)(cg + ((int)blockIdx.x & 1) * 16), 1u, __ATOMIC_RELAXED, __HIP_MEMORY_SCOPE_AGENT);
        pg8::Unit u0; pg8::StaticOrder S0; S0.init(NTOK, 512, 64, (int)blockIdx.x + (tid >> 10));
        if (S0.next(0, u0)) { gu32* c = cg + (u0.pm >> 4) * 16; unsigned sp = 0;
            while (__hip_atomic_load((unsigned*)c, __ATOMIC_RELAXED, __HIP_MEMORY_SCOPE_AGENT) < 32u) { __builtin_amdgcn_s_sleep(1); if (++sp > (1u << 22)) break; } }
        __builtin_amdgcn_fence(__ATOMIC_ACQUIRE, "agent"); asm volatile("s_waitcnt vmcnt(0)" ::: "memory"); }
    __syncthreads(); }
template <bool NEXT, bool BASE_BF16, bool OUT_BF16, bool XCH = true> struct EpiResidSplitT {
    static constexpr bool PERM = true, AFTER_DRAIN = true;
    const void* base_p; const void* base_s; void* out; const float* gate; bf16* xbuf; unsigned* flags; int epoch; int kh;
    bf16* Hn; const float* nw; const float* nsc; float* rsw;
    template <int KH> __device__ __forceinline__ void run(f32x4 (&acc)[2][2][4][2], const pg8::Unit& u, int wr, int wc, int fr, int fq, int tid, LAS unsigned char* lds) const {
        const int tile = u.pm * 4 + u.pn;
        const void* base = u.pm < 16 ? base_p : base_s;
        const int row0 = u.pm * 256 + KH * 128 + wr * 64 + fr; const int col0 = u.pn * 256 + wc * 32 + 8 * fq;
        f32x4 bpre[4][2][2];
#pragma unroll
        for (int m = 0; m < 4; ++m)
#pragma unroll
            for (int bj = 0; bj < 2; ++bj)
#pragma unroll
                for (int n = 0; n < 2; ++n) { const size_t eo = (size_t)(row0 + m * 16) * 1024 + col0 + bj * 128 + n * 4;
                    if (BASE_BF16) { const v2u bw = *(const v2u*)((const bf16*)base + eo); bpre[m][bj][n] = (f32x4){__uint_as_float(bw.x), __uint_as_float(bw.y), 0.f, 0.f}; }
                    else bpre[m][bj][n] = *(const f32x4*)((const float*)base + eo); }
        if (XCH) { bf16* xs = xbuf + ((size_t)(tile * 2 + KH) * 16) * 2048 + tid * 4;
#pragma unroll
        for (int bj = 0; bj < 2; ++bj)
#pragma unroll
            for (int m = 0; m < 4; ++m)
#pragma unroll
                for (int n = 0; n < 2; ++n) { const f32x4 a = acc[1 - KH][bj][m][n]; const unsigned long long w = (unsigned long long)pk2(a[0], a[1]) | ((unsigned long long)pk2(a[2], a[3]) << 32);
                    __hip_atomic_store((unsigned long long*)(xs + ((bj * 4 + m) * 2 + n) * 2048), w, __ATOMIC_RELAXED, __HIP_MEMORY_SCOPE_AGENT); }
        asm volatile("s_waitcnt vmcnt(0)" ::: "memory");
        __syncthreads();
        if (tid == 0) { gu32* fl = (gu32*)flags;
            __hip_atomic_store(fl + (tile * 2 + KH) * 64, (unsigned)epoch, __ATOMIC_RELAXED, __HIP_MEMORY_SCOPE_AGENT);
            unsigned sp = 0; while (__hip_atomic_load(fl + (tile * 2 + (1 - KH)) * 64, __ATOMIC_RELAXED, __HIP_MEMORY_SCOPE_AGENT) < (unsigned)epoch) { __builtin_amdgcn_s_sleep(1); if (++sp > (1u << 22)) break; } }
        __syncthreads(); }
        const bf16* xr = xbuf + ((size_t)(tile * 2 + (1 - KH)) * 16) * 2048 + tid * 4;
        const int cond = u.pm < 16 ? 0 : 1 + ((u.pm - 16) >> 2);
        const float* gp = gate + cond * 6144;
        f32x4 gv[2][2];
#pragma unroll
        for (int bj = 0; bj < 2; ++bj)
#pragma unroll
            for (int n = 0; n < 2; ++n) gv[bj][n] = *(const f32x4*)(gp + col0 + bj * 128 + n * 4);
        constexpr int MB = 2;
#pragma unroll
        for (int mp = 0; mp < 4 / MB; ++mp) {
        unsigned long long pwv[4][2][2];
        if (XCH) {
#pragma unroll
            for (int m = MB * mp; m < MB * mp + MB; ++m)
#pragma unroll
                for (int bj = 0; bj < 2; ++bj)
#pragma unroll
                    for (int n = 0; n < 2; ++n) pwv[m][bj][n] = __hip_atomic_load((const unsigned long long*)(xr + ((bj * 4 + m) * 2 + n) * 2048), __ATOMIC_RELAXED, __HIP_MEMORY_SCOPE_AGENT); }
#pragma unroll
        for (int m = MB * mp; m < MB * mp + MB; ++m) { const unsigned off = (unsigned)((row0 + m * 16) * 1024 + col0);
#pragma unroll
            for (int bj = 0; bj < 2; ++bj) { f32x4 yv[2];
#pragma unroll
                for (int n = 0; n < 2; ++n) { f32x4 p = {0.f, 0.f, 0.f, 0.f}; if (XCH) { const unsigned long long pw = pwv[m][bj][n]; const unsigned plo = (unsigned)pw, phi = (unsigned)(pw >> 32); p = (f32x4){bflo(plo), bfhi(plo), bflo(phi), bfhi(phi)}; }
                    f32x4 b; if (BASE_BF16) { const unsigned b0 = __float_as_uint(bpre[m][bj][n][0]), b1 = __float_as_uint(bpre[m][bj][n][1]); b = (f32x4){bflo(b0), bfhi(b0), bflo(b1), bfhi(b1)}; } else b = bpre[m][bj][n];
                    yv[n] = b + gv[bj][n] * (acc[KH][bj][m][n] + p);
                    if (NEXT) acc[KH][bj][m][n] = yv[n]; }
                if (OUT_BF16) { v4u ow; ow.x = pk2(yv[0][0], yv[0][1]); ow.y = pk2(yv[0][2], yv[0][3]); ow.z = pk2(yv[1][0], yv[1][1]); ow.w = pk2(yv[1][2], yv[1][3]);
                    __builtin_amdgcn_raw_buffer_store_b128(__builtin_bit_cast(pg8::u32x4, ow), __builtin_amdgcn_make_buffer_rsrc((void*)out, (short)0, 8192 * 1024 * 2, 0x00020000), (off + bj * 128) * 2u, 0, 16); }
                else { float* op = (float*)out + off + bj * 128; *(f32x4*)op = yv[0]; *(f32x4*)(op + 4) = yv[1]; } }
            } }
        if (NEXT) {
            asm volatile("" ::: "memory");
            int row0b = row0, col0b = col0; asm volatile("" : "+v"(row0b), "+v"(col0b));
            f32x4 av[2][2];
#pragma unroll
            for (int bj = 0; bj < 2; ++bj)
#pragma unroll
                for (int n = 0; n < 2; ++n) av[bj][n] = *(const f32x4*)(nw + col0b + bj * 128 + n * 4) * (*(const f32x4*)(nsc + cond * 6144 + col0b + bj * 128 + n * 4) + 1.0f);
#pragma unroll
            for (int m = 0; m < 4; ++m) { const int row = row0b + m * 16; const unsigned off = (unsigned)(row * 1024 + col0b); float ss = 0.f;
#pragma unroll
                for (int bj = 0; bj < 2; ++bj) { const f32x4 y0 = acc[KH][bj][m][0], y1 = acc[KH][bj][m][1];
                    ss += ((y0[0] * y0[0] + y0[1] * y0[1]) + (y0[2] * y0[2] + y0[3] * y0[3])) + ((y1[0] * y1[0] + y1[1] * y1[1]) + (y1[2] * y1[2] + y1[3] * y1[3]));
                    const f32x4 h0 = y0 * av[bj][0], h1 = y1 * av[bj][1];
                    v4u w; w.x = pk2(h0[0], h0[1]); w.y = pk2(h0[2], h0[3]); w.z = pk2(h1[0], h1[1]); w.w = pk2(h1[2], h1[3]);
                    __builtin_amdgcn_raw_buffer_store_b128(__builtin_bit_cast(pg8::u32x4, w), __builtin_amdgcn_make_buffer_rsrc((void*)Hn, (short)0, 8192 * 1024 * 2, 0x00020000), (off + bj * 128) * 2u, 0, 16); }
                ss += __shfl_xor(ss, 16); ss += __shfl_xor(ss, 32); if (fq == 0) ((LAS float*)lds)[(wr * 64 + m * 16 + fr) * 4 + wc] = ss; }
            __syncthreads();
            if (tid < 128) { const f32x4 p4 = *(const LAS f32x4*)((LAS float*)lds + tid * 4); __hip_atomic_store(rsw + (size_t)(u.pm * 256 + KH * 128 + tid) * 4 + u.pn, (p4[0] + p4[1]) + (p4[2] + p4[3]), __ATOMIC_RELAXED, __HIP_MEMORY_SCOPE_AGENT); }
        }
    }
    __device__ __forceinline__ void fused(f32x4 (&acc)[2][2][4][2], const pg8::Unit& u, int wr, int wc, int fr, int fq, LAS unsigned char* lds, int wid, int lane) const {
        if (kh == 0) run<0>(acc, u, wr, wc, fr, fq, wid * 64 + lane, lds); else run<1>(acc, u, wr, wc, fr, fq, wid * 64 + lane, lds);
    }
};

struct Args { const float* in[34]; float* out; unsigned char* ws; int ph_lo, ph_hi; };
typedef const __attribute__((address_space(4))) Args CArgs;
__device__ __forceinline__ CArgs* kargs() { CArgs* p = (CArgs*)__builtin_amdgcn_kernarg_segment_ptr(); asm volatile("" : "+s"(p)); return p; }
#define KA (*kargs())
#ifndef TS_ON
#define TS_ON 0
#endif
#ifndef TS_A
#define TS_A 0
#endif
#ifndef TS_B
#define TS_B 1
#endif
#ifndef TS_CAL
#define TS_CAL 0
#endif
#if TS_ON
#define STAMP(i) do { if (blockIdx.x == 0 && threadIdx.x == 0) ((unsigned long long*)((gu32*)(ws + WS_CTL) + CW_TS))[i] = __builtin_amdgcn_s_memrealtime(); } while (0)
#define STAMPB(i, blk) do { if (blockIdx.x == (blk) && threadIdx.x == 0) { asm volatile("s_waitcnt vmcnt(0)" ::: "memory"); ((unsigned long long*)((gu32*)(ws + WS_CTL) + CW_TS))[i] = __builtin_amdgcn_s_memrealtime(); } } while (0)
#else
#define STAMP(i) do {} while (0)
#define STAMPB(i, blk) do {} while (0)
#endif
__device__ __forceinline__ int tid_opaque() { int t = threadIdx.x; asm volatile("" : "+v"(t)); return t; }

__device__ __forceinline__ void p0_transpose_item(const float* W, int ld, int K, bf16* WT, int nblk, LAS float* scr, int item, int lane) {
    const int kb = item / nblk, nb = item % nblk, k0 = 64 * kb, n0 = 32 * nb;
#pragma unroll
    for (int i = 0; i < 8; ++i) { const int kk = 8 * i + (lane >> 3), c4 = 4 * (lane & 7); const f32x4 v = *(const f32x4*)(W + (size_t)(k0 + kk) * ld + n0 + c4);
        scr[kk * 33 + c4] = v[0]; scr[kk * 33 + c4 + 1] = v[1]; scr[kk * 33 + c4 + 2] = v[2]; scr[kk * 33 + c4 + 3] = v[3]; }
    LDS_WAIT(); asm volatile("" ::: "memory");
    const int c = lane & 7;
#pragma unroll
    for (int j = 0; j < 4; ++j) { const int n = (lane >> 3) + 8 * j; const LAS float* s = scr + (8 * c) * 33 + n;
        v4u o; o.x = pk2(s[0 * 33], s[1 * 33]); o.y = pk2(s[2 * 33], s[3 * 33]); o.z = pk2(s[4 * 33], s[5 * 33]); o.w = pk2(s[6 * 33], s[7 * 33]);
        *(GAS v4u*)(WT + (size_t)(n0 + n) * K + k0 + 8 * c) = o; }
    LDS_WAIT(); asm volatile("" ::: "memory");
}
__device__ __forceinline__ void ada_block(CArgs& A, LAS unsigned char* lds, int ab, int tid, int lane, int wave) {
    unsigned char* ws = A.ws;
    LAS float* sc = (LAS float*)(lds);
    LAS float* red = (LAS float*)(lds + 20480);
    for (int i = tid; i < 5 * 1024; i += 512) { const int c = i >> 10, k = i & 1023; const float x = c == 0 ? A.in[8][k] : A.in[7][(c - 1) * 1024 + k]; sc[i] = x / (1.f + __expf(-x)); }
    __syncthreads();
    const int layer = ab >> 7, n0 = (ab & 127) * 48;
    const float* W = A.in[11] + (size_t)layer * 1024 * 6144 + n0;
    const int kq = lane / 12, nq = lane % 12;
    f32x4 acc[5];
#pragma unroll
    for (int c = 0; c < 5; ++c) acc[c] = (f32x4){0.f, 0.f, 0.f, 0.f};
    if (kq < 4) {
#pragma unroll 8
        for (int i = 0; i < 32; ++i) { const int k = 128 * wave + 4 * i + kq; const f32x4 w = *(const f32x4*)(W + (size_t)k * 6144 + 4 * nq);
#pragma unroll
            for (int c = 0; c < 5; ++c) acc[c] += w * sc[c * 1024 + k]; }
#pragma unroll
        for (int c = 0; c < 5; ++c) *(LAS f32x4*)(red + ((wave * 4 + kq) * 5 + c) * 48 + 4 * nq) = acc[c];
    }
    __syncthreads();
    if (tid < 240) { const int c = tid / 48, n = tid % 48; float s = 0.f;
#pragma unroll 8
        for (int p = 0; p < 32; ++p) s += red[(p * 5 + c) * 48 + n];
        ((float*)(ws + WS_ADA))[(size_t)(layer * 5 + c) * 6144 + n0 + n] = s + A.in[12][layer * 6144 + n0 + n]; }
    __syncthreads();
}
__device__ __forceinline__ void ada_block32(CArgs& A, LAS unsigned char* lds, int ab, int tid, int lane, int wave) {
    unsigned char* ws = A.ws;
    LAS float* sc = (LAS float*)(lds);
    LAS float* red = (LAS float*)(lds + 20480);
    for (int i = tid; i < 5 * 1024; i += 512) { const int c = i >> 10, k = i & 1023; const float x = c == 0 ? A.in[8][k] : A.in[7][(c - 1) * 1024 + k]; sc[i] = x / (1.f + __expf(-x)); }
    __syncthreads();
    const int n0 = ab * 32, kq = lane >> 3, nq = lane & 7;
    const float* W = A.in[11] + n0 + 4 * nq;
    f32x4 acc[5];
#pragma unroll
    for (int c = 0; c < 5; ++c) acc[c] = (f32x4){0.f, 0.f, 0.f, 0.f};
#pragma unroll 8
    for (int i = 0; i < 16; ++i) { const int k = 128 * wave + 8 * i + kq; const f32x4 w = *(const f32x4*)(W + (size_t)k * 6144);
#pragma unroll
        for (int c = 0; c < 5; ++c) acc[c] += w * sc[c * 1024 + k]; }
#pragma unroll
    for (int c = 0; c < 5; ++c) *(LAS f32x4*)(red + ((wave * 8 + kq) * 5 + c) * 32 + 4 * nq) = acc[c];
    __syncthreads();
    if (tid < 160) { const int c = tid >> 5, n = tid & 31; float s_ = 0.f;
#pragma unroll 8
        for (int p = 0; p < 64; ++p) s_ += red[(p * 5 + c) * 32 + n];
        __hip_atomic_store((float*)(ws + WS_ADA) + (size_t)c * 6144 + n0 + n, s_ + A.in[12][n0 + n], __ATOMIC_RELAXED, __HIP_MEMORY_SCOPE_AGENT); }
    asm volatile("s_waitcnt vmcnt(0)" ::: "memory");
    __syncthreads();
    if (tid == 0) __hip_atomic_fetch_add((unsigned*)((gu32*)(ws + WS_CTL) + CW_ADACNT), 1u, __ATOMIC_RELAXED, __HIP_MEMORY_SCOPE_AGENT);
}
__device__ __forceinline__ void ada_wait(CArgs& A, int tid) {
    if (tid == 0) { gu32* cnt = (gu32*)(A.ws + WS_CTL) + CW_ADACNT; unsigned sp = 0;
        while (__hip_atomic_load(cnt, __ATOMIC_RELAXED, __HIP_MEMORY_SCOPE_AGENT) < 192u || __hip_atomic_load(cnt + 16, __ATOMIC_RELAXED, __HIP_MEMORY_SCOPE_AGENT) < 2u) { __builtin_amdgcn_s_sleep(1); if (++sp > (1u << 22)) break; }
        __builtin_amdgcn_fence(__ATOMIC_ACQUIRE, "agent"); asm volatile("s_waitcnt vmcnt(0)" ::: "memory"); }
    __syncthreads();
}
constexpr int T_IN = 16 * 65, T_OUT = 16 * 32, T_GLU = 8 * 16, T_M1 = 16 * 128, T_M2 = 64 * 32, T_QKV = 16 * 48, T_WO = 16 * 32;
constexpr int T_EARLY = T_IN + T_OUT + T_GLU, T_ALL = T_EARLY + 2 * T_M1 + 2 * T_M2 + T_QKV + T_WO;
__device__ __forceinline__ void transpose_items(CArgs& A, LAS unsigned char* lds, int it0, int it1, int gw, int ngw, int lane, int wave) {
    unsigned char* ws = A.ws;
    LAS float* scr = (LAS float*)(lds + wave * 16384);
    for (int it = it0 + gw; it < it1; it += ngw) {
        int r = it;
        if (r < T_IN) { const int kb = r / 65, nb = r % 65;
            if (nb < 64) p0_transpose_item(A.in[15], INE, 1024, (bf16*)(ws + WS_WIN), 64, scr, kb * 64 + nb, lane);
            else {   }
            continue; } r -= T_IN;
        if (r < T_OUT) { p0_transpose_item(A.in[16], 1024, 1024, (bf16*)(ws + WS_WOUT), 32, scr, r, lane); continue; } r -= T_OUT;
        if (r < T_GLU) { p0_transpose_item(A.in[25], 512, 512, (bf16*)(ws + WS_WGLU), 16, scr, r, lane); continue; } r -= T_GLU;
        if (r < 2 * T_M1) { const int l = r / T_M1; p0_transpose_item(A.in[13] + (size_t)l * 1024 * 4096, 4096, 1024, (bf16*)(ws + WS_W1) + (size_t)l * 4096 * 1024, 128, scr, r % T_M1, lane); continue; } r -= 2 * T_M1;
        if (r < 2 * T_M2) { const int l = r / T_M2; p0_transpose_item(A.in[14] + (size_t)l * 4096 * 1024, 1024, 4096, (bf16*)(ws + WS_W2) + (size_t)l * 1024 * 4096, 32, scr, r % T_M2, lane); continue; } r -= 2 * T_M2;
        if (r < T_QKV) { p0_transpose_item(A.in[30], 1536, 1024, (bf16*)(ws + WS_WQKV), 48, scr, r, lane); continue; } r -= T_QKV;
        p0_transpose_item(A.in[31], 1024, 1024, (bf16*)(ws + WS_WO), 32, scr, r, lane);
    }
}

template <bool GLR>
__device__ __forceinline__ void norm_phase(CArgs& A, LAS unsigned char* lds, const float* src_p, const float* src_s, const float* g, const float* ada, int ch_shift, int ch_scale,
                                           int tid, int lane, int wave) {
    unsigned char* ws = A.ws;
    bf16* H = (bf16*)(ws + WS_H);
    for (int blk = blockIdx.x; blk < NTOK / 32; blk += gridDim.x) {
        const int r0 = blk * 32; const int cond = r0 < NPR ? 0 : 1 + ((r0 - NPR) >> 10);
        const float* src = r0 < NPR ? src_p : src_s;
        const float* adc = ada + cond * 6144;
        f32x4 ga[4], gb[4];
#pragma unroll
        for (int j = 0; j < 4; ++j) { const int col = 8 * lane + 512 * (j >> 1) + 4 * (j & 1); const f32x4 gg = *(const f32x4*)(g + col), s1 = *(const f32x4*)(adc + ch_scale * 1024 + col); ga[j] = gg * (s1 + 1.0f); gb[j] = *(const f32x4*)(adc + ch_shift * 1024 + col); }
        const __amdgpu_buffer_rsrc_t hrs = __builtin_amdgcn_make_buffer_rsrc((void*)H, (short)0, 8192 * 1024 * 2, 0x00020000);
        f32x4 vv[4][4];
#pragma unroll
        for (int i = 0; i < 4; ++i) { const GAS f32x4* xr = (const GAS f32x4*)(src + (size_t)(r0 + wave * 4 + i) * 1024) + 2 * lane;
#pragma unroll
            for (int j = 0; j < 4; ++j) vv[i][j] = xr[128 * (j >> 1) + (j & 1)]; }
        asm volatile("" ::: "memory");
#pragma unroll
        for (int i = 0; i < 4; ++i) { const int row = r0 + wave * 4 + i;
            f32x4 v[4]; float s = 0.f;
#pragma unroll
            for (int j = 0; j < 4; ++j) { v[j] = vv[i][j]; s += (v[j].x * v[j].x + v[j].y * v[j].y) + (v[j].z * v[j].z + v[j].w * v[j].w); }
            const float rstd = __builtin_amdgcn_rsqf(wave_sum(s) * (1.f / 1024.f) + EPS);
#pragma unroll
            for (int c = 0; c < 2; ++c) { const f32x4 h0 = v[2 * c] * rstd * ga[2 * c] + gb[2 * c], h1 = v[2 * c + 1] * rstd * ga[2 * c + 1] + gb[2 * c + 1];
                v4u w; w.x = pk2(h0.x, h0.y); w.y = pk2(h0.z, h0.w); w.z = pk2(h1.x, h1.y); w.w = pk2(h1.z, h1.w);
                __builtin_amdgcn_raw_buffer_store_b128(__builtin_bit_cast(pg8::u32x4, w), hrs, (unsigned)((row * 1024 + 8 * lane + 512 * c) * 2), 0, 16);
                if (GLR) *(LAS v4u*)(lds + (wave * 4 + i) * 2064 + (8 * lane + 512 * c) * 2) = w; }
        }
        if (GLR) {
            __syncthreads();
            const bf16* WG = (const bf16*)(ws + WS_WGLR);
            const int r32 = lane & 31, hi = lane >> 5;
            f32x16 acc = {};
#pragma unroll
            for (int ks = 0; ks < 8; ++ks) { const int k = wave * 128 + ks * 16 + hi * 8;
                const bf16x8 a = *(const LAS bf16x8*)(lds + r32 * 2064 + k * 2);
                const bf16x8 b = *(const bf16x8*)(WG + (size_t)r32 * 1024 + k);
                acc = __builtin_amdgcn_mfma_f32_32x32x16_bf16(a, b, acc, 0, 0, 0); }
            LAS float* red = (LAS float*)(lds + 69632);
#pragma unroll
            for (int r = 0; r < 16; ++r) red[(wave * 32 + crow(r, hi)) * 32 + r32] = acc[r];
            __syncthreads();
            LAS float* glrs = (LAS float*)(lds + 69632 + 32768);
#pragma unroll
            for (int e = 0; e < 2; ++e) { const int idx = tid + 512 * e; float s = 0.f;
#pragma unroll
                for (int w = 0; w < 8; ++w) s += red[w * 1024 + idx];
                glrs[idx] = s; }
            __syncthreads();
            { const int dcol = tid >> 8, hk = tid & 255; float wg2[16];
#pragma unroll
                for (int r = 0; r < 16; ++r) wg2[r] = A.in[27][(size_t)(dcol * 16 + r) * 256 + hk];
                const float bg = A.in[28][dcol * 256 + hk];
                bf16* GDo = (bf16*)(ws + WS_GD);
                for (int row = 0; row < 32; ++row) { float x = bg;
#pragma unroll
                    for (int r = 0; r < 16; ++r) x = fmaf(glrs[row * 32 + 16 * dcol + r], wg2[r], x);
                    const float ls = fminf(x, 0.f) - __logf(1.f + __expf(-fabsf(x)));
                    GDo[(size_t)(r0 + row) * 512 + tid] = (bf16)f2bf(ls * (1.f / 16.f)); } }
            __syncthreads();
        }
    }
}

__device__ __forceinline__ float gelu_tanh(float y) { const float z = 0.7978845608028654f * (y + 0.044715f * y * y * y); const float e = __expf(2.f * z); const float t = 1.f - 2.f * __builtin_amdgcn_rcpf(e + 1.f); return 0.5f * y * (1.f + t); }
#define S5_PW(lds) ((LAS float*)(lds))
#define S5_BB(lds) (S5_PW(lds) + 2 * 17 * 64 * 2)
#define BBI(d, p, c) ((((d) * 64 + (p)) * 17 + (c)) * 2)
#define S5_CL(lds) (S5_BB(lds) + 2 * 64 * 17 * 2)
#define CLI(c, p) (((p) * 17 + (c)) * 2)
#define S5_KL(lds) (S5_CL(lds) + 64 * 17 * 2)
#define S5_DL(lds) (S5_KL(lds) + 2 * 16 * 16 * 16)
__device__ __forceinline__ void s5_small(CArgs& A, LAS unsigned char* lds, int g, bool write_bb, int tid) {
    unsigned char* ws = A.ws;
    LAS float* Pw = S5_PW(lds); LAS float* BBl = S5_BB(lds); LAS float* Cl = S5_CL(lds);
    if (tid < 128) { const int d = tid >> 6, p = tid & 63;
        const float lre = A.in[17][(d * 32 + g) * 64 + p], lim = A.in[18][(d * 32 + g) * 64 + p];
        const float dt = __expf(A.in[19][d * 32 + g]);
        const float a_ = lre * dt, th = lim * dt;
        const float sn = __sinf(th), cs = __cosf(th);
        const float ea = __expf(a_);
        const float lb_re = ea * cs, lb_im = ea * sn;
        const float sh = __sinf(0.5f * th);
        const float em1 = a_ * (1.f + a_ * (0.5f + a_ * (0.16666667f + a_ * (0.041666668f + a_ * 0.0083333338f))));
        const float nr = em1 * cs - 2.f * sh * sh, ni = ea * sn;
        const float den = 1.f / (lre * lre + lim * lim);
        const float cf_re = (nr * lre + ni * lim) * den, cf_im = (ni * lre - nr * lim) * den;
        float pr = 1.f, pi = 0.f;
        for (int t = 0; t <= 16; ++t) { Pw[((d * 17 + t) * 64 + p) * 2] = pr; Pw[((d * 17 + t) * 64 + p) * 2 + 1] = pi; const float n0 = pr * lb_re - pi * lb_im, n1 = pr * lb_im + pi * lb_re; pr = n0; pi = n1; }
        float* BBg = (float*)(ws + WS_BB) + (size_t)(g * 2 + d) * 2048;
        f32x4 br4[4], bi4[4];
#pragma unroll
        for (int k = 0; k < 4; ++k) { br4[k] = *(const f32x4*)(A.in[20] + (size_t)(g * 64 + p) * 16 + 4 * k); bi4[k] = *(const f32x4*)(A.in[21] + (size_t)(g * 64 + p) * 16 + 4 * k); }
#pragma unroll
        for (int c = 0; c < 16; ++c) { const float br = br4[c >> 2][c & 3], bi = bi4[c >> 2][c & 3];
            const float vr = cf_re * br - cf_im * bi, vi = cf_re * bi + cf_im * br;
            BBl[BBI(d, p, c)] = vr; BBl[BBI(d, p, c) + 1] = vi; if (write_bb) { BBg[p * 16 + c] = vr; BBg[1024 + p * 16 + c] = vi; } }
    } else { if (tid < 144) S5_DL(lds)[tid - 128] = A.in[24][g * 16 + tid - 128];
        for (int i = tid - 128; i < 1024; i += 384) { Cl[CLI(i >> 6, i & 63)] = A.in[22][(size_t)g * 1024 + i]; Cl[CLI(i >> 6, i & 63) + 1] = A.in[23][(size_t)g * 1024 + i]; } }
    __syncthreads();
}
__device__ __forceinline__ void s5_k_mfma(LAS unsigned char* lds, int lane, int wave) {
    LAS float* Pw = S5_PW(lds); LAS float* BBl = S5_BB(lds); LAS float* Cl = S5_CL(lds); LAS float* Kl = S5_KL(lds);
    const int rc = lane & 15, q = lane >> 4, d = wave >> 2;
    bf16x8 bfr[4];
#pragma unroll
    for (int ks = 0; ks < 4; ++ks) { unsigned w[4];
#pragma unroll
        for (int j = 0; j < 8; j += 2) { const int k0 = 32 * ks + 8 * q + j, p0 = k0 & 63, im = k0 >> 6;
            w[j >> 1] = pk2(BBl[BBI(d, p0, rc) + im], BBl[BBI(d, p0 + 1, rc) + im]); }
        bfr[ks] = __builtin_bit_cast(bf16x8, (v4u){w[0], w[1], w[2], w[3]}); }
#pragma unroll
    for (int t4 = 0; t4 < 4; ++t4) { const int tau = (wave & 3) * 4 + t4; f32x4 acc = {0.f, 0.f, 0.f, 0.f};
#pragma unroll
        for (int ks = 0; ks < 4; ++ks) { unsigned w[4];
#pragma unroll
            for (int j = 0; j < 8; j += 2) { float v[2];
#pragma unroll
                for (int e = 0; e < 2; ++e) { const int k = 32 * ks + 8 * q + j + e, p = k & 63; const float cr = Cl[CLI(rc, p)], ci = Cl[CLI(rc, p) + 1], pr = Pw[((d * 17 + tau) * 64 + p) * 2], pi = Pw[((d * 17 + tau) * 64 + p) * 2 + 1];
                    v[e] = k < 64 ? (cr * pr - ci * pi) : -(cr * pi + ci * pr); }
                w[j >> 1] = pk2(v[0], v[1]); }
            acc = __builtin_amdgcn_mfma_f32_16x16x32_bf16(__builtin_bit_cast(bf16x8, (v4u){w[0], w[1], w[2], w[3]}), bfr[ks], acc, 0, 0, 0); }
#pragma unroll
        for (int r = 0; r < 4; ++r) Kl[((d * 16 + tau) * 16 + 4 * q + r) * 16 + rc] = acc[r]; }
    __syncthreads();
}
__device__ __forceinline__ void s5_expand(CArgs& A, LAS unsigned char* lds, int g, int q, int tid) {
    unsigned char* ws = A.ws;
    LAS float* Pw = S5_PW(lds); LAS float* BBl = S5_BB(lds); LAS float* Cl = S5_CL(lds); LAS float* Kl = S5_KL(lds);
    unsigned* WYg = (unsigned*)((bf16*)(ws + WS_WY) + (size_t)g * 256 * 512);
    typedef float lf2 __attribute__((ext_vector_type(2)));
    for (int i = q * 32 * 256 + tid; i < (q + 1) * 32 * 256; i += 512) { const int n = i >> 8, k0 = (i & 255) * 2; const int t = n >> 4, c = n & 15; lf2 v;
        if (k0 < 256) { const int s_ = k0 >> 4, c2 = k0 & 15;
            if (s_ < t) v = *(const LAS lf2*)(Kl + ((0 * 16 + (t - s_)) * 16 + c) * 16 + c2);
            else if (s_ > t) v = *(const LAS lf2*)(Kl + ((1 * 16 + (s_ - t)) * 16 + c) * 16 + c2);
            else { v = *(const LAS lf2*)(Kl + ((0 * 16 + 0) * 16 + c) * 16 + c2) + *(const LAS lf2*)(Kl + ((1 * 16 + 0) * 16 + c) * 16 + c2); const float dd = S5_DL(lds)[c]; if (c == c2) v[0] += dd; if (c == c2 + 1) v[1] += dd; }
        } else { const int kk = k0 - 256, d = kk >> 7, im = (kk >> 6) & 1, p = kk & 63; const int tau = d == 0 ? t + 1 : 16 - t;
            const lf2 c0 = *(const LAS lf2*)(Cl + CLI(c, p)), c1 = *(const LAS lf2*)(Cl + CLI(c, p + 1));
            const lf2 p0 = *(const LAS lf2*)(Pw + ((d * 17 + tau) * 64 + p) * 2), p1 = *(const LAS lf2*)(Pw + ((d * 17 + tau) * 64 + p + 1) * 2);
            v[0] = im ? -(c0[0] * p0[1] + c0[1] * p0[0]) : (c0[0] * p0[0] - c0[1] * p0[1]);
            v[1] = im ? -(c1[0] * p1[1] + c1[1] * p1[0]) : (c1[0] * p1[0] - c1[1] * p1[1]); }
        WYg[i] = pk2(v[0], v[1]); }
    unsigned* WEg = (unsigned*)((bf16*)(ws + WS_WE) + (size_t)g * 256 * 512);
    for (int i = q * 32 * 128 + tid; i < (q + 1) * 32 * 128; i += 512) { const int n = i >> 7, k0 = (i & 127) * 2; const int d = n >> 7, im = (n >> 6) & 1, p = n & 63;
        const int s_ = k0 >> 4, c2 = k0 & 15; const int tau = d == 0 ? 15 - s_ : s_;
        const lf2 pw = *(const LAS lf2*)(Pw + ((d * 17 + tau) * 64 + p) * 2), b0 = *(const LAS lf2*)(BBl + BBI(d, p, c2)), b1 = *(const LAS lf2*)(BBl + BBI(d, p, c2 + 1));
        const float v0 = im ? (pw[0] * b0[1] + pw[1] * b0[0]) : (pw[0] * b0[0] - pw[1] * b0[1]), v1 = im ? (pw[0] * b1[1] + pw[1] * b1[0]) : (pw[0] * b1[0] - pw[1] * b1[1]);
        WEg[n * 256 + (i & 127)] = pk2(v0, v1); }
    __syncthreads();
}
__device__ __forceinline__ void s5_recur(CArgs& A, LAS unsigned char* lds, int g, int mt, int tid) {
    unsigned char* ws = A.ws;
    const bf16* EB = (const bf16*)(ws + WS_EBUF) + (size_t)(g * 512 + mt * 256) * 256;
    bf16* UHg = (bf16*)(ws + WS_UH) + (size_t)(g * 512 + mt * 256) * 512;
    LAS unsigned short* El = (LAS unsigned short*)lds;
    { v2u ew[32];
#pragma unroll
      for (int it = 0; it < 32; ++it) ew[it] = *(const v2u*)(EB + (size_t)(tid + 512 * it) * 4);
#pragma unroll
      for (int it = 0; it < 32; ++it) *(LAS v2u*)(El + (size_t)(tid + 512 * it) * 4) = ew[it]; }
    __syncthreads();
    { const int p = tid & 63, w = tid >> 6;
        float prd[2], pid[2];
#pragma unroll
        for (int d = 0; d < 2; ++d) { const float lre = A.in[17][(d * 32 + g) * 64 + p], lim = A.in[18][(d * 32 + g) * 64 + p]; const float dt = __expf(A.in[19][d * 32 + g]);
            const float sn = __sinf(lim * dt), cs = __cosf(lim * dt), ea = __expf(lre * dt); float pr = ea * cs, pi = ea * sn;
#pragma unroll
            for (int s_ = 0; s_ < 4; ++s_) { const float n0 = pr * pr - pi * pi, n1 = 2.f * pr * pi; pr = n0; pi = n1; }
            prd[d] = pr; pid[d] = pi; }
        if (mt == 1) { const int d = w >> 2, b = w & 3; const float pr = d ? prd[1] : prd[0], pi = d ? pid[1] : pid[0];
            float hr = A.in[2][(size_t)((b * 2 + d) * 32 + g) * 64 + p], hi_ = A.in[3][(size_t)((b * 2 + d) * 32 + g) * 64 + p];
#pragma unroll 8
            for (int st = 0; st < 64; ++st) { const int r = b * 64 + (d == 0 ? st : 63 - st);
                bf16* up = UHg + (size_t)r * 512 + 256 + d * 128 + p; up[0] = (bf16)f2bf(hr); up[64] = (bf16)f2bf(hi_);
                const float er = bf2f(El[r * 256 + d * 128 + p]), ei = bf2f(El[r * 256 + d * 128 + 64 + p]);
                const float n0 = pr * hr - pi * hi_ + er, n1 = pr * hi_ + pi * hr + ei; hr = n0; hi_ = n1; }
        } else {
#pragma unroll
            for (int d = 0; d < 2; ++d) { const float* BBg = (const float*)(ws + WS_BB) + (size_t)(g * 2 + d) * 2048 + p * 16; f32x4 br[4], bi[4];
#pragma unroll
                for (int q = 0; q < 4; ++q) { br[q] = *(const f32x4*)(BBg + 4 * q); bi[q] = *(const f32x4*)(BBg + 1024 + 4 * q); }
#pragma unroll
                for (int bs = 0; bs < 2; ++bs) { const int b = w + 8 * bs; const int r = b * 16 + (d == 0 ? 0 : 15), s_ = d == 0 ? 0 : 15;
                    const v4u u0 = *(const v4u*)(UHg + (size_t)r * 512 + s_ * 16), u1 = *(const v4u*)(UHg + (size_t)r * 512 + s_ * 16 + 8);
                    float fr_ = 0.f, fi_ = 0.f;
#pragma unroll
                    for (int e = 0; e < 4; ++e) { const float ua = bflo(u0[e]), ub = bfhi(u0[e]), uc = bflo(u1[e]), ud = bfhi(u1[e]);
                        fr_ += br[e >> 1][(2 * e) & 3] * ua + br[e >> 1][(2 * e + 1) & 3] * ub + br[2 + (e >> 1)][(2 * e) & 3] * uc + br[2 + (e >> 1)][(2 * e + 1) & 3] * ud;
                        fi_ += bi[e >> 1][(2 * e) & 3] * ua + bi[e >> 1][(2 * e + 1) & 3] * ub + bi[2 + (e >> 1)][(2 * e) & 3] * uc + bi[2 + (e >> 1)][(2 * e + 1) & 3] * ud; }
                    A.out[OUT_S5RE + (size_t)((b * 2 + d) * 32 + g) * 64 + p] = fr_; A.out[OUT_S5IM + (size_t)((b * 2 + d) * 32 + g) * 64 + p] = fi_; } }
            float hr[4] = {0.f, 0.f, 0.f, 0.f}, hi_[4] = {0.f, 0.f, 0.f, 0.f};
#pragma unroll 4
            for (int st = 0; st < 16; ++st) {
#pragma unroll
                for (int c4 = 0; c4 < 4; ++c4) { const int d = c4 >> 1, b = w + 8 * (c4 & 1); const int r = b * 16 + (d == 0 ? st : 15 - st);
                    bf16* up = UHg + (size_t)r * 512 + 256 + d * 128 + p; up[0] = (bf16)f2bf(hr[c4]); up[64] = (bf16)f2bf(hi_[c4]);
                    const float er = bf2f(El[r * 256 + d * 128 + p]), ei = bf2f(El[r * 256 + d * 128 + 64 + p]);
                    const float n0 = prd[d] * hr[c4] - pid[d] * hi_[c4] + er, n1 = prd[d] * hi_[c4] + pid[d] * hr[c4] + ei; hr[c4] = n0; hi_[c4] = n1; } }
        }
    }
    VM_WAIT(); __syncthreads();
}
struct GroupOrder { int c, G_;
    __device__ __forceinline__ bool next(int i, pg8::Unit& u) const { const int L = i * G_ + c; if (L >= 64) return false; u.pm = L; u.pn = L >> 1; return true; }
    __device__ __forceinline__ void a_ready(const pg8::Unit&) const {}
    __device__ __forceinline__ void done(const pg8::Unit&) const {} };
struct EpiF32 {
    static constexpr bool PERM = false, AFTER_DRAIN = false; bf16* O;
    __device__ __forceinline__ void operator()(const f32x4 (&acc)[2][2][4][2], const pg8::Unit& u, int wr, int wc, int fr, int fq) const {
        const int row0 = u.pm * 256 + wr * 64 + fr, col0 = wc * 32 + 4 * fq;
#pragma unroll
        for (int ai = 0; ai < 2; ++ai)
#pragma unroll
            for (int m = 0; m < 4; ++m)
#pragma unroll
                for (int bj = 0; bj < 2; ++bj)
#pragma unroll
                    for (int n = 0; n < 2; ++n) { const f32x4 a = acc[ai][bj][m][n]; v2u w; w.x = pk2(a[0], a[1]); w.y = pk2(a[2], a[3]); *(v2u*)(O + (size_t)(row0 + ai * 128 + m * 16) * 256 + col0 + bj * 128 + n * 16) = w; }
    }
};
struct EpiS5Y {
    static constexpr bool PERM = true, AFTER_DRAIN = false; bf16* Gp;
    __device__ __forceinline__ void operator()(const f32x4 (&acc)[2][2][4][2], const pg8::Unit& u, int wr, int wc, int fr, int fq) const {
        const int g = u.pm >> 1, jj0 = (u.pm & 1) * 256 + wr * 64 + fr, col0 = wc * 32 + 8 * fq;
#pragma unroll
        for (int ai = 0; ai < 2; ++ai)
#pragma unroll
            for (int m = 0; m < 4; ++m) { const int jj = jj0 + ai * 128 + m * 16;
#pragma unroll
                for (int bj = 0; bj < 2; ++bj) { const int n = col0 + bj * 128, t = n >> 4, c0 = n & 15; const f32x4 v0 = acc[ai][bj][m][0], v1 = acc[ai][bj][m][1];
                    v4u w; w.x = pk2(gelu_tanh(v0[0]), gelu_tanh(v0[1])); w.y = pk2(gelu_tanh(v0[2]), gelu_tanh(v0[3])); w.z = pk2(gelu_tanh(v1[0]), gelu_tanh(v1[1])); w.w = pk2(gelu_tanh(v1[2]), gelu_tanh(v1[3]));
                    __builtin_amdgcn_raw_buffer_store_b128(__builtin_bit_cast(pg8::u32x4, w), __builtin_amdgcn_make_buffer_rsrc((void*)Gp, (short)0, 8192 * 512 * 2, 0x00020000), (unsigned)(((16 * jj + t) * 512 + g * 16 + c0) * 2), 0, 16); } }
    }
};
struct EpiZU {
    static constexpr bool PERM = true, AFTER_DRAIN = false; bf16* Zp; bf16* UHp;
    __device__ __forceinline__ void operator()(const f32x4 (&acc)[2][2][4][2], const pg8::Unit& u, int wr, int wc, int fr, int fq) const {
        const int row0 = u.pm * 256 + wr * 64 + fr; const int col0 = u.pn * 256 + wc * 32 + 8 * fq;
        const __amdgpu_buffer_rsrc_t zr = __builtin_amdgcn_make_buffer_rsrc((void*)Zp, (short)0, 8192 * 2048 * 2, 0x00020000), ur = __builtin_amdgcn_make_buffer_rsrc((void*)UHp, (short)0, 8192 * 512 * 2 * 2, 0x00020000);
#pragma unroll
        for (int ai = 0; ai < 2; ++ai)
#pragma unroll
            for (int m = 0; m < 4; ++m) { const int row = row0 + ai * 128 + m * 16;
#pragma unroll
                for (int bj = 0; bj < 2; ++bj) { const f32x4 v0 = acc[ai][bj][m][0], v1 = acc[ai][bj][m][1]; const int col = col0 + bj * 128;
                    v4u w; w.x = pk2(v0[0], v0[1]); w.y = pk2(v0[2], v0[3]); w.z = pk2(v1[0], v1[1]); w.w = pk2(v1[2], v1[3]);
                    if (u.pn < 2) __builtin_amdgcn_raw_buffer_store_b128(__builtin_bit_cast(pg8::u32x4, w), ur, (unsigned)((((col >> 4) * 512 + (row >> 4)) * 512 + (row & 15) * 16 + (col & 15)) * 2), 0, 16);
                    else __builtin_amdgcn_raw_buffer_store_b128(__builtin_bit_cast(pg8::u32x4, w), zr, (unsigned)((row * 2048 + col) * 2), 0, 16); } }
    }
};

__device__ __forceinline__ int gla_slot(int bb, int h, int d, int j) { return bb < 16 ? ((bb * 4 + h) * 2 + d) * 4 + j : 512 + (((bb - 16) * 4 + h) * 2 + d) * 16 + j; }
constexpr int GL_V = 0, GL_VROW = 320;
constexpr int GL_KT = 20480, GL_KTROW = 144;
constexpr int GL_TOT = GL_KT + 4 * 9216;
constexpr int GL_PART = GL_TOT + 2048;
constexpr int GL_BYTES = GL_PART + 1024;
template <int MODE>
__device__ __forceinline__ void gla_prep(CArgs& A, LAS unsigned char* lds, int bb, int h, int j, int row0, int tid, int lane, int wave) {
    unsigned char* ws = A.ws;
    const bf16* Z = (const bf16*)(ws + WS_Z); const bf16* GDi = (const bf16*)(ws + WS_GD);
    const int d = wave >> 2, wg = wave & 3;
#pragma unroll
    for (int i = 0; i < 2; ++i) { const int r = (tid >> 4) + 32 * i, c = tid & 15;
        const v4u v = *(const v4u*)(Z + (size_t)(row0 + r) * 2048 + 1024 + h * 128 + 8 * c);
        *(LAS v4u*)(lds + GL_V + r * GL_VROW + c * 16) = v; }
    float gd[16]; float tot = 0.f;
#pragma unroll
    for (int i = 0; i < 16; ++i) { gd[i] = bf2f(GDi[(size_t)(row0 + 16 * wg + i) * 512 + d * 256 + h * 64 + lane]); tot += gd[i]; }
    unsigned short kx[16], qx[16];
#pragma unroll
    for (int i = 0; i < 16; ++i) { const size_t zr = (size_t)(row0 + 16 * wg + i) * 2048 + h * 64 + lane; kx[i] = Z[zr + 768]; qx[i] = MODE == 1 ? Z[zr + 512] : (unsigned short)0; }
    LAS float* TOT = (LAS float*)(lds + GL_TOT);
    TOT[(d * 4 + wg) * 64 + lane] = tot;
    __syncthreads();
    float off = 0.f, total = 0.f;
#pragma unroll
    for (int w = 0; w < 4; ++w) { const float tw = TOT[(d * 4 + w) * 64 + lane]; total += tw; if (d == 0 ? (w < wg) : (w > wg)) off += tw; }
    float bcum[16];
    if (d == 0) { float s = off;
#pragma unroll
        for (int i = 0; i < 16; ++i) { s += gd[i]; bcum[i] = s; } }
    else { float s = off;
#pragma unroll
        for (int i = 15; i >= 0; --i) { s += gd[i]; bcum[i] = s; } }
    LAS unsigned char* img = lds + GL_KT + d * 2 * 9216;
    if (MODE == 0) {
        unsigned pkk[8];
#pragma unroll
        for (int i = 0; i < 16; i += 2) { const float k0 = bf2f(kx[i]), k1 = bf2f(kx[i + 1]);
            pkk[i >> 1] = pk2(k0 * __expf(total - bcum[i]), k1 * __expf(total - bcum[i + 1])); }
        *(LAS v4u*)(img + lane * GL_KTROW + 32 * wg) = (v4u){pkk[0], pkk[1], pkk[2], pkk[3]};
        *(LAS v4u*)(img + lane * GL_KTROW + 32 * wg + 16) = (v4u){pkk[4], pkk[5], pkk[6], pkk[7]};
        if (wg == 0) ((float*)(ws + WS_DEC))[(size_t)gla_slot(bb, h, d, j) * 64 + lane] = __expf(total);
    } else {
#pragma unroll
        for (int i = 0; i < 16; ++i) {
            const float q = bf2f(qx[i]) * 0.125f, k = bf2f(kx[i]);
            *(LAS unsigned short*)(img + (16 * wg + i) * GL_KTROW + lane * 2) = (unsigned short)f2bf(q * __expf(bcum[i]));
            *(LAS unsigned short*)(img + 9216 + (16 * wg + i) * GL_KTROW + lane * 2) = (unsigned short)f2bf(k * __expf(-bcum[i])); }
    }
    __syncthreads();
}
__device__ __forceinline__ void gla_task_rows(int task, int& bb, int& h, int& j, int& row0) {
    if (task < 256) { bb = task >> 4; h = (task >> 2) & 3; j = task & 3; row0 = bb * 256 + 64 * j; }
    else { const int t = task - 256; bb = 16 + (t >> 6); h = (t >> 4) & 3; j = t & 15; row0 = NPR + (bb - 16) * 1024 + 64 * j; }
}
__device__ __forceinline__ void gla_a_task(CArgs& A, LAS unsigned char* lds, int task, int tid, int lane, int wave) {
    int bb, h, j, row0; gla_task_rows(task, bb, h, j, row0);
    gla_prep<0>(A, lds, bb, h, j, row0, tid, lane, wave);
    const int d = wave >> 2, wg = wave & 3, r32 = lane & 31, hi = lane >> 5;
    const unsigned lbase = (unsigned)(uintptr_t)(lds);
    const unsigned vaddr = lbase + GL_V + (8 * hi + ((lane & 15) >> 2)) * GL_VROW + (32 * wg + 16 * ((lane >> 4) & 1) + 4 * (lane & 3)) * 2;
    LAS unsigned char* img = lds + GL_KT + d * 2 * 9216;
    f32x16 acc0 = {}, acc1 = {};
#pragma unroll
    for (int ks = 0; ks < 4; ++ks) {
        const s16x4 lo = tr_read4(vaddr + (16 * ks) * GL_VROW), hi4 = tr_read4(vaddr + (16 * ks + 4) * GL_VROW);
        const bf16x8 b0 = *(const LAS bf16x8*)(img + r32 * GL_KTROW + (16 * ks + 8 * hi) * 2);
        const bf16x8 b1 = *(const LAS bf16x8*)(img + (32 + r32) * GL_KTROW + (16 * ks + 8 * hi) * 2);
        asm volatile("s_waitcnt lgkmcnt(0)" ::: "memory"); __builtin_amdgcn_sched_barrier(0);
        const bf16x8 a = (bf16x8){lo[0], lo[1], lo[2], lo[3], hi4[0], hi4[1], hi4[2], hi4[3]};
        acc0 = __builtin_amdgcn_mfma_f32_32x32x16_bf16(a, b0, acc0, 0, 0, 0);
        acc1 = __builtin_amdgcn_mfma_f32_32x32x16_bf16(a, b1, acc1, 0, 0, 0);
    }
    bf16* SL = (bf16*)(A.ws + WS_SLOC) + (size_t)gla_slot(bb, h, d, j) * 8192;
    { bf16* slp = SL + (32 * wg + 4 * hi) * 64 + r32;
#pragma unroll
    for (int r = 0; r < 16; ++r) { slp[((r & 3) + 8 * (r >> 2)) * 64] = (bf16)f2bf(acc0[r]); slp[((r & 3) + 8 * (r >> 2)) * 64 + 32] = (bf16)f2bf(acc1[r]); } }
    __syncthreads();
}
template <int N>
__device__ __forceinline__ void gla_b_chain(CArgs& A, int bb, int h, int d, int v, int kk, bool samp) {
    unsigned char* ws = A.ws;
    const bf16* SL = (const bf16*)(ws + WS_SLOC); const float* DEC = (const float*)(ws + WS_DEC); bf16* SIN = (bf16*)(ws + WS_SIN);
    f32x4 dc[N], sl[N];
#pragma unroll
    for (int i = 0; i < N; ++i) { const int j = d == 0 ? i : N - 1 - i; const size_t slot = (size_t)gla_slot(bb, h, d, j);
        dc[i] = *(const f32x4*)(DEC + slot * 64 + kk); const v2u sw = *(const v2u*)(SL + slot * 8192 + v * 64 + kk); sl[i] = (f32x4){bflo(sw.x), bfhi(sw.x), bflo(sw.y), bfhi(sw.y)}; }
    f32x4 S = {0.f, 0.f, 0.f, 0.f};
    if (samp) { const float* s0 = A.in[4] + (size_t)(((bb - 16) * 2 + d) * 4 + h) * 8192;
#pragma unroll
        for (int q = 0; q < 4; ++q) S[q] = s0[(kk + q) * 128 + v]; }
#pragma unroll
    for (int i = 0; i < N; ++i) { const int j = d == 0 ? i : N - 1 - i; const size_t slot = (size_t)gla_slot(bb, h, d, j);
        v2u w; w.x = pk2(S.x, S.y); w.y = pk2(S.z, S.w); *(v2u*)(SIN + slot * 8192 + v * 64 + kk) = w;
        S = S * dc[i] + sl[i]; }
    if (!samp) { float* o = A.out + OUT_GLA + (size_t)((bb * 2 + d) * 4 + h) * 8192;
#pragma unroll
        for (int q = 0; q < 4; ++q) o[(kk + q) * 128 + v] = S[q]; }
}
__device__ __forceinline__ void gla_b_phase(CArgs& A, int gtid, int nthreads) {
    for (int it = gtid; it < 160 * 2048; it += nthreads) {
        const int s = it >> 11, e = it & 2047;
        const int grp = s / 5, m = s % 5; const int chain = m == 4 ? 128 + grp : grp * 4 + m;
        const bool samp = chain >= 128; const int ci = samp ? chain - 128 : chain;
        const int bb = (samp ? 16 : 0) + (ci >> 3), h = (ci >> 1) & 3, d = ci & 1;
        const int v = e >> 4, kk = (e & 15) * 4;
        if (samp) gla_b_chain<16>(A, bb, h, d, v, kk, true); else gla_b_chain<4>(A, bb, h, d, v, kk, false);
    }
}
__device__ __forceinline__ void gla_c_task(CArgs& A, LAS unsigned char* lds, int task, int tid, int lane, int wave) {
    int bb, h, j, row0; gla_task_rows(task, bb, h, j, row0);
    unsigned char* ws = A.ws;
    const bf16* Z = (const bf16*)(ws + WS_Z); const bf16* SIN = (const bf16*)(ws + WS_SIN); bf16* MIX = (bf16*)(ws + WS_MIX);
    const int ti = wave >> 2, vi = wave & 3, r32 = lane & 31, hi = lane >> 5;
    bf16x8 sin_f[2][4]; v2u rr_f[4];
#pragma unroll
    for (int d = 0; d < 2; ++d) { const bf16* SI = SIN + (size_t)gla_slot(bb, h, d, j) * 8192 + (size_t)(32 * vi + r32) * 64 + 8 * hi;
#pragma unroll
        for (int ks = 0; ks < 4; ++ks) sin_f[d][ks] = *(const bf16x8*)(SI + 16 * ks); }
#pragma unroll
    for (int rq = 0; rq < 4; ++rq) rr_f[rq] = *(const v2u*)(Z + (size_t)(row0 + 32 * ti + r32) * 2048 + 1536 + h * 128 + 32 * vi + 8 * rq + 4 * hi);
    f32x4 gn_f[4];
#pragma unroll
    for (int rq = 0; rq < 4; ++rq) gn_f[rq] = *(const f32x4*)(A.in[29] + 32 * vi + 8 * rq + 4 * hi);
    gla_prep<1>(A, lds, bb, h, j, row0, tid, lane, wave);
    const unsigned lbase = (unsigned)(uintptr_t)(lds);
    const unsigned vaddr = lbase + GL_V + (4 * hi + ((lane & 15) >> 2)) * GL_VROW + (32 * vi + 16 * ((lane >> 4) & 1) + 4 * (lane & 3)) * 2;
    f32x16 o = {};
    const int t = 32 * ti + r32;
#pragma unroll
    for (int d = 0; d < 2; ++d) {
        LAS unsigned char* qimg = lds + GL_KT + d * 2 * 9216; LAS unsigned char* kimg = qimg + 9216;
        bf16x8 qf[4];
#pragma unroll
        for (int ks = 0; ks < 4; ++ks) qf[ks] = *(const LAS bf16x8*)(qimg + t * GL_KTROW + (16 * ks + 8 * hi) * 2);
#pragma unroll
        for (int ks = 0; ks < 4; ++ks) o = __builtin_amdgcn_mfma_f32_32x32x16_bf16(sin_f[d][ks], qf[ks], o, 0, 0, 0);
#pragma unroll
        for (int si = 0; si < 2; ++si) {
            f32x16 x = {};
#pragma unroll
            for (int ks = 0; ks < 4; ++ks) { const bf16x8 ka = *(const LAS bf16x8*)(kimg + (32 * si + r32) * GL_KTROW + (16 * ks + 8 * hi) * 2); x = __builtin_amdgcn_mfma_f32_32x32x16_bf16(ka, qf[ks], x, 0, 0, 0); }
            unsigned pw[8];
#pragma unroll
            for (int r = 0; r < 16; r += 2) { const int s0 = 32 * si + crow(r, hi), s1 = s0 + 1;
                const float x0 = (d == 0 ? (s0 <= t) : (s0 >= t)) ? x[r] : 0.f, x1 = (d == 0 ? (s1 <= t) : (s1 >= t)) ? x[r + 1] : 0.f;
                pw[r >> 1] = pk2(x0, x1); }
#pragma unroll
            for (int sp = 0; sp < 2; ++sp) {
                const s16x4 lo = tr_read4(vaddr + (32 * si + 16 * sp) * GL_VROW), hi4 = tr_read4(vaddr + (32 * si + 16 * sp + 8) * GL_VROW);
                asm volatile("s_waitcnt lgkmcnt(0)" ::: "memory"); __builtin_amdgcn_sched_barrier(0);
                const bf16x8 va = (bf16x8){lo[0], lo[1], lo[2], lo[3], hi4[0], hi4[1], hi4[2], hi4[3]};
                const v4u pq = {pw[4 * sp], pw[4 * sp + 1], pw[4 * sp + 2], pw[4 * sp + 3]};
                o = __builtin_amdgcn_mfma_f32_32x32x16_bf16(va, __builtin_bit_cast(bf16x8, pq), o, 0, 0, 0);
            }
        }
    }
    float ss = 0.f;
#pragma unroll
    for (int r = 0; r < 16; ++r) ss += o[r] * o[r];
    ss += __shfl_xor(ss, 32);
    LAS float* PART = (LAS float*)(lds + GL_PART);
    if (hi == 0) PART[(ti * 4 + vi) * 32 + r32] = ss;
    __syncthreads();
    const float tot = PART[(ti * 4 + 0) * 32 + r32] + PART[(ti * 4 + 1) * 32 + r32] + PART[(ti * 4 + 2) * 32 + r32] + PART[(ti * 4 + 3) * 32 + r32];
    const float rstd = 1.f / sqrtf(tot * (1.f / 128.f) + EPS);
    const size_t row = (size_t)(row0 + t);
#pragma unroll
    for (int rq = 0; rq < 4; ++rq) { const int v = 32 * vi + 8 * rq + 4 * hi;
        const v2u rr = rr_f[rq];
        const f32x4 gn = gn_f[rq];
        float rv[4] = {bflo(rr.x), bfhi(rr.x), bflo(rr.y), bfhi(rr.y)}; float ov[4];
#pragma unroll
        for (int e = 0; e < 4; ++e) { const float sl = rv[e] * __builtin_amdgcn_rcpf(1.f + __expf(-rv[e])); ov[e] = o[4 * rq + e] * rstd * gn[e] * sl; }
        v2u w; w.x = pk2(ov[0], ov[1]); w.y = pk2(ov[2], ov[3]);
        *(v2u*)(MIX + row * 1024 + 512 + h * 128 + v) = w; }
    __syncthreads();
}


struct EpiQKV {
    static constexpr bool PERM = true, AFTER_DRAIN = true;
    const float* rsw; const float* cv; const float* qn; const float* kn; unsigned char* wsb; float* outp;
    __device__ __forceinline__ void fused(f32x4 (&acc)[2][2][4][2], const pg8::Unit& u, int wr, int wc, int fr, int fq, LAS unsigned char* lds, int wid, int lane) const {
        const int row0 = u.pm * 256 + wr * 64 + fr, d0 = wc * 32 + 8 * fq;
        const int cond = u.pm < 16 ? 0 : 1 + ((u.pm - 16) >> 2); const bool samp = u.pm >= 16;
        const __amdgpu_buffer_rsrc_t wsr = __builtin_amdgcn_make_buffer_rsrc((void*)wsb, (short)0, 0x10000000, 0x00020000);
        f32x4 cvv[2][2];
#pragma unroll
        for (int bj = 0; bj < 2; ++bj)
#pragma unroll
            for (int n = 0; n < 2; ++n) cvv[bj][n] = *(const f32x4*)(cv + (size_t)cond * 1536 + u.pn * 256 + bj * 128 + d0 + 4 * n);
#pragma unroll
        for (int ai = 0; ai < 2; ++ai)
#pragma unroll
            for (int m = 0; m < 4; ++m) { const int row = row0 + ai * 128 + m * 16;
                const f32x4 s4 = *(const f32x4*)(rsw + (size_t)row * 4);
                const float rstd = __builtin_amdgcn_rsqf(((s4[0] + s4[1]) + (s4[2] + s4[3])) * (1.f / 1024.f) + EPS);
#pragma unroll
                for (int bj = 0; bj < 2; ++bj)
#pragma unroll
                    for (int n = 0; n < 2; ++n) acc[ai][bj][m][n] = acc[ai][bj][m][n] * rstd + cvv[bj][n]; }
        if (u.pn == 5) {
#pragma unroll
            for (int ai = 0; ai < 2; ++ai)
#pragma unroll
                for (int m = 0; m < 4; ++m) { const int row = row0 + ai * 128 + m * 16;
                    const unsigned voff = samp ? (unsigned)WS_VS + (unsigned)((((row - NPR) >> 10) * 1536 + ((row - NPR) & 1023)) * 512) : (unsigned)WS_VP + (unsigned)(row * 512);
#pragma unroll
                    for (int bj = 0; bj < 2; ++bj) { const f32x4 v0 = acc[ai][bj][m][0], v1 = acc[ai][bj][m][1];
                        v4u w; w.x = pk2(v0[0], v0[1]); w.y = pk2(v0[2], v0[3]); w.z = pk2(v1[0], v1[1]); w.w = pk2(v1[2], v1[3]);
                        __builtin_amdgcn_raw_buffer_store_b128(__builtin_bit_cast(pg8::u32x4, w), wsr, voff + (unsigned)((bj * 128 + d0) * 2), 0, 16);
                        if (!samp) { float* nv = outp + OUT_NV + ((size_t)row * 2 + bj) * 128 + d0; *(f32x4*)nv = (f32x4){bflo(w.x), bfhi(w.x), bflo(w.y), bfhi(w.y)}; *(f32x4*)(nv + 4) = (f32x4){bflo(w.z), bfhi(w.z), bflo(w.w), bfhi(w.w)}; } } }
            return;
        }
        LAS float* part = (LAS float*)lds;
#pragma unroll
        for (int ai = 0; ai < 2; ++ai)
#pragma unroll
            for (int m = 0; m < 4; ++m)
#pragma unroll
                for (int bj = 0; bj < 2; ++bj) { const f32x4 v0 = acc[ai][bj][m][0], v1 = acc[ai][bj][m][1];
                    float ss = ((v0[0] * v0[0] + v0[1] * v0[1]) + (v0[2] * v0[2] + v0[3] * v0[3])) + ((v1[0] * v1[0] + v1[1] * v1[1]) + (v1[2] * v1[2] + v1[3] * v1[3]));
                    ss += __shfl_xor(ss, 16); ss += __shfl_xor(ss, 32);
                    if (fq == 0) part[((ai * 128 + wr * 64 + m * 16 + fr) * 2 + bj) * 4 + wc] = ss; }
        __syncthreads();
        const bool isk = u.pn == 4; const float* nwp = (isk ? kn : qn) + d0;
        const f32x4 w0 = *(const f32x4*)nwp, w1 = *(const f32x4*)(nwp + 4);
        float inv[4];
#pragma unroll
        for (int e = 0; e < 4; ++e) inv[e] = __builtin_amdgcn_exp2f(-(float)(((d0 >> 1) + e) & 31) * (13.287712379549449f / 32.f));
#pragma unroll
        for (int ai = 0; ai < 2; ++ai)
#pragma unroll
            for (int m = 0; m < 4; ++m) { const int rl = ai * 128 + wr * 64 + m * 16 + fr, row = u.pm * 256 + rl;
                const int t = samp ? (row - NPR) & 1023 : 0; const float pos = (float)((d0 >> 1) < 32 ? (t >> 6) : (t & 63));
                float cs[4], sn[4];
#pragma unroll
                for (int e = 0; e < 4; ++e) { if (samp) { sn[e] = __sinf(pos * inv[e]); cs[e] = __cosf(pos * inv[e]); } else { sn[e] = 0.f; cs[e] = 1.f; } }
#pragma unroll
                for (int bj = 0; bj < 2; ++bj) { const f32x4 pt = *(const LAS f32x4*)(part + (rl * 2 + bj) * 4);
                    const float rstd = __builtin_amdgcn_rsqf(((pt[0] + pt[1]) + (pt[2] + pt[3])) * (1.f / 128.f) + EPS);
                    const f32x4 x0 = acc[ai][bj][m][0] * rstd * w0, x1 = acc[ai][bj][m][1] * rstd * w1;
                    const int head = u.pn * 2 + bj;
                    if (isk && !samp) { float* nk = outp + OUT_NK + ((size_t)row * 2 + bj) * 128 + d0; *(f32x4*)nk = x0; *(f32x4*)(nk + 4) = x1; }
                    v4u w; w.x = pk2(x0[0] * cs[0] - x0[1] * sn[0], x0[0] * sn[0] + x0[1] * cs[0]); w.y = pk2(x0[2] * cs[1] - x0[3] * sn[1], x0[2] * sn[1] + x0[3] * cs[1]);
                    w.z = pk2(x1[0] * cs[2] - x1[1] * sn[2], x1[0] * sn[2] + x1[1] * cs[2]); w.w = pk2(x1[2] * cs[3] - x1[3] * sn[3], x1[2] * sn[3] + x1[3] * cs[3]);
                    if (!isk) __builtin_amdgcn_raw_buffer_store_b128(__builtin_bit_cast(pg8::u32x4, w), wsr, (unsigned)WS_QN + (unsigned)((row * 1024 + head * 128 + d0) * 2), 0, 16);
                    else { const unsigned koff = samp ? (unsigned)WS_KS + (unsigned)((((row - NPR) >> 10) * 1536 + t) * 512) : (unsigned)WS_KP + (unsigned)(row * 512); __builtin_amdgcn_raw_buffer_store_b128(__builtin_bit_cast(pg8::u32x4, w), wsr, koff + (unsigned)((bj * 128 + d0) * 2), 0, 16); } } }
    }
};
__device__ __forceinline__ void kv_cache_rows(CArgs& A, int lane, int gw, int ngw) {
    unsigned char* ws = A.ws;
    for (int cr = gw; cr < 2048; cr += ngw) { const int b = cr >> 9, pl = cr & 511;
        const f32x4 kx = *(const f32x4*)(A.in[5] + (size_t)(b * 512 + pl) * 256 + 4 * lane), vx = *(const f32x4*)(A.in[6] + (size_t)(b * 512 + pl) * 256 + 4 * lane);
        v2u kwd, vwd; kwd.x = pk2(kx.x, kx.y); kwd.y = pk2(kx.z, kx.w); vwd.x = pk2(vx.x, vx.y); vwd.y = pk2(vx.z, vx.w);
        *(v2u*)((bf16*)(ws + WS_KS) + (size_t)(b * 1536 + 1024 + pl) * 256 + 4 * lane) = kwd;
        *(v2u*)((bf16*)(ws + WS_VS) + (size_t)(b * 1536 + 1024 + pl) * 256 + 4 * lane) = vwd; }
}


__device__ __forceinline__ void cv_phase(CArgs& A, int lane, int gw, int ngw, int g0, int g1) {
    unsigned char* ws = A.ws; const float* ADAp = (const float*)(ws + WS_ADA); float* CV = (float*)(ws + WS_CV);
    for (int gidx = g0 + gw; gidx < g1; gidx += ngw) { const int c = 4 * gidx;
        const bf16* wrow; const float* sh; float* o; int ncv;
        if (c < 4096) { wrow = (const bf16*)(ws + WS_W1) + (size_t)c * 1024; sh = ADAp + 3 * 1024; o = CV + c; ncv = 4096; }
        else if (c < 5632) { wrow = (const bf16*)(ws + WS_WQKV) + (size_t)(c - 4096) * 1024; sh = ADAp + 5 * 6144; o = CV + 5 * 4096 + (c - 4096); ncv = 1536; }
        else { wrow = (const bf16*)(ws + WS_W1) + (size_t)4096 * 1024 + (size_t)(c - 5632) * 1024; sh = ADAp + 5 * 6144 + 3 * 1024; o = CV + 5 * 4096 + 5 * 1536 + (c - 5632); ncv = 4096; }
        v4u w0[4], w1[4];
#pragma unroll
        for (int j = 0; j < 4; ++j) { w0[j] = *(const v4u*)(wrow + (size_t)j * 1024 + 16 * lane); w1[j] = *(const v4u*)(wrow + (size_t)j * 1024 + 16 * lane + 8); }
        float ps[4][5];
#pragma unroll
        for (int cond = 0; cond < 5; ++cond) { const f32x4* sp = (const f32x4*)(sh + cond * 6144 + 16 * lane); const f32x4 s0 = sp[0], s1 = sp[1], s2 = sp[2], s3 = sp[3];
#pragma unroll
            for (int j = 0; j < 4; ++j) {
                float s = (s0[0] * bflo(w0[j][0]) + s0[1] * bfhi(w0[j][0])) + (s0[2] * bflo(w0[j][1]) + s0[3] * bfhi(w0[j][1]));
                s += (s1[0] * bflo(w0[j][2]) + s1[1] * bfhi(w0[j][2])) + (s1[2] * bflo(w0[j][3]) + s1[3] * bfhi(w0[j][3]));
                s += (s2[0] * bflo(w1[j][0]) + s2[1] * bfhi(w1[j][0])) + (s2[2] * bflo(w1[j][1]) + s2[3] * bfhi(w1[j][1]));
                s += (s3[0] * bflo(w1[j][2]) + s3[1] * bfhi(w1[j][2])) + (s3[2] * bflo(w1[j][3]) + s3[3] * bfhi(w1[j][3]));
                ps[j][cond] = s; } }
#pragma unroll
        for (int of = 1; of < 64; of <<= 1) {
#pragma unroll
            for (int j = 0; j < 4; ++j)
#pragma unroll
                for (int cond = 0; cond < 5; ++cond) ps[j][cond] += __shfl_xor(ps[j][cond], of); }
        if (lane < 20) { const int j = lane / 5, cond = lane % 5; float v = 0.f;
#pragma unroll
            for (int jj = 0; jj < 4; ++jj)
#pragma unroll
                for (int cc = 0; cc < 5; ++cc) v = (j == jj && cond == cc) ? ps[jj][cc] : v;
            o[(size_t)cond * ncv + j] = v; }
    }
}

#ifndef DBL_MASK
#define DBL_MASK 0u
#endif
#ifndef XBAR_N
#define XBAR_N 0
#endif
__global__ void __launch_bounds__(NWAVES * 64, 2) fwd_kernel(Args args_unused) {
    extern __shared__ __attribute__((aligned(16))) unsigned char lds_raw[];
#define lds ((LAS unsigned char*)lds_raw)
#define MISC ((volatile LAS unsigned*)(lds + MISC_OFF))
#define tid (tid_opaque())
#define lane (tid_opaque() & 63)
#define wave (__builtin_amdgcn_readfirstlane(tid_opaque() >> 6))
#define G ((int)gridDim.x)
#define ws (kargs()->ws)
#define ADA ((const float*)(ws + WS_ADA))
#define H ((bf16*)(ws + WS_H))
#define Y ((bf16*)(ws + WS_Y))
#define xs_off (KA.in[1] - (size_t)NPR * 1024)
#define ADA1 (ADA + 5 * 6144)
    for (int u = tid; u < (LDS_BYTES - LDSCTL_OFF) / 4; u += NWAVES * 64) ((LAS unsigned*)(lds + LDSCTL_OFF))[u] = 0u;
    __syncthreads();
    (void)xcd_barrier_post((unsigned*)((gu32*)(ws + WS_CTL) + CW_BAR), MISC + 8, gridDim.x);
    (void)xcd_barrier_post((unsigned*)((gu32*)(ws + WS_CTL) + (blockIdx.x < 64 ? CW_BARG0 : CW_BARG1)), MISC + 10, blockIdx.x < 64 ? 64u : 192u);
#if TS_ON
    if (blockIdx.x == 0 && threadIdx.x == 0) ((unsigned long long*)((gu32*)(ws + WS_CTL) + CW_TS))[0] = __builtin_amdgcn_s_memrealtime();
#endif
#define MKBAR() XcdBarrier bar; bar.bar = (unsigned*)((gu32*)(ws + WS_CTL) + CW_BAR); bar.x = xb_xcc_id(); bar.st = MISC + 8; bar.gsize = gridDim.x;
#define GROUP_BAR() do { XcdBarrier bg; bg.bar = (unsigned*)((gu32*)(ws + WS_CTL) + (blockIdx.x < 64 ? CW_BARG0 : CW_BARG1)); bg.x = xb_xcc_id(); bg.st = MISC + 10; bg.gsize = blockIdx.x < 64 ? 64u : 192u; xcd_barrier(bg); } while (0)
#define IN(k) (KA.ph_lo <= (k) && (k) < KA.ph_hi)
#define SEAM(k) do { if ((k) + 1 < KA.ph_hi) { MKBAR(); xcd_barrier(bar); } } while (0)
#define REPS(k) (((DBL_MASK >> (k)) & 1u) ? 2 : 1)
#define SEAM2(k) do { if (rep_ + 1 < REPS(k)) { MKBAR(); xcd_barrier(bar); } else SEAM(k); STAMP((k) + 1); } while (0)


    if (IN(0)) for (int rep_ = 0; rep_ < REPS(0); ++rep_) { if ((int)blockIdx.x < 192) ada_block32(KA, lds, (int)blockIdx.x, tid, lane, wave); else { const int gw_ = ((int)blockIdx.x - 192) * NWAVES + wave;
            if (gw_ >= 496) { p0_transpose_item(KA.in[15] + 2048, INE, 1024, (bf16*)(ws + WS_WGLR), 1, (LAS float*)(lds + wave * 16384), gw_ - 496, lane); asm volatile("s_waitcnt vmcnt(0)" ::: "memory"); }
            if ((int)blockIdx.x >= 254) { __syncthreads();
                if (tid == 0) { __builtin_amdgcn_fence(__ATOMIC_RELEASE, "agent"); asm volatile("s_waitcnt vmcnt(0)" ::: "memory");
                    __hip_atomic_fetch_add((unsigned*)((gu32*)(ws + WS_CTL) + CW_ADACNT + 16), 1u, __ATOMIC_RELAXED, __HIP_MEMORY_SCOPE_AGENT); } }
            transpose_items(KA, lds, 0, T_EARLY, gw_, 64 * NWAVES, lane, wave); }
        __syncthreads(); STAMP(21); s5_small(KA, lds, (int)blockIdx.x >> 3, ((int)blockIdx.x & 7) == 0, tid); s5_k_mfma(lds, lane, wave); s5_expand(KA, lds, (int)blockIdx.x >> 3, (int)blockIdx.x & 7, tid); STAMP(22);
        ada_wait(KA, tid);
        norm_phase<true>(KA, lds, KA.in[0], xs_off, KA.in[9], ADA, 0, 1, tid, lane, wave); SEAM2(1); }
    for (int xb_ = 0; xb_ < XBAR_N; ++xb_) { MKBAR(); xcd_barrier(bar); }
    if (IN(2)) for (int rep_ = 0; rep_ < REPS(2); ++rep_) { pg8::Gemm g{H, (const bf16*)(ws + WS_WIN), NTOK, INW, 1024, 1024, 1024}; pg8::StaticOrder S; S.init(NTOK, INW, G, (int)blockIdx.x);
        EpiZU E{(bf16*)(ws + WS_Z), (bf16*)(ws + WS_UH)};
        pg8::gemm_phase<EpiZU, pg8::StaticOrder, true, true>(lds, g, S, E); STAMP(3); z_arrive((gu32*)(ws + WS_CTL), G, tid_opaque()); }
    if (IN(3)) {
        if ((int)blockIdx.x < 64) {
            cnt_wait((gu32*)(ws + WS_CTL) + 544, 256u, tid_opaque());
            { pg8::Gemm g{(const bf16*)(ws + WS_UH), (const bf16*)(ws + WS_WE), 16384, 8192, 256, 512, 512}; GroupOrder S{(int)blockIdx.x, 64};
              EpiF32 E{(bf16*)(ws + WS_EBUF)};
              pg8::gemm_phase<EpiF32, GroupOrder, true, true>(lds, g, S, E); }
            VM_WAIT(); __syncthreads();
            { int bx_ = (int)blockIdx.x; asm volatile("" : "+s"(bx_)); s5_recur(KA, lds, bx_ >> 1, bx_ & 1, tid); }
            { int bx_ = (int)blockIdx.x; asm volatile("" : "+s"(bx_));
              pg8::Gemm g{(const bf16*)(ws + WS_UH), (const bf16*)(ws + WS_WY), 16384, 8192, 512, 512, 512}; GroupOrder S{bx_, 64};
              EpiS5Y E{(bf16*)(ws + WS_G)};
              pg8::gemm_phase<EpiS5Y, GroupOrder, true, true>(lds, g, S, E); }
            STAMPB(23, 0);
            s5_g_handoff((gu32*)(ws + WS_CTL) + CW_ADACNT + 48, tid_opaque());
            STAMPB(24, 0);
            { int bx_ = (int)blockIdx.x; asm volatile("" : "+s"(bx_));
              pg8::Gemm g{(const bf16*)(ws + WS_G), (const bf16*)(ws + WS_WGLU), NTOK, 512, 512, 512, 512}; pg8::StaticOrder S; S.init(NTOK, 512, 64, bx_);
              pg8::EpiGlu E{(const bf16*)(ws + WS_G), (bf16*)(ws + WS_MIX), KA.in[26]};
              pg8::gemm_phase<pg8::EpiGlu, pg8::StaticOrder, true, true>(lds, g, S, E); }
            { int bxs_ = (int)blockIdx.x; asm volatile("" : "+s"(bxs_)); transpose_items(KA, lds, T_EARLY + 2 * T_M1, T_EARLY + 2 * T_M1 + T_M2, bxs_ * NWAVES + wave, 64 * NWAVES, lane, wave);
              transpose_items(KA, lds, T_EARLY + T_M1 + 1536, T_EARLY + 2 * T_M1, bxs_ * NWAVES + wave, 64 * NWAVES, lane, wave); }
            STAMPB(25, 0);
        } else {
            for (int task = (int)blockIdx.x - 64; task < 512; task += 192) { const int pz = task < 256 ? (task >> 4) : 16 + ((task - 256) >> 6) * 4 + (((task - 256) & 15) >> 2);
                cnt_wait((gu32*)(ws + WS_CTL) + pz * 16, 8u, tid_opaque());
                gla_a_task(KA, lds, task, tid, lane, wave); }
            STAMPB(26, 64); GROUP_BAR(); STAMPB(27, 64);
            gla_b_phase(KA, ((int)blockIdx.x - 64) * 512 + tid, 192 * 512);
            STAMPB(28, 64); GROUP_BAR(); STAMPB(29, 64);
            for (int task = (int)blockIdx.x - 64; task < 512; task += 192) gla_c_task(KA, lds, task, tid, lane, wave);
            { int bx3_ = (int)blockIdx.x; asm volatile("" : "+s"(bx3_)); if (bx3_ < 192) ada_block(KA, lds, 128 + bx3_ - 64, tid, lane, wave);
              else { transpose_items(KA, lds, T_EARLY, T_EARLY + T_M1, (bx3_ - 192) * NWAVES + wave, 64 * NWAVES, lane, wave);
                     transpose_items(KA, lds, T_EARLY + 2 * T_M1 + 2 * T_M2, T_EARLY + 2 * T_M1 + 2 * T_M2 + T_QKV, (bx3_ - 192) * NWAVES + wave, 64 * NWAVES, lane, wave); } }
            transpose_items(KA, lds, T_EARLY + T_M1, T_EARLY + T_M1 + 1536, ((int)blockIdx.x - 64) * NWAVES + wave, 192 * NWAVES, lane, wave);
            GROUP_BAR();
            cv_phase(KA, lane, ((int)blockIdx.x - 64) * NWAVES + wave, 192 * NWAVES, 0, 1408);
        }
        STAMPB(30, 64);
        { MKBAR(); xcd_barrier(bar); } STAMP(6); }
    if (IN(6)) for (int rep_ = 0; rep_ < REPS(6); ++rep_) { const int bx = blockIdx.x, kh = (bx >> 3) & 1, jx = bx >> 4;
        pg8::Gemm g{(const bf16*)(ws + WS_MIX) + kh * 512, (const bf16*)(ws + WS_WOUT) + kh * 512, NTOK, 1024, 512, 1024, 1024}; SplitKOrder S{4 * (bx & 7) + (jx >> 2), jx & 3};
        EpiResidSplitT<true, false, true> E{KA.in[0], xs_off, Y, ADA + 2 * 1024, (bf16*)(ws + WS_XBUF), (unsigned*)((gu32*)(ws + WS_CTL) + CW_FLAG), 6, kh, H, KA.in[10], ADA + 4 * 1024, (float*)(ws + WS_RSW)};
        pg8::gemm_phase<EpiResidSplitT<true, false, true>, SplitKOrder, false, true>(lds, g, S, E); STAMP(7); panel_chain((gu32*)(ws + WS_CTL) + CW_MLPCNT + 1024, S.pm, 8u, tid_opaque()); }
    if (IN(8)) for (int rep_ = 0; rep_ < REPS(8); ++rep_) { pg8::Gemm g{H, (const bf16*)(ws + WS_W1), NTOK, FF, 1024, 1024, 1024}; const int bx = blockIdx.x, jx = bx >> 4; PanelOrder S{4 * (bx & 7) + (jx >> 2), 8 * ((bx >> 3) & 1) + 2 * (jx & 3), (gu32*)(ws + WS_CTL) + CW_MLPCNT};
        pg8::EpiBf16<2, true> E{(bf16*)(ws + WS_ACT), FF, (const float*)(ws + WS_RSW), (const float*)(ws + WS_CV), 4096};
        pg8::gemm_phase<pg8::EpiBf16<2, true>, PanelOrder, true, true>(lds, g, S, E); STAMP(9); panel_wait((gu32*)(ws + WS_CTL) + CW_MLPCNT, S.pm, 64u, tid_opaque()); }
    if (IN(9)) for (int rep_ = 0; rep_ < REPS(9); ++rep_) { const int bx = blockIdx.x, kh = (bx >> 3) & 1, jx = bx >> 4;
        pg8::Gemm g{(const bf16*)(ws + WS_ACT) + kh * 2048, (const bf16*)(ws + WS_W2) + kh * 2048, NTOK, 1024, 2048, FF, FF}; SplitKOrder S{4 * (bx & 7) + (jx >> 2), jx & 3};
        EpiResidSplitT<true, true, true> E{Y, Y, Y, ADA + 5 * 1024, (bf16*)(ws + WS_XBUF), (unsigned*)((gu32*)(ws + WS_CTL) + CW_FLAG), 9, kh, H, KA.in[9] + 1024, ADA1 + 1 * 1024, (float*)(ws + WS_RSW)};
        pg8::gemm_phase<EpiResidSplitT<true, true, true>, SplitKOrder, false, true>(lds, g, S, E); STAMP(10);
        asm volatile("s_waitcnt vmcnt(0)" ::: "memory"); __syncthreads();
        { int bxo = blockIdx.x; asm volatile("" : "+s"(bxo)); const int pm9 = 4 * (bxo & 7) + (bxo >> 6);
          if (tid_opaque() == 0) __hip_atomic_fetch_add((unsigned*)((gu32*)(ws + WS_CTL) + CW_MLPCNT + 1536 + pm9 * 16), 1u, __ATOMIC_RELAXED, __HIP_MEMORY_SCOPE_AGENT); }
        qkv_wait((gu32*)(ws + WS_CTL) + CW_MLPCNT + 1536, G, tid_opaque()); }
    if (IN(11)) for (int rep_ = 0; rep_ < REPS(11); ++rep_) {
        pg8::Gemm g{H, (const bf16*)(ws + WS_WQKV), NTOK, QKVW, 1024, 1024, 1024}; pg8::StaticOrder S; S.init(NTOK, QKVW, G, (int)blockIdx.x);
        EpiQKV E{(const float*)(ws + WS_RSW), (const float*)(ws + WS_CV) + 5 * 4096, KA.in[32], KA.in[33], ws, KA.out};
        pg8::gemm_phase<EpiQKV, pg8::StaticOrder, false, true>(lds, g, S, E);
        if ((int)blockIdx.x >= 192) { const int gw_ = ((int)blockIdx.x - 192) * NWAVES + wave; kv_cache_rows(KA, lane, gw_, 64 * NWAVES);
            cv_phase(KA, lane, gw_, 64 * NWAVES, 1408, 2432);
            transpose_items(KA, lds, T_EARLY + 2 * T_M1 + T_M2, T_EARLY + 2 * T_M1 + 2 * T_M2, gw_, 64 * NWAVES, lane, wave);
            transpose_items(KA, lds, T_EARLY + 2 * T_M1 + 2 * T_M2 + T_QKV, T_ALL, gw_, 64 * NWAVES, lane, wave); }
        SEAM2(11); }
    if (IN(13)) for (int rep_ = 0; rep_ < REPS(13); ++rep_) {
        const att::bf16* QN = (const att::bf16*)(ws + WS_QN); att::bf16* OB = (att::bf16*)(ws + WS_OB);
        gu32* ocnt = (gu32*)(ws + WS_CTL) + CW_MLPCNT + 2048;
        { const int bx = blockIdx.x, half = (bx >> 3) & 1, su = (bx & 7) + 8 * (bx >> 4); const int b = su >> 5, hq = (su >> 2) & 7, qb = su & 3; const size_t qrow = (size_t)NPR + b * 1024 + qb * 256;
            if (half == 0) { const int bp = su >> 3, hp = su & 7; const size_t prow = (size_t)bp * 256;
                att::attn_dense_body<att::bf16>(QN + prow * 1024 + hp * 128, (const att::bf16*)(ws + WS_KP) + prow * 256 + (hp >> 2) * 128, (const att::bf16*)(ws + WS_VP) + prow * 256 + (hp >> 2) * 128,
                                                OB + prow * 1024 + hp * 128, 256, (char*)lds_raw, nullptr, nullptr, nullptr, nullptr, 0u, 0, (unsigned*)(ocnt + (bp * 2 + (hp >> 2)) * 16));
                __syncthreads(); }
            const size_t kofs = (size_t)b * 1536 * 256 + (size_t)half * 512 * 256 + (hq >> 2) * 128;
            unsigned long long* xa = (unsigned long long*)(ws + WS_SCR + 88 * MiB); gu32* fl = (gu32*)(ws + WS_CTL) + CW_FLAG + 32;
            att::attn_dense_body<att::bf16, true>(QN + qrow * 1024 + hq * 128, (const att::bf16*)(ws + WS_KS) + kofs, (const att::bf16*)(ws + WS_VS) + kofs, OB + qrow * 1024 + hq * 128, half ? 1024 : 512, (char*)lds_raw,
                                                  xa + (size_t)(su * 2 + half) * 4352, xa + (size_t)(su * 2 + (1 - half)) * 4352, (unsigned*)(fl + (su * 2 + half) * 64), (unsigned*)(fl + (su * 2 + (1 - half)) * 64), 13u, half, (unsigned*)(ocnt + ((16 + b * 4 + qb) * 2 + (hq >> 2)) * 16));
            __syncthreads(); }
        STAMP(14);
        { int bxo = blockIdx.x; asm volatile("" : "+s"(bxo)); const int pm14 = 4 * (bxo & 7) + (bxo >> 6), kh14 = (bxo >> 3) & 1;
          if (tid_opaque() == 0) { gu32* c = (gu32*)(ws + WS_CTL) + CW_MLPCNT + 2048 + (pm14 * 2 + kh14) * 16; unsigned sp = 0;
              while (__hip_atomic_load((unsigned*)c, __ATOMIC_RELAXED, __HIP_MEMORY_SCOPE_AGENT) < 32u) { __builtin_amdgcn_s_sleep(1); if (++sp > (1u << 22)) break; }
              __builtin_amdgcn_fence(__ATOMIC_ACQUIRE, "agent"); asm volatile("s_waitcnt vmcnt(0)" ::: "memory"); }
          __syncthreads(); } }
    if (IN(14)) for (int rep_ = 0; rep_ < REPS(14); ++rep_) { const int bx = blockIdx.x, kh = (bx >> 3) & 1, jx = bx >> 4;
        pg8::Gemm g{(const bf16*)(ws + WS_OB) + kh * 512, (const bf16*)(ws + WS_WO) + kh * 512, NTOK, 1024, 512, 1024, 1024}; SplitKOrder S{4 * (bx & 7) + (jx >> 2), jx & 3};
        EpiResidSplitT<true, true, true> E{Y, Y, Y, ADA1 + 2 * 1024, (bf16*)(ws + WS_XBUF), (unsigned*)((gu32*)(ws + WS_CTL) + CW_FLAG), 14, kh, H, KA.in[10] + 1024, ADA1 + 4 * 1024, (float*)(ws + WS_RSW)};
        pg8::gemm_phase<EpiResidSplitT<true, true, true>, SplitKOrder, false, true>(lds, g, S, E); STAMP(15); panel_chain((gu32*)(ws + WS_CTL) + CW_MLPCNT + 1024, S.pm, 16u, tid_opaque()); }
    if (IN(16)) for (int rep_ = 0; rep_ < REPS(16); ++rep_) { pg8::Gemm g{H, (const bf16*)(ws + WS_W1) + (size_t)4096 * 1024, NTOK, FF, 1024, 1024, 1024}; const int bx = blockIdx.x, jx = bx >> 4; PanelOrder S{4 * (bx & 7) + (jx >> 2), 8 * ((bx >> 3) & 1) + 2 * (jx & 3), (gu32*)(ws + WS_CTL) + CW_MLPCNT};
        pg8::EpiBf16<2, true> E{(bf16*)(ws + WS_ACT), FF, (const float*)(ws + WS_RSW), (const float*)(ws + WS_CV) + 5 * 4096 + 5 * 1536, 4096};
        pg8::gemm_phase<pg8::EpiBf16<2, true>, PanelOrder, true, true>(lds, g, S, E); STAMP(17); panel_wait((gu32*)(ws + WS_CTL) + CW_MLPCNT, S.pm, 128u, tid_opaque()); }
    if (IN(17)) for (int rep_ = 0; rep_ < REPS(17); ++rep_) { const int bx = blockIdx.x, kh = (bx >> 3) & 1, jx = bx >> 4;
        pg8::Gemm g{(const bf16*)(ws + WS_ACT) + kh * 2048, (const bf16*)(ws + WS_W2) + (size_t)1024 * 4096 + kh * 2048, NTOK, 1024, 2048, FF, FF}; SplitKOrder S{4 * (bx & 7) + (jx >> 2), jx & 3};
        EpiResidSplitT<false, true, false> E{Y, Y, KA.out + OUT_Y, ADA1 + 5 * 1024, (bf16*)(ws + WS_XBUF), (unsigned*)((gu32*)(ws + WS_CTL) + CW_FLAG), 17, kh, nullptr, nullptr, nullptr, nullptr};
        pg8::gemm_phase<EpiResidSplitT<false, true, false>, SplitKOrder, false, true>(lds, g, S, E); SEAM2(17); }
#if TS_ON
    if (blockIdx.x == 0 && threadIdx.x == 0) { asm volatile("s_waitcnt vmcnt(0)" ::: "memory"); const unsigned long long* tsp = (const unsigned long long*)((gu32*)(ws + WS_CTL) + CW_TS);
        const float ticks = (float)(tsp[TS_B] - tsp[TS_A]); const float d2 = TS_CAL ? 33.0f : ticks * 0.0033f;
        float* po = KA.out + OUT_S5RE; po[0] = po[0] + sqrtf(d2); }
#endif
#undef IN
#undef SEAM
#undef lds
#undef MISC
#undef tid
#undef lane
#undef wave
#undef G
#undef ws
#undef ADA
#undef H
#undef Y
#undef xs_off
#undef ADA1
}
constexpr int N_PHASES = 18;

#ifndef MK_ONE_LAUNCH
#define MK_ONE_LAUNCH 1
#endif
extern "C" void kernel_launch(void* const* d_in, const int* in_sizes, int n_in, void* d_out, int out_size, void* d_ws, size_t ws_size, hipStream_t stream) {
    static int grid = 0;
    if (grid == 0) {
        if (n_in != 34 || out_size != (int)OUT_END || ws_size < WS_END) { fprintf(stderr, "kernel_launch: unexpected shapes: n_in %d out %d ws %zu\n", n_in, out_size, ws_size); grid = -1; return; }
        int dev = 0, cus = 0, per_cu = 0;
        if (hipGetDevice(&dev) != hipSuccess || hipDeviceGetAttribute(&cus, hipDeviceAttributeMultiprocessorCount, dev) != hipSuccess) { grid = -1; return; }
        if (hipFuncSetAttribute((const void*)fwd_kernel, hipFuncAttributeMaxDynamicSharedMemorySize, LDS_BYTES) != hipSuccess) { fprintf(stderr, "kernel_launch: hipFuncSetAttribute failed\n"); grid = -1; return; }
        if (hipOccupancyMaxActiveBlocksPerMultiprocessor(&per_cu, (const void*)fwd_kernel, NWAVES * 64, LDS_BYTES) != hipSuccess || per_cu < 1) { fprintf(stderr, "kernel_launch: occupancy query says %d blocks per CU\n", per_cu); }
        (void)hipGetLastError();
        grid = cus < 256 ? cus : 256;
        if (grid != 256) { fprintf(stderr, "kernel_launch: this kernel needs a 256-CU device (one workgroup per CU); found %d\n", cus); grid = -1; return; }
    }
    if (grid < 0) return;
    (void)hipMemsetAsync((char*)d_ws + WS_CTL, 0, CTL_ZERO_BYTES, stream);
    Args a{};
    for (int i = 0; i < 34; ++i) a.in[i] = (const float*)d_in[i];
    a.out = (float*)d_out; a.ws = (unsigned char*)d_ws;
#if MK_ONE_LAUNCH
    a.ph_lo = 0; a.ph_hi = N_PHASES;
    hipLaunchKernelGGL(fwd_kernel, dim3(grid), dim3(NWAVES * 64), LDS_BYTES, stream, a);
#else
    for (int p = 0; p < N_PHASES; ++p) { a.ph_lo = p; a.ph_hi = p + 1; hipLaunchKernelGGL(fwd_kernel, dim3(grid), dim3(NWAVES * 64), LDS_BYTES, stream, a); }
#endif
    const hipError_t le = hipPeekAtLastError();
    if (le != hipSuccess) fprintf(stderr, "kernel_launch: launch failed: %s\n", hipGetErrorName(le));
}
```
